# Optimizing an MI355X kernel written in HIP

```python
import math
import jax, jax.numpy as jnp
from jax import lax
import numpy as np

D_MODEL = 1024
BATCH = 8
SEQ = 8192
DEPTH = 1

N_ATTN_HEADS = 8
ATTN_HEAD_DIM = 64
N_KV_GROUPS = 2
Q_LORA_RANK = 256
N_IDX_HEADS = 8
IDX_HEAD_DIM = 64
TOPK_MAX = 256
Q_BLOCK = 128
N_BUCKETS = 32
MAX_DISTANCE = 128
N_REC_HEADS = 4
REC_HEAD_DIM = 128
CHUNK = 64
FFN_HIDDEN = -(-8 * D_MODEL // (3 * 256)) * 256

ATTN_WIDTH = N_ATTN_HEADS * ATTN_HEAD_DIM
KV_WIDTH = N_KV_GROUPS * ATTN_HEAD_DIM
IDX_Q_WIDTH = N_IDX_HEADS * IDX_HEAD_DIM
REC_WIDTH = N_REC_HEADS * REC_HEAD_DIM
IN_SPLITS = [Q_LORA_RANK, KV_WIDTH, KV_WIDTH, IDX_HEAD_DIM, N_IDX_HEADS,
             REC_WIDTH, REC_WIDTH, REC_WIDTH, REC_WIDTH, 2 * D_MODEL]
IN_WIDTH = sum(IN_SPLITS)
IN_POINTS = [int(p) for p in np.cumsum(IN_SPLITS)[:-1]]
EPS = 1e-6

kernel_name = "hybrid_dsa_hgrn2_gated_block"


def rmsnorm(x, w):
    xf = x.astype(jnp.float32)
    y = xf * lax.rsqrt(jnp.mean(xf * xf, axis=-1, keepdims=True) + EPS)
    return (y * w.astype(jnp.float32)).astype(x.dtype)


def t5_bucket(n):
    max_exact = N_BUCKETS // 2
    nf = jnp.maximum(n, 1).astype(jnp.float32)
    large = max_exact + (jnp.log(nf / max_exact) / math.log(MAX_DISTANCE / max_exact)
                         * (N_BUCKETS - max_exact)).astype(jnp.int32)
    large = jnp.minimum(large, N_BUCKETS - 1)
    return jnp.where(n < max_exact, n, large)


def dsa_attention(q, k, v, qi, ki, wi, rel_bias):
    B, S = q.shape[0], q.shape[1]
    k_sel = min(TOPK_MAX, S // 4)
    nblk = S // Q_BLOCK
    R = N_ATTN_HEADS // N_KV_GROUPS
    key_pos = jnp.arange(S, dtype=jnp.int32)
    idx_scale = IDX_HEAD_DIM ** -0.5
    attn_scale = ATTN_HEAD_DIM ** -0.5
    wi = wi * (N_IDX_HEADS ** -0.5)

    def to_blocks(a):
        return a.reshape(B, nblk, Q_BLOCK, *a.shape[2:]).swapaxes(0, 1)

    def block(args):
        qb, qib, wib, start = args
        pos_q = start + jnp.arange(Q_BLOCK, dtype=jnp.int32)
        logits = jnp.einsum('bqhd,bsd->bqhs', qib, ki) * idx_scale
        score = jnp.einsum('bqhs,bqh->bqs', jax.nn.relu(logits), wib).astype(jnp.float32)
        causal = key_pos[None, :] <= pos_q[:, None]
        score = jnp.where(causal[None], score, -jnp.inf)
        _, idx = lax.top_k(score, k_sel)
        ksel = jax.vmap(lambda kb, ib: kb[ib])(k, idx)
        vsel = jax.vmap(lambda vb, ib: vb[ib])(v, idx)
        dist = pos_q[None, :, None] - idx
        valid = dist >= 0
        bias = rel_bias[t5_bucket(jnp.maximum(dist, 0))].astype(jnp.float32)
        bias = bias.reshape(B, Q_BLOCK, k_sel, N_KV_GROUPS, R).transpose(0, 1, 3, 4, 2)
        qg = qb.reshape(B, Q_BLOCK, N_KV_GROUPS, R, ATTN_HEAD_DIM)
        s = jnp.einsum('bqgrd,bqkgd->bqgrk', qg, ksel).astype(jnp.float32) * attn_scale + bias
        s = jnp.where(valid[:, :, None, None, :], s, -jnp.inf)
        p = jax.nn.softmax(s, axis=-1).astype(vsel.dtype)
        o = jnp.einsum('bqgrk,bqkgd->bqgrd', p, vsel)
        return o.reshape(B, Q_BLOCK, ATTN_WIDTH)

    starts = jnp.arange(nblk, dtype=jnp.int32) * Q_BLOCK
    out = lax.map(block, (to_blocks(q), to_blocks(qi), to_blocks(wi), starts))
    return out.swapaxes(0, 1).reshape(B, S, ATTN_WIDTH)


def hgrn2(q_raw, f_raw, i_raw, lb):
    B, S = q_raw.shape[0], q_raw.shape[1]
    n = S // CHUNK
    H, dk = N_REC_HEADS, REC_HEAD_DIM
    f = lb + (1.0 - lb) * jax.nn.sigmoid(f_raw.astype(jnp.float32))
    g = jnp.log(f)
    kk = 1.0 - f
    qq = jax.nn.silu(q_raw.astype(jnp.float32))
    vv = i_raw.astype(jnp.float32)

    def to_chunks(a):
        return a.reshape(B, n, CHUNK, H, dk).transpose(1, 0, 3, 2, 4)

    mask = jnp.tril(jnp.ones((CHUNK, CHUNK), dtype=bool))

    def step(state, inp):
        qc, kc, vc, gc = inp
        A = jnp.cumsum(gc, axis=-2)
        o_inter = jnp.einsum('bhtc,bhcv->bhtv', qc * jnp.exp(A), state)
        diff = A[:, :, :, None, :] - A[:, :, None, :, :]
        decay = jnp.exp(jnp.where(mask[:, :, None], diff, -jnp.inf))
        P = jnp.einsum('bhtc,bhsc,bhtsc->bhts', qc, kc, decay)
        o = o_inter + jnp.einsum('bhts,bhsv->bhtv', P, vc)
        A_last = A[:, :, -1:, :]
        new_state = jnp.exp(A_last[:, :, 0, :])[..., None] * state + \
            jnp.einsum('bhsc,bhsv->bhcv', kc * jnp.exp(A_last - A), vc)
        return new_state, o

    s0 = jnp.zeros((B, H, dk, dk), jnp.float32)
    _, o = lax.scan(step, s0, (to_chunks(qq), to_chunks(kk), to_chunks(vv), to_chunks(g)))
    return o.transpose(1, 0, 3, 2, 4).reshape(B, S, H, dk)


def setup_inputs(seed: int = 0) -> dict:
    key = jax.random.key(seed)
    ks = jax.random.split(key, 20)
    f32 = jnp.float32

    def w(k, shape, fan_in):
        return jax.random.normal(k, shape, f32) * (fan_in ** -0.5)

    def gain(k, shape):
        return 1.0 + 0.02 * jax.random.normal(k, shape, f32)

    return {
        "x": jax.random.normal(ks[0], (BATCH, SEQ, D_MODEL), f32),
        "c": jax.random.normal(ks[1], (BATCH, D_MODEL), f32),
        "w_ada": w(ks[2], (DEPTH, D_MODEL, 6 * D_MODEL), D_MODEL),
        "b_ada": 0.02 * jax.random.normal(ks[3], (DEPTH, 6 * D_MODEL), f32),
        "norm1_w": gain(ks[4], (DEPTH, D_MODEL)),
        "w_in": w(ks[5], (DEPTH, D_MODEL, IN_WIDTH), D_MODEL),
        "q_norm_w": gain(ks[6], (DEPTH, Q_LORA_RANK)),
        "w_uq": w(ks[7], (DEPTH, Q_LORA_RANK, ATTN_WIDTH), Q_LORA_RANK),
        "w_uq_idx": w(ks[8], (DEPTH, Q_LORA_RANK, IDX_Q_WIDTH), Q_LORA_RANK),
        "rel_bias": 0.5 * jax.random.normal(ks[9], (N_BUCKETS, N_ATTN_HEADS), f32),
        "lb_logits": 0.5 * jax.random.normal(ks[10], (DEPTH + 1, REC_WIDTH), f32),
        "rec_norm_w": gain(ks[11], (DEPTH, REC_HEAD_DIM)),
        "w_branch_attn": w(ks[12], (DEPTH, ATTN_WIDTH, D_MODEL), ATTN_WIDTH),
        "w_branch_rec": w(ks[13], (DEPTH, REC_WIDTH, D_MODEL), REC_WIDTH),
        "w_out": w(ks[14], (DEPTH, D_MODEL, D_MODEL), D_MODEL),
        "norm2_w": gain(ks[15], (DEPTH, D_MODEL)),
        "w_ffn_gate": w(ks[16], (DEPTH, D_MODEL, FFN_HIDDEN), D_MODEL),
        "w_ffn_up": w(ks[17], (DEPTH, D_MODEL, FFN_HIDDEN), D_MODEL),
        "w_ffn_down": w(ks[18], (DEPTH, FFN_HIDDEN, D_MODEL), FFN_HIDDEN),
        "final_norm_w": gain(ks[19], (D_MODEL,)),
    }


def reference(x, c, w_ada, b_ada, norm1_w, w_in, q_norm_w, w_uq, w_uq_idx, rel_bias,
              lb_logits, rec_norm_w, w_branch_attn, w_branch_rec, w_out, norm2_w,
              w_ffn_gate, w_ffn_up, w_ffn_down, final_norm_w):
    B, S, _ = x.shape
    lower_bounds = jnp.cumsum(jax.nn.softmax(lb_logits.astype(jnp.float32), axis=0), axis=0)
    c_act = jax.nn.silu(c)
    for layer in range(DEPTH):
        mod = (c_act @ w_ada[layer] + b_ada[layer])[:, None, :]
        sh1, sc1, g1, sh2, sc2, g2 = jnp.split(mod, 6, axis=-1)
        h = rmsnorm(x, norm1_w[layer]) * (1.0 + sc1) + sh1
        proj = h @ w_in[layer]
        cq, k, v, ki, wi, rq, rf, ri, rg, gates = jnp.split(proj, IN_POINTS, axis=-1)
        cq = rmsnorm(cq, q_norm_w[layer])
        q = (cq @ w_uq[layer]).reshape(B, S, N_ATTN_HEADS, ATTN_HEAD_DIM)
        qi = (cq @ w_uq_idx[layer]).reshape(B, S, N_IDX_HEADS, IDX_HEAD_DIM)
        k = k.reshape(B, S, N_KV_GROUPS, ATTN_HEAD_DIM)
        v = v.reshape(B, S, N_KV_GROUPS, ATTN_HEAD_DIM)
        attn = dsa_attention(q, k, v, qi, ki, wi, rel_bias)
        y_attn = attn @ w_branch_attn[layer]
        rec = hgrn2(rq, rf, ri, lower_bounds[layer]).astype(x.dtype)
        rec = rmsnorm(rec, rec_norm_w[layer]).reshape(B, S, REC_WIDTH) * jax.nn.silu(rg)
        y_rec = rec @ w_branch_rec[layer]
        g_attn, g_rec = jnp.split(jax.nn.sigmoid(gates), 2, axis=-1)
        mixed = (g_attn * y_attn + g_rec * y_rec) @ w_out[layer]
        x = x + g1 * mixed
        h2 = rmsnorm(x, norm2_w[layer]) * (1.0 + sc2) + sh2
        ffn = (jax.nn.silu(h2 @ w_ffn_gate[layer]) * (h2 @ w_ffn_up[layer])) @ w_ffn_down[layer]
        x = x + g2 * ffn
    return rmsnorm(x, final_norm_w)
```

```cpp
#include <hip/hip_runtime.h>
#include <cstdio>
#include <cstdint>
namespace pg8 {
#define PG8_LAS __attribute__((address_space(3)))
typedef unsigned short bf16_t;
typedef short bf16x8 __attribute__((ext_vector_type(8)));
typedef float f32x4 __attribute__((ext_vector_type(4)));
typedef unsigned u32x4 __attribute__((ext_vector_type(4)));
constexpr int BM = 256, BK = 64, HALF = 128, HTB = HALF * BK * 2  , STAGE_BYTES = 8 * HTB, NXCD = 8, WGM = 8;

__host__ __device__ __forceinline__ int lds_byte(int r, int c) { const int st = (r >> 4) * 2 + (c >> 5), rr = r & 15, cc = c & 31, ob = rr * 64 + cc * 2; return st * 1024 + (ob ^ (((ob >> 9) & 1) << 5)); }
__host__ __device__ __forceinline__ void stage_rc(int b, int& R, int& C) { const int st = b / 1024, sb = b % 1024, swz = sb ^ (((sb >> 9) & 1) << 5); R = (st >> 1) * 16 + swz / 64; C = (st & 1) * 32 + (swz % 64) / 2; }
__host__ __device__ __forceinline__ int perm32(int rho) { const int n = rho >> 4, i = rho & 15; return 8 * (i >> 2) + 4 * n + (i & 3); }

struct Unit { int pm, pn; };
struct Gemm { const bf16_t* A; const bf16_t* Bt; int M, N, K; };

struct StaticOrder {
    int nM, nN, nwg, G, c;
    __host__ __device__ void init(int M, int N, int G_, int c_) { nM = M / BM; nN = N / BM; nwg = nM * nN; G = G_; c = c_; }
    __host__ __device__ bool next(int i, Unit& u) const {
        const long L = (long)i * G + c; if (L >= nwg) return false;
        int wgid = (int)L; { const int q = nwg / NXCD, r = nwg % NXCD, xcd = wgid % NXCD, off = wgid / NXCD; wgid = (xcd < r ? xcd * (q + 1) : r * (q + 1) + (xcd - r) * q) + off; }
        const int nig = WGM * nN, gid = wgid / nig, fm = gid * WGM, gsz = (nM - fm) < WGM ? (nM - fm) : WGM;
        u.pm = fm + ((wgid % nig) % gsz); u.pn = (wgid % nig) / gsz; return true;
    }
    __device__ __forceinline__ void a_ready(const Unit&) const {}
    __device__ __forceinline__ void done(const Unit&) const {}
};

__device__ __forceinline__ unsigned cvt_pk_bf16(float lo, float hi) { unsigned r; asm volatile("v_cvt_pk_bf16_f32 %0, %1, %2" : "=v"(r) : "v"(lo), "v"(hi)); return r; }
__device__ __forceinline__ float fsigmoid(float x) { return __builtin_amdgcn_rcpf(1.0f + __expf(-x)); }
__device__ __forceinline__ float fsilu(float x) { return x * fsigmoid(x); }
__device__ __forceinline__ u32x4 pack8(const f32x4 a, const f32x4 b) { u32x4 w; w.x = cvt_pk_bf16(a[0], a[1]); w.y = cvt_pk_bf16(a[2], a[3]); w.z = cvt_pk_bf16(b[0], b[1]); w.w = cvt_pk_bf16(b[2], b[3]); return w; }
__device__ __forceinline__ float bf_lo(unsigned u) { return __builtin_bit_cast(float, u << 16); }
__device__ __forceinline__ float bf_hi(unsigned u) { return __builtin_bit_cast(float, u & 0xffff0000u); }

struct EpiInProj {
    static constexpr bool PERM = true, AFTER_DRAIN = false;
    bf16_t *CQ, *KV, *KI, *RQ, *GATES; float *WI, *CQSS; const float* LB;
    __device__ __forceinline__ void operator()(const f32x4 (&acc)[2][2][4][2], const Unit& u, int wr, int wc, int fr, int fq) const {
        const int row0 = u.pm * BM + wr * 64 + fr, pn = u.pn, cl = wc * 32 + 8 * fq;
        if (pn == 0) {
#pragma unroll
            for (int ai = 0; ai < 2; ++ai)
#pragma unroll
                for (int m = 0; m < 4; ++m) { const int row = row0 + ai * HALF + m * 16; float s = 0.f;
#pragma unroll
                    for (int bj = 0; bj < 2; ++bj) { const f32x4 a = acc[ai][bj][m][0], b = acc[ai][bj][m][1];
                        s += (a[0] * a[0] + a[1] * a[1]) + (a[2] * a[2] + a[3] * a[3]) + (b[0] * b[0] + b[1] * b[1]) + (b[2] * b[2] + b[3] * b[3]);
                        *(u32x4*)(CQ + (size_t)row * 256 + cl + bj * HALF) = pack8(a, b); }
                    s += __shfl_xor(s, 16); s += __shfl_xor(s, 32);
                    if (fq == 0) CQSS[(size_t)row * 4 + wc] = s; }
        } else if (pn == 1) {
#pragma unroll
            for (int ai = 0; ai < 2; ++ai)
#pragma unroll
                for (int m = 0; m < 4; ++m) { const int row = row0 + ai * HALF + m * 16;
#pragma unroll
                    for (int bj = 0; bj < 2; ++bj) *(u32x4*)(KV + (size_t)row * 256 + cl + bj * HALF) = pack8(acc[ai][bj][m][0], acc[ai][bj][m][1]); }
        } else if (pn == 2) {
#pragma unroll
            for (int ai = 0; ai < 2; ++ai)
#pragma unroll
                for (int m = 0; m < 4; ++m) { const int row = row0 + ai * HALF + m * 16;
                    if (wc < 2) *(u32x4*)(KI + (size_t)row * 64 + cl) = pack8(acc[ai][0][m][0], acc[ai][0][m][1]);
                    else if (wc == 2 && fq == 0) { *(f32x4*)(WI + (size_t)row * 8) = acc[ai][0][m][0]; *(f32x4*)(WI + (size_t)row * 8 + 4) = acc[ai][0][m][1]; } }
        } else if (pn <= 10) {
            const int kind = (pn - 3) >> 1, cb = ((pn - 3) & 1) * 256 + cl;
            bf16_t* dst = RQ + (size_t)kind * (size_t)(32u << 20);
#pragma unroll
            for (int bj = 0; bj < 2; ++bj) {
                f32x4 l0 = (f32x4){0.f, 0.f, 0.f, 0.f}, l1 = l0;
                if (kind == 1) { l0 = *(const f32x4*)(LB + cb + bj * HALF); l1 = *(const f32x4*)(LB + cb + bj * HALF + 4); }
#pragma unroll
                for (int ai = 0; ai < 2; ++ai)
#pragma unroll
                    for (int m = 0; m < 4; ++m) { const int row = row0 + ai * HALF + m * 16; f32x4 a = acc[ai][bj][m][0], b = acc[ai][bj][m][1];
                        if (kind == 0 || kind == 3) {
#pragma unroll
                            for (int j = 0; j < 4; ++j) { a[j] = fsilu(a[j]); b[j] = fsilu(b[j]); } }
                        else if (kind == 1) {
#pragma unroll
                            for (int j = 0; j < 4; ++j) { a[j] = __logf(l0[j] + (1.0f - l0[j]) * fsigmoid(a[j])); b[j] = __logf(l1[j] + (1.0f - l1[j]) * fsigmoid(b[j])); } }
                        *(u32x4*)(dst + (size_t)row * 512 + cb + bj * HALF) = pack8(a, b); }
            }
        } else {
            const int cb = (pn - 11) * 256 + cl;
#pragma unroll
            for (int ai = 0; ai < 2; ++ai)
#pragma unroll
                for (int m = 0; m < 4; ++m) { const int row = row0 + ai * HALF + m * 16;
#pragma unroll
                    for (int bj = 0; bj < 2; ++bj) { f32x4 a = acc[ai][bj][m][0], b = acc[ai][bj][m][1];
#pragma unroll
                        for (int j = 0; j < 4; ++j) { a[j] = fsigmoid(a[j]); b[j] = fsigmoid(b[j]); }
                        *(u32x4*)(GATES + (size_t)row * 2048 + cb + bj * HALF) = pack8(a, b); } }
        }
    }
};

struct EpiQ {
    static constexpr bool PERM = true, AFTER_DRAIN = false;
    bf16_t *Q; const float* CQSS;
    __device__ __forceinline__ void operator()(const f32x4 (&acc)[2][2][4][2], const Unit& u, int wr, int wc, int fr, int fq) const {
        const int row0 = u.pm * BM + wr * 64 + fr, pn = u.pn, cl = (pn & 1) * 256 + wc * 32 + 8 * fq;
        bf16_t* dst = Q + (pn < 2 ? (size_t)0 : (size_t)(32u << 20));
        const float sc = pn < 2 ? 0.125f : 1.0f;
#pragma unroll
        for (int ai = 0; ai < 2; ++ai)
#pragma unroll
            for (int m = 0; m < 4; ++m) { const int row = row0 + ai * HALF + m * 16;
                const f32x4 ss = *(const f32x4*)(CQSS + (size_t)row * 4);
                const float r = __builtin_amdgcn_rsqf(((ss[0] + ss[1]) + (ss[2] + ss[3])) * (1.0f / 256.0f) + 1e-6f) * sc;
#pragma unroll
                for (int bj = 0; bj < 2; ++bj) *(u32x4*)(dst + (size_t)row * 512 + cl + bj * HALF) = pack8(acc[ai][bj][m][0] * r, acc[ai][bj][m][1] * r); }
    }
};

template <int MODE> struct EpiBranch {
    static constexpr bool PERM = true, AFTER_DRAIN = false;
    bf16_t* MIX; const bf16_t* GATES;
    __device__ __forceinline__ void operator()(const f32x4 (&acc)[2][2][4][2], const Unit& u, int wr, int wc, int fr, int fq) const {
        const int row0 = u.pm * BM + wr * 64 + fr, cl = u.pn * 256 + wc * 32 + 8 * fq;
#pragma unroll
        for (int ai = 0; ai < 2; ++ai)
#pragma unroll
            for (int m = 0; m < 4; ++m) { const int row = row0 + ai * HALF + m * 16;
#pragma unroll
                for (int bj = 0; bj < 2; ++bj) { const int c = cl + bj * HALF;
                    const u32x4 g = *(const u32x4*)(GATES + (size_t)row * 2048 + MODE * 1024 + c);
                    f32x4 a = acc[ai][bj][m][0], b = acc[ai][bj][m][1];
                    a[0] *= bf_lo(g.x); a[1] *= bf_hi(g.x); a[2] *= bf_lo(g.y); a[3] *= bf_hi(g.y); b[0] *= bf_lo(g.z); b[1] *= bf_hi(g.z); b[2] *= bf_lo(g.w); b[3] *= bf_hi(g.w);
                    if (MODE == 1) { const u32x4 p = *(const u32x4*)(MIX + (size_t)row * 1024 + c);
                        a[0] += bf_lo(p.x); a[1] += bf_hi(p.x); a[2] += bf_lo(p.y); a[3] += bf_hi(p.y); b[0] += bf_lo(p.z); b[1] += bf_hi(p.z); b[2] += bf_lo(p.w); b[3] += bf_hi(p.w); }
                    *(u32x4*)(MIX + (size_t)row * 1024 + c) = pack8(a, b); } }
    }
};

struct EpiOut {
    static constexpr bool PERM = true, AFTER_DRAIN = false;
    const float* X; float* X1; bf16_t* XS; float* X1SS; const float* MOD; const float* CW2;
    __device__ __forceinline__ void operator()(const f32x4 (&acc)[2][2][4][2], const Unit& u, int wr, int wc, int fr, int fq) const {
        const int row0 = u.pm * BM + wr * 64 + fr, cl = u.pn * 256 + wc * 32 + 8 * fq, b = u.pm >> 5;
#pragma unroll
        for (int ai = 0; ai < 2; ++ai)
#pragma unroll
            for (int m = 0; m < 4; ++m) { const int row = row0 + ai * HALF + m * 16; float s = 0.f;
#pragma unroll
                for (int bj = 0; bj < 2; ++bj) { const int c = cl + bj * HALF;
                    const float* xp = X + (size_t)row * 1024 + c; const float* gp = MOD + b * 6144 + 2048 + c; const float* cp = CW2 + b * 1024 + c;
                    const f32x4 v0 = *(const f32x4*)(xp) + *(const f32x4*)(gp) * acc[ai][bj][m][0], v1 = *(const f32x4*)(xp + 4) + *(const f32x4*)(gp + 4) * acc[ai][bj][m][1];
                    *(f32x4*)(X1 + (size_t)row * 1024 + c) = v0; *(f32x4*)(X1 + (size_t)row * 1024 + c + 4) = v1;
                    s += (v0[0] * v0[0] + v0[1] * v0[1]) + (v0[2] * v0[2] + v0[3] * v0[3]) + (v1[0] * v1[0] + v1[1] * v1[1]) + (v1[2] * v1[2] + v1[3] * v1[3]);
                    *(u32x4*)(XS + (size_t)row * 1024 + c) = pack8(v0 * *(const f32x4*)(cp), v1 * *(const f32x4*)(cp + 4)); }
                s += __shfl_xor(s, 16); s += __shfl_xor(s, 32);
                if (fq == 0) X1SS[(size_t)row * 16 + u.pn * 4 + wc] = s; }
    }
};

struct EpiGateUp {
    static constexpr bool PERM = true, AFTER_DRAIN = false;
    bf16_t* HID; const float* X1SS; const float* BGU;
    __device__ __forceinline__ void operator()(const f32x4 (&acc)[2][2][4][2], const Unit& u, int wr, int wc, int fr, int fq) const {
        const int row0 = u.pm * BM + wr * 64 + fr, cl = wc * 32 + 8 * fq, b = u.pm >> 5;
        const float* bp = BGU + b * 5632 + u.pn * 256 + cl;
        const f32x4 bg0 = *(const f32x4*)(bp), bg1 = *(const f32x4*)(bp + 4), bu0 = *(const f32x4*)(bp + 128), bu1 = *(const f32x4*)(bp + 132);
#pragma unroll
        for (int ai = 0; ai < 2; ++ai)
#pragma unroll
            for (int m = 0; m < 4; ++m) { const int row = row0 + ai * HALF + m * 16;
                float s = 0.f;
#pragma unroll
                for (int q = 0; q < 4; ++q) { const f32x4 t = *(const f32x4*)(X1SS + (size_t)row * 16 + 4 * q); s += (t[0] + t[1]) + (t[2] + t[3]); }
                const float r = __builtin_amdgcn_rsqf(s * (1.0f / 1024.0f) + 1e-6f);
                f32x4 g0 = acc[ai][0][m][0] * r + bg0, g1 = acc[ai][0][m][1] * r + bg1; const f32x4 u0 = acc[ai][1][m][0] * r + bu0, u1 = acc[ai][1][m][1] * r + bu1;
#pragma unroll
                for (int j = 0; j < 4; ++j) { g0[j] = fsilu(g0[j]) * u0[j]; g1[j] = fsilu(g1[j]) * u1[j]; }
                *(u32x4*)(HID + (size_t)row * 2816 + u.pn * 128 + cl) = pack8(g0, g1); }
    }
};

struct EpiDown {
    static constexpr bool PERM = true, AFTER_DRAIN = false;
    const float* X1; float* OUT; float* X2SS; const float* MOD;
    __device__ __forceinline__ void operator()(const f32x4 (&acc)[2][2][4][2], const Unit& u, int wr, int wc, int fr, int fq) const {
        const int row0 = u.pm * BM + wr * 64 + fr, cl = u.pn * 256 + wc * 32 + 8 * fq, b = u.pm >> 5;
#pragma unroll
        for (int ai = 0; ai < 2; ++ai)
#pragma unroll
            for (int m = 0; m < 4; ++m) { const int row = row0 + ai * HALF + m * 16; float s = 0.f;
#pragma unroll
                for (int bj = 0; bj < 2; ++bj)
#pragma unroll
                    for (int n = 0; n < 2; ++n) { const int c = cl + bj * HALF + 4 * n;
                        const f32x4 v = *(const f32x4*)(X1 + (size_t)row * 1024 + c) + *(const f32x4*)(MOD + b * 6144 + 5120 + c) * acc[ai][bj][m][n];
                        *(f32x4*)(OUT + (size_t)row * 1024 + c) = v; s += (v[0] * v[0] + v[1] * v[1]) + (v[2] * v[2] + v[3] * v[3]); }
                s += __shfl_xor(s, 16); s += __shfl_xor(s, 32);
                if (fq == 0) X2SS[(size_t)row * 16 + u.pn * 4 + wc] = s; }
    }
};

template <class Epi, class Sched, bool ALIGN_EPI = false, bool SP2 = false>
__device__ __forceinline__ void gemm_phase(PG8_LAS unsigned char* lds, const Gemm g, const Sched& S, const Epi& E) {
    const int tid = threadIdx.x, wid = __builtin_amdgcn_readfirstlane(tid >> 6), lane = tid & 63, wr = wid >> 2, wc = wid & 3, fr = lane & 15, fq = lane >> 4;
    const int K = g.K, nt = K / BK;
    unsigned voffA[2], voffB[2];
#pragma unroll
    for (int i = 0; i < 2; ++i) { int R, C; stage_rc(tid * 16 + i * 8192, R, C); const int Rb = Epi::PERM ? ((R & ~31) + perm32(R & 31)) : R;
        voffA[i] = (unsigned)(R * K + C) * 2u; voffB[i] = (unsigned)(Rb * K + C) * 2u; }
    const size_t kstep = (size_t)(BK * 2);
    const size_t hstep = (size_t)HALF * K * 2;
    const size_t tstep = 2 * hstep;
    const unsigned ldsw = (unsigned)wid * 1024u;
    const int aoff = lds_byte(wr * 64 + fr, fq * 8), boff = lds_byte(wc * 32 + fr, fq * 8);
#define PG8_SA(b, h) (((b) * 2 + (h)) * HTB)
#define PG8_SB(b, h) ((4 + (b) * 2 + (h)) * HTB)
#define PG8_STAGE(bufoff, gbase, voff) do { _Pragma("unroll") for (int _i = 0; _i < 2; ++_i) \
        __builtin_amdgcn_global_load_lds((const unsigned*)((const char*)(gbase) + (voff)[_i]), (PG8_LAS unsigned*)(lds + (bufoff) + ldsw + _i * 8192), 16, 0, 0); } while (0)
#define PG8_LDA(dst, b, h) do { _Pragma("unroll") for (int m = 0; m < 4; ++m) _Pragma("unroll") for (int k = 0; k < 2; ++k) dst[m][k] = *(const PG8_LAS bf16x8*)(lds + PG8_SA(b, h) + aoff + m * 2048 + k * 1024); } while (0)
#define PG8_LDB(dst, b, h) do { _Pragma("unroll") for (int n = 0; n < 2; ++n) _Pragma("unroll") for (int k = 0; k < 2; ++k) dst[n][k] = *(const PG8_LAS bf16x8*)(lds + PG8_SB(b, h) + boff + n * 2048 + k * 1024); } while (0)
#define PG8_MMA(ai, bj, At, Bt) do { __builtin_amdgcn_s_setprio(1); _Pragma("unroll") for (int m = 0; m < 4; ++m) _Pragma("unroll") for (int n = 0; n < 2; ++n) _Pragma("unroll") for (int k = 0; k < 2; ++k) \
        acc[ai][bj][m][n] = __builtin_amdgcn_mfma_f32_16x16x32_bf16(Bt[n][k], At[m][k], acc[ai][bj][m][n], 0, 0, 0); __builtin_amdgcn_s_setprio(0); } while (0)
#define PG8_WAIT_V(n) asm volatile("s_waitcnt vmcnt(" #n ")" ::: "memory")
#define PG8_WAIT_L(n) asm volatile("s_waitcnt lgkmcnt(" #n ")" ::: "memory")
#define PG8_BAR __builtin_amdgcn_s_barrier()
#define PG8_SCHED __builtin_amdgcn_sched_barrier(0)
    Unit cur, nxt; int ui = 0;
    if (!S.next(0, cur)) return;
    f32x4 acc[2][2][4][2];
#pragma unroll
    for (int a = 0; a < 2; ++a)
#pragma unroll
        for (int b = 0; b < 2; ++b)
#pragma unroll
            for (int m = 0; m < 4; ++m)
#pragma unroll
                for (int n = 0; n < 2; ++n) acc[a][b][m][n] = (f32x4){0.f, 0.f, 0.f, 0.f};
    bf16x8 At[4][2], B0[2][2], B1[2][2];
    const char* cA = (const char*)g.A + (size_t)cur.pm * tstep; const char* cB = (const char*)g.Bt + (size_t)cur.pn * tstep;
    S.a_ready(cur);
    if constexpr (SP2) {
        PG8_STAGE(PG8_SB(0, 0), cB, voffB); PG8_STAGE(PG8_SB(0, 1), cB + hstep, voffB); PG8_STAGE(PG8_SA(0, 0), cA, voffA); PG8_STAGE(PG8_SA(0, 1), cA + hstep, voffA);
        if (wr == 1) PG8_BAR;
        PG8_WAIT_V(2); PG8_BAR;
        PG8_STAGE(PG8_SB(1, 0), cB + kstep, voffB); PG8_STAGE(PG8_SA(1, 0), cA + kstep, voffA); PG8_STAGE(PG8_SB(1, 1), cB + hstep + kstep, voffB);
        PG8_WAIT_V(6); PG8_BAR;
    } else {
        PG8_STAGE(PG8_SB(0, 0), cB, voffB); PG8_STAGE(PG8_SA(0, 0), cA, voffA); PG8_STAGE(PG8_SB(0, 1), cB + hstep, voffB); PG8_STAGE(PG8_SA(0, 1), cA + hstep, voffA);
        if (wr == 1) PG8_BAR;
        PG8_WAIT_V(4); PG8_BAR;
        PG8_STAGE(PG8_SB(1, 0), cB + kstep, voffB); PG8_STAGE(PG8_SA(1, 0), cA + kstep, voffA); PG8_STAGE(PG8_SB(1, 1), cB + hstep + kstep, voffB);
        PG8_WAIT_V(6); PG8_BAR;
    }
    for (;;) {
        const bool has_next = S.next(ui + 1, nxt);
        const char* nA = has_next ? (const char*)g.A + (size_t)nxt.pm * tstep : cA; const char* nB = has_next ? (const char*)g.Bt + (size_t)nxt.pn * tstep : cB;
        for (int t = 0; t < nt; t += 2) {
            const bool last = (t == nt - 2);
            const char* a1 = cA + (size_t)(t + 1) * kstep;
            const char* a2 = last ? nA : cA + (size_t)(t + 2) * kstep; const char* b2 = last ? nB : cB + (size_t)(t + 2) * kstep;
            const char* a3 = a2 + kstep; const char* b3 = b2 + kstep;
            if (last && has_next) S.a_ready(nxt);
            if constexpr (SP2) {
            PG8_LDB(B0, 0, 0); PG8_LDB(B1, 0, 1); PG8_SCHED; PG8_LDA(At, 0, 0); PG8_STAGE(PG8_SA(1, 1), a1 + hstep, voffA);
            PG8_WAIT_V(8); PG8_WAIT_L(0); PG8_BAR; PG8_MMA(0, 0, At, B0); PG8_MMA(0, 1, At, B1); PG8_BAR; PG8_SCHED;
            PG8_LDA(At, 0, 1); PG8_STAGE(PG8_SB(0, 0), b2, voffB); PG8_STAGE(PG8_SB(0, 1), b2 + hstep, voffB); PG8_STAGE(PG8_SA(0, 0), a2, voffA);
            PG8_WAIT_V(8); PG8_WAIT_L(0); PG8_BAR; PG8_MMA(1, 0, At, B0); PG8_MMA(1, 1, At, B1); PG8_BAR; PG8_SCHED;
            PG8_LDB(B0, 1, 0); PG8_LDB(B1, 1, 1); PG8_SCHED; PG8_LDA(At, 1, 0); PG8_STAGE(PG8_SA(0, 1), a2 + hstep, voffA);
            PG8_WAIT_V(8); PG8_WAIT_L(0); PG8_BAR; PG8_MMA(0, 0, At, B0); PG8_MMA(0, 1, At, B1); PG8_BAR; PG8_SCHED;
            PG8_LDA(At, 1, 1); PG8_STAGE(PG8_SB(1, 0), b3, voffB); PG8_STAGE(PG8_SB(1, 1), b3 + hstep, voffB); PG8_STAGE(PG8_SA(1, 0), a3, voffA);
            PG8_WAIT_V(8); PG8_WAIT_L(0); PG8_BAR; PG8_MMA(1, 0, At, B0); PG8_MMA(1, 1, At, B1); PG8_BAR; PG8_SCHED;
            } else {
            PG8_LDB(B0, 0, 0); PG8_SCHED; PG8_LDA(At, 0, 0); PG8_STAGE(PG8_SA(1, 1), a1 + hstep, voffA);
            PG8_WAIT_L(8); PG8_BAR; PG8_WAIT_L(0); PG8_MMA(0, 0, At, B0); PG8_BAR; PG8_SCHED;
            PG8_LDB(B1, 0, 1); PG8_STAGE(PG8_SB(0, 0), b2, voffB);
            PG8_BAR; PG8_WAIT_L(0); PG8_MMA(0, 1, At, B1); PG8_BAR;
            PG8_LDA(At, 0, 1); PG8_STAGE(PG8_SA(0, 0), a2, voffA);
            PG8_BAR; PG8_WAIT_L(0); PG8_MMA(1, 0, At, B0); PG8_BAR; PG8_SCHED;
            PG8_STAGE(PG8_SB(0, 1), b2 + hstep, voffB);
            PG8_WAIT_V(6); PG8_BAR; PG8_MMA(1, 1, At, B1); PG8_BAR;
            PG8_LDB(B0, 1, 0); PG8_SCHED; PG8_LDA(At, 1, 0); PG8_STAGE(PG8_SA(0, 1), a2 + hstep, voffA);
            PG8_WAIT_L(8); PG8_BAR; PG8_WAIT_L(0); PG8_MMA(0, 0, At, B0); PG8_BAR; PG8_SCHED;
            PG8_LDB(B1, 1, 1); PG8_STAGE(PG8_SB(1, 0), b3, voffB);
            PG8_BAR; PG8_WAIT_L(0); PG8_MMA(0, 1, At, B1); PG8_BAR;
            PG8_LDA(At, 1, 1); PG8_STAGE(PG8_SA(1, 0), a3, voffA);
            PG8_BAR; PG8_WAIT_L(0); PG8_MMA(1, 0, At, B0); PG8_BAR; PG8_SCHED;
            PG8_STAGE(PG8_SB(1, 1), b3 + hstep, voffB);
            PG8_WAIT_V(6); PG8_BAR; PG8_MMA(1, 1, At, B1); PG8_BAR;
            }
        }
        if constexpr (ALIGN_EPI) { if (wr == 0) PG8_BAR; }
        if constexpr (!Epi::AFTER_DRAIN) { E(acc, cur, wr, wc, fr, fq); S.done(cur); }
        if (!has_next) break;
#pragma unroll
        for (int a = 0; a < 2; ++a)
#pragma unroll
            for (int b = 0; b < 2; ++b)
#pragma unroll
                for (int m = 0; m < 4; ++m)
#pragma unroll
                    for (int n = 0; n < 2; ++n) acc[a][b][m][n] = (f32x4){0.f, 0.f, 0.f, 0.f};
        cur = nxt; cA = nA; cB = nB; ++ui;
        if constexpr (ALIGN_EPI) { if (wr == 1) PG8_BAR; }
    }
    PG8_WAIT_V(0);
    if constexpr (!ALIGN_EPI) { if (wr == 0) PG8_BAR; }
    PG8_BAR;
    if constexpr (Epi::AFTER_DRAIN) { E.fused(acc, cur, wr, wc, fr, fq, lds, wid, lane); S.done(cur); }
#undef PG8_SA
#undef PG8_SB
#undef PG8_STAGE
#undef PG8_LDA
#undef PG8_LDB
#undef PG8_MMA
#undef PG8_WAIT_V
#undef PG8_WAIT_L
#undef PG8_BAR
#undef PG8_SCHED
}
}
#ifndef PG8_SP2
#define PG8_SP2 true
#endif
#ifndef PG8_ALIGN
#define PG8_ALIGN true
#endif

constexpr int NWAVES = 8;
#ifndef MK_N_LAUNCHES
#define MK_N_LAUNCHES 1
#endif
constexpr int N_PHASES = 11;
constexpr int N_LAUNCHES = MK_N_LAUNCHES;
static_assert(N_LAUNCHES == 1 || N_LAUNCHES == N_PHASES, "MK_N_LAUNCHES is 1 or N_PHASES");

constexpr int NB = 8, SEQ = 8192, D = 1024, M = NB * SEQ;
constexpr int NPROJ = 4680, NPROJ_PAD = 4864, FF = 2816, NGU = 2 * FF;
constexpr float EPS = 1e-6f;

constexpr size_t MiB = 1u << 20;
constexpr size_t WS_CTL = 0, CTL_ZERO_BYTES = 1 * MiB;
constexpr size_t WS_MOD = 1 * MiB;
constexpr size_t WS_LB = WS_MOD + 256 * 1024;
constexpr size_t WS_CW2 = WS_MOD + 320 * 1024;
constexpr size_t WS_BGU = WS_MOD + 512 * 1024;
constexpr size_t WS_WIN = 3 * MiB, WS_WQ = 13 * MiB, WS_WBA = 14 * MiB, WS_WBR = 15 * MiB, WS_WOUT = 16 * MiB, WS_WGU = 18 * MiB, WS_WD = 29 * MiB;
constexpr size_t WS_CQSS = 35 * MiB, WS_X1SS = 36 * MiB, WS_X2SS = 40 * MiB;
constexpr size_t WS_XN = 64 * MiB;
constexpr size_t WS_CQ = 192 * MiB, WS_KV = 224 * MiB, WS_KI = 256 * MiB, WS_WI = 264 * MiB;
constexpr size_t WS_RQ = 272 * MiB, WS_RGL = 336 * MiB, WS_RI = 400 * MiB, WS_RGS = 464 * MiB;
constexpr size_t WS_Q = 528 * MiB, WS_QI = 592 * MiB;
constexpr size_t WS_ATT = 64 * MiB, WS_REC = 128 * MiB;
constexpr size_t WS_SCR = 656 * MiB;
constexpr size_t WS_HO = 784 * MiB;
constexpr size_t WS_MIX = 896 * MiB;
constexpr size_t WS_X1 = 64 * MiB, WS_XS = 320 * MiB, WS_HID = 448 * MiB;
constexpr size_t WS_END = 1024 * MiB;
static_assert(WS_RGL == WS_RQ + 64 * MiB && WS_RI == WS_RQ + 128 * MiB && WS_RGS == WS_RQ + 192 * MiB && WS_QI == WS_Q + 64 * MiB, "epilogue pointer arithmetic");
static_assert(WS_HID + (size_t)M * FF * 2 <= WS_END && WS_HO + (size_t)M * 512 * 4 <= WS_MIX + 16 * MiB, "map");

constexpr int CW_TMO = 0, CW_CODE = 1;
constexpr int CW_BAR = 4096;

constexpr int RING_OFF = 0, RING_BYTES = 131072;
constexpr int LDSCTL_OFF = RING_BYTES, MISC_OFF = LDSCTL_OFF + 320;
constexpr int LDS_BYTES = 147456;
static_assert(MISC_OFF + 128 <= LDS_BYTES, "LDS map");

#define GAS __attribute__((address_space(1)))
#define LAS __attribute__((address_space(3)))
typedef unsigned short bf16;
typedef unsigned v4u __attribute__((ext_vector_type(4)));
typedef unsigned v2u __attribute__((ext_vector_type(2)));
typedef float f32x4 __attribute__((ext_vector_type(4)));
typedef float f32x16 __attribute__((ext_vector_type(16)));
typedef short bf16x8 __attribute__((ext_vector_type(8)));
typedef GAS unsigned gu32;
#define RLX_AGENT __ATOMIC_RELAXED, __HIP_MEMORY_SCOPE_AGENT
#define LDS_WAIT() asm volatile("s_waitcnt lgkmcnt(0)" ::: "memory")
#define VM_WAIT() asm volatile("s_waitcnt vmcnt(0)" ::: "memory")
__device__ __forceinline__ unsigned f2bf(float f) { unsigned u = __builtin_bit_cast(unsigned, f); return (u + 0x7fffu + ((u >> 16) & 1u)) >> 16; }
__device__ __forceinline__ unsigned pk2(float lo, float hi) { return f2bf(lo) | (f2bf(hi) << 16); }
__device__ __forceinline__ float bflo(unsigned u) { return __builtin_bit_cast(float, u << 16); }
__device__ __forceinline__ float bfhi(unsigned u) { return __builtin_bit_cast(float, u & 0xffff0000u); }
__device__ __forceinline__ float bf1(bf16 h) { return __builtin_bit_cast(float, (unsigned)h << 16); }

#define XB_TMO      128
#define XB_XCNT(j)  (256  + 64 * (j))
#define XB_XSUB(j)  (1280 + 64 * (j))
#define XB_XGEN(j)  (2304 + 64 * (j))
#define XB_TOP      3328
#define XB_TOPGEN   3392
#define XCD_BAR_WORDS 3456
#define XB_SPIN_CAP (1u << 23)

__device__ __forceinline__ unsigned xb_ld(unsigned* p)              { return __hip_atomic_load(p, __ATOMIC_RELAXED, __HIP_MEMORY_SCOPE_AGENT); }
__device__ __forceinline__ unsigned xb_add(unsigned* p, unsigned v) { return __hip_atomic_fetch_add(p, v, __ATOMIC_RELAXED, __HIP_MEMORY_SCOPE_AGENT); }
__device__ __forceinline__ unsigned xb_xcc_id() { return (unsigned)__builtin_amdgcn_s_getreg((3 << 11) | 20) & 0xFu; }
#define XB_SPIN(cond, bar) do { unsigned _sp = 0; while (cond) { __builtin_amdgcn_s_sleep(1); \
    if ((++_sp & 255u) == 0u) { if (xb_ld(&(bar)[XB_TMO])) break; if (_sp > XB_SPIN_CAP) { atomicAdd(&(bar)[XB_TMO], 1u); break; } } } } while (0)

struct XcdBarrier { unsigned* bar; unsigned x; volatile LAS unsigned* st; };

__device__ __forceinline__ XcdBarrier xcd_barrier_post(unsigned* bar, volatile LAS unsigned* st) {
    XcdBarrier b; b.bar = bar; b.x = xb_xcc_id(); b.st = st;
    if (threadIdx.x == 0) (void)xb_add(&bar[XB_XCNT(b.x)], 1u);
    return b;
}
__device__ __forceinline__ void xcd_barrier_complete(unsigned* bar, unsigned x, unsigned& nloc, unsigned& nx) {
    const unsigned G = gridDim.x * gridDim.y * gridDim.z;
    unsigned sum, cnt, mine, sp = 0u;
    for (;;) {
        sum = 0u; cnt = 0u; mine = 0u;
#pragma unroll
        for (unsigned j = 0; j < 16; ++j) { const unsigned c = xb_ld(&bar[XB_XCNT(j)]); sum += c; cnt += (c > 0u) ? 1u : 0u; mine = (j == x) ? c : mine; }
        if (sum == G) break;
        __builtin_amdgcn_s_sleep(1);
        if ((++sp & 255u) == 0u) { if (xb_ld(&bar[XB_TMO])) break; if (sp > XB_SPIN_CAP) { atomicAdd(&bar[XB_TMO], 1u); break; } }
    }
    nloc = mine > 0u ? mine : 1u; nx = cnt > 0u ? cnt : 1u;
}
__device__ __forceinline__ void xcd_barrier(const XcdBarrier& b) {
    asm volatile("s_waitcnt vmcnt(0)" ::: "memory");
    __syncthreads();
    if (threadIdx.x == 0) {
        unsigned* bar = b.bar;
        __builtin_amdgcn_s_waitcnt(0);
        unsigned nloc = b.st[0], nx = b.st[1];
        if (nloc == 0u) { xcd_barrier_complete(bar, b.x, nloc, nx); b.st[0] = nloc; b.st[1] = nx; }
        const unsigned old = xb_add(&bar[XB_XSUB(b.x)], 1u);
        const unsigned gen = old / nloc;
        if (old + 1u == (gen + 1u) * nloc) {
            __builtin_amdgcn_fence(__ATOMIC_RELEASE, "agent");
            asm volatile("s_waitcnt vmcnt(0)" ::: "memory");
            const unsigned og = xb_add(&bar[XB_TOP], 1u);
            const unsigned tg = og / nx;
            if (og + 1u == (tg + 1u) * nx) xb_add(&bar[XB_TOPGEN], 1u);
            else XB_SPIN(xb_ld(&bar[XB_TOPGEN]) == tg, bar);
            __builtin_amdgcn_fence(__ATOMIC_ACQUIRE, "agent");
            xb_add(&bar[XB_XGEN(b.x)], 1u);
            asm volatile("s_waitcnt vmcnt(0)" ::: "memory");
        } else {
            XB_SPIN(xb_ld(&bar[XB_XGEN(b.x)]) == gen, bar);
            __builtin_amdgcn_fence(__ATOMIC_ACQUIRE, "agent");
            asm volatile("s_waitcnt vmcnt(0)" ::: "memory");
        }
    }
    __syncthreads();
}

struct Frame {
    LAS unsigned char* lds;
    volatile LAS unsigned* MISC;
    gu32* ctl;
    unsigned char* ws;
    int tid, lane, wave;
    int G;
    float* out;
};
__device__ __forceinline__ float wave_sum(float v) {
#pragma unroll
    for (int o = 1; o < 64; o <<= 1) v += __shfl_xor(v, o);
    return v;
}
__device__ __forceinline__ float wave_max(float v) {
#pragma unroll
    for (int o = 1; o < 64; o <<= 1) v = fmaxf(v, __shfl_xor(v, o));
    return v;
}

template <class SrcCol>
__device__ __forceinline__ void transpose_item(const float* W, int ldw, int K, bf16* WT, const float* ks, LAS float* scr, int item, int nblk, int lane, SrcCol src) {
    const int kb = item / nblk, nb = item % nblk, k0 = 64 * kb, n0 = 32 * nb;
    const float* Wp; const int sc = src(n0 + (lane & 31), Wp);
#pragma unroll 8
    for (int i = 0; i < 32; ++i) { const int kk = 2 * i + (lane >> 5); float v = 0.f; if (sc >= 0) { v = Wp[(size_t)(k0 + kk) * ldw + sc]; if (ks) v *= ks[k0 + kk]; } scr[kk * 33 + (lane & 31)] = v; }
    LDS_WAIT(); asm volatile("" ::: "memory");
    const int c = lane & 7;
#pragma unroll
    for (int j = 0; j < 4; ++j) { const int n = (lane >> 3) + 8 * j; const LAS float* s = scr + (8 * c) * 33 + n;
        v4u o; o.x = pk2(s[0 * 33], s[1 * 33]); o.y = pk2(s[2 * 33], s[3 * 33]); o.z = pk2(s[4 * 33], s[5 * 33]); o.w = pk2(s[6 * 33], s[7 * 33]);
        *(GAS v4u*)(WT + (size_t)(n0 + n) * K + k0 + 8 * c) = o; }
    LDS_WAIT(); asm volatile("" ::: "memory");
}
struct Args { const float* in[20]; float* out; unsigned char* ws; int ph_lo, ph_hi; };
template <class SrcCol>
__device__ __forceinline__ void gemv8(Frame& F, const LAS float* vec, int cpg, int ngrp, int ldw, SrcCol src, const float* bias, float* out, int ldo) {
    LAS float* red = (LAS float*)(F.lds + 32768);
    for (int jb = blockIdx.x; jb < ngrp; jb += F.G) {
        const int col = F.tid & 31, kg = F.tid >> 5; float a[8];
#pragma unroll
        for (int b = 0; b < 8; ++b) a[b] = 0.f;
        const float* Wp = nullptr; int sc = -1;
        if (col < cpg) sc = src(jb * cpg + col, Wp);
        if (sc >= 0) for (int k = kg * 64; k < kg * 64 + 64; ++k) { const float w = Wp[(size_t)k * ldw + sc];
#pragma unroll
            for (int b = 0; b < 8; ++b) a[b] += vec[b * 1024 + k] * w; }
#pragma unroll
        for (int b = 0; b < 8; ++b) red[(kg * 8 + b) * 32 + col] = a[b];
        __syncthreads();
        if (F.tid < 256) { const int b = F.tid >> 5, c2 = F.tid & 31;
            if (c2 < cpg) { float s = 0.f; for (int k2 = 0; k2 < 16; ++k2) s += red[(k2 * 8 + b) * 32 + c2]; const int jj = jb * cpg + c2; out[b * ldo + jj] = s + (bias ? bias[jj] : 0.f); } }
        __syncthreads();
    }
}
struct SrcWin { const float* W; __device__ __forceinline__ int operator()(int d, const float*& Wp) const { Wp = W; return d < 584 ? d : (d < 768 ? -1 : d - 184); } };
__device__ __forceinline__ const float* psel(const float* a, const float* b, bool takeb) { const unsigned long long x = (unsigned long long)a, y = (unsigned long long)b, m = takeb ? ~0ull : 0ull; return (const float*)(x ^ ((x ^ y) & m)); }
struct SrcWq { const float *Wa, *Wb; __device__ __forceinline__ int operator()(int d, const float*& Wp) const { Wp = psel(Wa, Wb, d >= 512); return d & 511; } };
struct SrcId { const float* W; __device__ __forceinline__ int operator()(int d, const float*& Wp) const { Wp = W; return d; } };
struct SrcGu { const float *Wg, *Wu; __device__ __forceinline__ int operator()(int d, const float*& Wp) const { const int t = d >> 8, w = d & 255; Wp = psel(Wg, Wu, w >= 128); return t * 128 + (w & 127); } };

__device__ __forceinline__ void p0_prologue(Frame& F, const Args& A) {
    LAS float* cact = (LAS float*)(F.lds);
    for (int i = F.tid; i < 8192; i += NWAVES * 64) { const float v = A.in[1][i]; cact[i] = v / (1.0f + __expf(-v)); }
    __syncthreads();
    gemv8(F, cact, 24, 256, 6144, SrcId{A.in[2]}, A.in[3], (float*)(F.ws + WS_MOD), 6144);
    if (blockIdx.x == 0) { const float* l = A.in[10]; float* LB = (float*)(F.ws + WS_LB);
        for (int c = F.tid; c < 512; c += NWAVES * 64) LB[c] = 1.0f / (1.0f + __expf(l[512 + c] - l[c])); }
    __syncthreads();
    LAS float* scr = (LAS float*)(F.lds + 49152 + F.wave * 8448);
    const int gw = blockIdx.x * NWAVES + F.wave, NGW = F.G * NWAVES;
    constexpr int I_IN = 16 * 152, I_Q = 4 * 32, I_BA = 8 * 32, I_BR = 8 * 32, I_O = 16 * 32, I_GU = 16 * 176, I_D = 44 * 32;
    constexpr int NITEMS = I_IN + I_Q + I_BA + I_BR + I_O + I_GU + I_D;
    for (int it = gw; it < NITEMS; it += NGW) {
        int r = it;
        if (r < I_IN) { transpose_item(A.in[5], NPROJ, 1024, (bf16*)(F.ws + WS_WIN), nullptr, scr, r, 152, F.lane, SrcWin{A.in[5]}); continue; } r -= I_IN;
        if (r < I_Q) { transpose_item(nullptr, 512, 256, (bf16*)(F.ws + WS_WQ), A.in[6], scr, r, 32, F.lane, SrcWq{A.in[7], A.in[8]}); continue; } r -= I_Q;
        if (r < I_BA) { transpose_item(nullptr, 1024, 512, (bf16*)(F.ws + WS_WBA), nullptr, scr, r, 32, F.lane, SrcId{A.in[12]}); continue; } r -= I_BA;
        if (r < I_BR) { transpose_item(nullptr, 1024, 512, (bf16*)(F.ws + WS_WBR), nullptr, scr, r, 32, F.lane, SrcId{A.in[13]}); continue; } r -= I_BR;
        if (r < I_O) { transpose_item(nullptr, 1024, 1024, (bf16*)(F.ws + WS_WOUT), nullptr, scr, r, 32, F.lane, SrcId{A.in[14]}); continue; } r -= I_O;
        if (r < I_GU) { transpose_item(nullptr, FF, 1024, (bf16*)(F.ws + WS_WGU), nullptr, scr, r, 176, F.lane, SrcGu{A.in[16], A.in[17]}); continue; } r -= I_GU;
        transpose_item(nullptr, 1024, FF, (bf16*)(F.ws + WS_WD), nullptr, scr, r, 32, F.lane, SrcId{A.in[18]});
    }
}

__device__ __forceinline__ void p1_norm(Frame& F, const Args& A) {
    const float* MOD = (const float*)(F.ws + WS_MOD);
    { float* CW2 = (float*)(F.ws + WS_CW2); const int g = blockIdx.x * (NWAVES * 64) + F.tid;
      if (g < 8192) { const int b = g >> 10, c = g & 1023; CW2[g] = A.in[15][c] * (1.0f + MOD[b * 6144 + 4096 + c]); } }
    { LAS float* sh2 = (LAS float*)(F.lds);
      for (int i = F.tid; i < 8192; i += NWAVES * 64) sh2[i] = MOD[(i >> 10) * 6144 + 3072 + (i & 1023)];
      __syncthreads();
      gemv8(F, sh2, 22, 256, FF, SrcGu{A.in[16], A.in[17]}, nullptr, (float*)(F.ws + WS_BGU), NGU); }
    const int gw = blockIdx.x * NWAVES + F.wave, NGW = F.G * NWAVES; bf16* XN = (bf16*)(F.ws + WS_XN);
    for (int m = gw; m < M; m += NGW) {
        const int b = m >> 13;
        const GAS f32x4* xr = (const GAS f32x4*)(A.in[0] + (size_t)m * D) + F.lane;
        f32x4 v[4]; float s = 0.f;
#pragma unroll
        for (int j = 0; j < 4; ++j) { v[j] = xr[64 * j]; s += (v[j].x * v[j].x + v[j].y * v[j].y) + (v[j].z * v[j].z + v[j].w * v[j].w); }
        const float r = 1.0f / sqrtf(wave_sum(s) * (1.0f / D) + EPS);
        GAS unsigned long long* o8 = (GAS unsigned long long*)(XN + (size_t)m * D) + F.lane;
#pragma unroll
        for (int j = 0; j < 4; ++j) { const int c = 4 * F.lane + 256 * j;
            const f32x4 w = *(const f32x4*)(A.in[4] + c), sc = *(const f32x4*)(MOD + b * 6144 + 1024 + c), sh = *(const f32x4*)(MOD + b * 6144 + c);
            const f32x4 y = v[j] * r * w * (sc + 1.0f) + sh;
            o8[64 * j] = (unsigned long long)pk2(y.x, y.y) | ((unsigned long long)pk2(y.z, y.w) << 32); }
    }
}

__device__ __forceinline__ void hgrn_naive(Frame& F, int gw) {
    const int b = gw >> 3, h = (gw >> 1) & 3, vh = gw & 1;
    const bf16* rq = (const bf16*)(F.ws + WS_RQ) + (size_t)b * SEQ * 512 + h * 128;
    const bf16* rg = (const bf16*)(F.ws + WS_RGL) + (size_t)b * SEQ * 512 + h * 128;
    const bf16* ri = (const bf16*)(F.ws + WS_RI) + (size_t)b * SEQ * 512 + h * 128 + vh * 64 + F.lane;
    float* ho = (float*)(F.ws + WS_HO) + (size_t)b * SEQ * 512 + h * 128 + vh * 64 + F.lane;
    float S[128];
#pragma unroll
    for (int c = 0; c < 128; ++c) S[c] = 0.f;
    for (int t = 0; t < SEQ; ++t) {
        const unsigned* qrow = (const unsigned*)(rq + (size_t)t * 512); const unsigned* grow = (const unsigned*)(rg + (size_t)t * 512);
        const float vv = bf1(ri[(size_t)t * 512]); float o = 0.f;
#pragma unroll
        for (int c2 = 0; c2 < 64; ++c2) { const unsigned qq = qrow[c2], gg = grow[c2];
            const float f0 = __expf(bflo(gg)), f1 = __expf(bfhi(gg));
            S[2 * c2] = f0 * S[2 * c2] + (1.0f - f0) * vv; S[2 * c2 + 1] = f1 * S[2 * c2 + 1] + (1.0f - f1) * vv;
            o += bflo(qq) * S[2 * c2] + bfhi(qq) * S[2 * c2 + 1]; }
        ho[(size_t)t * 512] = o;
    }
}

__device__ __forceinline__ unsigned f2key(float x) {
    const _Float16 hh = (_Float16)x; const unsigned bits = (unsigned)__builtin_bit_cast(unsigned short, hh);
    return (bits & 0x8000u) ? (~bits & 0xffffu) : (bits | 0x8000u);
}
__device__ __forceinline__ void dsa_unit(Frame& F, int b, int t0) {
    const int lane = F.lane, w = F.wave, qc = lane & 31, hf = lane >> 5;
    const bf16* KI = (const bf16*)(F.ws + WS_KI) + (size_t)b * SEQ * 64;
    const bf16* QI = (const bf16*)(F.ws + WS_QI) + (size_t)(b * SEQ + t0) * 512;
    const float* WI = (const float*)(F.ws + WS_WI) + (size_t)(b * SEQ + t0) * 8;
    unsigned short* scr = (unsigned short*)(F.ws + WS_SCR) + (size_t)blockIdx.x * (32 * 8192);
    const int nkb = t0 / 32 + 1;
#ifndef NO_PASS1
    {
        bf16x8 qf[8][4]; float wv[8];
#pragma unroll
        for (int h = 0; h < 8; ++h) { wv[h] = WI[qc * 8 + h];
#pragma unroll
            for (int ks = 0; ks < 4; ++ks) qf[h][ks] = *(const bf16x8*)(QI + (size_t)qc * 512 + h * 64 + ks * 16 + hf * 8); }
#pragma unroll 1
        for (int kb = w; kb < nkb; kb += NWAVES) {
            const int s0 = kb * 32; bf16x8 kf[4];
#pragma unroll
            for (int ks = 0; ks < 4; ++ks) kf[ks] = *(const bf16x8*)(KI + (size_t)(s0 + qc) * 64 + ks * 16 + hf * 8);
            f32x16 sc;
#pragma unroll
            for (int r = 0; r < 16; ++r) sc[r] = 0.f;
#pragma unroll
            for (int h = 0; h < 8; ++h) { f32x16 a;
#pragma unroll
                for (int r = 0; r < 16; ++r) a[r] = 0.f;
#pragma unroll
                for (int ks = 0; ks < 4; ++ks) a = __builtin_amdgcn_mfma_f32_32x32x16_bf16(kf[ks], qf[h][ks], a, 0, 0, 0);
                asm volatile("s_nop 15\n\ts_nop 7" : "+v"(a));
#pragma unroll
                for (int r = 0; r < 16; ++r) asm volatile("v_max_f32 %1, 0, %1\n\tv_fmac_f32 %0, %2, %1" : "+v"(sc[r]), "+v"(a[r]) : "v"(wv[h]));
                __builtin_amdgcn_sched_barrier(0); }
#pragma unroll
            for (int rr = 0; rr < 4; ++rr) { unsigned kk[4];
#pragma unroll
                for (int i = 0; i < 4; ++i) { const int key = s0 + 8 * rr + 4 * hf + i; kk[i] = (key <= t0 + qc) ? f2key(sc[4 * rr + i]) : 0u; }
                v2u o; o.x = kk[0] | (kk[1] << 16); o.y = kk[2] | (kk[3] << 16);
                *(v2u*)(scr + (size_t)qc * 8192 + s0 + 8 * rr + 4 * hf) = o; }
        }
    }
#endif
    __syncthreads();
    LAS float* Pw = (LAS float*)(F.lds) + w * 2048; LAS unsigned short* idxl = (LAS unsigned short*)(F.lds + 65536) + w * 256;
    const LAS float* rb = (const LAS float*)(F.lds + 69632); const LAS int* lut = (const LAS int*)(F.lds + 70656);
    const bf16* KV = (const bf16*)(F.ws + WS_KV) + (size_t)b * SEQ * 256;
    const int nk = nkb * 32, ndw = nk >> 1;
#pragma unroll 1
    for (int qq = 0; qq < 4; ++qq) {
        const int ql = w * 4 + qq, t = t0 + ql, nvalid = t + 1, nsel = nvalid < 256 ? nvalid : 256;
        const unsigned* rowd = (const unsigned*)(scr + (size_t)ql * 8192);
        int ln = lane; asm volatile("" : "+v"(ln));
        unsigned rv[64];
#pragma unroll
        for (int j = 0; j < 64; ++j) { const unsigned val = rowd[j * 64 + ln]; rv[j] = (ln < ndw - j * 64) ? val : 0u; }
        unsigned T = 0u; int need = 0;
        if (nvalid > 256) {
#pragma unroll 1
            for (int bit = 15; bit >= 0; --bit) { const unsigned cand = T | (1u << bit); int c = 0;
#pragma unroll
                for (int g = 0; g < 8; ++g) if (g * 1024 < nk) {
#pragma unroll
                    for (int j = 8 * g; j < 8 * g + 8; ++j) { c += ((rv[j] & 0xffffu) >= cand) ? 1 : 0; c += ((rv[j] >> 16) >= cand) ? 1 : 0; } }
#pragma unroll
                for (int o = 1; o < 64; o <<= 1) c += __shfl_xor(c, o);
                if (c >= 256) T = cand; }
            int c = 0;
#pragma unroll
            for (int g = 0; g < 8; ++g) if (g * 1024 < nk) {
#pragma unroll
                for (int j = 8 * g; j < 8 * g + 8; ++j) { c += ((rv[j] & 0xffffu) > T) ? 1 : 0; c += ((rv[j] >> 16) > T) ? 1 : 0; } }
#pragma unroll
            for (int o = 1; o < 64; o <<= 1) c += __shfl_xor(c, o);
            need = 256 - c;
        }
        {
            int base = 0, tiebase = 0; const unsigned long long lt = (1ull << ln) - 1ull; const int ln2 = 2 * ln;
#pragma unroll
            for (int g = 0; g < 8; ++g) if (g * 1024 < nk) {
#pragma unroll
                for (int j = 8 * g; j < 8 * g + 8; ++j) { const unsigned lo = rv[j] & 0xffffu, hi = rv[j] >> 16;
                    const bool el = lo == T, eh = hi == T; const unsigned long long mel = __ballot(el), meh = __ballot(eh);
                    const int trl = tiebase + __popcll(mel & lt) + __popcll(meh & lt), trh = trl + (el ? 1 : 0);
                    const bool sl = lo > T || (el && trl < need), sh = hi > T || (eh && trh < need);
                    const unsigned long long msl = __ballot(sl), msh = __ballot(sh);
                    const int pl = base + __popcll(msl & lt) + __popcll(msh & lt), ph = pl + (sl ? 1 : 0);
                    if (sl && pl < 256) idxl[pl] = (unsigned short)(ln2 + 128 * j); if (sh && ph < 256) idxl[ph] = (unsigned short)(ln2 + 128 * j + 1);
                    base += __popcll(msl) + __popcll(msh); tiebase += __popcll(mel) + __popcll(meh); __builtin_amdgcn_sched_barrier(0); } }
        }
        LDS_WAIT(); asm volatile("" ::: "memory");
#ifndef NO_ATT
        const unsigned* qrow = (const unsigned*)((const bf16*)(F.ws + WS_Q) + (size_t)(b * SEQ + t) * 512);
        float sc[8][4]; int sk[4]; const v4u* kr[4];
#pragma unroll
        for (int jj = 0; jj < 4; ++jj) { const int j = lane + 64 * jj; sk[jj] = (j < nsel) ? (int)idxl[j] : 0; kr[jj] = (const v4u*)(KV + (size_t)sk[jj] * 256); }
#pragma unroll
        for (int g = 0; g < 2; ++g) { float d4[4][4];
#pragma unroll
            for (int jj = 0; jj < 4; ++jj)
#pragma unroll
                for (int h4 = 0; h4 < 4; ++h4) d4[jj][h4] = 0.f;
#pragma unroll 1
            for (int c8 = 0; c8 < 8; ++c8) { unsigned qd[4][4];
#pragma unroll
                for (int h4 = 0; h4 < 4; ++h4)
#pragma unroll
                    for (int i = 0; i < 4; ++i) qd[h4][i] = qrow[(g * 4 + h4) * 32 + c8 * 4 + i];
#pragma unroll
                for (int jj = 0; jj < 4; ++jj) { const v4u kk = kr[jj][g * 8 + c8];
                    const float k0 = bflo(kk.x), k1 = bfhi(kk.x), k2 = bflo(kk.y), k3 = bfhi(kk.y), k4 = bflo(kk.z), k5 = bfhi(kk.z), k6 = bflo(kk.w), k7 = bfhi(kk.w);
#pragma unroll
                    for (int h4 = 0; h4 < 4; ++h4)
                        d4[jj][h4] += (k0 * bflo(qd[h4][0]) + k1 * bfhi(qd[h4][0])) + (k2 * bflo(qd[h4][1]) + k3 * bfhi(qd[h4][1])) + (k4 * bflo(qd[h4][2]) + k5 * bfhi(qd[h4][2])) + (k6 * bflo(qd[h4][3]) + k7 * bfhi(qd[h4][3])); } }
#pragma unroll
            for (int jj = 0; jj < 4; ++jj) { const int dist = t - sk[jj]; const int bk = dist < 128 ? lut[dist] : 31; const bool valid = (lane + 64 * jj) < nsel;
#pragma unroll
                for (int h4 = 0; h4 < 4; ++h4) sc[g * 4 + h4][jj] = valid ? d4[jj][h4] + rb[bk * 8 + g * 4 + h4] : -INFINITY; } }
#pragma unroll
        for (int h = 0; h < 8; ++h) { const float mx = wave_max(fmaxf(fmaxf(sc[h][0], sc[h][1]), fmaxf(sc[h][2], sc[h][3]))); float e[4], su = 0.f;
#pragma unroll
            for (int jj = 0; jj < 4; ++jj) { e[jj] = __expf(sc[h][jj] - mx); su += e[jj]; }
            const float inv = 1.0f / wave_sum(su);
#pragma unroll
            for (int jj = 0; jj < 4; ++jj) sc[h][jj] = e[jj] * inv; }
#pragma unroll
        for (int jj = 0; jj < 4; ++jj) { const int j = lane + 64 * jj;
            *(LAS f32x4*)(Pw + j * 8) = (f32x4){sc[0][jj], sc[1][jj], sc[2][jj], sc[3][jj]}; *(LAS f32x4*)(Pw + j * 8 + 4) = (f32x4){sc[4][jj], sc[5][jj], sc[6][jj], sc[7][jj]}; }
        LDS_WAIT(); asm volatile("" ::: "memory");
        float oa[8];
#pragma unroll
        for (int h = 0; h < 8; ++h) oa[h] = 0.f;
        for (int j = 0; j < nsel; ++j) { const int s = idxl[j]; const bf16* vr = KV + (size_t)s * 256 + 128;
            const float v0 = bf1(vr[lane]), v1 = bf1(vr[64 + lane]); const f32x4 p0 = *(const LAS f32x4*)(Pw + j * 8), p1 = *(const LAS f32x4*)(Pw + j * 8 + 4);
            oa[0] += p0[0] * v0; oa[1] += p0[1] * v0; oa[2] += p0[2] * v0; oa[3] += p0[3] * v0; oa[4] += p1[0] * v1; oa[5] += p1[1] * v1; oa[6] += p1[2] * v1; oa[7] += p1[3] * v1; }
        bf16* orow = (bf16*)(F.ws + WS_ATT) + (size_t)(b * SEQ + t) * 512;
#pragma unroll
        for (int h = 0; h < 8; ++h) orow[h * 64 + lane] = (bf16)f2bf(oa[h]);
#endif
        LDS_WAIT(); asm volatile("" ::: "memory");
    }
    __syncthreads();
}

__device__ __forceinline__ void p4_mixers(Frame& F, const Args& A) {
    { LAS float* rb = (LAS float*)(F.lds + 69632); LAS int* lut = (LAS int*)(F.lds + 70656);
      if (F.tid < 256) rb[F.tid] = A.in[9][F.tid];
      if (F.tid < 128) { const int n = F.tid; int v = n; if (n >= 16) { v = 16 + (int)(__logf((float)n * (1.0f / 16.0f)) * (16.0f / 2.0794415416798357f)); v = v < 31 ? v : 31; } lut[n] = v; }
      __syncthreads(); }
    const int nh = F.G > 16 ? 8 : 0;
    #ifndef NO_HGRN
    if (nh == 0 || (int)blockIdx.x < nh) for (int gw = blockIdx.x * NWAVES + F.wave; gw < 64; gw += (nh ? nh : F.G) * NWAVES) hgrn_naive(F, gw);
#endif
#ifndef NO_DSA
    if (nh == 0 || (int)blockIdx.x >= nh) for (int u = (int)blockIdx.x - nh; u < 2048; u += F.G - nh) { const int b = u & 7, qb = 255 - (u >> 3); dsa_unit(F, b, qb * 32); }
#endif
}

__device__ __forceinline__ void p5_recnorm(Frame& F, const Args& A) {
    const int gw = blockIdx.x * NWAVES + F.wave, NGW = F.G * NWAVES;
    const float* HO = (const float*)(F.ws + WS_HO); const bf16* RGS = (const bf16*)(F.ws + WS_RGS); bf16* REC = (bf16*)(F.ws + WS_REC);
    const f32x4 w0 = *(const f32x4*)(A.in[11] + (F.lane & 15) * 8), w1 = *(const f32x4*)(A.in[11] + (F.lane & 15) * 8 + 4);
    for (int m = gw; m < M; m += NGW) {
        const f32x4 a = *(const f32x4*)(HO + (size_t)m * 512 + F.lane * 8), c = *(const f32x4*)(HO + (size_t)m * 512 + F.lane * 8 + 4);
        float s = (a[0] * a[0] + a[1] * a[1]) + (a[2] * a[2] + a[3] * a[3]) + (c[0] * c[0] + c[1] * c[1]) + (c[2] * c[2] + c[3] * c[3]);
        s += __shfl_xor(s, 1); s += __shfl_xor(s, 2); s += __shfl_xor(s, 4); s += __shfl_xor(s, 8);
        const float r = 1.0f / sqrtf(s * (1.0f / 128.0f) + EPS);
        const v4u g = *(const v4u*)(RGS + (size_t)m * 512 + F.lane * 8);
        v4u o; o.x = pk2(a[0] * r * w0[0] * bflo(g.x), a[1] * r * w0[1] * bfhi(g.x)); o.y = pk2(a[2] * r * w0[2] * bflo(g.y), a[3] * r * w0[3] * bfhi(g.y));
        o.z = pk2(c[0] * r * w1[0] * bflo(g.z), c[1] * r * w1[1] * bfhi(g.z)); o.w = pk2(c[2] * r * w1[2] * bflo(g.w), c[3] * r * w1[3] * bfhi(g.w));
        *(v4u*)(REC + (size_t)m * 512 + F.lane * 8) = o;
    }
}

__device__ __forceinline__ void p10_final(Frame& F, const Args& A) {
    const int gw = blockIdx.x * NWAVES + F.wave, NGW = F.G * NWAVES; const float* SS = (const float*)(F.ws + WS_X2SS);
    for (int m = gw; m < M; m += NGW) {
        float s = F.lane < 16 ? SS[(size_t)m * 16 + F.lane] : 0.f; s = wave_sum(s);
        const float r = 1.0f / sqrtf(s * (1.0f / D) + EPS);
        GAS f32x4* xr = (GAS f32x4*)(F.out + (size_t)m * D) + F.lane;
#pragma unroll
        for (int j = 0; j < 4; ++j) { const f32x4 w = *(const f32x4*)(A.in[19] + 4 * F.lane + 256 * j); xr[64 * j] = xr[64 * j] * r * w; }
    }
}

__global__ void __launch_bounds__(NWAVES * 64, 2) fwd_kernel(Args args) {
    extern __shared__ __attribute__((aligned(16))) unsigned char lds[];
    Frame F;
    F.lds = (LAS unsigned char*)lds;
    F.MISC = (volatile LAS unsigned*)(F.lds + MISC_OFF);
    F.tid = threadIdx.x; F.lane = F.tid & 63; F.wave = __builtin_amdgcn_readfirstlane(F.tid >> 6);
    F.G = gridDim.x;
    F.ws = args.ws; F.ctl = (gu32*)(args.ws + WS_CTL); F.out = args.out;
    for (int u = F.tid; u < (LDS_BYTES - LDSCTL_OFF) / 4; u += NWAVES * 64) ((LAS unsigned*)(F.lds + LDSCTL_OFF))[u] = 0u;
    __syncthreads();
    XcdBarrier bar; bar.bar = (unsigned*)(F.ctl + CW_BAR); bar.x = 0; bar.st = nullptr;
    if (N_LAUNCHES == 1) bar = xcd_barrier_post((unsigned*)(F.ctl + CW_BAR), F.MISC + 8);
#define GRID_BAR() do { if (N_LAUNCHES == 1) xcd_barrier(bar); } while (0)
    const int lo = args.ph_lo, hi = args.ph_hi;
#ifdef ONLY_PHASE
#define IN(k) ((k) == ONLY_PHASE && lo <= (k) && (k) < hi)
#else
#define IN(k) (lo <= (k) && (k) < hi)
#endif
#define BOTH(k) (IN(k) && IN((k) + 1))
    const float* MOD = (const float*)(F.ws + WS_MOD);

    if (IN(0)) { p0_prologue(F, args); if (BOTH(0)) GRID_BAR(); }
    if (IN(1)) { p1_norm(F, args); if (BOTH(1)) GRID_BAR(); }
    if (IN(2)) {
        pg8::Gemm g{(const bf16*)(F.ws + WS_XN), (const bf16*)(F.ws + WS_WIN), M, NPROJ_PAD, 1024}; pg8::StaticOrder S; S.init(M, NPROJ_PAD, F.G, (int)blockIdx.x);
        pg8::EpiInProj E{(bf16*)(F.ws + WS_CQ), (bf16*)(F.ws + WS_KV), (bf16*)(F.ws + WS_KI), (bf16*)(F.ws + WS_RQ), (bf16*)F.out,
                         (float*)(F.ws + WS_WI), (float*)(F.ws + WS_CQSS), (const float*)(F.ws + WS_LB)};
        pg8::gemm_phase<pg8::EpiInProj, pg8::StaticOrder, PG8_ALIGN, PG8_SP2>(F.lds + RING_OFF, g, S, E);
        if (BOTH(2)) GRID_BAR();
    }
    if (IN(3)) {
        pg8::Gemm g{(const bf16*)(F.ws + WS_CQ), (const bf16*)(F.ws + WS_WQ), M, 1024, 256}; pg8::StaticOrder S; S.init(M, 1024, F.G, (int)blockIdx.x);
        pg8::EpiQ E{(bf16*)(F.ws + WS_Q), (const float*)(F.ws + WS_CQSS)};
        pg8::gemm_phase<pg8::EpiQ, pg8::StaticOrder, PG8_ALIGN, PG8_SP2>(F.lds + RING_OFF, g, S, E);
        if (BOTH(3)) GRID_BAR();
    }
    if (IN(4)) { p4_mixers(F, args); if (BOTH(4)) GRID_BAR(); }
    if (IN(5)) { p5_recnorm(F, args); if (BOTH(5)) GRID_BAR(); }
    if (IN(6)) {
        pg8::StaticOrder S; S.init(M, 1024, F.G, (int)blockIdx.x);
        { pg8::Gemm g{(const bf16*)(F.ws + WS_ATT), (const bf16*)(F.ws + WS_WBA), M, 1024, 512}; pg8::EpiBranch<0> E{(bf16*)(F.ws + WS_MIX), (const bf16*)F.out};
          pg8::gemm_phase<pg8::EpiBranch<0>, pg8::StaticOrder, PG8_ALIGN, PG8_SP2>(F.lds + RING_OFF, g, S, E); }
        { pg8::Gemm g{(const bf16*)(F.ws + WS_REC), (const bf16*)(F.ws + WS_WBR), M, 1024, 512}; pg8::EpiBranch<1> E{(bf16*)(F.ws + WS_MIX), (const bf16*)F.out};
          pg8::gemm_phase<pg8::EpiBranch<1>, pg8::StaticOrder, PG8_ALIGN, PG8_SP2>(F.lds + RING_OFF, g, S, E); }
        if (BOTH(6)) GRID_BAR();
    }
    if (IN(7)) {
        pg8::Gemm g{(const bf16*)(F.ws + WS_MIX), (const bf16*)(F.ws + WS_WOUT), M, 1024, 1024}; pg8::StaticOrder S; S.init(M, 1024, F.G, (int)blockIdx.x);
        pg8::EpiOut E{args.in[0], (float*)(F.ws + WS_X1), (bf16*)(F.ws + WS_XS), (float*)(F.ws + WS_X1SS), MOD, (const float*)(F.ws + WS_CW2)};
        pg8::gemm_phase<pg8::EpiOut, pg8::StaticOrder, PG8_ALIGN, PG8_SP2>(F.lds + RING_OFF, g, S, E);
        if (BOTH(7)) GRID_BAR();
    }
    if (IN(8)) {
        pg8::Gemm g{(const bf16*)(F.ws + WS_XS), (const bf16*)(F.ws + WS_WGU), M, NGU, 1024}; pg8::StaticOrder S; S.init(M, NGU, F.G, (int)blockIdx.x);
        pg8::EpiGateUp E{(bf16*)(F.ws + WS_HID), (const float*)(F.ws + WS_X1SS), (const float*)(F.ws + WS_BGU)};
        pg8::gemm_phase<pg8::EpiGateUp, pg8::StaticOrder, PG8_ALIGN, PG8_SP2>(F.lds + RING_OFF, g, S, E);
        if (BOTH(8)) GRID_BAR();
    }
    if (IN(9)) {
        pg8::Gemm g{(const bf16*)(F.ws + WS_HID), (const bf16*)(F.ws + WS_WD), M, 1024, FF}; pg8::StaticOrder S; S.init(M, 1024, F.G, (int)blockIdx.x);
        pg8::EpiDown E{(const float*)(F.ws + WS_X1), F.out, (float*)(F.ws + WS_X2SS), MOD};
        pg8::gemm_phase<pg8::EpiDown, pg8::StaticOrder, PG8_ALIGN, PG8_SP2>(F.lds + RING_OFF, g, S, E);
        if (BOTH(9)) GRID_BAR();
    }
    if (IN(10)) p10_final(F, args);
#undef IN
#undef BOTH
}

extern "C" void kernel_launch(void* const* d_in, const int* in_sizes, int n_in, void* d_out, int out_size, void* d_ws, size_t ws_size, hipStream_t stream) {
    static int grid = 0;
    if (grid == 0) {
        if (n_in != 20 || in_sizes[0] != M * D || out_size != M * D || ws_size < WS_END) { fprintf(stderr, "kernel_launch: unexpected shapes (n_in %d, in0 %d, out %d, ws %zu); nothing launched\n", n_in, n_in > 0 ? in_sizes[0] : -1, out_size, ws_size); grid = -1; return; }
        int dev = 0, cus = 0, per_cu = 0;
        if (hipGetDevice(&dev) != hipSuccess || hipDeviceGetAttribute(&cus, hipDeviceAttributeMultiprocessorCount, dev) != hipSuccess) { grid = -1; return; }
        if (hipFuncSetAttribute((const void*)fwd_kernel, hipFuncAttributeMaxDynamicSharedMemorySize, LDS_BYTES) != hipSuccess) { fprintf(stderr, "kernel_launch: hipFuncSetAttribute failed\n"); grid = -1; return; }
        if (hipOccupancyMaxActiveBlocksPerMultiprocessor(&per_cu, (const void*)fwd_kernel, NWAVES * 64, LDS_BYTES) != hipSuccess || per_cu < 1)
            fprintf(stderr, "kernel_launch: note: occupancy query reports %d workgroups per CU\n", per_cu);
        (void)hipGetLastError();
        grid = cus;
    }
    if (grid < 0) return;
    if (hipMemsetAsync((char*)d_ws + WS_CTL, 0, CTL_ZERO_BYTES, stream) != hipSuccess) { fprintf(stderr, "kernel_launch: memset failed\n"); return; }
    Args a{};
    for (int i = 0; i < 20; ++i) a.in[i] = (const float*)d_in[i];
    a.out = (float*)d_out; a.ws = (unsigned char*)d_ws;
    for (int li = 0; li < N_LAUNCHES; ++li) {
        a.ph_lo = (N_LAUNCHES == 1) ? 0 : li; a.ph_hi = (N_LAUNCHES == 1) ? N_PHASES : li + 1;
        hipLaunchKernelGGL(fwd_kernel, dim3(grid), dim3(NWAVES * 64), LDS_BYTES, stream, a);
        const hipError_t le = hipPeekAtLastError();
        if (le != hipSuccess) { fprintf(stderr, "kernel_launch: launch %d failed: %s\n", li, hipGetErrorName(le)); break; }
    }
}
```

```cpp
#include <hip/hip_runtime.h>
#include <cstdio>
#include <cstdint>
namespace pg8 {
#define PG8_LAS __attribute__((address_space(3)))
typedef unsigned short bf16_t;
typedef short bf16x8 __attribute__((ext_vector_type(8)));
typedef float f32x4 __attribute__((ext_vector_type(4)));
typedef unsigned u32x4 __attribute__((ext_vector_type(4)));
constexpr int BM = 256, BK = 64, HALF = 128, HTB = HALF * BK * 2  , STAGE_BYTES = 8 * HTB, NXCD = 8, WGM = 8;

__host__ __device__ __forceinline__ int lds_byte(int r, int c) { const int st = (r >> 4) * 2 + (c >> 5), rr = r & 15, cc = c & 31, ob = rr * 64 + cc * 2; return st * 1024 + (ob ^ (((ob >> 9) & 1) << 5)); }
__host__ __device__ __forceinline__ void stage_rc(int b, int& R, int& C) { const int st = b / 1024, sb = b % 1024, swz = sb ^ (((sb >> 9) & 1) << 5); R = (st >> 1) * 16 + swz / 64; C = (st & 1) * 32 + (swz % 64) / 2; }
__host__ __device__ __forceinline__ int perm32(int rho) { const int n = rho >> 4, i = rho & 15; return 8 * (i >> 2) + 4 * n + (i & 3); }

struct Unit { int pm, pn; };
struct Gemm { const bf16_t* A; const bf16_t* Bt; int M, N, K; };

struct StaticOrder {
    int nM, nN, nwg, G, c;
    __host__ __device__ void init(int M, int N, int G_, int c_) { nM = M / BM; nN = N / BM; nwg = nM * nN; G = G_; c = c_; }
    __host__ __device__ bool next(int i, Unit& u) const {
        const long L = (long)i * G + c; if (L >= nwg) return false;
        int wgid = (int)L; { const int q = nwg / NXCD, r = nwg % NXCD, xcd = wgid % NXCD, off = wgid / NXCD; wgid = (xcd < r ? xcd * (q + 1) : r * (q + 1) + (xcd - r) * q) + off; }
        const int nig = WGM * nN, gid = wgid / nig, fm = gid * WGM, gsz = (nM - fm) < WGM ? (nM - fm) : WGM;
        u.pm = fm + ((wgid % nig) % gsz); u.pn = (wgid % nig) / gsz; return true;
    }
    __device__ __forceinline__ void a_ready(const Unit&) const {}
    __device__ __forceinline__ void done(const Unit&) const {}
};

__device__ __forceinline__ unsigned cvt_pk_bf16(float lo, float hi) { unsigned r; asm volatile("v_cvt_pk_bf16_f32 %0, %1, %2" : "=v"(r) : "v"(lo), "v"(hi)); return r; }
__device__ __forceinline__ float fsigmoid(float x) { return __builtin_amdgcn_rcpf(1.0f + __expf(-x)); }
__device__ __forceinline__ float fsilu(float x) { return x * fsigmoid(x); }
__device__ __forceinline__ u32x4 pack8(const f32x4 a, const f32x4 b) { u32x4 w; w.x = cvt_pk_bf16(a[0], a[1]); w.y = cvt_pk_bf16(a[2], a[3]); w.z = cvt_pk_bf16(b[0], b[1]); w.w = cvt_pk_bf16(b[2], b[3]); return w; }
__device__ __forceinline__ float bf_lo(unsigned u) { return __builtin_bit_cast(float, u << 16); }
__device__ __forceinline__ float bf_hi(unsigned u) { return __builtin_bit_cast(float, u & 0xffff0000u); }

struct EpiInProj {
    static constexpr bool PERM = true, AFTER_DRAIN = false;
    bf16_t *CQ, *KV, *KI, *RQ, *GATES; float *WI, *CQSS; const float* LB;
    __device__ __forceinline__ void operator()(const f32x4 (&acc)[2][2][4][2], const Unit& u, int wr, int wc, int fr, int fq) const {
        const int row0 = u.pm * BM + wr * 64 + fr, pn = u.pn, cl = wc * 32 + 8 * fq;
        if (pn == 0) {
#pragma unroll
            for (int ai = 0; ai < 2; ++ai)
#pragma unroll
                for (int m = 0; m < 4; ++m) { const int row = row0 + ai * HALF + m * 16; float s = 0.f;
#pragma unroll
                    for (int bj = 0; bj < 2; ++bj) { const f32x4 a = acc[ai][bj][m][0], b = acc[ai][bj][m][1];
                        s += (a[0] * a[0] + a[1] * a[1]) + (a[2] * a[2] + a[3] * a[3]) + (b[0] * b[0] + b[1] * b[1]) + (b[2] * b[2] + b[3] * b[3]);
                        *(u32x4*)(CQ + (size_t)row * 256 + cl + bj * HALF) = pack8(a, b); }
                    s += __shfl_xor(s, 16); s += __shfl_xor(s, 32);
                    if (fq == 0) CQSS[(size_t)row * 4 + wc] = s; }
        } else if (pn == 1) {
#pragma unroll
            for (int ai = 0; ai < 2; ++ai)
#pragma unroll
                for (int m = 0; m < 4; ++m) { const int row = row0 + ai * HALF + m * 16;
#pragma unroll
                    for (int bj = 0; bj < 2; ++bj) *(u32x4*)(KV + (size_t)row * 256 + cl + bj * HALF) = pack8(acc[ai][bj][m][0], acc[ai][bj][m][1]); }
        } else if (pn == 2) {
#pragma unroll
            for (int ai = 0; ai < 2; ++ai)
#pragma unroll
                for (int m = 0; m < 4; ++m) { const int row = row0 + ai * HALF + m * 16;
                    if (wc < 2) *(u32x4*)(KI + (size_t)row * 64 + cl) = pack8(acc[ai][0][m][0], acc[ai][0][m][1]);
                    else if (wc == 2 && fq == 0) { *(f32x4*)(WI + (size_t)row * 8) = acc[ai][0][m][0]; *(f32x4*)(WI + (size_t)row * 8 + 4) = acc[ai][0][m][1]; } }
        } else if (pn <= 10) {
            const int kind = (pn - 3) >> 1, cb = ((pn - 3) & 1) * 256 + cl;
            bf16_t* dst = RQ + (size_t)kind * (size_t)(32u << 20);
#pragma unroll
            for (int bj = 0; bj < 2; ++bj) {
                f32x4 l0 = (f32x4){0.f, 0.f, 0.f, 0.f}, l1 = l0;
                if (kind == 1) { l0 = *(const f32x4*)(LB + cb + bj * HALF); l1 = *(const f32x4*)(LB + cb + bj * HALF + 4); }
#pragma unroll
                for (int ai = 0; ai < 2; ++ai)
#pragma unroll
                    for (int m = 0; m < 4; ++m) { const int row = row0 + ai * HALF + m * 16; f32x4 a = acc[ai][bj][m][0], b = acc[ai][bj][m][1];
                        if (kind == 0 || kind == 3) {
#pragma unroll
                            for (int j = 0; j < 4; ++j) { a[j] = fsilu(a[j]); b[j] = fsilu(b[j]); } }
                        else if (kind == 1) {
#pragma unroll
                            for (int j = 0; j < 4; ++j) { a[j] = __logf(l0[j] + (1.0f - l0[j]) * fsigmoid(a[j])); b[j] = __logf(l1[j] + (1.0f - l1[j]) * fsigmoid(b[j])); } }
                        *(u32x4*)(dst + (size_t)row * 512 + cb + bj * HALF) = pack8(a, b); }
            }
        } else {
            const int cb = (pn - 11) * 256 + cl;
#pragma unroll
            for (int ai = 0; ai < 2; ++ai)
#pragma unroll
                for (int m = 0; m < 4; ++m) { const int row = row0 + ai * HALF + m * 16;
#pragma unroll
                    for (int bj = 0; bj < 2; ++bj) { f32x4 a = acc[ai][bj][m][0], b = acc[ai][bj][m][1];
#pragma unroll
                        for (int j = 0; j < 4; ++j) { a[j] = fsigmoid(a[j]); b[j] = fsigmoid(b[j]); }
                        *(u32x4*)(GATES + (size_t)row * 2048 + cb + bj * HALF) = pack8(a, b); } }
        }
    }
};

struct EpiQ {
    static constexpr bool PERM = true, AFTER_DRAIN = false;
    bf16_t *Q; const float* CQSS;
    __device__ __forceinline__ void operator()(const f32x4 (&acc)[2][2][4][2], const Unit& u, int wr, int wc, int fr, int fq) const {
        const int row0 = u.pm * BM + wr * 64 + fr, pn = u.pn, cl = (pn & 1) * 256 + wc * 32 + 8 * fq;
        bf16_t* dst = Q + (pn < 2 ? (size_t)0 : (size_t)(32u << 20));
        const float sc = pn < 2 ? 0.125f : 1.0f;
#pragma unroll
        for (int ai = 0; ai < 2; ++ai)
#pragma unroll
            for (int m = 0; m < 4; ++m) { const int row = row0 + ai * HALF + m * 16;
                const f32x4 ss = *(const f32x4*)(CQSS + (size_t)row * 4);
                const float r = __builtin_amdgcn_rsqf(((ss[0] + ss[1]) + (ss[2] + ss[3])) * (1.0f / 256.0f) + 1e-6f) * sc;
#pragma unroll
                for (int bj = 0; bj < 2; ++bj) *(u32x4*)(dst + (size_t)row * 512 + cl + bj * HALF) = pack8(acc[ai][bj][m][0] * r, acc[ai][bj][m][1] * r); }
    }
};

template <int MODE> struct EpiBranch {
    static constexpr bool PERM = true, AFTER_DRAIN = false;
    bf16_t* MIX; const bf16_t* GATES;
    __device__ __forceinline__ void operator()(const f32x4 (&acc)[2][2][4][2], const Unit& u, int wr, int wc, int fr, int fq) const {
        const int row0 = u.pm * BM + wr * 64 + fr, cl = u.pn * 256 + wc * 32 + 8 * fq;
#pragma unroll
        for (int ai = 0; ai < 2; ++ai)
#pragma unroll
            for (int m = 0; m < 4; ++m) { const int row = row0 + ai * HALF + m * 16;
#pragma unroll
                for (int bj = 0; bj < 2; ++bj) { const int c = cl + bj * HALF;
                    const u32x4 g = *(const u32x4*)(GATES + (size_t)row * 2048 + MODE * 1024 + c);
                    f32x4 a = acc[ai][bj][m][0], b = acc[ai][bj][m][1];
                    a[0] *= bf_lo(g.x); a[1] *= bf_hi(g.x); a[2] *= bf_lo(g.y); a[3] *= bf_hi(g.y); b[0] *= bf_lo(g.z); b[1] *= bf_hi(g.z); b[2] *= bf_lo(g.w); b[3] *= bf_hi(g.w);
                    if (MODE == 1) { const u32x4 p = *(const u32x4*)(MIX + (size_t)row * 1024 + c);
                        a[0] += bf_lo(p.x); a[1] += bf_hi(p.x); a[2] += bf_lo(p.y); a[3] += bf_hi(p.y); b[0] += bf_lo(p.z); b[1] += bf_hi(p.z); b[2] += bf_lo(p.w); b[3] += bf_hi(p.w); }
                    *(u32x4*)(MIX + (size_t)row * 1024 + c) = pack8(a, b); } }
    }
};

struct EpiOut {
    static constexpr bool PERM = true, AFTER_DRAIN = false;
    const float* X; float* X1; bf16_t* XS; float* X1SS; const float* MOD; const float* CW2;
    __device__ __forceinline__ void operator()(const f32x4 (&acc)[2][2][4][2], const Unit& u, int wr, int wc, int fr, int fq) const {
        const int row0 = u.pm * BM + wr * 64 + fr, cl = u.pn * 256 + wc * 32 + 8 * fq, b = u.pm >> 5;
#pragma unroll
        for (int ai = 0; ai < 2; ++ai)
#pragma unroll
            for (int m = 0; m < 4; ++m) { const int row = row0 + ai * HALF + m * 16; float s = 0.f;
#pragma unroll
                for (int bj = 0; bj < 2; ++bj) { const int c = cl + bj * HALF;
                    const float* xp = X + (size_t)row * 1024 + c; const float* gp = MOD + b * 6144 + 2048 + c; const float* cp = CW2 + b * 1024 + c;
                    const f32x4 v0 = *(const f32x4*)(xp) + *(const f32x4*)(gp) * acc[ai][bj][m][0], v1 = *(const f32x4*)(xp + 4) + *(const f32x4*)(gp + 4) * acc[ai][bj][m][1];
                    *(f32x4*)(X1 + (size_t)row * 1024 + c) = v0; *(f32x4*)(X1 + (size_t)row * 1024 + c + 4) = v1;
                    s += (v0[0] * v0[0] + v0[1] * v0[1]) + (v0[2] * v0[2] + v0[3] * v0[3]) + (v1[0] * v1[0] + v1[1] * v1[1]) + (v1[2] * v1[2] + v1[3] * v1[3]);
                    *(u32x4*)(XS + (size_t)row * 1024 + c) = pack8(v0 * *(const f32x4*)(cp), v1 * *(const f32x4*)(cp + 4)); }
                s += __shfl_xor(s, 16); s += __shfl_xor(s, 32);
                if (fq == 0) X1SS[(size_t)row * 16 + u.pn * 4 + wc] = s; }
    }
};

struct EpiGateUp {
    static constexpr bool PERM = true, AFTER_DRAIN = false;
    bf16_t* HID; const float* X1SS; const float* BGU;
    __device__ __forceinline__ void operator()(const f32x4 (&acc)[2][2][4][2], const Unit& u, int wr, int wc, int fr, int fq) const {
        const int row0 = u.pm * BM + wr * 64 + fr, cl = wc * 32 + 8 * fq, b = u.pm >> 5;
        const float* bp = BGU + b * 5632 + u.pn * 256 + cl;
        const f32x4 bg0 = *(const f32x4*)(bp), bg1 = *(const f32x4*)(bp + 4), bu0 = *(const f32x4*)(bp + 128), bu1 = *(const f32x4*)(bp + 132);
#pragma unroll
        for (int ai = 0; ai < 2; ++ai)
#pragma unroll
            for (int m = 0; m < 4; ++m) { const int row = row0 + ai * HALF + m * 16;
                float s = 0.f;
#pragma unroll
                for (int q = 0; q < 4; ++q) { const f32x4 t = *(const f32x4*)(X1SS + (size_t)row * 16 + 4 * q); s += (t[0] + t[1]) + (t[2] + t[3]); }
                const float r = __builtin_amdgcn_rsqf(s * (1.0f / 1024.0f) + 1e-6f);
                f32x4 g0 = acc[ai][0][m][0] * r + bg0, g1 = acc[ai][0][m][1] * r + bg1; const f32x4 u0 = acc[ai][1][m][0] * r + bu0, u1 = acc[ai][1][m][1] * r + bu1;
#pragma unroll
                for (int j = 0; j < 4; ++j) { g0[j] = fsilu(g0[j]) * u0[j]; g1[j] = fsilu(g1[j]) * u1[j]; }
                *(u32x4*)(HID + (size_t)row * 2816 + u.pn * 128 + cl) = pack8(g0, g1); }
    }
};

struct EpiDown {
    static constexpr bool PERM = true, AFTER_DRAIN = false;
    const float* X1; float* OUT; float* X2SS; const float* MOD;
    __device__ __forceinline__ void operator()(const f32x4 (&acc)[2][2][4][2], const Unit& u, int wr, int wc, int fr, int fq) const {
        const int row0 = u.pm * BM + wr * 64 + fr, cl = u.pn * 256 + wc * 32 + 8 * fq, b = u.pm >> 5;
#pragma unroll
        for (int ai = 0; ai < 2; ++ai)
#pragma unroll
            for (int m = 0; m < 4; ++m) { const int row = row0 + ai * HALF + m * 16; float s = 0.f;
#pragma unroll
                for (int bj = 0; bj < 2; ++bj)
#pragma unroll
                    for (int n = 0; n < 2; ++n) { const int c = cl + bj * HALF + 4 * n;
                        const f32x4 v = *(const f32x4*)(X1 + (size_t)row * 1024 + c) + *(const f32x4*)(MOD + b * 6144 + 5120 + c) * acc[ai][bj][m][n];
                        *(f32x4*)(OUT + (size_t)row * 1024 + c) = v; s += (v[0] * v[0] + v[1] * v[1]) + (v[2] * v[2] + v[3] * v[3]); }
                s += __shfl_xor(s, 16); s += __shfl_xor(s, 32);
                if (fq == 0) X2SS[(size_t)row * 16 + u.pn * 4 + wc] = s; }
    }
};

template <class Epi, class Sched, bool ALIGN_EPI = false, bool SP2 = false>
__device__ __forceinline__ void gemm_phase(PG8_LAS unsigned char* lds, const Gemm g, const Sched& S, const Epi& E) {
    const int tid = threadIdx.x, wid = __builtin_amdgcn_readfirstlane(tid >> 6), lane = tid & 63, wr = wid >> 2, wc = wid & 3, fr = lane & 15, fq = lane >> 4;
    const int K = g.K, nt = K / BK;
    unsigned voffA[2], voffB[2];
#pragma unroll
    for (int i = 0; i < 2; ++i) { int R, C; stage_rc(tid * 16 + i * 8192, R, C); const int Rb = Epi::PERM ? ((R & ~31) + perm32(R & 31)) : R;
        voffA[i] = (unsigned)(R * K + C) * 2u; voffB[i] = (unsigned)(Rb * K + C) * 2u; }
    const size_t kstep = (size_t)(BK * 2);
    const size_t hstep = (size_t)HALF * K * 2;
    const size_t tstep = 2 * hstep;
    const unsigned ldsw = (unsigned)wid * 1024u;
    const int aoff = lds_byte(wr * 64 + fr, fq * 8), boff = lds_byte(wc * 32 + fr, fq * 8);
#define PG8_SA(b, h) (((b) * 2 + (h)) * HTB)
#define PG8_SB(b, h) ((4 + (b) * 2 + (h)) * HTB)
#define PG8_STAGE(bufoff, gbase, voff) do { _Pragma("unroll") for (int _i = 0; _i < 2; ++_i) \
        __builtin_amdgcn_global_load_lds((const unsigned*)((const char*)(gbase) + (voff)[_i]), (PG8_LAS unsigned*)(lds + (bufoff) + ldsw + _i * 8192), 16, 0, 0); } while (0)
#define PG8_LDA(dst, b, h) do { _Pragma("unroll") for (int m = 0; m < 4; ++m) _Pragma("unroll") for (int k = 0; k < 2; ++k) dst[m][k] = *(const PG8_LAS bf16x8*)(lds + PG8_SA(b, h) + aoff + m * 2048 + k * 1024); } while (0)
#define PG8_LDB(dst, b, h) do { _Pragma("unroll") for (int n = 0; n < 2; ++n) _Pragma("unroll") for (int k = 0; k < 2; ++k) dst[n][k] = *(const PG8_LAS bf16x8*)(lds + PG8_SB(b, h) + boff + n * 2048 + k * 1024); } while (0)
#define PG8_MMA(ai, bj, At, Bt) do { __builtin_amdgcn_s_setprio(1); _Pragma("unroll") for (int m = 0; m < 4; ++m) _Pragma("unroll") for (int n = 0; n < 2; ++n) _Pragma("unroll") for (int k = 0; k < 2; ++k) \
        acc[ai][bj][m][n] = __builtin_amdgcn_mfma_f32_16x16x32_bf16(Bt[n][k], At[m][k], acc[ai][bj][m][n], 0, 0, 0); __builtin_amdgcn_s_setprio(0); } while (0)
#define PG8_WAIT_V(n) asm volatile("s_waitcnt vmcnt(" #n ")" ::: "memory")
#define PG8_WAIT_L(n) asm volatile("s_waitcnt lgkmcnt(" #n ")" ::: "memory")
#define PG8_BAR __builtin_amdgcn_s_barrier()
#define PG8_SCHED __builtin_amdgcn_sched_barrier(0)
    Unit cur, nxt; int ui = 0;
    if (!S.next(0, cur)) return;
    f32x4 acc[2][2][4][2];
#pragma unroll
    for (int a = 0; a < 2; ++a)
#pragma unroll
        for (int b = 0; b < 2; ++b)
#pragma unroll
            for (int m = 0; m < 4; ++m)
#pragma unroll
                for (int n = 0; n < 2; ++n) acc[a][b][m][n] = (f32x4){0.f, 0.f, 0.f, 0.f};
    bf16x8 At[4][2], B0[2][2], B1[2][2];
    const char* cA = (const char*)g.A + (size_t)cur.pm * tstep; const char* cB = (const char*)g.Bt + (size_t)cur.pn * tstep;
    S.a_ready(cur);
    if constexpr (SP2) {
        PG8_STAGE(PG8_SB(0, 0), cB, voffB); PG8_STAGE(PG8_SB(0, 1), cB + hstep, voffB); PG8_STAGE(PG8_SA(0, 0), cA, voffA); PG8_STAGE(PG8_SA(0, 1), cA + hstep, voffA);
        if (wr == 1) PG8_BAR;
        PG8_WAIT_V(2); PG8_BAR;
        PG8_STAGE(PG8_SB(1, 0), cB + kstep, voffB); PG8_STAGE(PG8_SA(1, 0), cA + kstep, voffA); PG8_STAGE(PG8_SB(1, 1), cB + hstep + kstep, voffB);
        PG8_WAIT_V(6); PG8_BAR;
    } else {
        PG8_STAGE(PG8_SB(0, 0), cB, voffB); PG8_STAGE(PG8_SA(0, 0), cA, voffA); PG8_STAGE(PG8_SB(0, 1), cB + hstep, voffB); PG8_STAGE(PG8_SA(0, 1), cA + hstep, voffA);
        if (wr == 1) PG8_BAR;
        PG8_WAIT_V(4); PG8_BAR;
        PG8_STAGE(PG8_SB(1, 0), cB + kstep, voffB); PG8_STAGE(PG8_SA(1, 0), cA + kstep, voffA); PG8_STAGE(PG8_SB(1, 1), cB + hstep + kstep, voffB);
        PG8_WAIT_V(6); PG8_BAR;
    }
    for (;;) {
        const bool has_next = S.next(ui + 1, nxt);
        const char* nA = has_next ? (const char*)g.A + (size_t)nxt.pm * tstep : cA; const char* nB = has_next ? (const char*)g.Bt + (size_t)nxt.pn * tstep : cB;
        for (int t = 0; t < nt; t += 2) {
            const bool last = (t == nt - 2);
            const char* a1 = cA + (size_t)(t + 1) * kstep;
            const char* a2 = last ? nA : cA + (size_t)(t + 2) * kstep; const char* b2 = last ? nB : cB + (size_t)(t + 2) * kstep;
            const char* a3 = a2 + kstep; const char* b3 = b2 + kstep;
            if (last && has_next) S.a_ready(nxt);
            if constexpr (SP2) {
            PG8_LDB(B0, 0, 0); PG8_LDB(B1, 0, 1); PG8_SCHED; PG8_LDA(At, 0, 0); PG8_STAGE(PG8_SA(1, 1), a1 + hstep, voffA);
            PG8_WAIT_V(8); PG8_WAIT_L(0); PG8_BAR; PG8_MMA(0, 0, At, B0); PG8_MMA(0, 1, At, B1); PG8_BAR; PG8_SCHED;
            PG8_LDA(At, 0, 1); PG8_STAGE(PG8_SB(0, 0), b2, voffB); PG8_STAGE(PG8_SB(0, 1), b2 + hstep, voffB); PG8_STAGE(PG8_SA(0, 0), a2, voffA);
            PG8_WAIT_V(8); PG8_WAIT_L(0); PG8_BAR; PG8_MMA(1, 0, At, B0); PG8_MMA(1, 1, At, B1); PG8_BAR; PG8_SCHED;
            PG8_LDB(B0, 1, 0); PG8_LDB(B1, 1, 1); PG8_SCHED; PG8_LDA(At, 1, 0); PG8_STAGE(PG8_SA(0, 1), a2 + hstep, voffA);
            PG8_WAIT_V(8); PG8_WAIT_L(0); PG8_BAR; PG8_MMA(0, 0, At, B0); PG8_MMA(0, 1, At, B1); PG8_BAR; PG8_SCHED;
            PG8_LDA(At, 1, 1); PG8_STAGE(PG8_SB(1, 0), b3, voffB); PG8_STAGE(PG8_SB(1, 1), b3 + hstep, voffB); PG8_STAGE(PG8_SA(1, 0), a3, voffA);
            PG8_WAIT_V(8); PG8_WAIT_L(0); PG8_BAR; PG8_MMA(1, 0, At, B0); PG8_MMA(1, 1, At, B1); PG8_BAR; PG8_SCHED;
            } else {
            PG8_LDB(B0, 0, 0); PG8_SCHED; PG8_LDA(At, 0, 0); PG8_STAGE(PG8_SA(1, 1), a1 + hstep, voffA);
            PG8_WAIT_L(8); PG8_BAR; PG8_WAIT_L(0); PG8_MMA(0, 0, At, B0); PG8_BAR; PG8_SCHED;
            PG8_LDB(B1, 0, 1); PG8_STAGE(PG8_SB(0, 0), b2, voffB);
            PG8_BAR; PG8_WAIT_L(0); PG8_MMA(0, 1, At, B1); PG8_BAR;
            PG8_LDA(At, 0, 1); PG8_STAGE(PG8_SA(0, 0), a2, voffA);
            PG8_BAR; PG8_WAIT_L(0); PG8_MMA(1, 0, At, B0); PG8_BAR; PG8_SCHED;
            PG8_STAGE(PG8_SB(0, 1), b2 + hstep, voffB);
            PG8_WAIT_V(6); PG8_BAR; PG8_MMA(1, 1, At, B1); PG8_BAR;
            PG8_LDB(B0, 1, 0); PG8_SCHED; PG8_LDA(At, 1, 0); PG8_STAGE(PG8_SA(0, 1), a2 + hstep, voffA);
            PG8_WAIT_L(8); PG8_BAR; PG8_WAIT_L(0); PG8_MMA(0, 0, At, B0); PG8_BAR; PG8_SCHED;
            PG8_LDB(B1, 1, 1); PG8_STAGE(PG8_SB(1, 0), b3, voffB);
            PG8_BAR; PG8_WAIT_L(0); PG8_MMA(0, 1, At, B1); PG8_BAR;
            PG8_LDA(At, 1, 1); PG8_STAGE(PG8_SA(1, 0), a3, voffA);
            PG8_BAR; PG8_WAIT_L(0); PG8_MMA(1, 0, At, B0); PG8_BAR; PG8_SCHED;
            PG8_STAGE(PG8_SB(1, 1), b3 + hstep, voffB);
            PG8_WAIT_V(6); PG8_BAR; PG8_MMA(1, 1, At, B1); PG8_BAR;
            }
        }
        if constexpr (ALIGN_EPI) { if (wr == 0) PG8_BAR; }
        if constexpr (!Epi::AFTER_DRAIN) { E(acc, cur, wr, wc, fr, fq); S.done(cur); }
        if (!has_next) break;
#pragma unroll
        for (int a = 0; a < 2; ++a)
#pragma unroll
            for (int b = 0; b < 2; ++b)
#pragma unroll
                for (int m = 0; m < 4; ++m)
#pragma unroll
                    for (int n = 0; n < 2; ++n) acc[a][b][m][n] = (f32x4){0.f, 0.f, 0.f, 0.f};
        cur = nxt; cA = nA; cB = nB; ++ui;
        if constexpr (ALIGN_EPI) { if (wr == 1) PG8_BAR; }
    }
    PG8_WAIT_V(0);
    if constexpr (!ALIGN_EPI) { if (wr == 0) PG8_BAR; }
    PG8_BAR;
    if constexpr (Epi::AFTER_DRAIN) { E.fused(acc, cur, wr, wc, fr, fq, lds, wid, lane); S.done(cur); }
#undef PG8_SA
#undef PG8_SB
#undef PG8_STAGE
#undef PG8_LDA
#undef PG8_LDB
#undef PG8_MMA
#undef PG8_WAIT_V
#undef PG8_WAIT_L
#undef PG8_BAR
#undef PG8_SCHED
}
}
#ifndef PG8_SP2
#define PG8_SP2 true
#endif
#ifndef PG8_ALIGN
#define PG8_ALIGN true
#endif

constexpr int NWAVES = 8;
#ifndef MK_N_LAUNCHES
#define MK_N_LAUNCHES 1
#endif
constexpr int N_PHASES = 11;
constexpr int N_LAUNCHES = MK_N_LAUNCHES;
static_assert(N_LAUNCHES == 1 || N_LAUNCHES == N_PHASES, "MK_N_LAUNCHES is 1 or N_PHASES");

constexpr int NB = 8, SEQ = 8192, D = 1024, M = NB * SEQ;
constexpr int NPROJ = 4680, NPROJ_PAD = 4864, FF = 2816, NGU = 2 * FF;
constexpr float EPS = 1e-6f;

constexpr size_t MiB = 1u << 20;
constexpr size_t WS_CTL = 0, CTL_ZERO_BYTES = 1 * MiB;
constexpr size_t WS_MOD = 1 * MiB;
constexpr size_t WS_LB = WS_MOD + 256 * 1024;
constexpr size_t WS_CW2 = WS_MOD + 320 * 1024;
constexpr size_t WS_BGU = WS_MOD + 512 * 1024;
constexpr size_t WS_WIN = 3 * MiB, WS_WQ = 13 * MiB, WS_WBA = 14 * MiB, WS_WBR = 15 * MiB, WS_WOUT = 16 * MiB, WS_WGU = 18 * MiB, WS_WD = 29 * MiB;
constexpr size_t WS_CQSS = 35 * MiB, WS_X1SS = 36 * MiB, WS_X2SS = 40 * MiB;
constexpr size_t WS_XN = 64 * MiB;
constexpr size_t WS_CQ = 192 * MiB, WS_KV = 224 * MiB, WS_KI = 256 * MiB, WS_WI = 264 * MiB;
constexpr size_t WS_RQ = 272 * MiB, WS_RGL = 336 * MiB, WS_RI = 400 * MiB, WS_RGS = 464 * MiB;
constexpr size_t WS_Q = 528 * MiB, WS_QI = 592 * MiB;
constexpr size_t WS_ATT = 64 * MiB, WS_REC = 128 * MiB;
constexpr size_t WS_SCR = 656 * MiB;
constexpr size_t WS_OLOC = 784 * MiB, WS_QHAT = 848 * MiB, WS_U = 912 * MiB, WS_DS = 928 * MiB;
constexpr size_t WS_MIX = 896 * MiB;
constexpr size_t WS_X1 = 64 * MiB, WS_XS = 320 * MiB, WS_HID = 448 * MiB;
constexpr size_t WS_END = 1024 * MiB;
static_assert(WS_RGL == WS_RQ + 64 * MiB && WS_RI == WS_RQ + 128 * MiB && WS_RGS == WS_RQ + 192 * MiB && WS_QI == WS_Q + 64 * MiB, "epilogue pointer arithmetic");
static_assert(WS_HID + (size_t)M * FF * 2 <= WS_END && WS_DS + 256 * 128 * 4 <= WS_END, "map");

constexpr int CW_TMO = 0, CW_CODE = 1;
constexpr int CW_BAR = 4096;

constexpr int RING_OFF = 0, RING_BYTES = 131072;
constexpr int LDS_BYTES = 163840;
constexpr int LDSCTL_OFF = LDS_BYTES - 1024, MISC_OFF = LDSCTL_OFF + 320;
static_assert(MISC_OFF + 128 <= LDS_BYTES, "LDS map");

#define GAS __attribute__((address_space(1)))
#define LAS __attribute__((address_space(3)))
typedef unsigned short bf16;
typedef unsigned v4u __attribute__((ext_vector_type(4)));
typedef unsigned v2u __attribute__((ext_vector_type(2)));
typedef float f32x4 __attribute__((ext_vector_type(4)));
typedef float f32x16 __attribute__((ext_vector_type(16)));
typedef short bf16x8 __attribute__((ext_vector_type(8)));
typedef GAS unsigned gu32;
#define RLX_AGENT __ATOMIC_RELAXED, __HIP_MEMORY_SCOPE_AGENT
#define LDS_WAIT() asm volatile("s_waitcnt lgkmcnt(0)" ::: "memory")
#define VM_WAIT() asm volatile("s_waitcnt vmcnt(0)" ::: "memory")
__device__ __forceinline__ unsigned f2bf(float f) { unsigned u = __builtin_bit_cast(unsigned, f); return (u + 0x7fffu + ((u >> 16) & 1u)) >> 16; }
__device__ __forceinline__ unsigned pk2(float lo, float hi) { return f2bf(lo) | (f2bf(hi) << 16); }
__device__ __forceinline__ float bflo(unsigned u) { return __builtin_bit_cast(float, u << 16); }
__device__ __forceinline__ float bfhi(unsigned u) { return __builtin_bit_cast(float, u & 0xffff0000u); }
__device__ __forceinline__ float bf1(bf16 h) { return __builtin_bit_cast(float, (unsigned)h << 16); }

#define XB_TMO      128
#define XB_XCNT(j)  (256  + 64 * (j))
#define XB_XSUB(j)  (1280 + 64 * (j))
#define XB_XGEN(j)  (2304 + 64 * (j))
#define XB_TOP      3328
#define XB_TOPGEN   3392
#define XCD_BAR_WORDS 3456
#define XB_SPIN_CAP (1u << 23)

__device__ __forceinline__ unsigned xb_ld(unsigned* p)              { return __hip_atomic_load(p, __ATOMIC_RELAXED, __HIP_MEMORY_SCOPE_AGENT); }
__device__ __forceinline__ unsigned xb_add(unsigned* p, unsigned v) { return __hip_atomic_fetch_add(p, v, __ATOMIC_RELAXED, __HIP_MEMORY_SCOPE_AGENT); }
__device__ __forceinline__ unsigned xb_xcc_id() { return (unsigned)__builtin_amdgcn_s_getreg((3 << 11) | 20) & 0xFu; }
#define XB_SPIN(cond, bar) do { unsigned _sp = 0; while (cond) { __builtin_amdgcn_s_sleep(1); \
    if ((++_sp & 255u) == 0u) { if (xb_ld(&(bar)[XB_TMO])) break; if (_sp > XB_SPIN_CAP) { atomicAdd(&(bar)[XB_TMO], 1u); break; } } } } while (0)

struct XcdBarrier { unsigned* bar; unsigned x; volatile LAS unsigned* st; };

__device__ __forceinline__ XcdBarrier xcd_barrier_post(unsigned* bar, volatile LAS unsigned* st) {
    XcdBarrier b; b.bar = bar; b.x = xb_xcc_id(); b.st = st;
    if (threadIdx.x == 0) (void)xb_add(&bar[XB_XCNT(b.x)], 1u);
    return b;
}
__device__ __forceinline__ void xcd_barrier_complete(unsigned* bar, unsigned x, unsigned& nloc, unsigned& nx) {
    const unsigned G = gridDim.x * gridDim.y * gridDim.z;
    unsigned sum, cnt, mine, sp = 0u;
    for (;;) {
        sum = 0u; cnt = 0u; mine = 0u;
#pragma unroll
        for (unsigned j = 0; j < 16; ++j) { const unsigned c = xb_ld(&bar[XB_XCNT(j)]); sum += c; cnt += (c > 0u) ? 1u : 0u; mine = (j == x) ? c : mine; }
        if (sum == G) break;
        __builtin_amdgcn_s_sleep(1);
        if ((++sp & 255u) == 0u) { if (xb_ld(&bar[XB_TMO])) break; if (sp > XB_SPIN_CAP) { atomicAdd(&bar[XB_TMO], 1u); break; } }
    }
    nloc = mine > 0u ? mine : 1u; nx = cnt > 0u ? cnt : 1u;
}
__device__ __forceinline__ void xcd_barrier(const XcdBarrier& b) {
    asm volatile("s_waitcnt vmcnt(0)" ::: "memory");
    __syncthreads();
    if (threadIdx.x == 0) {
        unsigned* bar = b.bar;
        __builtin_amdgcn_s_waitcnt(0);
        unsigned nloc = b.st[0], nx = b.st[1];
        if (nloc == 0u) { xcd_barrier_complete(bar, b.x, nloc, nx); b.st[0] = nloc; b.st[1] = nx; }
        const unsigned old = xb_add(&bar[XB_XSUB(b.x)], 1u);
        const unsigned gen = old / nloc;
        if (old + 1u == (gen + 1u) * nloc) {
            __builtin_amdgcn_fence(__ATOMIC_RELEASE, "agent");
            asm volatile("s_waitcnt vmcnt(0)" ::: "memory");
            const unsigned og = xb_add(&bar[XB_TOP], 1u);
            const unsigned tg = og / nx;
            if (og + 1u == (tg + 1u) * nx) xb_add(&bar[XB_TOPGEN], 1u);
            else XB_SPIN(xb_ld(&bar[XB_TOPGEN]) == tg, bar);
            __builtin_amdgcn_fence(__ATOMIC_ACQUIRE, "agent");
            xb_add(&bar[XB_XGEN(b.x)], 1u);
            asm volatile("s_waitcnt vmcnt(0)" ::: "memory");
        } else {
            XB_SPIN(xb_ld(&bar[XB_XGEN(b.x)]) == gen, bar);
            __builtin_amdgcn_fence(__ATOMIC_ACQUIRE, "agent");
            asm volatile("s_waitcnt vmcnt(0)" ::: "memory");
        }
    }
    __syncthreads();
}

struct Frame {
    LAS unsigned char* lds;
    volatile LAS unsigned* MISC;
    gu32* ctl;
    unsigned char* ws;
    int tid, lane, wave;
    int G;
    float* out;
};
__device__ __forceinline__ float wave_sum(float v) {
#pragma unroll
    for (int o = 1; o < 64; o <<= 1) v += __shfl_xor(v, o);
    return v;
}
__device__ __forceinline__ float wave_max(float v) {
#pragma unroll
    for (int o = 1; o < 64; o <<= 1) v = fmaxf(v, __shfl_xor(v, o));
    return v;
}

template <class SrcCol>
__device__ __forceinline__ void transpose_item(const float* W, int ldw, int K, bf16* WT, const float* ks, LAS float* scr, int item, int nblk, int lane, SrcCol src) {
    const int kb = item / nblk, nb = item % nblk, k0 = 64 * kb, n0 = 32 * nb;
    const float* Wp; const int sc = src(n0 + (lane & 31), Wp);
#pragma unroll 8
    for (int i = 0; i < 32; ++i) { const int kk = 2 * i + (lane >> 5); float v = 0.f; if (sc >= 0) { v = Wp[(size_t)(k0 + kk) * ldw + sc]; if (ks) v *= ks[k0 + kk]; } scr[kk * 33 + (lane & 31)] = v; }
    LDS_WAIT(); asm volatile("" ::: "memory");
    const int c = lane & 7;
#pragma unroll
    for (int j = 0; j < 4; ++j) { const int n = (lane >> 3) + 8 * j; const LAS float* s = scr + (8 * c) * 33 + n;
        v4u o; o.x = pk2(s[0 * 33], s[1 * 33]); o.y = pk2(s[2 * 33], s[3 * 33]); o.z = pk2(s[4 * 33], s[5 * 33]); o.w = pk2(s[6 * 33], s[7 * 33]);
        *(GAS v4u*)(WT + (size_t)(n0 + n) * K + k0 + 8 * c) = o; }
    LDS_WAIT(); asm volatile("" ::: "memory");
}
struct Args { const float* in[20]; float* out; unsigned char* ws; int ph_lo, ph_hi; };
template <class SrcCol>
__device__ __forceinline__ void gemv8(Frame& F, const LAS float* vec, int cpg, int ngrp, int ldw, SrcCol src, const float* bias, float* out, int ldo) {
    LAS float* red = (LAS float*)(F.lds + 32768);
    for (int jb = blockIdx.x; jb < ngrp; jb += F.G) {
        const int col = F.tid & 31, kg = F.tid >> 5; float a[8];
#pragma unroll
        for (int b = 0; b < 8; ++b) a[b] = 0.f;
        const float* Wp = nullptr; int sc = -1;
        if (col < cpg) sc = src(jb * cpg + col, Wp);
        if (sc >= 0) for (int k = kg * 64; k < kg * 64 + 64; ++k) { const float w = Wp[(size_t)k * ldw + sc];
#pragma unroll
            for (int b = 0; b < 8; ++b) a[b] += vec[b * 1024 + k] * w; }
#pragma unroll
        for (int b = 0; b < 8; ++b) red[(kg * 8 + b) * 32 + col] = a[b];
        __syncthreads();
        if (F.tid < 256) { const int b = F.tid >> 5, c2 = F.tid & 31;
            if (c2 < cpg) { float s = 0.f; for (int k2 = 0; k2 < 16; ++k2) s += red[(k2 * 8 + b) * 32 + c2]; const int jj = jb * cpg + c2; out[b * ldo + jj] = s + (bias ? bias[jj] : 0.f); } }
        __syncthreads();
    }
}
struct SrcWin { const float* W; __device__ __forceinline__ int operator()(int d, const float*& Wp) const { Wp = W; return d < 584 ? d : (d < 768 ? -1 : d - 184); } };
__device__ __forceinline__ const float* psel(const float* a, const float* b, bool takeb) { const unsigned long long x = (unsigned long long)a, y = (unsigned long long)b, m = takeb ? ~0ull : 0ull; return (const float*)(x ^ ((x ^ y) & m)); }
struct SrcWq { const float *Wa, *Wb; __device__ __forceinline__ int operator()(int d, const float*& Wp) const { Wp = psel(Wa, Wb, d >= 512); return d & 511; } };
struct SrcId { const float* W; __device__ __forceinline__ int operator()(int d, const float*& Wp) const { Wp = W; return d; } };
struct SrcGu { const float *Wg, *Wu; __device__ __forceinline__ int operator()(int d, const float*& Wp) const { const int t = d >> 8, w = d & 255; Wp = psel(Wg, Wu, w >= 128); return t * 128 + (w & 127); } };

__device__ __forceinline__ void p0_prologue(Frame& F, const Args& A) {
    LAS float* cact = (LAS float*)(F.lds);
    for (int i = F.tid; i < 8192; i += NWAVES * 64) { const float v = A.in[1][i]; cact[i] = v / (1.0f + __expf(-v)); }
    __syncthreads();
    gemv8(F, cact, 24, 256, 6144, SrcId{A.in[2]}, A.in[3], (float*)(F.ws + WS_MOD), 6144);
    if (blockIdx.x == 0) { const float* l = A.in[10]; float* LB = (float*)(F.ws + WS_LB);
        for (int c = F.tid; c < 512; c += NWAVES * 64) LB[c] = 1.0f / (1.0f + __expf(l[512 + c] - l[c])); }
    __syncthreads();
    LAS float* scr = (LAS float*)(F.lds + 49152 + F.wave * 8448);
    const int gw = blockIdx.x * NWAVES + F.wave, NGW = F.G * NWAVES;
    constexpr int I_IN = 16 * 152, I_Q = 4 * 32, I_BA = 8 * 32, I_BR = 8 * 32, I_O = 16 * 32, I_GU = 16 * 176, I_D = 44 * 32;
    constexpr int NITEMS = I_IN + I_Q + I_BA + I_BR + I_O + I_GU + I_D;
    for (int it = gw; it < NITEMS; it += NGW) {
        int r = it;
        if (r < I_IN) { transpose_item(A.in[5], NPROJ, 1024, (bf16*)(F.ws + WS_WIN), nullptr, scr, r, 152, F.lane, SrcWin{A.in[5]}); continue; } r -= I_IN;
        if (r < I_Q) { transpose_item(nullptr, 512, 256, (bf16*)(F.ws + WS_WQ), A.in[6], scr, r, 32, F.lane, SrcWq{A.in[7], A.in[8]}); continue; } r -= I_Q;
        if (r < I_BA) { transpose_item(nullptr, 1024, 512, (bf16*)(F.ws + WS_WBA), nullptr, scr, r, 32, F.lane, SrcId{A.in[12]}); continue; } r -= I_BA;
        if (r < I_BR) { transpose_item(nullptr, 1024, 512, (bf16*)(F.ws + WS_WBR), nullptr, scr, r, 32, F.lane, SrcId{A.in[13]}); continue; } r -= I_BR;
        if (r < I_O) { transpose_item(nullptr, 1024, 1024, (bf16*)(F.ws + WS_WOUT), nullptr, scr, r, 32, F.lane, SrcId{A.in[14]}); continue; } r -= I_O;
        if (r < I_GU) { transpose_item(nullptr, FF, 1024, (bf16*)(F.ws + WS_WGU), nullptr, scr, r, 176, F.lane, SrcGu{A.in[16], A.in[17]}); continue; } r -= I_GU;
        transpose_item(nullptr, 1024, FF, (bf16*)(F.ws + WS_WD), nullptr, scr, r, 32, F.lane, SrcId{A.in[18]});
    }
}

__device__ __forceinline__ void p1_norm(Frame& F, const Args& A) {
    const float* MOD = (const float*)(F.ws + WS_MOD);
    { float* CW2 = (float*)(F.ws + WS_CW2); const int g = blockIdx.x * (NWAVES * 64) + F.tid;
      if (g < 8192) { const int b = g >> 10, c = g & 1023; CW2[g] = A.in[15][c] * (1.0f + MOD[b * 6144 + 4096 + c]); } }
    { LAS float* sh2 = (LAS float*)(F.lds);
      for (int i = F.tid; i < 8192; i += NWAVES * 64) sh2[i] = MOD[(i >> 10) * 6144 + 3072 + (i & 1023)];
      __syncthreads();
      gemv8(F, sh2, 22, 256, FF, SrcGu{A.in[16], A.in[17]}, nullptr, (float*)(F.ws + WS_BGU), NGU); }
    const int gw = blockIdx.x * NWAVES + F.wave, NGW = F.G * NWAVES; bf16* XN = (bf16*)(F.ws + WS_XN);
    for (int m = gw; m < M; m += NGW) {
        const int b = m >> 13;
        const GAS f32x4* xr = (const GAS f32x4*)(A.in[0] + (size_t)m * D) + F.lane;
        f32x4 v[4]; float s = 0.f;
#pragma unroll
        for (int j = 0; j < 4; ++j) { v[j] = xr[64 * j]; s += (v[j].x * v[j].x + v[j].y * v[j].y) + (v[j].z * v[j].z + v[j].w * v[j].w); }
        const float r = 1.0f / sqrtf(wave_sum(s) * (1.0f / D) + EPS);
        GAS unsigned long long* o8 = (GAS unsigned long long*)(XN + (size_t)m * D) + F.lane;
#pragma unroll
        for (int j = 0; j < 4; ++j) { const int c = 4 * F.lane + 256 * j;
            const f32x4 w = *(const f32x4*)(A.in[4] + c), sc = *(const f32x4*)(MOD + b * 6144 + 1024 + c), sh = *(const f32x4*)(MOD + b * 6144 + c);
            const f32x4 y = v[j] * r * w * (sc + 1.0f) + sh;
            o8[64 * j] = (unsigned long long)pk2(y.x, y.y) | ((unsigned long long)pk2(y.z, y.w) << 32); }
    }
}

constexpr int H_QC = 0, H_QB = 17408, H_K = 34816, H_KT = 78336, H_VT = 96768, H_PM = 115200, H_ST = 124416, H_BT = 159232, H_AL = 161280;
constexpr int HS128 = 272, HS64 = 144;
__device__ __forceinline__ unsigned short f2bfs(float f) { return (unsigned short)f2bf(f); }
__device__ __forceinline__ void hgrn_h1_unit(Frame& F, int unit) {
    const int b = unit >> 5, h = (unit >> 3) & 3, n = unit & 7;
    const int tid = F.tid, lane = F.lane, w = F.wave, c = tid & 127, bi = tid >> 7, l15 = lane & 15, l4 = lane >> 4;
    const size_t rowbase = (size_t)(b * SEQ + n * 1024) * 512 + h * 128;
    const bf16* RQ = (const bf16*)(F.ws + WS_RQ) + rowbase; const bf16* RGL = (const bf16*)(F.ws + WS_RGL) + rowbase; const bf16* RI = (const bf16*)(F.ws + WS_RI) + rowbase;
    bf16* OLOC = (bf16*)(F.ws + WS_OLOC) + rowbase; bf16* QHAT = (bf16*)(F.ws + WS_QHAT) + rowbase;
    LAS unsigned char* L = F.lds; LAS float* BT = (LAS float*)(L + H_BT); LAS float* AL = (LAS float*)(L + H_AL);
    f32x4 acc[8];
#pragma unroll
    for (int vb = 0; vb < 8; ++vb) acc[vb] = (f32x4){0.f, 0.f, 0.f, 0.f};
    float asup = 0.f;
    for (int i = tid; i < 64 * HS64 / 4; i += NWAVES * 64) ((LAS unsigned*)(L + H_PM))[i] = 0u;
#pragma unroll 1
    for (int ci = 0; ci < 16; ++ci) {
        const size_t r0 = (size_t)(ci * 64 + bi * 16) * 512 + c;
        float gq[16], qq[16], al[16]; unsigned vp[8];
#pragma unroll
        for (int r = 0; r < 16; ++r) { gq[r] = bf1(RGL[r0 + (size_t)r * 512]); qq[r] = bf1(RQ[r0 + (size_t)r * 512]); }
#pragma unroll
        for (int r = 0; r < 8; ++r) vp[r] = (unsigned)RI[r0 + (size_t)(2 * r) * 512] | ((unsigned)RI[r0 + (size_t)(2 * r + 1) * 512] << 16);
        { float run = 0.f;
#pragma unroll
          for (int r = 0; r < 16; ++r) { run += gq[r]; al[r] = run; }
          BT[bi * 128 + c] = run; }
        if (ci > 0) {
#pragma unroll
            for (int vb = 0; vb < 8; ++vb) { v2u o; o.x = pk2(acc[vb][0], acc[vb][1]); o.y = pk2(acc[vb][2], acc[vb][3]);
                *(LAS v2u*)(L + H_ST + (16 * vb + l15) * HS128 + (16 * w + 4 * l4) * 2) = o; } }
        *(LAS v4u*)(L + H_VT + c * HS64 + bi * 32) = (v4u){vp[0], vp[1], vp[2], vp[3]}; *(LAS v4u*)(L + H_VT + c * HS64 + bi * 32 + 16) = (v4u){vp[4], vp[5], vp[6], vp[7]};
        __syncthreads();
        const float b0 = BT[c], b1 = BT[128 + c], b2 = BT[256 + c], b3 = BT[384 + c];
        const float ab1 = b0, ab2 = b0 + b1, ab3 = ab2 + b2, alast = ab3 + b3;
        const float ab = bi == 0 ? 0.f : bi == 1 ? ab1 : bi == 2 ? ab2 : ab3;
        if (bi == 0) AL[c] = alast;
        unsigned kp[8];
#pragma unroll
        for (int r = 0; r < 16; ++r) { const int t = bi * 16 + r; const float Av = ab + al[r];
            *(LAS unsigned short*)(L + H_QC + t * HS128 + c * 2) = f2bfs(qq[r] * __expf(Av));
            QHAT[r0 + (size_t)r * 512] = f2bfs(qq[r] * __expf(Av + asup));
            *(LAS unsigned short*)(L + H_QB + t * HS128 + c * 2) = f2bfs(qq[r] * __expf(al[r]));
            const float kk = 1.0f - __expf(gq[r]);
            const unsigned ke = f2bf(kk * __expf(alast - Av)); if (r & 1) kp[r >> 1] |= ke << 16; else kp[r >> 1] = ke;
            if (bi <= 0) *(LAS unsigned short*)(L + H_K + (0 + t) * HS128 + c * 2) = f2bfs(kk * __expf(0.f - Av));
            if (bi <= 1) *(LAS unsigned short*)(L + H_K + (16 + t) * HS128 + c * 2) = f2bfs(kk * __expf(ab1 - Av));
            if (bi <= 2) *(LAS unsigned short*)(L + H_K + (48 + t) * HS128 + c * 2) = f2bfs(kk * __expf(ab2 - Av));
            *(LAS unsigned short*)(L + H_K + (96 + t) * HS128 + c * 2) = f2bfs(kk * __expf(ab3 - Av)); }
        *(LAS v4u*)(L + H_KT + c * HS64 + bi * 32) = (v4u){kp[0], kp[1], kp[2], kp[3]}; *(LAS v4u*)(L + H_KT + c * HS64 + bi * 32 + 16) = (v4u){kp[4], kp[5], kp[6], kp[7]};
        asup += alast;
        __syncthreads();
#pragma unroll
        for (int rep = 0; rep < 2; ++rep) { const int tile = w + 8 * rep;
            if (tile < 10) { const int i = tile < 1 ? 0 : tile < 3 ? 1 : tile < 6 ? 2 : 3, j = tile - (i * (i + 1)) / 2;
                const LAS unsigned char* ap = L + H_QB + (16 * i + l15) * HS128 + l4 * 16; const LAS unsigned char* bp = L + H_K + (8 * i * (i + 1) + 16 * j + l15) * HS128 + l4 * 16;
                f32x4 p = (f32x4){0.f, 0.f, 0.f, 0.f};
#pragma unroll
                for (int ks = 0; ks < 4; ++ks) p = __builtin_amdgcn_mfma_f32_16x16x32_bf16(*(const LAS bf16x8*)(ap + ks * 64), *(const LAS bf16x8*)(bp + ks * 64), p, 0, 0, 0);
#pragma unroll
                for (int r = 0; r < 4; ++r) { const float pv = (i == j && l15 > 4 * l4 + r) ? 0.f : p[r];
                    *(LAS unsigned short*)(L + H_PM + (16 * i + 4 * l4 + r) * HS64 + (16 * j + l15) * 2) = f2bfs(pv); } } }
        __syncthreads();
#pragma unroll
        for (int tb = 0; tb < 4; ++tb) { f32x4 o = (f32x4){0.f, 0.f, 0.f, 0.f};
#pragma unroll
            for (int ks = 0; ks < 2; ++ks) if (32 * ks < 16 * (tb + 1))
                o = __builtin_amdgcn_mfma_f32_16x16x32_bf16(*(const LAS bf16x8*)(L + H_VT + (16 * w + l15) * HS64 + l4 * 16 + ks * 64), *(const LAS bf16x8*)(L + H_PM + (16 * tb + l15) * HS64 + l4 * 16 + ks * 64), o, 0, 0, 0);
            if (ci > 0) {
#pragma unroll
                for (int ks = 0; ks < 4; ++ks)
                    o = __builtin_amdgcn_mfma_f32_16x16x32_bf16(*(const LAS bf16x8*)(L + H_ST + (16 * w + l15) * HS128 + l4 * 16 + ks * 64), *(const LAS bf16x8*)(L + H_QC + (16 * tb + l15) * HS128 + l4 * 16 + ks * 64), o, 0, 0, 0); }
            v2u ov; ov.x = pk2(o[0], o[1]); ov.y = pk2(o[2], o[3]);
            *(v2u*)(OLOC + (size_t)(ci * 64 + 16 * tb + l15) * 512 + 16 * w + 4 * l4) = ov; }
        { const f32x4 dv = *(const LAS f32x4*)(AL + 16 * w + 4 * l4); const f32x4 d = (f32x4){__expf(dv[0]), __expf(dv[1]), __expf(dv[2]), __expf(dv[3])};
          const bf16x8 ka0 = *(const LAS bf16x8*)(L + H_KT + (16 * w + l15) * HS64 + l4 * 16), ka1 = *(const LAS bf16x8*)(L + H_KT + (16 * w + l15) * HS64 + l4 * 16 + 64);
#pragma unroll
          for (int vb = 0; vb < 8; ++vb) { f32x4 s = acc[vb] * d;
              s = __builtin_amdgcn_mfma_f32_16x16x32_bf16(ka0, *(const LAS bf16x8*)(L + H_VT + (16 * vb + l15) * HS64 + l4 * 16), s, 0, 0, 0);
              s = __builtin_amdgcn_mfma_f32_16x16x32_bf16(ka1, *(const LAS bf16x8*)(L + H_VT + (16 * vb + l15) * HS64 + l4 * 16 + 64), s, 0, 0, 0);
              acc[vb] = s; } }
        __syncthreads();
    }
    f32x4* U = (f32x4*)(F.ws + WS_U);
#pragma unroll
    for (int vb = 0; vb < 8; ++vb) U[(size_t)((unit * 8 + w) * 8 + vb) * 64 + lane] = acc[vb];
    if (bi == 0) ((float*)(F.ws + WS_DS))[unit * 128 + c] = __expf(asup);
}
__device__ __forceinline__ void hgrn_h3_unit(Frame& F, const Args& A, int unit) {
    const int b = unit >> 5, h = (unit >> 3) & 3, n = unit & 7;
    const int lane = F.lane, w = F.wave, l15 = lane & 15, l4 = lane >> 4;
    LAS unsigned char* L = F.lds;
    const f32x4* U = (const f32x4*)(F.ws + WS_U); const float* DS = (const float*)(F.ws + WS_DS);
    f32x4 S[8];
#pragma unroll
    for (int vb = 0; vb < 8; ++vb) S[vb] = (f32x4){0.f, 0.f, 0.f, 0.f};
    for (int m = 0; m < n; ++m) { const int um = unit - n + m; const f32x4 d = *(const f32x4*)(DS + um * 128 + 16 * w + 4 * l4);
#pragma unroll
        for (int vb = 0; vb < 8; ++vb) S[vb] = S[vb] * d + U[(size_t)((um * 8 + w) * 8 + vb) * 64 + lane]; }
#pragma unroll
    for (int vb = 0; vb < 8; ++vb) { v2u o; o.x = pk2(S[vb][0], S[vb][1]); o.y = pk2(S[vb][2], S[vb][3]);
        *(LAS v2u*)(L + H_ST + (16 * vb + l15) * HS128 + (16 * w + 4 * l4) * 2) = o; }
    __syncthreads();
    const size_t rowbase = (size_t)(b * SEQ + n * 1024 + 128 * w) * 512 + h * 128;
    const bf16* QHAT = (const bf16*)(F.ws + WS_QHAT) + rowbase; const bf16* OLOC = (const bf16*)(F.ws + WS_OLOC) + rowbase;
    const bf16* RGS = (const bf16*)(F.ws + WS_RGS) + rowbase; bf16* REC = (bf16*)(F.ws + WS_REC) + rowbase;
    f32x4 rw[8];
#pragma unroll
    for (int vb = 0; vb < 8; ++vb) rw[vb] = *(const f32x4*)(A.in[11] + 16 * vb + 4 * l4);
#pragma unroll 1
    for (int tb = 0; tb < 8; ++tb) { const size_t tr = (size_t)(16 * tb + l15) * 512;
        bf16x8 qh[4];
#pragma unroll
        for (int ks = 0; ks < 4; ++ks) qh[ks] = *(const bf16x8*)(QHAT + tr + 32 * ks + 8 * l4);
        f32x4 o[8]; float ss = 0.f;
#pragma unroll
        for (int vb = 0; vb < 8; ++vb) { f32x4 a = (f32x4){0.f, 0.f, 0.f, 0.f};
            if (n > 0) {
#pragma unroll
                for (int ks = 0; ks < 4; ++ks) a = __builtin_amdgcn_mfma_f32_16x16x32_bf16(*(const LAS bf16x8*)(L + H_ST + (16 * vb + l15) * HS128 + l4 * 16 + ks * 64), qh[ks], a, 0, 0, 0); }
            const v2u ol = *(const v2u*)(OLOC + tr + 16 * vb + 4 * l4);
            a[0] += bflo(ol.x); a[1] += bfhi(ol.x); a[2] += bflo(ol.y); a[3] += bfhi(ol.y);
            o[vb] = a; ss += (a[0] * a[0] + a[1] * a[1]) + (a[2] * a[2] + a[3] * a[3]); }
        ss += __shfl_xor(ss, 16); ss += __shfl_xor(ss, 32);
        const float r = 1.0f / sqrtf(ss * (1.0f / 128.0f) + EPS);
#pragma unroll
        for (int vb = 0; vb < 8; ++vb) { const v2u g = *(const v2u*)(RGS + tr + 16 * vb + 4 * l4); const f32x4 y = o[vb] * r * rw[vb];
            v2u ov; ov.x = pk2(y[0] * bflo(g.x), y[1] * bfhi(g.x)); ov.y = pk2(y[2] * bflo(g.y), y[3] * bfhi(g.y));
            *(v2u*)(REC + tr + 16 * vb + 4 * l4) = ov; }
    }
    __syncthreads();
}

__device__ __forceinline__ unsigned f2key(float x) {
    const _Float16 hh = (_Float16)x; const unsigned bits = (unsigned)__builtin_bit_cast(unsigned short, hh);
    return (bits & 0x8000u) ? (~bits & 0xffffu) : (bits | 0x8000u);
}
__device__ __forceinline__ void dsa_unit(Frame& F, int b, int t0) {
    const int lane = F.lane, w = F.wave, qc = lane & 31, hf = lane >> 5;
    const bf16* KI = (const bf16*)(F.ws + WS_KI) + (size_t)b * SEQ * 64;
    const bf16* QI = (const bf16*)(F.ws + WS_QI) + (size_t)(b * SEQ + t0) * 512;
    const float* WI = (const float*)(F.ws + WS_WI) + (size_t)(b * SEQ + t0) * 8;
    unsigned short* scr = (unsigned short*)(F.ws + WS_SCR) + (size_t)blockIdx.x * (32 * 8192);
    const int nkb = t0 / 32 + 1;
#ifndef NO_PASS1
    {
        bf16x8 qf[8][4]; float wv[8];
#pragma unroll
        for (int h = 0; h < 8; ++h) { wv[h] = WI[qc * 8 + h];
#pragma unroll
            for (int ks = 0; ks < 4; ++ks) qf[h][ks] = *(const bf16x8*)(QI + (size_t)qc * 512 + h * 64 + ks * 16 + hf * 8); }
#pragma unroll 1
        for (int kb = w; kb < nkb; kb += NWAVES) {
            const int s0 = kb * 32; bf16x8 kf[4];
#pragma unroll
            for (int ks = 0; ks < 4; ++ks) kf[ks] = *(const bf16x8*)(KI + (size_t)(s0 + qc) * 64 + ks * 16 + hf * 8);
            f32x16 sc;
#pragma unroll
            for (int r = 0; r < 16; ++r) sc[r] = 0.f;
#pragma unroll
            for (int h = 0; h < 8; ++h) { f32x16 a;
#pragma unroll
                for (int r = 0; r < 16; ++r) a[r] = 0.f;
#pragma unroll
                for (int ks = 0; ks < 4; ++ks) a = __builtin_amdgcn_mfma_f32_32x32x16_bf16(kf[ks], qf[h][ks], a, 0, 0, 0);
                asm volatile("s_nop 15\n\ts_nop 7" : "+v"(a));
#pragma unroll
                for (int r = 0; r < 16; ++r) asm volatile("v_max_f32 %1, 0, %1\n\tv_fmac_f32 %0, %2, %1" : "+v"(sc[r]), "+v"(a[r]) : "v"(wv[h]));
                __builtin_amdgcn_sched_barrier(0); }
#pragma unroll
            for (int rr = 0; rr < 4; ++rr) { unsigned kk[4];
#pragma unroll
                for (int i = 0; i < 4; ++i) { const int key = s0 + 8 * rr + 4 * hf + i; kk[i] = (key <= t0 + qc) ? f2key(sc[4 * rr + i]) : 0u; }
                v2u o; o.x = kk[0] | (kk[1] << 16); o.y = kk[2] | (kk[3] << 16);
                *(v2u*)(scr + (size_t)qc * 8192 + s0 + 8 * rr + 4 * hf) = o; }
        }
    }
#endif
    __syncthreads();
    LAS float* Pw = (LAS float*)(F.lds) + w * 2048; LAS unsigned short* idxl = (LAS unsigned short*)(F.lds + 65536) + w * 256;
    const LAS float* rb = (const LAS float*)(F.lds + 69632); const LAS int* lut = (const LAS int*)(F.lds + 70656);
    const bf16* KV = (const bf16*)(F.ws + WS_KV) + (size_t)b * SEQ * 256;
    const int nk = nkb * 32, ndw = nk >> 1;
#pragma unroll 1
    for (int qq = 0; qq < 4; ++qq) {
        const int ql = w * 4 + qq, t = t0 + ql, nvalid = t + 1, nsel = nvalid < 256 ? nvalid : 256;
        const unsigned* rowd = (const unsigned*)(scr + (size_t)ql * 8192);
        int ln = lane; asm volatile("" : "+v"(ln));
        unsigned rv[64];
#pragma unroll
        for (int j = 0; j < 64; ++j) { const unsigned val = rowd[j * 64 + ln]; rv[j] = (ln < ndw - j * 64) ? val : 0u; }
        unsigned T = 0u; int need = 0;
        if (nvalid > 256) {
#pragma unroll 1
            for (int bit = 15; bit >= 0; --bit) { const unsigned cand = T | (1u << bit); int c = 0;
#pragma unroll
                for (int g = 0; g < 8; ++g) if (g * 1024 < nk) {
#pragma unroll
                    for (int j = 8 * g; j < 8 * g + 8; ++j) { c += ((rv[j] & 0xffffu) >= cand) ? 1 : 0; c += ((rv[j] >> 16) >= cand) ? 1 : 0; } }
#pragma unroll
                for (int o = 1; o < 64; o <<= 1) c += __shfl_xor(c, o);
                if (c >= 256) T = cand; }
            int c = 0;
#pragma unroll
            for (int g = 0; g < 8; ++g) if (g * 1024 < nk) {
#pragma unroll
                for (int j = 8 * g; j < 8 * g + 8; ++j) { c += ((rv[j] & 0xffffu) > T) ? 1 : 0; c += ((rv[j] >> 16) > T) ? 1 : 0; } }
#pragma unroll
            for (int o = 1; o < 64; o <<= 1) c += __shfl_xor(c, o);
            need = 256 - c;
        }
        {
            int base = 0, tiebase = 0; const unsigned long long lt = (1ull << ln) - 1ull; const int ln2 = 2 * ln;
#pragma unroll
            for (int g = 0; g < 8; ++g) if (g * 1024 < nk) {
#pragma unroll
                for (int j = 8 * g; j < 8 * g + 8; ++j) { const unsigned lo = rv[j] & 0xffffu, hi = rv[j] >> 16;
                    const bool el = lo == T, eh = hi == T; const unsigned long long mel = __ballot(el), meh = __ballot(eh);
                    const int trl = tiebase + __popcll(mel & lt) + __popcll(meh & lt), trh = trl + (el ? 1 : 0);
                    const bool sl = lo > T || (el && trl < need), sh = hi > T || (eh && trh < need);
                    const unsigned long long msl = __ballot(sl), msh = __ballot(sh);
                    const int pl = base + __popcll(msl & lt) + __popcll(msh & lt), ph = pl + (sl ? 1 : 0);
                    if (sl && pl < 256) idxl[pl] = (unsigned short)(ln2 + 128 * j); if (sh && ph < 256) idxl[ph] = (unsigned short)(ln2 + 128 * j + 1);
                    base += __popcll(msl) + __popcll(msh); tiebase += __popcll(mel) + __popcll(meh); __builtin_amdgcn_sched_barrier(0); } }
        }
        LDS_WAIT(); asm volatile("" ::: "memory");
#ifndef NO_ATT
        const unsigned* qrow = (const unsigned*)((const bf16*)(F.ws + WS_Q) + (size_t)(b * SEQ + t) * 512);
        float sc[8][4]; int sk[4]; const v4u* kr[4];
#pragma unroll
        for (int jj = 0; jj < 4; ++jj) { const int j = lane + 64 * jj; sk[jj] = (j < nsel) ? (int)idxl[j] : 0; kr[jj] = (const v4u*)(KV + (size_t)sk[jj] * 256); }
#pragma unroll
        for (int g = 0; g < 2; ++g) { float d4[4][4];
#pragma unroll
            for (int jj = 0; jj < 4; ++jj)
#pragma unroll
                for (int h4 = 0; h4 < 4; ++h4) d4[jj][h4] = 0.f;
#pragma unroll 1
            for (int c8 = 0; c8 < 8; ++c8) { unsigned qd[4][4];
#pragma unroll
                for (int h4 = 0; h4 < 4; ++h4)
#pragma unroll
                    for (int i = 0; i < 4; ++i) qd[h4][i] = qrow[(g * 4 + h4) * 32 + c8 * 4 + i];
#pragma unroll
                for (int jj = 0; jj < 4; ++jj) { const v4u kk = kr[jj][g * 8 + c8];
                    const float k0 = bflo(kk.x), k1 = bfhi(kk.x), k2 = bflo(kk.y), k3 = bfhi(kk.y), k4 = bflo(kk.z), k5 = bfhi(kk.z), k6 = bflo(kk.w), k7 = bfhi(kk.w);
#pragma unroll
                    for (int h4 = 0; h4 < 4; ++h4)
                        d4[jj][h4] += (k0 * bflo(qd[h4][0]) + k1 * bfhi(qd[h4][0])) + (k2 * bflo(qd[h4][1]) + k3 * bfhi(qd[h4][1])) + (k4 * bflo(qd[h4][2]) + k5 * bfhi(qd[h4][2])) + (k6 * bflo(qd[h4][3]) + k7 * bfhi(qd[h4][3])); } }
#pragma unroll
            for (int jj = 0; jj < 4; ++jj) { const int dist = t - sk[jj]; const int bk = dist < 128 ? lut[dist] : 31; const bool valid = (lane + 64 * jj) < nsel;
#pragma unroll
                for (int h4 = 0; h4 < 4; ++h4) sc[g * 4 + h4][jj] = valid ? d4[jj][h4] + rb[bk * 8 + g * 4 + h4] : -INFINITY; } }
#pragma unroll
        for (int h = 0; h < 8; ++h) { const float mx = wave_max(fmaxf(fmaxf(sc[h][0], sc[h][1]), fmaxf(sc[h][2], sc[h][3]))); float e[4], su = 0.f;
#pragma unroll
            for (int jj = 0; jj < 4; ++jj) { e[jj] = __expf(sc[h][jj] - mx); su += e[jj]; }
            const float inv = 1.0f / wave_sum(su);
#pragma unroll
            for (int jj = 0; jj < 4; ++jj) sc[h][jj] = e[jj] * inv; }
#pragma unroll
        for (int jj = 0; jj < 4; ++jj) { const int j = lane + 64 * jj;
            *(LAS f32x4*)(Pw + j * 8) = (f32x4){sc[0][jj], sc[1][jj], sc[2][jj], sc[3][jj]}; *(LAS f32x4*)(Pw + j * 8 + 4) = (f32x4){sc[4][jj], sc[5][jj], sc[6][jj], sc[7][jj]}; }
        LDS_WAIT(); asm volatile("" ::: "memory");
        float oa[8];
#pragma unroll
        for (int h = 0; h < 8; ++h) oa[h] = 0.f;
        for (int j = 0; j < nsel; ++j) { const int s = idxl[j]; const bf16* vr = KV + (size_t)s * 256 + 128;
            const float v0 = bf1(vr[lane]), v1 = bf1(vr[64 + lane]); const f32x4 p0 = *(const LAS f32x4*)(Pw + j * 8), p1 = *(const LAS f32x4*)(Pw + j * 8 + 4);
            oa[0] += p0[0] * v0; oa[1] += p0[1] * v0; oa[2] += p0[2] * v0; oa[3] += p0[3] * v0; oa[4] += p1[0] * v1; oa[5] += p1[1] * v1; oa[6] += p1[2] * v1; oa[7] += p1[3] * v1; }
        bf16* orow = (bf16*)(F.ws + WS_ATT) + (size_t)(b * SEQ + t) * 512;
#pragma unroll
        for (int h = 0; h < 8; ++h) orow[h * 64 + lane] = (bf16)f2bf(oa[h]);
#endif
        LDS_WAIT(); asm volatile("" ::: "memory");
    }
    __syncthreads();
}

__device__ __forceinline__ void p4_mixers(Frame& F, const Args& A) {
    for (int u = blockIdx.x; u < 256; u += F.G) hgrn_h1_unit(F, u);
    __syncthreads();
    { LAS float* rb = (LAS float*)(F.lds + 69632); LAS int* lut = (LAS int*)(F.lds + 70656);
      if (F.tid < 256) rb[F.tid] = A.in[9][F.tid];
      if (F.tid < 128) { const int n = F.tid; int v = n; if (n >= 16) { v = 16 + (int)(__logf((float)n * (1.0f / 16.0f)) * (16.0f / 2.0794415416798357f)); v = v < 31 ? v : 31; } lut[n] = v; }
      __syncthreads(); }
    for (int u = blockIdx.x; u < 2048; u += F.G) { const int b = u & 7, qb = 255 - (u >> 3); dsa_unit(F, b, qb * 32); }
}

__device__ __forceinline__ void p5_rec(Frame& F, const Args& A) { for (int u = blockIdx.x; u < 256; u += F.G) hgrn_h3_unit(F, A, u); }

__device__ __forceinline__ void p10_final(Frame& F, const Args& A) {
    const int gw = blockIdx.x * NWAVES + F.wave, NGW = F.G * NWAVES; const float* SS = (const float*)(F.ws + WS_X2SS);
    for (int m = gw; m < M; m += NGW) {
        float s = F.lane < 16 ? SS[(size_t)m * 16 + F.lane] : 0.f; s = wave_sum(s);
        const float r = 1.0f / sqrtf(s * (1.0f / D) + EPS);
        GAS f32x4* xr = (GAS f32x4*)(F.out + (size_t)m * D) + F.lane;
#pragma unroll
        for (int j = 0; j < 4; ++j) { const f32x4 w = *(const f32x4*)(A.in[19] + 4 * F.lane + 256 * j); xr[64 * j] = xr[64 * j] * r * w; }
    }
}

__global__ void __launch_bounds__(NWAVES * 64, 2) fwd_kernel(Args args) {
    extern __shared__ __attribute__((aligned(16))) unsigned char lds[];
    Frame F;
    F.lds = (LAS unsigned char*)lds;
    F.MISC = (volatile LAS unsigned*)(F.lds + MISC_OFF);
    F.tid = threadIdx.x; F.lane = F.tid & 63; F.wave = __builtin_amdgcn_readfirstlane(F.tid >> 6);
    F.G = gridDim.x;
    F.ws = args.ws; F.ctl = (gu32*)(args.ws + WS_CTL); F.out = args.out;
    for (int u = F.tid; u < (LDS_BYTES - LDSCTL_OFF) / 4; u += NWAVES * 64) ((LAS unsigned*)(F.lds + LDSCTL_OFF))[u] = 0u;
    __syncthreads();
    XcdBarrier bar; bar.bar = (unsigned*)(F.ctl + CW_BAR); bar.x = 0; bar.st = nullptr;
    if (N_LAUNCHES == 1) bar = xcd_barrier_post((unsigned*)(F.ctl + CW_BAR), F.MISC + 8);
#define GRID_BAR() do { if (N_LAUNCHES == 1) xcd_barrier(bar); } while (0)
    const int lo = args.ph_lo, hi = args.ph_hi;
#ifdef ONLY_PHASE
#define IN(k) ((k) == ONLY_PHASE && lo <= (k) && (k) < hi)
#else
#define IN(k) (lo <= (k) && (k) < hi)
#endif
#define BOTH(k) (IN(k) && IN((k) + 1))
    const float* MOD = (const float*)(F.ws + WS_MOD);

    if (IN(0)) { p0_prologue(F, args); if (BOTH(0)) GRID_BAR(); }
    if (IN(1)) { p1_norm(F, args); if (BOTH(1)) GRID_BAR(); }
    if (IN(2)) {
        pg8::Gemm g{(const bf16*)(F.ws + WS_XN), (const bf16*)(F.ws + WS_WIN), M, NPROJ_PAD, 1024}; pg8::StaticOrder S; S.init(M, NPROJ_PAD, F.G, (int)blockIdx.x);
        pg8::EpiInProj E{(bf16*)(F.ws + WS_CQ), (bf16*)(F.ws + WS_KV), (bf16*)(F.ws + WS_KI), (bf16*)(F.ws + WS_RQ), (bf16*)F.out,
                         (float*)(F.ws + WS_WI), (float*)(F.ws + WS_CQSS), (const float*)(F.ws + WS_LB)};
        pg8::gemm_phase<pg8::EpiInProj, pg8::StaticOrder, PG8_ALIGN, PG8_SP2>(F.lds + RING_OFF, g, S, E);
        if (BOTH(2)) GRID_BAR();
    }
    if (IN(3)) {
        pg8::Gemm g{(const bf16*)(F.ws + WS_CQ), (const bf16*)(F.ws + WS_WQ), M, 1024, 256}; pg8::StaticOrder S; S.init(M, 1024, F.G, (int)blockIdx.x);
        pg8::EpiQ E{(bf16*)(F.ws + WS_Q), (const float*)(F.ws + WS_CQSS)};
        pg8::gemm_phase<pg8::EpiQ, pg8::StaticOrder, PG8_ALIGN, PG8_SP2>(F.lds + RING_OFF, g, S, E);
        if (BOTH(3)) GRID_BAR();
    }
    if (IN(4)) { p4_mixers(F, args); if (BOTH(4)) GRID_BAR(); }
    if (IN(5)) { p5_rec(F, args); if (BOTH(5)) GRID_BAR(); }
    if (IN(6)) {
        pg8::StaticOrder S; S.init(M, 1024, F.G, (int)blockIdx.x);
        { pg8::Gemm g{(const bf16*)(F.ws + WS_ATT), (const bf16*)(F.ws + WS_WBA), M, 1024, 512}; pg8::EpiBranch<0> E{(bf16*)(F.ws + WS_MIX), (const bf16*)F.out};
          pg8::gemm_phase<pg8::EpiBranch<0>, pg8::StaticOrder, PG8_ALIGN, PG8_SP2>(F.lds + RING_OFF, g, S, E); }
        { pg8::Gemm g{(const bf16*)(F.ws + WS_REC), (const bf16*)(F.ws + WS_WBR), M, 1024, 512}; pg8::EpiBranch<1> E{(bf16*)(F.ws + WS_MIX), (const bf16*)F.out};
          pg8::gemm_phase<pg8::EpiBranch<1>, pg8::StaticOrder, PG8_ALIGN, PG8_SP2>(F.lds + RING_OFF, g, S, E); }
        if (BOTH(6)) GRID_BAR();
    }
    if (IN(7)) {
        pg8::Gemm g{(const bf16*)(F.ws + WS_MIX), (const bf16*)(F.ws + WS_WOUT), M, 1024, 1024}; pg8::StaticOrder S; S.init(M, 1024, F.G, (int)blockIdx.x);
        pg8::EpiOut E{args.in[0], (float*)(F.ws + WS_X1), (bf16*)(F.ws + WS_XS), (float*)(F.ws + WS_X1SS), MOD, (const float*)(F.ws + WS_CW2)};
        pg8::gemm_phase<pg8::EpiOut, pg8::StaticOrder, PG8_ALIGN, PG8_SP2>(F.lds + RING_OFF, g, S, E);
        if (BOTH(7)) GRID_BAR();
    }
    if (IN(8)) {
        pg8::Gemm g{(const bf16*)(F.ws + WS_XS), (const bf16*)(F.ws + WS_WGU), M, NGU, 1024}; pg8::StaticOrder S; S.init(M, NGU, F.G, (int)blockIdx.x);
        pg8::EpiGateUp E{(bf16*)(F.ws + WS_HID), (const float*)(F.ws + WS_X1SS), (const float*)(F.ws + WS_BGU)};
        pg8::gemm_phase<pg8::EpiGateUp, pg8::StaticOrder, PG8_ALIGN, PG8_SP2>(F.lds + RING_OFF, g, S, E);
        if (BOTH(8)) GRID_BAR();
    }
    if (IN(9)) {
        pg8::Gemm g{(const bf16*)(F.ws + WS_HID), (const bf16*)(F.ws + WS_WD), M, 1024, FF}; pg8::StaticOrder S; S.init(M, 1024, F.G, (int)blockIdx.x);
        pg8::EpiDown E{(const float*)(F.ws + WS_X1), F.out, (float*)(F.ws + WS_X2SS), MOD};
        pg8::gemm_phase<pg8::EpiDown, pg8::StaticOrder, PG8_ALIGN, PG8_SP2>(F.lds + RING_OFF, g, S, E);
        if (BOTH(9)) GRID_BAR();
    }
    if (IN(10)) p10_final(F, args);
#undef IN
#undef BOTH
}

extern "C" void kernel_launch(void* const* d_in, const int* in_sizes, int n_in, void* d_out, int out_size, void* d_ws, size_t ws_size, hipStream_t stream) {
    static int grid = 0;
    if (grid == 0) {
        if (n_in != 20 || in_sizes[0] != M * D || out_size != M * D || ws_size < WS_END) { fprintf(stderr, "kernel_launch: unexpected shapes (n_in %d, in0 %d, out %d, ws %zu); nothing launched\n", n_in, n_in > 0 ? in_sizes[0] : -1, out_size, ws_size); grid = -1; return; }
        int dev = 0, cus = 0, per_cu = 0;
        if (hipGetDevice(&dev) != hipSuccess || hipDeviceGetAttribute(&cus, hipDeviceAttributeMultiprocessorCount, dev) != hipSuccess) { grid = -1; return; }
        if (hipFuncSetAttribute((const void*)fwd_kernel, hipFuncAttributeMaxDynamicSharedMemorySize, LDS_BYTES) != hipSuccess) { fprintf(stderr, "kernel_launch: hipFuncSetAttribute failed\n"); grid = -1; return; }
        if (hipOccupancyMaxActiveBlocksPerMultiprocessor(&per_cu, (const void*)fwd_kernel, NWAVES * 64, LDS_BYTES) != hipSuccess || per_cu < 1)
            fprintf(stderr, "kernel_launch: note: occupancy query reports %d workgroups per CU\n", per_cu);
        (void)hipGetLastError();
        grid = cus;
    }
    if (grid < 0) return;
    if (hipMemsetAsync((char*)d_ws + WS_CTL, 0, CTL_ZERO_BYTES, stream) != hipSuccess) { fprintf(stderr, "kernel_launch: memset failed\n"); return; }
    Args a{};
    for (int i = 0; i < 20; ++i) a.in[i] = (const float*)d_in[i];
    a.out = (float*)d_out; a.ws = (unsigned char*)d_ws;
    for (int li = 0; li < N_LAUNCHES; ++li) {
        a.ph_lo = (N_LAUNCHES == 1) ? 0 : li; a.ph_hi = (N_LAUNCHES == 1) ? N_PHASES : li + 1;
        hipLaunchKernelGGL(fwd_kernel, dim3(grid), dim3(NWAVES * 64), LDS_BYTES, stream, a);
        const hipError_t le = hipPeekAtLastError();
        if (le != hipSuccess) { fprintf(stderr, "kernel_launch: launch %d failed: %s\n", li, hipGetErrorName(le)); break; }
    }
}
```

```cpp
#include <hip/hip_runtime.h>
#include <cstdio>
#include <cstdint>
namespace pg8 {
#define PG8_LAS __attribute__((address_space(3)))
typedef unsigned short bf16_t;
typedef short bf16x8 __attribute__((ext_vector_type(8)));
typedef float f32x4 __attribute__((ext_vector_type(4)));
typedef unsigned u32x4 __attribute__((ext_vector_type(4)));
constexpr int BM = 256, BK = 64, HALF = 128, HTB = HALF * BK * 2  , STAGE_BYTES = 8 * HTB, NXCD = 8, WGM = 8;

__host__ __device__ __forceinline__ int lds_byte(int r, int c) { const int st = (r >> 4) * 2 + (c >> 5), rr = r & 15, cc = c & 31, ob = rr * 64 + cc * 2; return st * 1024 + (ob ^ (((ob >> 9) & 1) << 5)); }
__host__ __device__ __forceinline__ void stage_rc(int b, int& R, int& C) { const int st = b / 1024, sb = b % 1024, swz = sb ^ (((sb >> 9) & 1) << 5); R = (st >> 1) * 16 + swz / 64; C = (st & 1) * 32 + (swz % 64) / 2; }
__host__ __device__ __forceinline__ int perm32(int rho) { const int n = rho >> 4, i = rho & 15; return 8 * (i >> 2) + 4 * n + (i & 3); }

struct Unit { int pm, pn; };
struct Gemm { const bf16_t* A; const bf16_t* Bt; int M, N, K; };

struct StaticOrder {
    int nM, nN, nwg, G, c;
    __host__ __device__ void init(int M, int N, int G_, int c_) { nM = M / BM; nN = N / BM; nwg = nM * nN; G = G_; c = c_; }
    __host__ __device__ bool next(int i, Unit& u) const {
        const long L = (long)i * G + c; if (L >= nwg) return false;
        int wgid = (int)L; { const int q = nwg / NXCD, r = nwg % NXCD, xcd = wgid % NXCD, off = wgid / NXCD; wgid = (xcd < r ? xcd * (q + 1) : r * (q + 1) + (xcd - r) * q) + off; }
        const int nig = WGM * nN, gid = wgid / nig, fm = gid * WGM, gsz = (nM - fm) < WGM ? (nM - fm) : WGM;
        u.pm = fm + ((wgid % nig) % gsz); u.pn = (wgid % nig) / gsz; return true;
    }
    __device__ __forceinline__ void a_ready(const Unit&) const {}
    __device__ __forceinline__ void done(const Unit&) const {}
};

__device__ __forceinline__ unsigned cvt_pk_bf16(float lo, float hi) { unsigned r; asm volatile("v_cvt_pk_bf16_f32 %0, %1, %2" : "=v"(r) : "v"(lo), "v"(hi)); return r; }
__device__ __forceinline__ float fsigmoid(float x) { return __builtin_amdgcn_rcpf(1.0f + __expf(-x)); }
__device__ __forceinline__ float fsilu(float x) { return x * fsigmoid(x); }
__device__ __forceinline__ u32x4 pack8(const f32x4 a, const f32x4 b) { u32x4 w; w.x = cvt_pk_bf16(a[0], a[1]); w.y = cvt_pk_bf16(a[2], a[3]); w.z = cvt_pk_bf16(b[0], b[1]); w.w = cvt_pk_bf16(b[2], b[3]); return w; }
__device__ __forceinline__ float bf_lo(unsigned u) { return __builtin_bit_cast(float, u << 16); }
__device__ __forceinline__ float bf_hi(unsigned u) { return __builtin_bit_cast(float, u & 0xffff0000u); }

struct EpiInProj {
    static constexpr bool PERM = true, AFTER_DRAIN = false;
    bf16_t *CQ, *KV, *KI, *RQ, *GATES; float *WI, *CQSS; const float* LB;
    __device__ __forceinline__ void operator()(const f32x4 (&acc)[2][2][4][2], const Unit& u, int wr, int wc, int fr, int fq) const {
        const int row0 = u.pm * BM + wr * 64 + fr, pn = u.pn, cl = wc * 32 + 8 * fq;
        if (pn == 0) {
#pragma unroll
            for (int ai = 0; ai < 2; ++ai)
#pragma unroll
                for (int m = 0; m < 4; ++m) { const int row = row0 + ai * HALF + m * 16; float s = 0.f;
#pragma unroll
                    for (int bj = 0; bj < 2; ++bj) { const f32x4 a = acc[ai][bj][m][0], b = acc[ai][bj][m][1];
                        s += (a[0] * a[0] + a[1] * a[1]) + (a[2] * a[2] + a[3] * a[3]) + (b[0] * b[0] + b[1] * b[1]) + (b[2] * b[2] + b[3] * b[3]);
                        *(u32x4*)(CQ + (size_t)row * 256 + cl + bj * HALF) = pack8(a, b); }
                    s += __shfl_xor(s, 16); s += __shfl_xor(s, 32);
                    if (fq == 0) CQSS[(size_t)row * 4 + wc] = s; }
        } else if (pn == 1) {
#pragma unroll
            for (int ai = 0; ai < 2; ++ai)
#pragma unroll
                for (int m = 0; m < 4; ++m) { const int row = row0 + ai * HALF + m * 16;
#pragma unroll
                    for (int bj = 0; bj < 2; ++bj) *(u32x4*)(KV + (size_t)row * 256 + cl + bj * HALF) = pack8(acc[ai][bj][m][0], acc[ai][bj][m][1]); }
        } else if (pn == 2) {
#pragma unroll
            for (int ai = 0; ai < 2; ++ai)
#pragma unroll
                for (int m = 0; m < 4; ++m) { const int row = row0 + ai * HALF + m * 16;
                    if (wc < 2) *(u32x4*)(KI + (size_t)row * 64 + cl) = pack8(acc[ai][0][m][0], acc[ai][0][m][1]);
                    else if (wc == 2 && fq == 0) { *(f32x4*)(WI + (size_t)row * 8) = acc[ai][0][m][0]; *(f32x4*)(WI + (size_t)row * 8 + 4) = acc[ai][0][m][1]; } }
        } else if (pn <= 10) {
            const int kind = (pn - 3) >> 1, cb = ((pn - 3) & 1) * 256 + cl;
            bf16_t* dst = RQ + (size_t)kind * (size_t)(32u << 20);
#pragma unroll
            for (int bj = 0; bj < 2; ++bj) {
                f32x4 l0 = (f32x4){0.f, 0.f, 0.f, 0.f}, l1 = l0;
                if (kind == 1) { l0 = *(const f32x4*)(LB + cb + bj * HALF); l1 = *(const f32x4*)(LB + cb + bj * HALF + 4); }
#pragma unroll
                for (int ai = 0; ai < 2; ++ai)
#pragma unroll
                    for (int m = 0; m < 4; ++m) { const int row = row0 + ai * HALF + m * 16; f32x4 a = acc[ai][bj][m][0], b = acc[ai][bj][m][1];
                        if (kind == 0 || kind == 3) {
#pragma unroll
                            for (int j = 0; j < 4; ++j) { a[j] = fsilu(a[j]); b[j] = fsilu(b[j]); } }
                        else if (kind == 1) {
#pragma unroll
                            for (int j = 0; j < 4; ++j) { a[j] = __logf(l0[j] + (1.0f - l0[j]) * fsigmoid(a[j])); b[j] = __logf(l1[j] + (1.0f - l1[j]) * fsigmoid(b[j])); } }
                        *(u32x4*)(dst + (size_t)row * 512 + cb + bj * HALF) = pack8(a, b); }
            }
        } else {
            const int cb = (pn - 11) * 256 + cl;
#pragma unroll
            for (int ai = 0; ai < 2; ++ai)
#pragma unroll
                for (int m = 0; m < 4; ++m) { const int row = row0 + ai * HALF + m * 16;
#pragma unroll
                    for (int bj = 0; bj < 2; ++bj) { f32x4 a = acc[ai][bj][m][0], b = acc[ai][bj][m][1];
#pragma unroll
                        for (int j = 0; j < 4; ++j) { a[j] = fsigmoid(a[j]); b[j] = fsigmoid(b[j]); }
                        *(u32x4*)(GATES + (size_t)row * 2048 + cb + bj * HALF) = pack8(a, b); } }
        }
    }
};

struct EpiQ {
    static constexpr bool PERM = true, AFTER_DRAIN = false;
    bf16_t *Q; const float* CQSS;
    __device__ __forceinline__ void operator()(const f32x4 (&acc)[2][2][4][2], const Unit& u, int wr, int wc, int fr, int fq) const {
        const int row0 = u.pm * BM + wr * 64 + fr, pn = u.pn, cl = (pn & 1) * 256 + wc * 32 + 8 * fq;
        bf16_t* dst = Q + (pn < 2 ? (size_t)0 : (size_t)(32u << 20));
        const float sc = pn < 2 ? 0.125f : 1.0f;
#pragma unroll
        for (int ai = 0; ai < 2; ++ai)
#pragma unroll
            for (int m = 0; m < 4; ++m) { const int row = row0 + ai * HALF + m * 16;
                const f32x4 ss = *(const f32x4*)(CQSS + (size_t)row * 4);
                const float r = __builtin_amdgcn_rsqf(((ss[0] + ss[1]) + (ss[2] + ss[3])) * (1.0f / 256.0f) + 1e-6f) * sc;
#pragma unroll
                for (int bj = 0; bj < 2; ++bj) *(u32x4*)(dst + (size_t)row * 512 + cl + bj * HALF) = pack8(acc[ai][bj][m][0] * r, acc[ai][bj][m][1] * r); }
    }
};

template <int MODE> struct EpiBranch {
    static constexpr bool PERM = true, AFTER_DRAIN = false;
    bf16_t* MIX; const bf16_t* GATES;
    __device__ __forceinline__ void operator()(const f32x4 (&acc)[2][2][4][2], const Unit& u, int wr, int wc, int fr, int fq) const {
        const int row0 = u.pm * BM + wr * 64 + fr, cl = u.pn * 256 + wc * 32 + 8 * fq;
#pragma unroll
        for (int ai = 0; ai < 2; ++ai)
#pragma unroll
            for (int m = 0; m < 4; ++m) { const int row = row0 + ai * HALF + m * 16;
#pragma unroll
                for (int bj = 0; bj < 2; ++bj) { const int c = cl + bj * HALF;
                    const u32x4 g = *(const u32x4*)(GATES + (size_t)row * 2048 + MODE * 1024 + c);
                    f32x4 a = acc[ai][bj][m][0], b = acc[ai][bj][m][1];
                    a[0] *= bf_lo(g.x); a[1] *= bf_hi(g.x); a[2] *= bf_lo(g.y); a[3] *= bf_hi(g.y); b[0] *= bf_lo(g.z); b[1] *= bf_hi(g.z); b[2] *= bf_lo(g.w); b[3] *= bf_hi(g.w);
                    if (MODE == 1) { const u32x4 p = *(const u32x4*)(MIX + (size_t)row * 1024 + c);
                        a[0] += bf_lo(p.x); a[1] += bf_hi(p.x); a[2] += bf_lo(p.y); a[3] += bf_hi(p.y); b[0] += bf_lo(p.z); b[1] += bf_hi(p.z); b[2] += bf_lo(p.w); b[3] += bf_hi(p.w); }
                    *(u32x4*)(MIX + (size_t)row * 1024 + c) = pack8(a, b); } }
    }
};

struct EpiOut {
    static constexpr bool PERM = true, AFTER_DRAIN = false;
    const float* X; float* X1; bf16_t* XS; float* X1SS; const float* MOD; const float* CW2;
    __device__ __forceinline__ void operator()(const f32x4 (&acc)[2][2][4][2], const Unit& u, int wr, int wc, int fr, int fq) const {
        const int row0 = u.pm * BM + wr * 64 + fr, cl = u.pn * 256 + wc * 32 + 8 * fq, b = u.pm >> 5;
#pragma unroll
        for (int ai = 0; ai < 2; ++ai)
#pragma unroll
            for (int m = 0; m < 4; ++m) { const int row = row0 + ai * HALF + m * 16; float s = 0.f;
#pragma unroll
                for (int bj = 0; bj < 2; ++bj) { const int c = cl + bj * HALF;
                    const float* xp = X + (size_t)row * 1024 + c; const float* gp = MOD + b * 6144 + 2048 + c; const float* cp = CW2 + b * 1024 + c;
                    const f32x4 v0 = *(const f32x4*)(xp) + *(const f32x4*)(gp) * acc[ai][bj][m][0], v1 = *(const f32x4*)(xp + 4) + *(const f32x4*)(gp + 4) * acc[ai][bj][m][1];
                    *(f32x4*)(X1 + (size_t)row * 1024 + c) = v0; *(f32x4*)(X1 + (size_t)row * 1024 + c + 4) = v1;
                    s += (v0[0] * v0[0] + v0[1] * v0[1]) + (v0[2] * v0[2] + v0[3] * v0[3]) + (v1[0] * v1[0] + v1[1] * v1[1]) + (v1[2] * v1[2] + v1[3] * v1[3]);
                    *(u32x4*)(XS + (size_t)row * 1024 + c) = pack8(v0 * *(const f32x4*)(cp), v1 * *(const f32x4*)(cp + 4)); }
                s += __shfl_xor(s, 16); s += __shfl_xor(s, 32);
                if (fq == 0) X1SS[(size_t)row * 16 + u.pn * 4 + wc] = s; }
    }
};

struct EpiGateUp {
    static constexpr bool PERM = true, AFTER_DRAIN = false;
    bf16_t* HID; const float* X1SS; const float* BGU;
    __device__ __forceinline__ void operator()(const f32x4 (&acc)[2][2][4][2], const Unit& u, int wr, int wc, int fr, int fq) const {
        const int row0 = u.pm * BM + wr * 64 + fr, cl = wc * 32 + 8 * fq, b = u.pm >> 5;
        const float* bp = BGU + b * 5632 + u.pn * 256 + cl;
        const f32x4 bg0 = *(const f32x4*)(bp), bg1 = *(const f32x4*)(bp + 4), bu0 = *(const f32x4*)(bp + 128), bu1 = *(const f32x4*)(bp + 132);
#pragma unroll
        for (int ai = 0; ai < 2; ++ai)
#pragma unroll
            for (int m = 0; m < 4; ++m) { const int row = row0 + ai * HALF + m * 16;
                float s = 0.f;
#pragma unroll
                for (int q = 0; q < 4; ++q) { const f32x4 t = *(const f32x4*)(X1SS + (size_t)row * 16 + 4 * q); s += (t[0] + t[1]) + (t[2] + t[3]); }
                const float r = __builtin_amdgcn_rsqf(s * (1.0f / 1024.0f) + 1e-6f);
                f32x4 g0 = acc[ai][0][m][0] * r + bg0, g1 = acc[ai][0][m][1] * r + bg1; const f32x4 u0 = acc[ai][1][m][0] * r + bu0, u1 = acc[ai][1][m][1] * r + bu1;
#pragma unroll
                for (int j = 0; j < 4; ++j) { g0[j] = fsilu(g0[j]) * u0[j]; g1[j] = fsilu(g1[j]) * u1[j]; }
                *(u32x4*)(HID + (size_t)row * 2816 + u.pn * 128 + cl) = pack8(g0, g1); }
    }
};

struct EpiDown {
    static constexpr bool PERM = true, AFTER_DRAIN = false;
    const float* X1; float* OUT; float* X2SS; const float* MOD;
    __device__ __forceinline__ void operator()(const f32x4 (&acc)[2][2][4][2], const Unit& u, int wr, int wc, int fr, int fq) const {
        const int row0 = u.pm * BM + wr * 64 + fr, cl = u.pn * 256 + wc * 32 + 8 * fq, b = u.pm >> 5;
#pragma unroll
        for (int ai = 0; ai < 2; ++ai)
#pragma unroll
            for (int m = 0; m < 4; ++m) { const int row = row0 + ai * HALF + m * 16; float s = 0.f;
#pragma unroll
                for (int bj = 0; bj < 2; ++bj)
#pragma unroll
                    for (int n = 0; n < 2; ++n) { const int c = cl + bj * HALF + 4 * n;
                        const f32x4 v = *(const f32x4*)(X1 + (size_t)row * 1024 + c) + *(const f32x4*)(MOD + b * 6144 + 5120 + c) * acc[ai][bj][m][n];
                        *(f32x4*)(OUT + (size_t)row * 1024 + c) = v; s += (v[0] * v[0] + v[1] * v[1]) + (v[2] * v[2] + v[3] * v[3]); }
                s += __shfl_xor(s, 16); s += __shfl_xor(s, 32);
                if (fq == 0) X2SS[(size_t)row * 16 + u.pn * 4 + wc] = s; }
    }
};

template <class Epi, class Sched, bool ALIGN_EPI = false, bool SP2 = false>
__device__ __forceinline__ void gemm_phase(PG8_LAS unsigned char* lds, const Gemm g, const Sched& S, const Epi& E) {
    const int tid = threadIdx.x, wid = __builtin_amdgcn_readfirstlane(tid >> 6), lane = tid & 63, wr = wid >> 2, wc = wid & 3, fr = lane & 15, fq = lane >> 4;
    const int K = g.K, nt = K / BK;
    unsigned voffA[2], voffB[2];
#pragma unroll
    for (int i = 0; i < 2; ++i) { int R, C; stage_rc(tid * 16 + i * 8192, R, C); const int Rb = Epi::PERM ? ((R & ~31) + perm32(R & 31)) : R;
        voffA[i] = (unsigned)(R * K + C) * 2u; voffB[i] = (unsigned)(Rb * K + C) * 2u; }
    const size_t kstep = (size_t)(BK * 2);
    const size_t hstep = (size_t)HALF * K * 2;
    const size_t tstep = 2 * hstep;
    const unsigned ldsw = (unsigned)wid * 1024u;
    const int aoff = lds_byte(wr * 64 + fr, fq * 8), boff = lds_byte(wc * 32 + fr, fq * 8);
#define PG8_SA(b, h) (((b) * 2 + (h)) * HTB)
#define PG8_SB(b, h) ((4 + (b) * 2 + (h)) * HTB)
#define PG8_STAGE(bufoff, gbase, voff) do { _Pragma("unroll") for (int _i = 0; _i < 2; ++_i) \
        __builtin_amdgcn_global_load_lds((const unsigned*)((const char*)(gbase) + (voff)[_i]), (PG8_LAS unsigned*)(lds + (bufoff) + ldsw + _i * 8192), 16, 0, 0); } while (0)
#define PG8_LDA(dst, b, h) do { _Pragma("unroll") for (int m = 0; m < 4; ++m) _Pragma("unroll") for (int k = 0; k < 2; ++k) dst[m][k] = *(const PG8_LAS bf16x8*)(lds + PG8_SA(b, h) + aoff + m * 2048 + k * 1024); } while (0)
#define PG8_LDB(dst, b, h) do { _Pragma("unroll") for (int n = 0; n < 2; ++n) _Pragma("unroll") for (int k = 0; k < 2; ++k) dst[n][k] = *(const PG8_LAS bf16x8*)(lds + PG8_SB(b, h) + boff + n * 2048 + k * 1024); } while (0)
#define PG8_MMA(ai, bj, At, Bt) do { __builtin_amdgcn_s_setprio(1); _Pragma("unroll") for (int m = 0; m < 4; ++m) _Pragma("unroll") for (int n = 0; n < 2; ++n) _Pragma("unroll") for (int k = 0; k < 2; ++k) \
        acc[ai][bj][m][n] = __builtin_amdgcn_mfma_f32_16x16x32_bf16(Bt[n][k], At[m][k], acc[ai][bj][m][n], 0, 0, 0); __builtin_amdgcn_s_setprio(0); } while (0)
#define PG8_WAIT_V(n) asm volatile("s_waitcnt vmcnt(" #n ")" ::: "memory")
#define PG8_WAIT_L(n) asm volatile("s_waitcnt lgkmcnt(" #n ")" ::: "memory")
#define PG8_BAR __builtin_amdgcn_s_barrier()
#define PG8_SCHED __builtin_amdgcn_sched_barrier(0)
    Unit cur, nxt; int ui = 0;
    if (!S.next(0, cur)) return;
    f32x4 acc[2][2][4][2];
#pragma unroll
    for (int a = 0; a < 2; ++a)
#pragma unroll
        for (int b = 0; b < 2; ++b)
#pragma unroll
            for (int m = 0; m < 4; ++m)
#pragma unroll
                for (int n = 0; n < 2; ++n) acc[a][b][m][n] = (f32x4){0.f, 0.f, 0.f, 0.f};
    bf16x8 At[4][2], B0[2][2], B1[2][2];
    const char* cA = (const char*)g.A + (size_t)cur.pm * tstep; const char* cB = (const char*)g.Bt + (size_t)cur.pn * tstep;
    S.a_ready(cur);
    if constexpr (SP2) {
        PG8_STAGE(PG8_SB(0, 0), cB, voffB); PG8_STAGE(PG8_SB(0, 1), cB + hstep, voffB); PG8_STAGE(PG8_SA(0, 0), cA, voffA); PG8_STAGE(PG8_SA(0, 1), cA + hstep, voffA);
        if (wr == 1) PG8_BAR;
        PG8_WAIT_V(2); PG8_BAR;
        PG8_STAGE(PG8_SB(1, 0), cB + kstep, voffB); PG8_STAGE(PG8_SA(1, 0), cA + kstep, voffA); PG8_STAGE(PG8_SB(1, 1), cB + hstep + kstep, voffB);
        PG8_WAIT_V(6); PG8_BAR;
    } else {
        PG8_STAGE(PG8_SB(0, 0), cB, voffB); PG8_STAGE(PG8_SA(0, 0), cA, voffA); PG8_STAGE(PG8_SB(0, 1), cB + hstep, voffB); PG8_STAGE(PG8_SA(0, 1), cA + hstep, voffA);
        if (wr == 1) PG8_BAR;
        PG8_WAIT_V(4); PG8_BAR;
        PG8_STAGE(PG8_SB(1, 0), cB + kstep, voffB); PG8_STAGE(PG8_SA(1, 0), cA + kstep, voffA); PG8_STAGE(PG8_SB(1, 1), cB + hstep + kstep, voffB);
        PG8_WAIT_V(6); PG8_BAR;
    }
    for (;;) {
        const bool has_next = S.next(ui + 1, nxt);
        const char* nA = has_next ? (const char*)g.A + (size_t)nxt.pm * tstep : cA; const char* nB = has_next ? (const char*)g.Bt + (size_t)nxt.pn * tstep : cB;
        for (int t = 0; t < nt; t += 2) {
            const bool last = (t == nt - 2);
            const char* a1 = cA + (size_t)(t + 1) * kstep;
            const char* a2 = last ? nA : cA + (size_t)(t + 2) * kstep; const char* b2 = last ? nB : cB + (size_t)(t + 2) * kstep;
            const char* a3 = a2 + kstep; const char* b3 = b2 + kstep;
            if (last && has_next) S.a_ready(nxt);
            if constexpr (SP2) {
            PG8_LDB(B0, 0, 0); PG8_LDB(B1, 0, 1); PG8_SCHED; PG8_LDA(At, 0, 0); PG8_STAGE(PG8_SA(1, 1), a1 + hstep, voffA);
            PG8_WAIT_V(8); PG8_WAIT_L(0); PG8_BAR; PG8_MMA(0, 0, At, B0); PG8_MMA(0, 1, At, B1); PG8_BAR; PG8_SCHED;
            PG8_LDA(At, 0, 1); PG8_STAGE(PG8_SB(0, 0), b2, voffB); PG8_STAGE(PG8_SB(0, 1), b2 + hstep, voffB); PG8_STAGE(PG8_SA(0, 0), a2, voffA);
            PG8_WAIT_V(8); PG8_WAIT_L(0); PG8_BAR; PG8_MMA(1, 0, At, B0); PG8_MMA(1, 1, At, B1); PG8_BAR; PG8_SCHED;
            PG8_LDB(B0, 1, 0); PG8_LDB(B1, 1, 1); PG8_SCHED; PG8_LDA(At, 1, 0); PG8_STAGE(PG8_SA(0, 1), a2 + hstep, voffA);
            PG8_WAIT_V(8); PG8_WAIT_L(0); PG8_BAR; PG8_MMA(0, 0, At, B0); PG8_MMA(0, 1, At, B1); PG8_BAR; PG8_SCHED;
            PG8_LDA(At, 1, 1); PG8_STAGE(PG8_SB(1, 0), b3, voffB); PG8_STAGE(PG8_SB(1, 1), b3 + hstep, voffB); PG8_STAGE(PG8_SA(1, 0), a3, voffA);
            PG8_WAIT_V(8); PG8_WAIT_L(0); PG8_BAR; PG8_MMA(1, 0, At, B0); PG8_MMA(1, 1, At, B1); PG8_BAR; PG8_SCHED;
            } else {
            PG8_LDB(B0, 0, 0); PG8_SCHED; PG8_LDA(At, 0, 0); PG8_STAGE(PG8_SA(1, 1), a1 + hstep, voffA);
            PG8_WAIT_L(8); PG8_BAR; PG8_WAIT_L(0); PG8_MMA(0, 0, At, B0); PG8_BAR; PG8_SCHED;
            PG8_LDB(B1, 0, 1); PG8_STAGE(PG8_SB(0, 0), b2, voffB);
            PG8_BAR; PG8_WAIT_L(0); PG8_MMA(0, 1, At, B1); PG8_BAR;
            PG8_LDA(At, 0, 1); PG8_STAGE(PG8_SA(0, 0), a2, voffA);
            PG8_BAR; PG8_WAIT_L(0); PG8_MMA(1, 0, At, B0); PG8_BAR; PG8_SCHED;
            PG8_STAGE(PG8_SB(0, 1), b2 + hstep, voffB);
            PG8_WAIT_V(6); PG8_BAR; PG8_MMA(1, 1, At, B1); PG8_BAR;
            PG8_LDB(B0, 1, 0); PG8_SCHED; PG8_LDA(At, 1, 0); PG8_STAGE(PG8_SA(0, 1), a2 + hstep, voffA);
            PG8_WAIT_L(8); PG8_BAR; PG8_WAIT_L(0); PG8_MMA(0, 0, At, B0); PG8_BAR; PG8_SCHED;
            PG8_LDB(B1, 1, 1); PG8_STAGE(PG8_SB(1, 0), b3, voffB);
            PG8_BAR; PG8_WAIT_L(0); PG8_MMA(0, 1, At, B1); PG8_BAR;
            PG8_LDA(At, 1, 1); PG8_STAGE(PG8_SA(1, 0), a3, voffA);
            PG8_BAR; PG8_WAIT_L(0); PG8_MMA(1, 0, At, B0); PG8_BAR; PG8_SCHED;
            PG8_STAGE(PG8_SB(1, 1), b3 + hstep, voffB);
            PG8_WAIT_V(6); PG8_BAR; PG8_MMA(1, 1, At, B1); PG8_BAR;
            }
        }
        if constexpr (ALIGN_EPI) { if (wr == 0) PG8_BAR; }
        if constexpr (!Epi::AFTER_DRAIN) { E(acc, cur, wr, wc, fr, fq); S.done(cur); }
        if (!has_next) break;
#pragma unroll
        for (int a = 0; a < 2; ++a)
#pragma unroll
            for (int b = 0; b < 2; ++b)
#pragma unroll
                for (int m = 0; m < 4; ++m)
#pragma unroll
                    for (int n = 0; n < 2; ++n) acc[a][b][m][n] = (f32x4){0.f, 0.f, 0.f, 0.f};
        cur = nxt; cA = nA; cB = nB; ++ui;
        if constexpr (ALIGN_EPI) { if (wr == 1) PG8_BAR; }
    }
    PG8_WAIT_V(0);
    if constexpr (!ALIGN_EPI) { if (wr == 0) PG8_BAR; }
    PG8_BAR;
    if constexpr (Epi::AFTER_DRAIN) { E.fused(acc, cur, wr, wc, fr, fq, lds, wid, lane); S.done(cur); }
#undef PG8_SA
#undef PG8_SB
#undef PG8_STAGE
#undef PG8_LDA
#undef PG8_LDB
#undef PG8_MMA
#undef PG8_WAIT_V
#undef PG8_WAIT_L
#undef PG8_BAR
#undef PG8_SCHED
}
}
#ifndef PG8_SP2
#define PG8_SP2 true
#endif
#ifndef PG8_ALIGN
#define PG8_ALIGN true
#endif

constexpr int NWAVES = 8;
#ifndef MK_N_LAUNCHES
#define MK_N_LAUNCHES 1
#endif
constexpr int N_PHASES = 11;
constexpr int N_LAUNCHES = MK_N_LAUNCHES;
static_assert(N_LAUNCHES == 1 || N_LAUNCHES == N_PHASES, "MK_N_LAUNCHES is 1 or N_PHASES");

constexpr int NB = 8, SEQ = 8192, D = 1024, M = NB * SEQ;
constexpr int NPROJ = 4680, NPROJ_PAD = 4864, FF = 2816, NGU = 2 * FF;
constexpr float EPS = 1e-6f;

constexpr size_t MiB = 1u << 20;
constexpr size_t WS_CTL = 0, CTL_ZERO_BYTES = 1 * MiB;
constexpr size_t WS_MOD = 1 * MiB;
constexpr size_t WS_LB = WS_MOD + 256 * 1024;
constexpr size_t WS_CW2 = WS_MOD + 320 * 1024;
constexpr size_t WS_BGU = WS_MOD + 512 * 1024;
constexpr size_t WS_WIN = 3 * MiB, WS_WQ = 13 * MiB, WS_WBA = 14 * MiB, WS_WBR = 15 * MiB, WS_WOUT = 16 * MiB, WS_WGU = 18 * MiB, WS_WD = 29 * MiB;
constexpr size_t WS_CQSS = 35 * MiB, WS_X1SS = 36 * MiB, WS_X2SS = 40 * MiB;
constexpr size_t WS_XN = 64 * MiB;
constexpr size_t WS_CQ = 192 * MiB, WS_KV = 224 * MiB, WS_KI = 256 * MiB, WS_WI = 264 * MiB;
constexpr size_t WS_RQ = 272 * MiB, WS_RGL = 336 * MiB, WS_RI = 400 * MiB, WS_RGS = 464 * MiB;
constexpr size_t WS_Q = 528 * MiB, WS_QI = 592 * MiB;
constexpr size_t WS_ATT = 64 * MiB, WS_REC = 128 * MiB;
constexpr size_t WS_SCR = 656 * MiB;
constexpr size_t WS_OLOC = 784 * MiB, WS_QHAT = 848 * MiB, WS_U = 912 * MiB, WS_DS = 928 * MiB;
constexpr size_t WS_MIX = 896 * MiB;
constexpr size_t WS_X1 = 64 * MiB, WS_XS = 320 * MiB, WS_HID = 448 * MiB;
constexpr size_t WS_END = 1024 * MiB;
static_assert(WS_RGL == WS_RQ + 64 * MiB && WS_RI == WS_RQ + 128 * MiB && WS_RGS == WS_RQ + 192 * MiB && WS_QI == WS_Q + 64 * MiB, "epilogue pointer arithmetic");
static_assert(WS_HID + (size_t)M * FF * 2 <= WS_END && WS_DS + 256 * 128 * 4 <= WS_END, "map");

constexpr int CW_TMO = 0, CW_CODE = 1;
constexpr int CW_BAR = 4096;

constexpr int RING_OFF = 0, RING_BYTES = 131072;
constexpr int LDS_BYTES = 163840;
constexpr int LDSCTL_OFF = LDS_BYTES - 1024, MISC_OFF = LDSCTL_OFF + 320;
static_assert(MISC_OFF + 128 <= LDS_BYTES, "LDS map");

#define GAS __attribute__((address_space(1)))
#define LAS __attribute__((address_space(3)))
typedef unsigned short bf16;
typedef unsigned v4u __attribute__((ext_vector_type(4)));
typedef unsigned v2u __attribute__((ext_vector_type(2)));
typedef float f32x4 __attribute__((ext_vector_type(4)));
typedef float f32x16 __attribute__((ext_vector_type(16)));
typedef short bf16x8 __attribute__((ext_vector_type(8)));
typedef GAS unsigned gu32;
#define RLX_AGENT __ATOMIC_RELAXED, __HIP_MEMORY_SCOPE_AGENT
#define LDS_WAIT() asm volatile("s_waitcnt lgkmcnt(0)" ::: "memory")
#define VM_WAIT() asm volatile("s_waitcnt vmcnt(0)" ::: "memory")
__device__ __forceinline__ unsigned f2bf(float f) { unsigned u = __builtin_bit_cast(unsigned, f); return (u + 0x7fffu + ((u >> 16) & 1u)) >> 16; }
__device__ __forceinline__ unsigned pk2(float lo, float hi) { return f2bf(lo) | (f2bf(hi) << 16); }
__device__ __forceinline__ float bflo(unsigned u) { return __builtin_bit_cast(float, u << 16); }
__device__ __forceinline__ float bfhi(unsigned u) { return __builtin_bit_cast(float, u & 0xffff0000u); }
__device__ __forceinline__ float bf1(bf16 h) { return __builtin_bit_cast(float, (unsigned)h << 16); }

#define XB_TMO      128
#define XB_XCNT(j)  (256  + 64 * (j))
#define XB_XSUB(j)  (1280 + 64 * (j))
#define XB_XGEN(j)  (2304 + 64 * (j))
#define XB_TOP      3328
#define XB_TOPGEN   3392
#define XCD_BAR_WORDS 3456
#define XB_SPIN_CAP (1u << 23)

__device__ __forceinline__ unsigned xb_ld(unsigned* p)              { return __hip_atomic_load(p, __ATOMIC_RELAXED, __HIP_MEMORY_SCOPE_AGENT); }
__device__ __forceinline__ unsigned xb_add(unsigned* p, unsigned v) { return __hip_atomic_fetch_add(p, v, __ATOMIC_RELAXED, __HIP_MEMORY_SCOPE_AGENT); }
__device__ __forceinline__ unsigned xb_xcc_id() { return (unsigned)__builtin_amdgcn_s_getreg((3 << 11) | 20) & 0xFu; }
#define XB_SPIN(cond, bar) do { unsigned _sp = 0; while (cond) { __builtin_amdgcn_s_sleep(1); \
    if ((++_sp & 255u) == 0u) { if (xb_ld(&(bar)[XB_TMO])) break; if (_sp > XB_SPIN_CAP) { atomicAdd(&(bar)[XB_TMO], 1u); break; } } } } while (0)

struct XcdBarrier { unsigned* bar; unsigned x; volatile LAS unsigned* st; };

__device__ __forceinline__ XcdBarrier xcd_barrier_post(unsigned* bar, volatile LAS unsigned* st) {
    XcdBarrier b; b.bar = bar; b.x = xb_xcc_id(); b.st = st;
    if (threadIdx.x == 0) (void)xb_add(&bar[XB_XCNT(b.x)], 1u);
    return b;
}
__device__ __forceinline__ void xcd_barrier_complete(unsigned* bar, unsigned x, unsigned& nloc, unsigned& nx) {
    const unsigned G = gridDim.x * gridDim.y * gridDim.z;
    unsigned sum, cnt, mine, sp = 0u;
    for (;;) {
        sum = 0u; cnt = 0u; mine = 0u;
#pragma unroll
        for (unsigned j = 0; j < 16; ++j) { const unsigned c = xb_ld(&bar[XB_XCNT(j)]); sum += c; cnt += (c > 0u) ? 1u : 0u; mine = (j == x) ? c : mine; }
        if (sum == G) break;
        __builtin_amdgcn_s_sleep(1);
        if ((++sp & 255u) == 0u) { if (xb_ld(&bar[XB_TMO])) break; if (sp > XB_SPIN_CAP) { atomicAdd(&bar[XB_TMO], 1u); break; } }
    }
    nloc = mine > 0u ? mine : 1u; nx = cnt > 0u ? cnt : 1u;
}
__device__ __forceinline__ void xcd_barrier(const XcdBarrier& b) {
    asm volatile("s_waitcnt vmcnt(0)" ::: "memory");
    __syncthreads();
    if (threadIdx.x == 0) {
        unsigned* bar = b.bar;
        __builtin_amdgcn_s_waitcnt(0);
        unsigned nloc = b.st[0], nx = b.st[1];
        if (nloc == 0u) { xcd_barrier_complete(bar, b.x, nloc, nx); b.st[0] = nloc; b.st[1] = nx; }
        const unsigned old = xb_add(&bar[XB_XSUB(b.x)], 1u);
        const unsigned gen = old / nloc;
        if (old + 1u == (gen + 1u) * nloc) {
            __builtin_amdgcn_fence(__ATOMIC_RELEASE, "agent");
            asm volatile("s_waitcnt vmcnt(0)" ::: "memory");
            const unsigned og = xb_add(&bar[XB_TOP], 1u);
            const unsigned tg = og / nx;
            if (og + 1u == (tg + 1u) * nx) xb_add(&bar[XB_TOPGEN], 1u);
            else XB_SPIN(xb_ld(&bar[XB_TOPGEN]) == tg, bar);
            __builtin_amdgcn_fence(__ATOMIC_ACQUIRE, "agent");
            xb_add(&bar[XB_XGEN(b.x)], 1u);
            asm volatile("s_waitcnt vmcnt(0)" ::: "memory");
        } else {
            XB_SPIN(xb_ld(&bar[XB_XGEN(b.x)]) == gen, bar);
            __builtin_amdgcn_fence(__ATOMIC_ACQUIRE, "agent");
            asm volatile("s_waitcnt vmcnt(0)" ::: "memory");
        }
    }
    __syncthreads();
}

struct Frame {
    LAS unsigned char* lds;
    volatile LAS unsigned* MISC;
    gu32* ctl;
    unsigned char* ws;
    int tid, lane, wave;
    int G;
    float* out;
};
__device__ __forceinline__ float wave_sum(float v) {
#pragma unroll
    for (int o = 1; o < 64; o <<= 1) v += __shfl_xor(v, o);
    return v;
}
__device__ __forceinline__ float wave_max(float v) {
#pragma unroll
    for (int o = 1; o < 64; o <<= 1) v = fmaxf(v, __shfl_xor(v, o));
    return v;
}

template <class SrcCol>
__device__ __forceinline__ void transpose_item(const float* W, int ldw, int K, bf16* WT, const float* ks, LAS float* scr, int item, int nblk, int lane, SrcCol src) {
    const int kb = item / nblk, nb = item % nblk, k0 = 64 * kb, n0 = 32 * nb;
    const float* Wp; const int sc = src(n0 + (lane & 31), Wp);
#pragma unroll 8
    for (int i = 0; i < 32; ++i) { const int kk = 2 * i + (lane >> 5); float v = 0.f; if (sc >= 0) { v = Wp[(size_t)(k0 + kk) * ldw + sc]; if (ks) v *= ks[k0 + kk]; } scr[kk * 33 + (lane & 31)] = v; }
    LDS_WAIT(); asm volatile("" ::: "memory");
    const int c = lane & 7;
#pragma unroll
    for (int j = 0; j < 4; ++j) { const int n = (lane >> 3) + 8 * j; const LAS float* s = scr + (8 * c) * 33 + n;
        v4u o; o.x = pk2(s[0 * 33], s[1 * 33]); o.y = pk2(s[2 * 33], s[3 * 33]); o.z = pk2(s[4 * 33], s[5 * 33]); o.w = pk2(s[6 * 33], s[7 * 33]);
        *(GAS v4u*)(WT + (size_t)(n0 + n) * K + k0 + 8 * c) = o; }
    LDS_WAIT(); asm volatile("" ::: "memory");
}
struct Args { const float* in[20]; float* out; unsigned char* ws; int ph_lo, ph_hi; };
template <class SrcCol>
__device__ __forceinline__ void gemv8(Frame& F, const LAS float* vec, int cpg, int ngrp, int ldw, SrcCol src, const float* bias, float* out, int ldo) {
    LAS float* red = (LAS float*)(F.lds + 32768);
    for (int jb = blockIdx.x; jb < ngrp; jb += F.G) {
        const int col = F.tid & 31, kg = F.tid >> 5; float a[8];
#pragma unroll
        for (int b = 0; b < 8; ++b) a[b] = 0.f;
        const float* Wp = nullptr; int sc = -1;
        if (col < cpg) sc = src(jb * cpg + col, Wp);
        if (sc >= 0) for (int k = kg * 64; k < kg * 64 + 64; ++k) { const float w = Wp[(size_t)k * ldw + sc];
#pragma unroll
            for (int b = 0; b < 8; ++b) a[b] += vec[b * 1024 + k] * w; }
#pragma unroll
        for (int b = 0; b < 8; ++b) red[(kg * 8 + b) * 32 + col] = a[b];
        __syncthreads();
        if (F.tid < 256) { const int b = F.tid >> 5, c2 = F.tid & 31;
            if (c2 < cpg) { float s = 0.f; for (int k2 = 0; k2 < 16; ++k2) s += red[(k2 * 8 + b) * 32 + c2]; const int jj = jb * cpg + c2; out[b * ldo + jj] = s + (bias ? bias[jj] : 0.f); } }
        __syncthreads();
    }
}
struct SrcWin { const float* W; __device__ __forceinline__ int operator()(int d, const float*& Wp) const { Wp = W; return d < 584 ? d : (d < 768 ? -1 : d - 184); } };
__device__ __forceinline__ const float* psel(const float* a, const float* b, bool takeb) { const unsigned long long x = (unsigned long long)a, y = (unsigned long long)b, m = takeb ? ~0ull : 0ull; return (const float*)(x ^ ((x ^ y) & m)); }
struct SrcWq { const float *Wa, *Wb; __device__ __forceinline__ int operator()(int d, const float*& Wp) const { Wp = psel(Wa, Wb, d >= 512); return d & 511; } };
struct SrcId { const float* W; __device__ __forceinline__ int operator()(int d, const float*& Wp) const { Wp = W; return d; } };
struct SrcGu { const float *Wg, *Wu; __device__ __forceinline__ int operator()(int d, const float*& Wp) const { const int t = d >> 8, w = d & 255; Wp = psel(Wg, Wu, w >= 128); return t * 128 + (w & 127); } };

__device__ __forceinline__ void p0_prologue(Frame& F, const Args& A) {
    LAS float* cact = (LAS float*)(F.lds);
    for (int i = F.tid; i < 8192; i += NWAVES * 64) { const float v = A.in[1][i]; cact[i] = v / (1.0f + __expf(-v)); }
    __syncthreads();
    gemv8(F, cact, 24, 256, 6144, SrcId{A.in[2]}, A.in[3], (float*)(F.ws + WS_MOD), 6144);
    if (blockIdx.x == 0) { const float* l = A.in[10]; float* LB = (float*)(F.ws + WS_LB);
        for (int c = F.tid; c < 512; c += NWAVES * 64) LB[c] = 1.0f / (1.0f + __expf(l[512 + c] - l[c])); }
    __syncthreads();
    LAS float* scr = (LAS float*)(F.lds + 49152 + F.wave * 8448);
    const int gw = blockIdx.x * NWAVES + F.wave, NGW = F.G * NWAVES;
    constexpr int I_IN = 16 * 152, I_Q = 4 * 32, I_BA = 8 * 32, I_BR = 8 * 32, I_O = 16 * 32, I_GU = 16 * 176, I_D = 44 * 32;
    constexpr int NITEMS = I_IN + I_Q + I_BA + I_BR + I_O + I_GU + I_D;
    for (int it = gw; it < NITEMS; it += NGW) {
        int r = it;
        if (r < I_IN) { transpose_item(A.in[5], NPROJ, 1024, (bf16*)(F.ws + WS_WIN), nullptr, scr, r, 152, F.lane, SrcWin{A.in[5]}); continue; } r -= I_IN;
        if (r < I_Q) { transpose_item(nullptr, 512, 256, (bf16*)(F.ws + WS_WQ), A.in[6], scr, r, 32, F.lane, SrcWq{A.in[7], A.in[8]}); continue; } r -= I_Q;
        if (r < I_BA) { transpose_item(nullptr, 1024, 512, (bf16*)(F.ws + WS_WBA), nullptr, scr, r, 32, F.lane, SrcId{A.in[12]}); continue; } r -= I_BA;
        if (r < I_BR) { transpose_item(nullptr, 1024, 512, (bf16*)(F.ws + WS_WBR), nullptr, scr, r, 32, F.lane, SrcId{A.in[13]}); continue; } r -= I_BR;
        if (r < I_O) { transpose_item(nullptr, 1024, 1024, (bf16*)(F.ws + WS_WOUT), nullptr, scr, r, 32, F.lane, SrcId{A.in[14]}); continue; } r -= I_O;
        if (r < I_GU) { transpose_item(nullptr, FF, 1024, (bf16*)(F.ws + WS_WGU), nullptr, scr, r, 176, F.lane, SrcGu{A.in[16], A.in[17]}); continue; } r -= I_GU;
        transpose_item(nullptr, 1024, FF, (bf16*)(F.ws + WS_WD), nullptr, scr, r, 32, F.lane, SrcId{A.in[18]});
    }
}

__device__ __forceinline__ void p1_norm(Frame& F, const Args& A) {
    const float* MOD = (const float*)(F.ws + WS_MOD);
    { float* CW2 = (float*)(F.ws + WS_CW2); const int g = blockIdx.x * (NWAVES * 64) + F.tid;
      if (g < 8192) { const int b = g >> 10, c = g & 1023; CW2[g] = A.in[15][c] * (1.0f + MOD[b * 6144 + 4096 + c]); } }
    { LAS float* sh2 = (LAS float*)(F.lds);
      for (int i = F.tid; i < 8192; i += NWAVES * 64) sh2[i] = MOD[(i >> 10) * 6144 + 3072 + (i & 1023)];
      __syncthreads();
      gemv8(F, sh2, 22, 256, FF, SrcGu{A.in[16], A.in[17]}, nullptr, (float*)(F.ws + WS_BGU), NGU); }
    const int gw = blockIdx.x * NWAVES + F.wave, NGW = F.G * NWAVES; bf16* XN = (bf16*)(F.ws + WS_XN);
    for (int m = gw; m < M; m += NGW) {
        const int b = m >> 13;
        const GAS f32x4* xr = (const GAS f32x4*)(A.in[0] + (size_t)m * D) + F.lane;
        f32x4 v[4]; float s = 0.f;
#pragma unroll
        for (int j = 0; j < 4; ++j) { v[j] = xr[64 * j]; s += (v[j].x * v[j].x + v[j].y * v[j].y) + (v[j].z * v[j].z + v[j].w * v[j].w); }
        const float r = 1.0f / sqrtf(wave_sum(s) * (1.0f / D) + EPS);
        GAS unsigned long long* o8 = (GAS unsigned long long*)(XN + (size_t)m * D) + F.lane;
#pragma unroll
        for (int j = 0; j < 4; ++j) { const int c = 4 * F.lane + 256 * j;
            const f32x4 w = *(const f32x4*)(A.in[4] + c), sc = *(const f32x4*)(MOD + b * 6144 + 1024 + c), sh = *(const f32x4*)(MOD + b * 6144 + c);
            const f32x4 y = v[j] * r * w * (sc + 1.0f) + sh;
            o8[64 * j] = (unsigned long long)pk2(y.x, y.y) | ((unsigned long long)pk2(y.z, y.w) << 32); }
    }
}

constexpr int H_QC = 0, H_QB = 17408, H_K = 34816, H_KT = 78336, H_VT = 96768, H_PM = 115200, H_ST = 124416, H_BT = 159232, H_AL = 161280;
constexpr int HS128 = 272, HS64 = 144;
__device__ __forceinline__ unsigned short f2bfs(float f) { return (unsigned short)f2bf(f); }
__device__ __forceinline__ void hgrn_h1_unit(Frame& F, int unit) {
    const int b = unit >> 5, h = (unit >> 3) & 3, n = unit & 7;
    const int tid = F.tid, lane = F.lane, w = F.wave, c = tid & 127, bi = tid >> 7, l15 = lane & 15, l4 = lane >> 4;
    const size_t rowbase = (size_t)(b * SEQ + n * 1024) * 512 + h * 128;
    const bf16* RQ = (const bf16*)(F.ws + WS_RQ) + rowbase; const bf16* RGL = (const bf16*)(F.ws + WS_RGL) + rowbase; const bf16* RI = (const bf16*)(F.ws + WS_RI) + rowbase;
    bf16* OLOC = (bf16*)(F.ws + WS_OLOC) + rowbase; bf16* QHAT = (bf16*)(F.ws + WS_QHAT) + rowbase;
    LAS unsigned char* L = F.lds; LAS float* BT = (LAS float*)(L + H_BT); LAS float* AL = (LAS float*)(L + H_AL);
    f32x4 acc[8];
#pragma unroll
    for (int vb = 0; vb < 8; ++vb) acc[vb] = (f32x4){0.f, 0.f, 0.f, 0.f};
    float asup = 0.f;
    for (int i = tid; i < 64 * HS64 / 4; i += NWAVES * 64) ((LAS unsigned*)(L + H_PM))[i] = 0u;
#pragma unroll 1
    for (int ci = 0; ci < 16; ++ci) {
        const size_t r0 = (size_t)(ci * 64 + bi * 16) * 512 + c;
        float gq[16], qq[16], al[16]; unsigned vp[8];
#pragma unroll
        for (int r = 0; r < 16; ++r) { gq[r] = bf1(RGL[r0 + (size_t)r * 512]); qq[r] = bf1(RQ[r0 + (size_t)r * 512]); }
#pragma unroll
        for (int r = 0; r < 8; ++r) vp[r] = (unsigned)RI[r0 + (size_t)(2 * r) * 512] | ((unsigned)RI[r0 + (size_t)(2 * r + 1) * 512] << 16);
        { float run = 0.f;
#pragma unroll
          for (int r = 0; r < 16; ++r) { run += gq[r]; al[r] = run; }
          BT[bi * 128 + c] = run; }
        if (ci > 0) {
#pragma unroll
            for (int vb = 0; vb < 8; ++vb) { v2u o; o.x = pk2(acc[vb][0], acc[vb][1]); o.y = pk2(acc[vb][2], acc[vb][3]);
                *(LAS v2u*)(L + H_ST + (16 * vb + l15) * HS128 + (16 * w + 4 * l4) * 2) = o; } }
        *(LAS v4u*)(L + H_VT + c * HS64 + bi * 32) = (v4u){vp[0], vp[1], vp[2], vp[3]}; *(LAS v4u*)(L + H_VT + c * HS64 + bi * 32 + 16) = (v4u){vp[4], vp[5], vp[6], vp[7]};
        __syncthreads();
        const float b0 = BT[c], b1 = BT[128 + c], b2 = BT[256 + c], b3 = BT[384 + c];
        const float ab1 = b0, ab2 = b0 + b1, ab3 = ab2 + b2, alast = ab3 + b3;
        const float ab = bi == 0 ? 0.f : bi == 1 ? ab1 : bi == 2 ? ab2 : ab3;
        if (bi == 0) AL[c] = alast;
        unsigned kp[8];
#pragma unroll
        for (int r = 0; r < 16; ++r) { const int t = bi * 16 + r; const float Av = ab + al[r];
            *(LAS unsigned short*)(L + H_QC + t * HS128 + c * 2) = f2bfs(qq[r] * __expf(Av));
            QHAT[r0 + (size_t)r * 512] = f2bfs(qq[r] * __expf(Av + asup));
            *(LAS unsigned short*)(L + H_QB + t * HS128 + c * 2) = f2bfs(qq[r] * __expf(al[r]));
            const float kk = 1.0f - __expf(gq[r]);
            const unsigned ke = f2bf(kk * __expf(alast - Av)); if (r & 1) kp[r >> 1] |= ke << 16; else kp[r >> 1] = ke;
            if (bi <= 0) *(LAS unsigned short*)(L + H_K + (0 + t) * HS128 + c * 2) = f2bfs(kk * __expf(0.f - Av));
            if (bi <= 1) *(LAS unsigned short*)(L + H_K + (16 + t) * HS128 + c * 2) = f2bfs(kk * __expf(ab1 - Av));
            if (bi <= 2) *(LAS unsigned short*)(L + H_K + (48 + t) * HS128 + c * 2) = f2bfs(kk * __expf(ab2 - Av));
            *(LAS unsigned short*)(L + H_K + (96 + t) * HS128 + c * 2) = f2bfs(kk * __expf(ab3 - Av)); }
        *(LAS v4u*)(L + H_KT + c * HS64 + bi * 32) = (v4u){kp[0], kp[1], kp[2], kp[3]}; *(LAS v4u*)(L + H_KT + c * HS64 + bi * 32 + 16) = (v4u){kp[4], kp[5], kp[6], kp[7]};
        asup += alast;
        __syncthreads();
#pragma unroll
        for (int rep = 0; rep < 2; ++rep) { const int tile = w + 8 * rep;
            if (tile < 10) { const int i = tile < 1 ? 0 : tile < 3 ? 1 : tile < 6 ? 2 : 3, j = tile - (i * (i + 1)) / 2;
                const LAS unsigned char* ap = L + H_QB + (16 * i + l15) * HS128 + l4 * 16; const LAS unsigned char* bp = L + H_K + (8 * i * (i + 1) + 16 * j + l15) * HS128 + l4 * 16;
                f32x4 p = (f32x4){0.f, 0.f, 0.f, 0.f};
#pragma unroll
                for (int ks = 0; ks < 4; ++ks) p = __builtin_amdgcn_mfma_f32_16x16x32_bf16(*(const LAS bf16x8*)(ap + ks * 64), *(const LAS bf16x8*)(bp + ks * 64), p, 0, 0, 0);
#pragma unroll
                for (int r = 0; r < 4; ++r) { const float pv = (i == j && l15 > 4 * l4 + r) ? 0.f : p[r];
                    *(LAS unsigned short*)(L + H_PM + (16 * i + 4 * l4 + r) * HS64 + (16 * j + l15) * 2) = f2bfs(pv); } } }
        __syncthreads();
#pragma unroll
        for (int tb = 0; tb < 4; ++tb) { f32x4 o = (f32x4){0.f, 0.f, 0.f, 0.f};
#pragma unroll
            for (int ks = 0; ks < 2; ++ks) if (32 * ks < 16 * (tb + 1))
                o = __builtin_amdgcn_mfma_f32_16x16x32_bf16(*(const LAS bf16x8*)(L + H_VT + (16 * w + l15) * HS64 + l4 * 16 + ks * 64), *(const LAS bf16x8*)(L + H_PM + (16 * tb + l15) * HS64 + l4 * 16 + ks * 64), o, 0, 0, 0);
            if (ci > 0) {
#pragma unroll
                for (int ks = 0; ks < 4; ++ks)
                    o = __builtin_amdgcn_mfma_f32_16x16x32_bf16(*(const LAS bf16x8*)(L + H_ST + (16 * w + l15) * HS128 + l4 * 16 + ks * 64), *(const LAS bf16x8*)(L + H_QC + (16 * tb + l15) * HS128 + l4 * 16 + ks * 64), o, 0, 0, 0); }
            v2u ov; ov.x = pk2(o[0], o[1]); ov.y = pk2(o[2], o[3]);
            *(v2u*)(OLOC + (size_t)(ci * 64 + 16 * tb + l15) * 512 + 16 * w + 4 * l4) = ov; }
        { const f32x4 dv = *(const LAS f32x4*)(AL + 16 * w + 4 * l4); const f32x4 d = (f32x4){__expf(dv[0]), __expf(dv[1]), __expf(dv[2]), __expf(dv[3])};
          const bf16x8 ka0 = *(const LAS bf16x8*)(L + H_KT + (16 * w + l15) * HS64 + l4 * 16), ka1 = *(const LAS bf16x8*)(L + H_KT + (16 * w + l15) * HS64 + l4 * 16 + 64);
#pragma unroll
          for (int vb = 0; vb < 8; ++vb) { f32x4 s = acc[vb] * d;
              s = __builtin_amdgcn_mfma_f32_16x16x32_bf16(ka0, *(const LAS bf16x8*)(L + H_VT + (16 * vb + l15) * HS64 + l4 * 16), s, 0, 0, 0);
              s = __builtin_amdgcn_mfma_f32_16x16x32_bf16(ka1, *(const LAS bf16x8*)(L + H_VT + (16 * vb + l15) * HS64 + l4 * 16 + 64), s, 0, 0, 0);
              acc[vb] = s; } }
        __syncthreads();
    }
    f32x4* U = (f32x4*)(F.ws + WS_U);
#pragma unroll
    for (int vb = 0; vb < 8; ++vb) U[(size_t)((unit * 8 + w) * 8 + vb) * 64 + lane] = acc[vb];
    if (bi == 0) ((float*)(F.ws + WS_DS))[unit * 128 + c] = __expf(asup);
}
__device__ __forceinline__ void hgrn_h3_unit(Frame& F, const Args& A, int unit) {
    const int b = unit >> 5, h = (unit >> 3) & 3, n = unit & 7;
    const int lane = F.lane, w = F.wave, l15 = lane & 15, l4 = lane >> 4;
    LAS unsigned char* L = F.lds;
    const f32x4* U = (const f32x4*)(F.ws + WS_U); const float* DS = (const float*)(F.ws + WS_DS);
    f32x4 S[8];
#pragma unroll
    for (int vb = 0; vb < 8; ++vb) S[vb] = (f32x4){0.f, 0.f, 0.f, 0.f};
    for (int m = 0; m < n; ++m) { const int um = unit - n + m; const f32x4 d = *(const f32x4*)(DS + um * 128 + 16 * w + 4 * l4);
#pragma unroll
        for (int vb = 0; vb < 8; ++vb) S[vb] = S[vb] * d + U[(size_t)((um * 8 + w) * 8 + vb) * 64 + lane]; }
#pragma unroll
    for (int vb = 0; vb < 8; ++vb) { v2u o; o.x = pk2(S[vb][0], S[vb][1]); o.y = pk2(S[vb][2], S[vb][3]);
        *(LAS v2u*)(L + H_ST + (16 * vb + l15) * HS128 + (16 * w + 4 * l4) * 2) = o; }
    __syncthreads();
    const size_t rowbase = (size_t)(b * SEQ + n * 1024 + 128 * w) * 512 + h * 128;
    const bf16* QHAT = (const bf16*)(F.ws + WS_QHAT) + rowbase; const bf16* OLOC = (const bf16*)(F.ws + WS_OLOC) + rowbase;
    const bf16* RGS = (const bf16*)(F.ws + WS_RGS) + rowbase; bf16* REC = (bf16*)(F.ws + WS_REC) + rowbase;
    f32x4 rw[8];
#pragma unroll
    for (int vb = 0; vb < 8; ++vb) rw[vb] = *(const f32x4*)(A.in[11] + 16 * vb + 4 * l4);
#pragma unroll 1
    for (int tb = 0; tb < 8; ++tb) { const size_t tr = (size_t)(16 * tb + l15) * 512;
        bf16x8 qh[4];
#pragma unroll
        for (int ks = 0; ks < 4; ++ks) qh[ks] = *(const bf16x8*)(QHAT + tr + 32 * ks + 8 * l4);
        f32x4 o[8]; float ss = 0.f;
#pragma unroll
        for (int vb = 0; vb < 8; ++vb) { f32x4 a = (f32x4){0.f, 0.f, 0.f, 0.f};
            if (n > 0) {
#pragma unroll
                for (int ks = 0; ks < 4; ++ks) a = __builtin_amdgcn_mfma_f32_16x16x32_bf16(*(const LAS bf16x8*)(L + H_ST + (16 * vb + l15) * HS128 + l4 * 16 + ks * 64), qh[ks], a, 0, 0, 0); }
            const v2u ol = *(const v2u*)(OLOC + tr + 16 * vb + 4 * l4);
            a[0] += bflo(ol.x); a[1] += bfhi(ol.x); a[2] += bflo(ol.y); a[3] += bfhi(ol.y);
            o[vb] = a; ss += (a[0] * a[0] + a[1] * a[1]) + (a[2] * a[2] + a[3] * a[3]); }
        ss += __shfl_xor(ss, 16); ss += __shfl_xor(ss, 32);
        const float r = 1.0f / sqrtf(ss * (1.0f / 128.0f) + EPS);
#pragma unroll
        for (int vb = 0; vb < 8; ++vb) { const v2u g = *(const v2u*)(RGS + tr + 16 * vb + 4 * l4); const f32x4 y = o[vb] * r * rw[vb];
            v2u ov; ov.x = pk2(y[0] * bflo(g.x), y[1] * bfhi(g.x)); ov.y = pk2(y[2] * bflo(g.y), y[3] * bfhi(g.y));
            *(v2u*)(REC + tr + 16 * vb + 4 * l4) = ov; }
    }
    __syncthreads();
}

__device__ __forceinline__ unsigned f2key(float x) {
    const _Float16 hh = (_Float16)x; const unsigned bits = (unsigned)__builtin_bit_cast(unsigned short, hh);
    return (bits & 0x8000u) ? (~bits & 0xffffu) : (bits | 0x8000u);
}
constexpr int DSA_VIMG = 73728;
typedef unsigned u32x4p __attribute__((ext_vector_type(4)));
__device__ __forceinline__ void dsa_unit(Frame& F, int b, int t0) {
    const int lane = F.lane, w = F.wave, qc = lane & 31, hf = lane >> 5;
    const bf16* KI = (const bf16*)(F.ws + WS_KI) + (size_t)b * SEQ * 64;
    const bf16* QI = (const bf16*)(F.ws + WS_QI) + (size_t)(b * SEQ + t0) * 512;
    const float* WI = (const float*)(F.ws + WS_WI) + (size_t)(b * SEQ + t0) * 8;
    unsigned short* scr = (unsigned short*)(F.ws + WS_SCR) + (size_t)blockIdx.x * (32 * 8192);
    const int nkb = t0 / 32 + 1;
#ifndef NO_PASS1
    {
        const int l15 = lane & 15, l4 = lane >> 4, qg = w >> 2, ql = 16 * qg + l15;
        bf16x8 qf[8][2]; float wv[8];
#pragma unroll
        for (int h = 0; h < 8; ++h) { wv[h] = WI[ql * 8 + h];
#pragma unroll
            for (int ks = 0; ks < 2; ++ks) qf[h][ks] = *(const bf16x8*)(QI + (size_t)ql * 512 + h * 64 + ks * 32 + l4 * 8); }
        const int lim = t0 + ql - 4 * l4;
        for (int kb = (w & 3); kb < 2 * nkb; kb += 4) {
            const int s0 = kb * 16;
            const bf16x8 k0 = *(const bf16x8*)(KI + (size_t)(s0 + l15) * 64 + l4 * 8), k1 = *(const bf16x8*)(KI + (size_t)(s0 + l15) * 64 + 32 + l4 * 8);
            f32x4 sc = (f32x4){0.f, 0.f, 0.f, 0.f};
#pragma unroll
            for (int h = 0; h < 8; ++h) { f32x4 a = (f32x4){0.f, 0.f, 0.f, 0.f};
                a = __builtin_amdgcn_mfma_f32_16x16x32_bf16(k0, qf[h][0], a, 0, 0, 0); a = __builtin_amdgcn_mfma_f32_16x16x32_bf16(k1, qf[h][1], a, 0, 0, 0);
#pragma unroll
                for (int r = 0; r < 4; ++r) sc[r] = __builtin_fmaf(wv[h], __builtin_amdgcn_fmed3f(a[r], 0.f, __builtin_inff()), sc[r]); }
            unsigned kk[4];
#pragma unroll
            for (int r = 0; r < 4; ++r) kk[r] = (s0 + r <= lim) ? f2key(sc[r]) : 0u;
            v2u o; o.x = kk[0] | (kk[1] << 16); o.y = kk[2] | (kk[3] << 16);
            *(v2u*)(scr + (size_t)ql * 8192 + s0 + 4 * l4) = o;
        }
    }
#endif
    __syncthreads();
    LAS unsigned short* idxl = (LAS unsigned short*)(F.lds + 65536) + w * 256;
    const LAS float* rb = (const LAS float*)(F.lds + 69632); const LAS int* lut = (const LAS int*)(F.lds + 70656);
    const bf16* KV = (const bf16*)(F.ws + WS_KV) + (size_t)b * SEQ * 256;
    const int nk = nkb * 32, ndw = nk >> 1;
#pragma unroll 1
    for (int qq = 0; qq < 4; ++qq) {
        const int ql = w * 4 + qq, t = t0 + ql, nvalid = t + 1, nsel = nvalid < 256 ? nvalid : 256;
        const unsigned* rowd = (const unsigned*)(scr + (size_t)ql * 8192);
        int ln = lane; asm volatile("" : "+v"(ln));
        unsigned rv[64];
#pragma unroll
        for (int j = 0; j < 64; ++j) { const unsigned val = rowd[j * 64 + ln]; rv[j] = (ln < ndw - j * 64) ? val : 0u; }
        unsigned T = 0u; int need = 0;
        if (nvalid > 256) {
#pragma unroll 1
            for (int bit = 15; bit >= 0; --bit) { const unsigned cand = T | (1u << bit); int c = 0;
#pragma unroll
                for (int g = 0; g < 8; ++g) if (g * 1024 < nk) {
#pragma unroll
                    for (int j = 8 * g; j < 8 * g + 8; ++j) { c += ((rv[j] & 0xffffu) >= cand) ? 1 : 0; c += ((rv[j] >> 16) >= cand) ? 1 : 0; } }
#pragma unroll
                for (int o = 1; o < 64; o <<= 1) c += __shfl_xor(c, o);
                if (c >= 256) T = cand; }
            int c = 0;
#pragma unroll
            for (int g = 0; g < 8; ++g) if (g * 1024 < nk) {
#pragma unroll
                for (int j = 8 * g; j < 8 * g + 8; ++j) { c += ((rv[j] & 0xffffu) > T) ? 1 : 0; c += ((rv[j] >> 16) > T) ? 1 : 0; } }
#pragma unroll
            for (int o = 1; o < 64; o <<= 1) c += __shfl_xor(c, o);
            need = 256 - c;
        }
        {
            int base = 0, tiebase = 0; const unsigned long long lt = (1ull << ln) - 1ull; const int ln2 = 2 * ln;
#pragma unroll
            for (int g = 0; g < 8; ++g) if (g * 1024 < nk) {
#pragma unroll
                for (int j = 8 * g; j < 8 * g + 8; ++j) { const unsigned lo = rv[j] & 0xffffu, hi = rv[j] >> 16;
                    const bool el = lo == T, eh = hi == T; const unsigned long long mel = __ballot(el), meh = __ballot(eh);
                    const int trl = tiebase + __popcll(mel & lt) + __popcll(meh & lt), trh = trl + (el ? 1 : 0);
                    const bool sl = lo > T || (el && trl < need), sh = hi > T || (eh && trh < need);
                    const unsigned long long msl = __ballot(sl), msh = __ballot(sh);
                    const int pl = base + __popcll(msl & lt) + __popcll(msh & lt), ph = pl + (sl ? 1 : 0);
                    if (sl && pl < 256) idxl[pl] = (unsigned short)(ln2 + 128 * j); if (sh && ph < 256) idxl[ph] = (unsigned short)(ln2 + 128 * j + 1);
                    base += __popcll(msl) + __popcll(msh); tiebase += __popcll(mel) + __popcll(meh); __builtin_amdgcn_sched_barrier(0); } }
        }
        LDS_WAIT(); asm volatile("" ::: "memory");
        {
            const int l15 = lane & 15, l4 = lane >> 4;
#pragma unroll
            for (int jj = 0; jj < 4; ++jj) { const int j = lane + 64 * jj; if (j >= nsel) idxl[j] = 0; }
            LDS_WAIT(); asm volatile("" ::: "memory");
            const bf16* qrow = (const bf16*)(F.ws + WS_Q) + (size_t)(b * SEQ + t) * 512 + (l15 & 7) * 64 + 8 * l4;
            bf16x8 bq[2][2];
#pragma unroll
            for (int g = 0; g < 2; ++g)
#pragma unroll
                for (int ks = 0; ks < 2; ++ks) { bf16x8 v = *(const bf16x8*)(qrow + 32 * ks); if ((l15 >> 2) != g) v = (bf16x8){0, 0, 0, 0, 0, 0, 0, 0}; bq[g][ks] = v; }
            f32x4 sa[16];
#pragma unroll
            for (int blk = 0; blk < 16; ++blk) { const bf16* kr = KV + (size_t)idxl[16 * blk + l15] * 256 + 8 * l4;
                const bf16x8 a00 = *(const bf16x8*)(kr), a01 = *(const bf16x8*)(kr + 32), a10 = *(const bf16x8*)(kr + 64), a11 = *(const bf16x8*)(kr + 96);
                f32x4 acc = (f32x4){0.f, 0.f, 0.f, 0.f};
                acc = __builtin_amdgcn_mfma_f32_16x16x32_bf16(a00, bq[0][0], acc, 0, 0, 0); acc = __builtin_amdgcn_mfma_f32_16x16x32_bf16(a01, bq[0][1], acc, 0, 0, 0);
                acc = __builtin_amdgcn_mfma_f32_16x16x32_bf16(a10, bq[1][0], acc, 0, 0, 0); acc = __builtin_amdgcn_mfma_f32_16x16x32_bf16(a11, bq[1][1], acc, 0, 0, 0);
                sa[blk] = acc; }
            float mx = -INFINITY;
#pragma unroll
            for (int blk = 0; blk < 16; ++blk)
#pragma unroll
                for (int r = 0; r < 4; ++r) { const int j = 16 * blk + 4 * l4 + r; const int dist = t - (int)idxl[j]; const int bk = dist < 128 ? lut[dist] : 31;
                    const float v = (j < nsel) ? sa[blk][r] + rb[bk * 8 + (l15 & 7)] : -INFINITY; sa[blk][r] = v; mx = fmaxf(mx, v); }
            mx = fmaxf(mx, __shfl_xor(mx, 16)); mx = fmaxf(mx, __shfl_xor(mx, 32));
            float su = 0.f;
#pragma unroll
            for (int blk = 0; blk < 16; ++blk)
#pragma unroll
                for (int r = 0; r < 4; ++r) { const float e = __expf(sa[blk][r] - mx); sa[blk][r] = e; su += e; }
            su += __shfl_xor(su, 16); su += __shfl_xor(su, 32);
            const float inv = 1.0f / su;
            f32x4 oa[2][4];
#pragma unroll
            for (int g = 0; g < 2; ++g)
#pragma unroll
                for (int c = 0; c < 4; ++c) oa[g][c] = (f32x4){0.f, 0.f, 0.f, 0.f};
            LAS unsigned char* vimg = F.lds + DSA_VIMG + w * 9216;
            const unsigned traddr = (unsigned)(size_t)(vimg + (4 * l4 + (l15 >> 2)) * 144 + (l15 & 3) * 8);
#pragma unroll
            for (int ks = 0; ks < 8; ++ks) {
#pragma unroll
                for (int i = 0; i < 8; ++i) { const int key = 4 * i + l4, ch = l15;
                    const v4u vv = *(const v4u*)(KV + (size_t)idxl[32 * ks + key] * 256 + 128 + ch * 8);
                    *(LAS v4u*)(vimg + (ch >> 3) * 4608 + key * 144 + (ch & 7) * 16) = vv; }
                LDS_WAIT(); asm volatile("" ::: "memory");
                u32x4p pa; pa.x = pk2(sa[2 * ks][0], sa[2 * ks][1]); pa.y = pk2(sa[2 * ks][2], sa[2 * ks][3]); pa.z = pk2(sa[2 * ks + 1][0], sa[2 * ks + 1][1]); pa.w = pk2(sa[2 * ks + 1][2], sa[2 * ks + 1][3]);
                const bf16x8 pfrag = __builtin_bit_cast(bf16x8, pa);
#pragma unroll
                for (int g = 0; g < 2; ++g)
#pragma unroll
                    for (int c = 0; c < 4; ++c) { v2u lo, hi;
                        asm volatile("ds_read_b64_tr_b16 %0, %2 offset:%3\n\tds_read_b64_tr_b16 %1, %2 offset:%4\n\ts_waitcnt lgkmcnt(0)" : "=&v"(lo), "=&v"(hi) : "v"(traddr), "n"(g * 4608 + c * 32), "n"(g * 4608 + c * 32 + 16 * 144) : "memory");
                        u32x4p bb; bb.x = lo.x; bb.y = lo.y; bb.z = hi.x; bb.w = hi.y;
                        oa[g][c] = __builtin_amdgcn_mfma_f32_16x16x32_bf16(pfrag, __builtin_bit_cast(bf16x8, bb), oa[g][c], 0, 0, 0); }
                asm volatile("" ::: "memory");
            }
            bf16* orow = (bf16*)(F.ws + WS_ATT) + (size_t)(b * SEQ + t) * 512;
#pragma unroll
            for (int r = 0; r < 4; ++r) { const float i0 = __shfl(inv, r), i1 = __shfl(inv, 4 + r);
                if (l4 < 2) {
#pragma unroll
                    for (int c = 0; c < 4; ++c) { const float v = l4 == 0 ? oa[0][c][r] * i0 : oa[1][c][r] * i1; orow[(4 * l4 + r) * 64 + 16 * c + l15] = (bf16)f2bf(v); } } }
        }
        LDS_WAIT(); asm volatile("" ::: "memory");
    }
    __syncthreads();
}

__device__ __forceinline__ void p4_mixers(Frame& F, const Args& A) {
    for (int u = blockIdx.x; u < 256; u += F.G) hgrn_h1_unit(F, u);
    __syncthreads();
    { LAS float* rb = (LAS float*)(F.lds + 69632); LAS int* lut = (LAS int*)(F.lds + 70656);
      if (F.tid < 256) rb[F.tid] = A.in[9][F.tid];
      if (F.tid < 128) { const int n = F.tid; int v = n; if (n >= 16) { v = 16 + (int)(__logf((float)n * (1.0f / 16.0f)) * (16.0f / 2.0794415416798357f)); v = v < 31 ? v : 31; } lut[n] = v; }
      __syncthreads(); }
    for (int u = blockIdx.x; u < 2048; u += F.G) { const int b = u & 7, qb = 255 - (u >> 3); dsa_unit(F, b, qb * 32); }
}

__device__ __forceinline__ void p5_rec(Frame& F, const Args& A) { for (int u = blockIdx.x; u < 256; u += F.G) hgrn_h3_unit(F, A, u); }

__device__ __forceinline__ void p10_final(Frame& F, const Args& A) {
    const int gw = blockIdx.x * NWAVES + F.wave, NGW = F.G * NWAVES; const float* SS = (const float*)(F.ws + WS_X2SS);
    for (int m = gw; m < M; m += NGW) {
        float s = F.lane < 16 ? SS[(size_t)m * 16 + F.lane] : 0.f; s = wave_sum(s);
        const float r = 1.0f / sqrtf(s * (1.0f / D) + EPS);
        GAS f32x4* xr = (GAS f32x4*)(F.out + (size_t)m * D) + F.lane;
#pragma unroll
        for (int j = 0; j < 4; ++j) { const f32x4 w = *(const f32x4*)(A.in[19] + 4 * F.lane + 256 * j); xr[64 * j] = xr[64 * j] * r * w; }
    }
}

__global__ void __launch_bounds__(NWAVES * 64, 2) fwd_kernel(Args args) {
    extern __shared__ __attribute__((aligned(16))) unsigned char lds[];
    Frame F;
    F.lds = (LAS unsigned char*)lds;
    F.MISC = (volatile LAS unsigned*)(F.lds + MISC_OFF);
    F.tid = threadIdx.x; F.lane = F.tid & 63; F.wave = __builtin_amdgcn_readfirstlane(F.tid >> 6);
    F.G = gridDim.x;
    F.ws = args.ws; F.ctl = (gu32*)(args.ws + WS_CTL); F.out = args.out;
    for (int u = F.tid; u < (LDS_BYTES - LDSCTL_OFF) / 4; u += NWAVES * 64) ((LAS unsigned*)(F.lds + LDSCTL_OFF))[u] = 0u;
    __syncthreads();
    XcdBarrier bar; bar.bar = (unsigned*)(F.ctl + CW_BAR); bar.x = 0; bar.st = nullptr;
    if (N_LAUNCHES == 1) bar = xcd_barrier_post((unsigned*)(F.ctl + CW_BAR), F.MISC + 8);
#define GRID_BAR() do { if (N_LAUNCHES == 1) xcd_barrier(bar); } while (0)
    const int lo = args.ph_lo, hi = args.ph_hi;
#ifdef ONLY_PHASE
#define IN(k) ((k) == ONLY_PHASE && lo <= (k) && (k) < hi)
#else
#define IN(k) (lo <= (k) && (k) < hi)
#endif
#define BOTH(k) (IN(k) && IN((k) + 1))
    const float* MOD = (const float*)(F.ws + WS_MOD);

    if (IN(0)) { p0_prologue(F, args); if (BOTH(0)) GRID_BAR(); }
    if (IN(1)) { p1_norm(F, args); if (BOTH(1)) GRID_BAR(); }
    if (IN(2)) {
        pg8::Gemm g{(const bf16*)(F.ws + WS_XN), (const bf16*)(F.ws + WS_WIN), M, NPROJ_PAD, 1024}; pg8::StaticOrder S; S.init(M, NPROJ_PAD, F.G, (int)blockIdx.x);
        pg8::EpiInProj E{(bf16*)(F.ws + WS_CQ), (bf16*)(F.ws + WS_KV), (bf16*)(F.ws + WS_KI), (bf16*)(F.ws + WS_RQ), (bf16*)F.out,
                         (float*)(F.ws + WS_WI), (float*)(F.ws + WS_CQSS), (const float*)(F.ws + WS_LB)};
        pg8::gemm_phase<pg8::EpiInProj, pg8::StaticOrder, PG8_ALIGN, PG8_SP2>(F.lds + RING_OFF, g, S, E);
        if (BOTH(2)) GRID_BAR();
    }
    if (IN(3)) {
        pg8::Gemm g{(const bf16*)(F.ws + WS_CQ), (const bf16*)(F.ws + WS_WQ), M, 1024, 256}; pg8::StaticOrder S; S.init(M, 1024, F.G, (int)blockIdx.x);
        pg8::EpiQ E{(bf16*)(F.ws + WS_Q), (const float*)(F.ws + WS_CQSS)};
        pg8::gemm_phase<pg8::EpiQ, pg8::StaticOrder, PG8_ALIGN, PG8_SP2>(F.lds + RING_OFF, g, S, E);
        if (BOTH(3)) GRID_BAR();
    }
    if (IN(4)) { p4_mixers(F, args); if (BOTH(4)) GRID_BAR(); }
    if (IN(5)) { p5_rec(F, args); if (BOTH(5)) GRID_BAR(); }
    if (IN(6)) {
        pg8::StaticOrder S; S.init(M, 1024, F.G, (int)blockIdx.x);
        { pg8::Gemm g{(const bf16*)(F.ws + WS_ATT), (const bf16*)(F.ws + WS_WBA), M, 1024, 512}; pg8::EpiBranch<0> E{(bf16*)(F.ws + WS_MIX), (const bf16*)F.out};
          pg8::gemm_phase<pg8::EpiBranch<0>, pg8::StaticOrder, PG8_ALIGN, PG8_SP2>(F.lds + RING_OFF, g, S, E); }
        { pg8::Gemm g{(const bf16*)(F.ws + WS_REC), (const bf16*)(F.ws + WS_WBR), M, 1024, 512}; pg8::EpiBranch<1> E{(bf16*)(F.ws + WS_MIX), (const bf16*)F.out};
          pg8::gemm_phase<pg8::EpiBranch<1>, pg8::StaticOrder, PG8_ALIGN, PG8_SP2>(F.lds + RING_OFF, g, S, E); }
        if (BOTH(6)) GRID_BAR();
    }
    if (IN(7)) {
        pg8::Gemm g{(const bf16*)(F.ws + WS_MIX), (const bf16*)(F.ws + WS_WOUT), M, 1024, 1024}; pg8::StaticOrder S; S.init(M, 1024, F.G, (int)blockIdx.x);
        pg8::EpiOut E{args.in[0], (float*)(F.ws + WS_X1), (bf16*)(F.ws + WS_XS), (float*)(F.ws + WS_X1SS), MOD, (const float*)(F.ws + WS_CW2)};
        pg8::gemm_phase<pg8::EpiOut, pg8::StaticOrder, PG8_ALIGN, PG8_SP2>(F.lds + RING_OFF, g, S, E);
        if (BOTH(7)) GRID_BAR();
    }
    if (IN(8)) {
        pg8::Gemm g{(const bf16*)(F.ws + WS_XS), (const bf16*)(F.ws + WS_WGU), M, NGU, 1024}; pg8::StaticOrder S; S.init(M, NGU, F.G, (int)blockIdx.x);
        pg8::EpiGateUp E{(bf16*)(F.ws + WS_HID), (const float*)(F.ws + WS_X1SS), (const float*)(F.ws + WS_BGU)};
        pg8::gemm_phase<pg8::EpiGateUp, pg8::StaticOrder, PG8_ALIGN, PG8_SP2>(F.lds + RING_OFF, g, S, E);
        if (BOTH(8)) GRID_BAR();
    }
    if (IN(9)) {
        pg8::Gemm g{(const bf16*)(F.ws + WS_HID), (const bf16*)(F.ws + WS_WD), M, 1024, FF}; pg8::StaticOrder S; S.init(M, 1024, F.G, (int)blockIdx.x);
        pg8::EpiDown E{(const float*)(F.ws + WS_X1), F.out, (float*)(F.ws + WS_X2SS), MOD};
        pg8::gemm_phase<pg8::EpiDown, pg8::StaticOrder, PG8_ALIGN, PG8_SP2>(F.lds + RING_OFF, g, S, E);
        if (BOTH(9)) GRID_BAR();
    }
    if (IN(10)) p10_final(F, args);
#undef IN
#undef BOTH
}

extern "C" void kernel_launch(void* const* d_in, const int* in_sizes, int n_in, void* d_out, int out_size, void* d_ws, size_t ws_size, hipStream_t stream) {
    static int grid = 0;
    if (grid == 0) {
        if (n_in != 20 || in_sizes[0] != M * D || out_size != M * D || ws_size < WS_END) { fprintf(stderr, "kernel_launch: unexpected shapes (n_in %d, in0 %d, out %d, ws %zu); nothing launched\n", n_in, n_in > 0 ? in_sizes[0] : -1, out_size, ws_size); grid = -1; return; }
        int dev = 0, cus = 0, per_cu = 0;
        if (hipGetDevice(&dev) != hipSuccess || hipDeviceGetAttribute(&cus, hipDeviceAttributeMultiprocessorCount, dev) != hipSuccess) { grid = -1; return; }
        if (hipFuncSetAttribute((const void*)fwd_kernel, hipFuncAttributeMaxDynamicSharedMemorySize, LDS_BYTES) != hipSuccess) { fprintf(stderr, "kernel_launch: hipFuncSetAttribute failed\n"); grid = -1; return; }
        if (hipOccupancyMaxActiveBlocksPerMultiprocessor(&per_cu, (const void*)fwd_kernel, NWAVES * 64, LDS_BYTES) != hipSuccess || per_cu < 1)
            fprintf(stderr, "kernel_launch: note: occupancy query reports %d workgroups per CU\n", per_cu);
        (void)hipGetLastError();
        grid = cus;
    }
    if (grid < 0) return;
    if (hipMemsetAsync((char*)d_ws + WS_CTL, 0, CTL_ZERO_BYTES, stream) != hipSuccess) { fprintf(stderr, "kernel_launch: memset failed\n"); return; }
    Args a{};
    for (int i = 0; i < 20; ++i) a.in[i] = (const float*)d_in[i];
    a.out = (float*)d_out; a.ws = (unsigned char*)d_ws;
    for (int li = 0; li < N_LAUNCHES; ++li) {
        a.ph_lo = (N_LAUNCHES == 1) ? 0 : li; a.ph_hi = (N_LAUNCHES == 1) ? N_PHASES : li + 1;
        hipLaunchKernelGGL(fwd_kernel, dim3(grid), dim3(NWAVES * 64), LDS_BYTES, stream, a);
        const hipError_t le = hipPeekAtLastError();
        if (le != hipSuccess) { fprintf(stderr, "kernel_launch: launch %d failed: %s\n", li, hipGetErrorName(le)); break; }
    }
}
```

```cpp
#include <hip/hip_runtime.h>
#include <cstdio>
#include <cstdint>
namespace pg8 {
#define PG8_LAS __attribute__((address_space(3)))
typedef unsigned short bf16_t;
typedef short bf16x8 __attribute__((ext_vector_type(8)));
typedef float f32x4 __attribute__((ext_vector_type(4)));
typedef unsigned u32x4 __attribute__((ext_vector_type(4)));
constexpr int BM = 256, BK = 64, HALF = 128, HTB = HALF * BK * 2  , STAGE_BYTES = 8 * HTB, NXCD = 8, WGM = 8;

__host__ __device__ __forceinline__ int lds_byte(int r, int c) { const int st = (r >> 4) * 2 + (c >> 5), rr = r & 15, cc = c & 31, ob = rr * 64 + cc * 2; return st * 1024 + (ob ^ (((ob >> 9) & 1) << 5)); }
__host__ __device__ __forceinline__ void stage_rc(int b, int& R, int& C) { const int st = b / 1024, sb = b % 1024, swz = sb ^ (((sb >> 9) & 1) << 5); R = (st >> 1) * 16 + swz / 64; C = (st & 1) * 32 + (swz % 64) / 2; }
__host__ __device__ __forceinline__ int perm32(int rho) { const int n = rho >> 4, i = rho & 15; return 8 * (i >> 2) + 4 * n + (i & 3); }

struct Unit { int pm, pn; };
struct Gemm { const bf16_t* A; const bf16_t* Bt; int M, N, K; };

struct StaticOrder {
    int nM, nN, nwg, G, c;
    __host__ __device__ void init(int M, int N, int G_, int c_) { nM = M / BM; nN = N / BM; nwg = nM * nN; G = G_; c = c_; }
    __host__ __device__ bool next(int i, Unit& u) const {
        const long L = (long)i * G + c; if (L >= nwg) return false;
        int wgid = (int)L; { const int q = nwg / NXCD, r = nwg % NXCD, xcd = wgid % NXCD, off = wgid / NXCD; wgid = (xcd < r ? xcd * (q + 1) : r * (q + 1) + (xcd - r) * q) + off; }
        const int nig = WGM * nN, gid = wgid / nig, fm = gid * WGM, gsz = (nM - fm) < WGM ? (nM - fm) : WGM;
        u.pm = fm + ((wgid % nig) % gsz); u.pn = (wgid % nig) / gsz; return true;
    }
    __device__ __forceinline__ void a_ready(const Unit&) const {}
    __device__ __forceinline__ void done(const Unit&) const {}
};

__device__ __forceinline__ unsigned cvt_pk_bf16(float lo, float hi) { unsigned r; asm volatile("v_cvt_pk_bf16_f32 %0, %1, %2" : "=v"(r) : "v"(lo), "v"(hi)); return r; }
__device__ __forceinline__ float fsigmoid(float x) { return __builtin_amdgcn_rcpf(1.0f + __expf(-x)); }
__device__ __forceinline__ float fsilu(float x) { return x * fsigmoid(x); }
__device__ __forceinline__ u32x4 pack8(const f32x4 a, const f32x4 b) { u32x4 w; w.x = cvt_pk_bf16(a[0], a[1]); w.y = cvt_pk_bf16(a[2], a[3]); w.z = cvt_pk_bf16(b[0], b[1]); w.w = cvt_pk_bf16(b[2], b[3]); return w; }
__device__ __forceinline__ float bf_lo(unsigned u) { return __builtin_bit_cast(float, u << 16); }
__device__ __forceinline__ float bf_hi(unsigned u) { return __builtin_bit_cast(float, u & 0xffff0000u); }

struct EpiInProj {
    static constexpr bool PERM = true, AFTER_DRAIN = false;
    bf16_t *CQ, *KV, *KI, *RQ, *GATES; float *WI, *CQSS; const float* LB;
    __device__ __forceinline__ void operator()(const f32x4 (&acc)[2][2][4][2], const Unit& u, int wr, int wc, int fr, int fq) const {
        const int row0 = u.pm * BM + wr * 64 + fr, pn = u.pn, cl = wc * 32 + 8 * fq;
        if (pn == 0) {
#pragma unroll
            for (int ai = 0; ai < 2; ++ai)
#pragma unroll
                for (int m = 0; m < 4; ++m) { const int row = row0 + ai * HALF + m * 16; float s = 0.f;
#pragma unroll
                    for (int bj = 0; bj < 2; ++bj) { const f32x4 a = acc[ai][bj][m][0], b = acc[ai][bj][m][1];
                        s += (a[0] * a[0] + a[1] * a[1]) + (a[2] * a[2] + a[3] * a[3]) + (b[0] * b[0] + b[1] * b[1]) + (b[2] * b[2] + b[3] * b[3]);
                        *(u32x4*)(CQ + (size_t)row * 256 + cl + bj * HALF) = pack8(a, b); }
                    s += __shfl_xor(s, 16); s += __shfl_xor(s, 32);
                    if (fq == 0) CQSS[(size_t)row * 4 + wc] = s; }
        } else if (pn == 1) {
#pragma unroll
            for (int ai = 0; ai < 2; ++ai)
#pragma unroll
                for (int m = 0; m < 4; ++m) { const int row = row0 + ai * HALF + m * 16;
#pragma unroll
                    for (int bj = 0; bj < 2; ++bj) *(u32x4*)(KV + (size_t)row * 256 + cl + bj * HALF) = pack8(acc[ai][bj][m][0], acc[ai][bj][m][1]); }
        } else if (pn == 2) {
#pragma unroll
            for (int ai = 0; ai < 2; ++ai)
#pragma unroll
                for (int m = 0; m < 4; ++m) { const int row = row0 + ai * HALF + m * 16;
                    if (wc < 2) *(u32x4*)(KI + (size_t)row * 64 + cl) = pack8(acc[ai][0][m][0], acc[ai][0][m][1]);
                    else if (wc == 2 && fq == 0) { *(f32x4*)(WI + (size_t)row * 8) = acc[ai][0][m][0]; *(f32x4*)(WI + (size_t)row * 8 + 4) = acc[ai][0][m][1]; } }
        } else if (pn <= 10) {
            const int kind = (pn - 3) >> 1, cb = ((pn - 3) & 1) * 256 + cl;
            bf16_t* dst = RQ + (size_t)kind * (size_t)(32u << 20);
#pragma unroll
            for (int bj = 0; bj < 2; ++bj) {
                f32x4 l0 = (f32x4){0.f, 0.f, 0.f, 0.f}, l1 = l0;
                if (kind == 1) { l0 = *(const f32x4*)(LB + cb + bj * HALF); l1 = *(const f32x4*)(LB + cb + bj * HALF + 4); }
#pragma unroll
                for (int ai = 0; ai < 2; ++ai)
#pragma unroll
                    for (int m = 0; m < 4; ++m) { const int row = row0 + ai * HALF + m * 16; f32x4 a = acc[ai][bj][m][0], b = acc[ai][bj][m][1];
                        if (kind == 0 || kind == 3) {
#pragma unroll
                            for (int j = 0; j < 4; ++j) { a[j] = fsilu(a[j]); b[j] = fsilu(b[j]); } }
                        else if (kind == 1) {
#pragma unroll
                            for (int j = 0; j < 4; ++j) { a[j] = __logf(l0[j] + (1.0f - l0[j]) * fsigmoid(a[j])); b[j] = __logf(l1[j] + (1.0f - l1[j]) * fsigmoid(b[j])); } }
                        *(u32x4*)(dst + (size_t)row * 512 + cb + bj * HALF) = pack8(a, b); }
            }
        } else {
            const int cb = (pn - 11) * 256 + cl;
#pragma unroll
            for (int ai = 0; ai < 2; ++ai)
#pragma unroll
                for (int m = 0; m < 4; ++m) { const int row = row0 + ai * HALF + m * 16;
#pragma unroll
                    for (int bj = 0; bj < 2; ++bj) { f32x4 a = acc[ai][bj][m][0], b = acc[ai][bj][m][1];
#pragma unroll
                        for (int j = 0; j < 4; ++j) { a[j] = fsigmoid(a[j]); b[j] = fsigmoid(b[j]); }
                        *(u32x4*)(GATES + (size_t)row * 2048 + cb + bj * HALF) = pack8(a, b); } }
        }
    }
};

struct EpiQ {
    static constexpr bool PERM = true, AFTER_DRAIN = false;
    bf16_t *Q; const float* CQSS;
    __device__ __forceinline__ void operator()(const f32x4 (&acc)[2][2][4][2], const Unit& u, int wr, int wc, int fr, int fq) const {
        const int row0 = u.pm * BM + wr * 64 + fr, pn = u.pn, cl = (pn & 1) * 256 + wc * 32 + 8 * fq;
        bf16_t* dst = Q + (pn < 2 ? (size_t)0 : (size_t)(32u << 20));
        const float sc = pn < 2 ? 0.125f : 1.0f;
#pragma unroll
        for (int ai = 0; ai < 2; ++ai)
#pragma unroll
            for (int m = 0; m < 4; ++m) { const int row = row0 + ai * HALF + m * 16;
                const f32x4 ss = *(const f32x4*)(CQSS + (size_t)row * 4);
                const float r = __builtin_amdgcn_rsqf(((ss[0] + ss[1]) + (ss[2] + ss[3])) * (1.0f / 256.0f) + 1e-6f) * sc;
#pragma unroll
                for (int bj = 0; bj < 2; ++bj) *(u32x4*)(dst + (size_t)row * 512 + cl + bj * HALF) = pack8(acc[ai][bj][m][0] * r, acc[ai][bj][m][1] * r); }
    }
};

template <int MODE> struct EpiBranch {
    static constexpr bool PERM = true, AFTER_DRAIN = false;
    bf16_t* MIX; const bf16_t* GATES;
    __device__ __forceinline__ void operator()(const f32x4 (&acc)[2][2][4][2], const Unit& u, int wr, int wc, int fr, int fq) const {
        const int row0 = u.pm * BM + wr * 64 + fr, cl = u.pn * 256 + wc * 32 + 8 * fq;
#pragma unroll
        for (int ai = 0; ai < 2; ++ai)
#pragma unroll
            for (int m = 0; m < 4; ++m) { const int row = row0 + ai * HALF + m * 16;
#pragma unroll
                for (int bj = 0; bj < 2; ++bj) { const int c = cl + bj * HALF;
                    const u32x4 g = *(const u32x4*)(GATES + (size_t)row * 2048 + MODE * 1024 + c);
                    f32x4 a = acc[ai][bj][m][0], b = acc[ai][bj][m][1];
                    a[0] *= bf_lo(g.x); a[1] *= bf_hi(g.x); a[2] *= bf_lo(g.y); a[3] *= bf_hi(g.y); b[0] *= bf_lo(g.z); b[1] *= bf_hi(g.z); b[2] *= bf_lo(g.w); b[3] *= bf_hi(g.w);
                    if (MODE == 1) { const u32x4 p = *(const u32x4*)(MIX + (size_t)row * 1024 + c);
                        a[0] += bf_lo(p.x); a[1] += bf_hi(p.x); a[2] += bf_lo(p.y); a[3] += bf_hi(p.y); b[0] += bf_lo(p.z); b[1] += bf_hi(p.z); b[2] += bf_lo(p.w); b[3] += bf_hi(p.w); }
                    *(u32x4*)(MIX + (size_t)row * 1024 + c) = pack8(a, b); } }
    }
};

struct EpiOut {
    static constexpr bool PERM = true, AFTER_DRAIN = false;
    const float* X; float* X1; bf16_t* XS; float* X1SS; const float* MOD; const float* CW2;
    __device__ __forceinline__ void operator()(const f32x4 (&acc)[2][2][4][2], const Unit& u, int wr, int wc, int fr, int fq) const {
        const int row0 = u.pm * BM + wr * 64 + fr, cl = u.pn * 256 + wc * 32 + 8 * fq, b = u.pm >> 5;
#pragma unroll
        for (int ai = 0; ai < 2; ++ai)
#pragma unroll
            for (int m = 0; m < 4; ++m) { const int row = row0 + ai * HALF + m * 16; float s = 0.f;
#pragma unroll
                for (int bj = 0; bj < 2; ++bj) { const int c = cl + bj * HALF;
                    const float* xp = X + (size_t)row * 1024 + c; const float* gp = MOD + b * 6144 + 2048 + c; const float* cp = CW2 + b * 1024 + c;
                    const f32x4 v0 = *(const f32x4*)(xp) + *(const f32x4*)(gp) * acc[ai][bj][m][0], v1 = *(const f32x4*)(xp + 4) + *(const f32x4*)(gp + 4) * acc[ai][bj][m][1];
                    *(f32x4*)(X1 + (size_t)row * 1024 + c) = v0; *(f32x4*)(X1 + (size_t)row * 1024 + c + 4) = v1;
                    s += (v0[0] * v0[0] + v0[1] * v0[1]) + (v0[2] * v0[2] + v0[3] * v0[3]) + (v1[0] * v1[0] + v1[1] * v1[1]) + (v1[2] * v1[2] + v1[3] * v1[3]);
                    *(u32x4*)(XS + (size_t)row * 1024 + c) = pack8(v0 * *(const f32x4*)(cp), v1 * *(const f32x4*)(cp + 4)); }
                s += __shfl_xor(s, 16); s += __shfl_xor(s, 32);
                if (fq == 0) X1SS[(size_t)row * 16 + u.pn * 4 + wc] = s; }
    }
};

struct EpiGateUp {
    static constexpr bool PERM = true, AFTER_DRAIN = false;
    bf16_t* HID; const float* X1SS; const float* BGU;
    __device__ __forceinline__ void operator()(const f32x4 (&acc)[2][2][4][2], const Unit& u, int wr, int wc, int fr, int fq) const {
        const int row0 = u.pm * BM + wr * 64 + fr, cl = wc * 32 + 8 * fq, b = u.pm >> 5;
        const float* bp = BGU + b * 5632 + u.pn * 256 + cl;
        const f32x4 bg0 = *(const f32x4*)(bp), bg1 = *(const f32x4*)(bp + 4), bu0 = *(const f32x4*)(bp + 128), bu1 = *(const f32x4*)(bp + 132);
#pragma unroll
        for (int ai = 0; ai < 2; ++ai)
#pragma unroll
            for (int m = 0; m < 4; ++m) { const int row = row0 + ai * HALF + m * 16;
                float s = 0.f;
#pragma unroll
                for (int q = 0; q < 4; ++q) { const f32x4 t = *(const f32x4*)(X1SS + (size_t)row * 16 + 4 * q); s += (t[0] + t[1]) + (t[2] + t[3]); }
                const float r = __builtin_amdgcn_rsqf(s * (1.0f / 1024.0f) + 1e-6f);
                f32x4 g0 = acc[ai][0][m][0] * r + bg0, g1 = acc[ai][0][m][1] * r + bg1; const f32x4 u0 = acc[ai][1][m][0] * r + bu0, u1 = acc[ai][1][m][1] * r + bu1;
#pragma unroll
                for (int j = 0; j < 4; ++j) { g0[j] = fsilu(g0[j]) * u0[j]; g1[j] = fsilu(g1[j]) * u1[j]; }
                *(u32x4*)(HID + (size_t)row * 2816 + u.pn * 128 + cl) = pack8(g0, g1); }
    }
};

struct EpiDown {
    static constexpr bool PERM = true, AFTER_DRAIN = false;
    const float* X1; float* OUT; float* X2SS; const float* MOD;
    __device__ __forceinline__ void operator()(const f32x4 (&acc)[2][2][4][2], const Unit& u, int wr, int wc, int fr, int fq) const {
        const int row0 = u.pm * BM + wr * 64 + fr, cl = u.pn * 256 + wc * 32 + 8 * fq, b = u.pm >> 5;
#pragma unroll
        for (int ai = 0; ai < 2; ++ai)
#pragma unroll
            for (int m = 0; m < 4; ++m) { const int row = row0 + ai * HALF + m * 16; float s = 0.f;
#pragma unroll
                for (int bj = 0; bj < 2; ++bj)
#pragma unroll
                    for (int n = 0; n < 2; ++n) { const int c = cl + bj * HALF + 4 * n;
                        const f32x4 v = *(const f32x4*)(X1 + (size_t)row * 1024 + c) + *(const f32x4*)(MOD + b * 6144 + 5120 + c) * acc[ai][bj][m][n];
                        *(f32x4*)(OUT + (size_t)row * 1024 + c) = v; s += (v[0] * v[0] + v[1] * v[1]) + (v[2] * v[2] + v[3] * v[3]); }
                s += __shfl_xor(s, 16); s += __shfl_xor(s, 32);
                if (fq == 0) X2SS[(size_t)row * 16 + u.pn * 4 + wc] = s; }
    }
};

template <class Epi, class Sched, bool ALIGN_EPI = false, bool SP2 = false>
__device__ __forceinline__ void gemm_phase(PG8_LAS unsigned char* lds, const Gemm g, const Sched& S, const Epi& E) {
    const int tid = threadIdx.x, wid = __builtin_amdgcn_readfirstlane(tid >> 6), lane = tid & 63, wr = wid >> 2, wc = wid & 3, fr = lane & 15, fq = lane >> 4;
    const int K = g.K, nt = K / BK;
    unsigned voffA[2], voffB[2];
#pragma unroll
    for (int i = 0; i < 2; ++i) { int R, C; stage_rc(tid * 16 + i * 8192, R, C); const int Rb = Epi::PERM ? ((R & ~31) + perm32(R & 31)) : R;
        voffA[i] = (unsigned)(R * K + C) * 2u; voffB[i] = (unsigned)(Rb * K + C) * 2u; }
    const size_t kstep = (size_t)(BK * 2);
    const size_t hstep = (size_t)HALF * K * 2;
    const size_t tstep = 2 * hstep;
    const unsigned ldsw = (unsigned)wid * 1024u;
    const int aoff = lds_byte(wr * 64 + fr, fq * 8), boff = lds_byte(wc * 32 + fr, fq * 8);
#define PG8_SA(b, h) (((b) * 2 + (h)) * HTB)
#define PG8_SB(b, h) ((4 + (b) * 2 + (h)) * HTB)
#define PG8_STAGE(bufoff, gbase, voff) do { _Pragma("unroll") for (int _i = 0; _i < 2; ++_i) \
        __builtin_amdgcn_global_load_lds((const unsigned*)((const char*)(gbase) + (voff)[_i]), (PG8_LAS unsigned*)(lds + (bufoff) + ldsw + _i * 8192), 16, 0, 0); } while (0)
#define PG8_LDA(dst, b, h) do { _Pragma("unroll") for (int m = 0; m < 4; ++m) _Pragma("unroll") for (int k = 0; k < 2; ++k) dst[m][k] = *(const PG8_LAS bf16x8*)(lds + PG8_SA(b, h) + aoff + m * 2048 + k * 1024); } while (0)
#define PG8_LDB(dst, b, h) do { _Pragma("unroll") for (int n = 0; n < 2; ++n) _Pragma("unroll") for (int k = 0; k < 2; ++k) dst[n][k] = *(const PG8_LAS bf16x8*)(lds + PG8_SB(b, h) + boff + n * 2048 + k * 1024); } while (0)
#define PG8_MMA(ai, bj, At, Bt) do { __builtin_amdgcn_s_setprio(1); _Pragma("unroll") for (int m = 0; m < 4; ++m) _Pragma("unroll") for (int n = 0; n < 2; ++n) _Pragma("unroll") for (int k = 0; k < 2; ++k) \
        acc[ai][bj][m][n] = __builtin_amdgcn_mfma_f32_16x16x32_bf16(Bt[n][k], At[m][k], acc[ai][bj][m][n], 0, 0, 0); __builtin_amdgcn_s_setprio(0); } while (0)
#define PG8_WAIT_V(n) asm volatile("s_waitcnt vmcnt(" #n ")" ::: "memory")
#define PG8_WAIT_L(n) asm volatile("s_waitcnt lgkmcnt(" #n ")" ::: "memory")
#define PG8_BAR __builtin_amdgcn_s_barrier()
#define PG8_SCHED __builtin_amdgcn_sched_barrier(0)
    Unit cur, nxt; int ui = 0;
    if (!S.next(0, cur)) return;
    f32x4 acc[2][2][4][2];
#pragma unroll
    for (int a = 0; a < 2; ++a)
#pragma unroll
        for (int b = 0; b < 2; ++b)
#pragma unroll
            for (int m = 0; m < 4; ++m)
#pragma unroll
                for (int n = 0; n < 2; ++n) acc[a][b][m][n] = (f32x4){0.f, 0.f, 0.f, 0.f};
    bf16x8 At[4][2], B0[2][2], B1[2][2];
    const char* cA = (const char*)g.A + (size_t)cur.pm * tstep; const char* cB = (const char*)g.Bt + (size_t)cur.pn * tstep;
    S.a_ready(cur);
    if constexpr (SP2) {
        PG8_STAGE(PG8_SB(0, 0), cB, voffB); PG8_STAGE(PG8_SB(0, 1), cB + hstep, voffB); PG8_STAGE(PG8_SA(0, 0), cA, voffA); PG8_STAGE(PG8_SA(0, 1), cA + hstep, voffA);
        if (wr == 1) PG8_BAR;
        PG8_WAIT_V(2); PG8_BAR;
        PG8_STAGE(PG8_SB(1, 0), cB + kstep, voffB); PG8_STAGE(PG8_SA(1, 0), cA + kstep, voffA); PG8_STAGE(PG8_SB(1, 1), cB + hstep + kstep, voffB);
        PG8_WAIT_V(6); PG8_BAR;
    } else {
        PG8_STAGE(PG8_SB(0, 0), cB, voffB); PG8_STAGE(PG8_SA(0, 0), cA, voffA); PG8_STAGE(PG8_SB(0, 1), cB + hstep, voffB); PG8_STAGE(PG8_SA(0, 1), cA + hstep, voffA);
        if (wr == 1) PG8_BAR;
        PG8_WAIT_V(4); PG8_BAR;
        PG8_STAGE(PG8_SB(1, 0), cB + kstep, voffB); PG8_STAGE(PG8_SA(1, 0), cA + kstep, voffA); PG8_STAGE(PG8_SB(1, 1), cB + hstep + kstep, voffB);
        PG8_WAIT_V(6); PG8_BAR;
    }
    for (;;) {
        const bool has_next = S.next(ui + 1, nxt);
        const char* nA = has_next ? (const char*)g.A + (size_t)nxt.pm * tstep : cA; const char* nB = has_next ? (const char*)g.Bt + (size_t)nxt.pn * tstep : cB;
        for (int t = 0; t < nt; t += 2) {
            const bool last = (t == nt - 2);
            const char* a1 = cA + (size_t)(t + 1) * kstep;
            const char* a2 = last ? nA : cA + (size_t)(t + 2) * kstep; const char* b2 = last ? nB : cB + (size_t)(t + 2) * kstep;
            const char* a3 = a2 + kstep; const char* b3 = b2 + kstep;
            if (last && has_next) S.a_ready(nxt);
            if constexpr (SP2) {
            PG8_LDB(B0, 0, 0); PG8_LDB(B1, 0, 1); PG8_SCHED; PG8_LDA(At, 0, 0); PG8_STAGE(PG8_SA(1, 1), a1 + hstep, voffA);
            PG8_WAIT_V(8); PG8_WAIT_L(0); PG8_BAR; PG8_MMA(0, 0, At, B0); PG8_MMA(0, 1, At, B1); PG8_BAR; PG8_SCHED;
            PG8_LDA(At, 0, 1); PG8_STAGE(PG8_SB(0, 0), b2, voffB); PG8_STAGE(PG8_SB(0, 1), b2 + hstep, voffB); PG8_STAGE(PG8_SA(0, 0), a2, voffA);
            PG8_WAIT_V(8); PG8_WAIT_L(0); PG8_BAR; PG8_MMA(1, 0, At, B0); PG8_MMA(1, 1, At, B1); PG8_BAR; PG8_SCHED;
            PG8_LDB(B0, 1, 0); PG8_LDB(B1, 1, 1); PG8_SCHED; PG8_LDA(At, 1, 0); PG8_STAGE(PG8_SA(0, 1), a2 + hstep, voffA);
            PG8_WAIT_V(8); PG8_WAIT_L(0); PG8_BAR; PG8_MMA(0, 0, At, B0); PG8_MMA(0, 1, At, B1); PG8_BAR; PG8_SCHED;
            PG8_LDA(At, 1, 1); PG8_STAGE(PG8_SB(1, 0), b3, voffB); PG8_STAGE(PG8_SB(1, 1), b3 + hstep, voffB); PG8_STAGE(PG8_SA(1, 0), a3, voffA);
            PG8_WAIT_V(8); PG8_WAIT_L(0); PG8_BAR; PG8_MMA(1, 0, At, B0); PG8_MMA(1, 1, At, B1); PG8_BAR; PG8_SCHED;
            } else {
            PG8_LDB(B0, 0, 0); PG8_SCHED; PG8_LDA(At, 0, 0); PG8_STAGE(PG8_SA(1, 1), a1 + hstep, voffA);
            PG8_WAIT_L(8); PG8_BAR; PG8_WAIT_L(0); PG8_MMA(0, 0, At, B0); PG8_BAR; PG8_SCHED;
            PG8_LDB(B1, 0, 1); PG8_STAGE(PG8_SB(0, 0), b2, voffB);
            PG8_BAR; PG8_WAIT_L(0); PG8_MMA(0, 1, At, B1); PG8_BAR;
            PG8_LDA(At, 0, 1); PG8_STAGE(PG8_SA(0, 0), a2, voffA);
            PG8_BAR; PG8_WAIT_L(0); PG8_MMA(1, 0, At, B0); PG8_BAR; PG8_SCHED;
            PG8_STAGE(PG8_SB(0, 1), b2 + hstep, voffB);
            PG8_WAIT_V(6); PG8_BAR; PG8_MMA(1, 1, At, B1); PG8_BAR;
            PG8_LDB(B0, 1, 0); PG8_SCHED; PG8_LDA(At, 1, 0); PG8_STAGE(PG8_SA(0, 1), a2 + hstep, voffA);
            PG8_WAIT_L(8); PG8_BAR; PG8_WAIT_L(0); PG8_MMA(0, 0, At, B0); PG8_BAR; PG8_SCHED;
            PG8_LDB(B1, 1, 1); PG8_STAGE(PG8_SB(1, 0), b3, voffB);
            PG8_BAR; PG8_WAIT_L(0); PG8_MMA(0, 1, At, B1); PG8_BAR;
            PG8_LDA(At, 1, 1); PG8_STAGE(PG8_SA(1, 0), a3, voffA);
            PG8_BAR; PG8_WAIT_L(0); PG8_MMA(1, 0, At, B0); PG8_BAR; PG8_SCHED;
            PG8_STAGE(PG8_SB(1, 1), b3 + hstep, voffB);
            PG8_WAIT_V(6); PG8_BAR; PG8_MMA(1, 1, At, B1); PG8_BAR;
            }
        }
        if constexpr (ALIGN_EPI) { if (wr == 0) PG8_BAR; }
        if constexpr (!Epi::AFTER_DRAIN) { E(acc, cur, wr, wc, fr, fq); S.done(cur); }
        if (!has_next) break;
#pragma unroll
        for (int a = 0; a < 2; ++a)
#pragma unroll
            for (int b = 0; b < 2; ++b)
#pragma unroll
                for (int m = 0; m < 4; ++m)
#pragma unroll
                    for (int n = 0; n < 2; ++n) acc[a][b][m][n] = (f32x4){0.f, 0.f, 0.f, 0.f};
        cur = nxt; cA = nA; cB = nB; ++ui;
        if constexpr (ALIGN_EPI) { if (wr == 1) PG8_BAR; }
    }
    PG8_WAIT_V(0);
    if constexpr (!ALIGN_EPI) { if (wr == 0) PG8_BAR; }
    PG8_BAR;
    if constexpr (Epi::AFTER_DRAIN) { E.fused(acc, cur, wr, wc, fr, fq, lds, wid, lane); S.done(cur); }
#undef PG8_SA
#undef PG8_SB
#undef PG8_STAGE
#undef PG8_LDA
#undef PG8_LDB
#undef PG8_MMA
#undef PG8_WAIT_V
#undef PG8_WAIT_L
#undef PG8_BAR
#undef PG8_SCHED
}
}
#ifndef PG8_SP2
#define PG8_SP2 true
#endif
#ifndef PG8_ALIGN
#define PG8_ALIGN true
#endif

constexpr int NWAVES = 8;
#ifndef MK_N_LAUNCHES
#define MK_N_LAUNCHES 1
#endif
constexpr int N_PHASES = 11;
constexpr int N_LAUNCHES = MK_N_LAUNCHES;
static_assert(N_LAUNCHES == 1 || N_LAUNCHES == N_PHASES, "MK_N_LAUNCHES is 1 or N_PHASES");

constexpr int NB = 8, SEQ = 8192, D = 1024, M = NB * SEQ;
constexpr int NPROJ = 4680, NPROJ_PAD = 4864, FF = 2816, NGU = 2 * FF;
constexpr float EPS = 1e-6f;

constexpr size_t MiB = 1u << 20;
constexpr size_t WS_CTL = 0, CTL_ZERO_BYTES = 1 * MiB;
constexpr size_t WS_MOD = 1 * MiB;
constexpr size_t WS_LB = WS_MOD + 256 * 1024;
constexpr size_t WS_CW2 = WS_MOD + 320 * 1024;
constexpr size_t WS_BGU = WS_MOD + 512 * 1024;
constexpr size_t WS_WIN = 3 * MiB, WS_WQ = 13 * MiB, WS_WBA = 14 * MiB, WS_WBR = 15 * MiB, WS_WOUT = 16 * MiB, WS_WGU = 18 * MiB, WS_WD = 29 * MiB;
constexpr size_t WS_CQSS = 35 * MiB, WS_X1SS = 36 * MiB, WS_X2SS = 40 * MiB;
constexpr size_t WS_XN = 64 * MiB;
constexpr size_t WS_CQ = 192 * MiB, WS_KV = 224 * MiB, WS_KI = 256 * MiB, WS_WI = 264 * MiB;
constexpr size_t WS_RQ = 272 * MiB, WS_RGL = 336 * MiB, WS_RI = 400 * MiB, WS_RGS = 464 * MiB;
constexpr size_t WS_Q = 528 * MiB, WS_QI = 592 * MiB;
constexpr size_t WS_ATT = 64 * MiB, WS_REC = 128 * MiB;
constexpr size_t WS_SCR = 656 * MiB;
constexpr size_t WS_OLOC = 784 * MiB, WS_QHAT = 848 * MiB, WS_U = 912 * MiB, WS_DS = 928 * MiB;
constexpr size_t WS_MIX = 896 * MiB;
constexpr size_t WS_X1 = 64 * MiB, WS_XS = 320 * MiB, WS_HID = 448 * MiB;
constexpr size_t WS_END = 1024 * MiB;
static_assert(WS_RGL == WS_RQ + 64 * MiB && WS_RI == WS_RQ + 128 * MiB && WS_RGS == WS_RQ + 192 * MiB && WS_QI == WS_Q + 64 * MiB, "epilogue pointer arithmetic");
static_assert(WS_HID + (size_t)M * FF * 2 <= WS_END && WS_DS + 256 * 128 * 4 <= WS_END, "map");

constexpr int CW_TMO = 0, CW_CODE = 1;
constexpr int CW_BAR = 4096;

constexpr int RING_OFF = 0, RING_BYTES = 131072;
constexpr int LDS_BYTES = 163840;
constexpr int LDSCTL_OFF = LDS_BYTES - 1024, MISC_OFF = LDSCTL_OFF + 320;
static_assert(MISC_OFF + 128 <= LDS_BYTES, "LDS map");

#define GAS __attribute__((address_space(1)))
#define LAS __attribute__((address_space(3)))
typedef unsigned short bf16;
typedef unsigned v4u __attribute__((ext_vector_type(4)));
typedef unsigned v2u __attribute__((ext_vector_type(2)));
typedef float f32x4 __attribute__((ext_vector_type(4)));
typedef float f32x16 __attribute__((ext_vector_type(16)));
typedef short bf16x8 __attribute__((ext_vector_type(8)));
typedef GAS unsigned gu32;
#define RLX_AGENT __ATOMIC_RELAXED, __HIP_MEMORY_SCOPE_AGENT
#define LDS_WAIT() asm volatile("s_waitcnt lgkmcnt(0)" ::: "memory")
#define VM_WAIT() asm volatile("s_waitcnt vmcnt(0)" ::: "memory")
__device__ __forceinline__ unsigned f2bf(float f) { unsigned u = __builtin_bit_cast(unsigned, f); return (u + 0x7fffu + ((u >> 16) & 1u)) >> 16; }
__device__ __forceinline__ unsigned pk2(float lo, float hi) { return f2bf(lo) | (f2bf(hi) << 16); }
__device__ __forceinline__ float bflo(unsigned u) { return __builtin_bit_cast(float, u << 16); }
__device__ __forceinline__ float bfhi(unsigned u) { return __builtin_bit_cast(float, u & 0xffff0000u); }
__device__ __forceinline__ float bf1(bf16 h) { return __builtin_bit_cast(float, (unsigned)h << 16); }

#define XB_TMO      128
#define XB_XCNT(j)  (256  + 64 * (j))
#define XB_XSUB(j)  (1280 + 64 * (j))
#define XB_XGEN(j)  (2304 + 64 * (j))
#define XB_TOP      3328
#define XB_TOPGEN   3392
#define XCD_BAR_WORDS 3456
#define XB_SPIN_CAP (1u << 23)

__device__ __forceinline__ unsigned xb_ld(unsigned* p)              { return __hip_atomic_load(p, __ATOMIC_RELAXED, __HIP_MEMORY_SCOPE_AGENT); }
__device__ __forceinline__ unsigned xb_add(unsigned* p, unsigned v) { return __hip_atomic_fetch_add(p, v, __ATOMIC_RELAXED, __HIP_MEMORY_SCOPE_AGENT); }
__device__ __forceinline__ unsigned xb_xcc_id() { return (unsigned)__builtin_amdgcn_s_getreg((3 << 11) | 20) & 0xFu; }
#define XB_SPIN(cond, bar) do { unsigned _sp = 0; while (cond) { __builtin_amdgcn_s_sleep(1); \
    if ((++_sp & 255u) == 0u) { if (xb_ld(&(bar)[XB_TMO])) break; if (_sp > XB_SPIN_CAP) { atomicAdd(&(bar)[XB_TMO], 1u); break; } } } } while (0)

struct XcdBarrier { unsigned* bar; unsigned x; volatile LAS unsigned* st; };

__device__ __forceinline__ XcdBarrier xcd_barrier_post(unsigned* bar, volatile LAS unsigned* st) {
    XcdBarrier b; b.bar = bar; b.x = xb_xcc_id(); b.st = st;
    if (threadIdx.x == 0) (void)xb_add(&bar[XB_XCNT(b.x)], 1u);
    return b;
}
__device__ __forceinline__ void xcd_barrier_complete(unsigned* bar, unsigned x, unsigned& nloc, unsigned& nx) {
    const unsigned G = gridDim.x * gridDim.y * gridDim.z;
    unsigned sum, cnt, mine, sp = 0u;
    for (;;) {
        sum = 0u; cnt = 0u; mine = 0u;
#pragma unroll
        for (unsigned j = 0; j < 16; ++j) { const unsigned c = xb_ld(&bar[XB_XCNT(j)]); sum += c; cnt += (c > 0u) ? 1u : 0u; mine = (j == x) ? c : mine; }
        if (sum == G) break;
        __builtin_amdgcn_s_sleep(1);
        if ((++sp & 255u) == 0u) { if (xb_ld(&bar[XB_TMO])) break; if (sp > XB_SPIN_CAP) { atomicAdd(&bar[XB_TMO], 1u); break; } }
    }
    nloc = mine > 0u ? mine : 1u; nx = cnt > 0u ? cnt : 1u;
}
__device__ __forceinline__ void xcd_barrier(const XcdBarrier& b) {
    asm volatile("s_waitcnt vmcnt(0)" ::: "memory");
    __syncthreads();
    if (threadIdx.x == 0) {
        unsigned* bar = b.bar;
        __builtin_amdgcn_s_waitcnt(0);
        unsigned nloc = b.st[0], nx = b.st[1];
        if (nloc == 0u) { xcd_barrier_complete(bar, b.x, nloc, nx); b.st[0] = nloc; b.st[1] = nx; }
        const unsigned old = xb_add(&bar[XB_XSUB(b.x)], 1u);
        const unsigned gen = old / nloc;
        if (old + 1u == (gen + 1u) * nloc) {
            __builtin_amdgcn_fence(__ATOMIC_RELEASE, "agent");
            asm volatile("s_waitcnt vmcnt(0)" ::: "memory");
            const unsigned og = xb_add(&bar[XB_TOP], 1u);
            const unsigned tg = og / nx;
            if (og + 1u == (tg + 1u) * nx) xb_add(&bar[XB_TOPGEN], 1u);
            else XB_SPIN(xb_ld(&bar[XB_TOPGEN]) == tg, bar);
            __builtin_amdgcn_fence(__ATOMIC_ACQUIRE, "agent");
            xb_add(&bar[XB_XGEN(b.x)], 1u);
            asm volatile("s_waitcnt vmcnt(0)" ::: "memory");
        } else {
            XB_SPIN(xb_ld(&bar[XB_XGEN(b.x)]) == gen, bar);
            __builtin_amdgcn_fence(__ATOMIC_ACQUIRE, "agent");
            asm volatile("s_waitcnt vmcnt(0)" ::: "memory");
        }
    }
    __syncthreads();
}

struct Frame {
    LAS unsigned char* lds;
    volatile LAS unsigned* MISC;
    gu32* ctl;
    unsigned char* ws;
    int tid, lane, wave;
    int G;
    float* out;
};
__device__ __forceinline__ float wave_sum(float v) {
#pragma unroll
    for (int o = 1; o < 64; o <<= 1) v += __shfl_xor(v, o);
    return v;
}
__device__ __forceinline__ float wave_max(float v) {
#pragma unroll
    for (int o = 1; o < 64; o <<= 1) v = fmaxf(v, __shfl_xor(v, o));
    return v;
}

template <class SrcCol>
__device__ __forceinline__ void transpose_item(const float* W, int ldw, int K, bf16* WT, const float* ks, LAS float* scr, int item, int nblk, int lane, SrcCol src) {
    const int kb = item / nblk, nb = item % nblk, k0 = 64 * kb, n0 = 32 * nb;
    const float* Wp; const int sc = src(n0 + (lane & 31), Wp);
#pragma unroll 8
    for (int i = 0; i < 32; ++i) { const int kk = 2 * i + (lane >> 5); float v = 0.f; if (sc >= 0) { v = Wp[(size_t)(k0 + kk) * ldw + sc]; if (ks) v *= ks[k0 + kk]; } scr[kk * 33 + (lane & 31)] = v; }
    LDS_WAIT(); asm volatile("" ::: "memory");
    const int c = lane & 7;
#pragma unroll
    for (int j = 0; j < 4; ++j) { const int n = (lane >> 3) + 8 * j; const LAS float* s = scr + (8 * c) * 33 + n;
        v4u o; o.x = pk2(s[0 * 33], s[1 * 33]); o.y = pk2(s[2 * 33], s[3 * 33]); o.z = pk2(s[4 * 33], s[5 * 33]); o.w = pk2(s[6 * 33], s[7 * 33]);
        *(GAS v4u*)(WT + (size_t)(n0 + n) * K + k0 + 8 * c) = o; }
    LDS_WAIT(); asm volatile("" ::: "memory");
}
struct Args { const float* in[20]; float* out; unsigned char* ws; int ph_lo, ph_hi; };
template <class SrcCol>
__device__ __forceinline__ void gemv8(Frame& F, const LAS float* vec, int cpg, int ngrp, int ldw, SrcCol src, const float* bias, float* out, int ldo) {
    LAS float* red = (LAS float*)(F.lds + 32768);
    for (int jb = blockIdx.x; jb < ngrp; jb += F.G) {
        const int col = F.tid & 31, kg = F.tid >> 5; float a[8];
#pragma unroll
        for (int b = 0; b < 8; ++b) a[b] = 0.f;
        const float* Wp = nullptr; int sc = -1;
        if (col < cpg) sc = src(jb * cpg + col, Wp);
        if (sc >= 0) for (int k = kg * 64; k < kg * 64 + 64; ++k) { const float w = Wp[(size_t)k * ldw + sc];
#pragma unroll
            for (int b = 0; b < 8; ++b) a[b] += vec[b * 1024 + k] * w; }
#pragma unroll
        for (int b = 0; b < 8; ++b) red[(kg * 8 + b) * 32 + col] = a[b];
        __syncthreads();
        if (F.tid < 256) { const int b = F.tid >> 5, c2 = F.tid & 31;
            if (c2 < cpg) { float s = 0.f; for (int k2 = 0; k2 < 16; ++k2) s += red[(k2 * 8 + b) * 32 + c2]; const int jj = jb * cpg + c2; out[b * ldo + jj] = s + (bias ? bias[jj] : 0.f); } }
        __syncthreads();
    }
}
struct SrcWin { const float* W; __device__ __forceinline__ int operator()(int d, const float*& Wp) const { Wp = W; return d < 584 ? d : (d < 768 ? -1 : d - 184); } };
__device__ __forceinline__ const float* psel(const float* a, const float* b, bool takeb) { const unsigned long long x = (unsigned long long)a, y = (unsigned long long)b, m = takeb ? ~0ull : 0ull; return (const float*)(x ^ ((x ^ y) & m)); }
struct SrcWq { const float *Wa, *Wb; __device__ __forceinline__ int operator()(int d, const float*& Wp) const { Wp = psel(Wa, Wb, d >= 512); return d & 511; } };
struct SrcId { const float* W; __device__ __forceinline__ int operator()(int d, const float*& Wp) const { Wp = W; return d; } };
struct SrcGu { const float *Wg, *Wu; __device__ __forceinline__ int operator()(int d, const float*& Wp) const { const int t = d >> 8, w = d & 255; Wp = psel(Wg, Wu, w >= 128); return t * 128 + (w & 127); } };

__device__ __forceinline__ void p0_prologue(Frame& F, const Args& A) {
    LAS float* cact = (LAS float*)(F.lds);
    for (int i = F.tid; i < 8192; i += NWAVES * 64) { const float v = A.in[1][i]; cact[i] = v / (1.0f + __expf(-v)); }
    __syncthreads();
    gemv8(F, cact, 24, 256, 6144, SrcId{A.in[2]}, A.in[3], (float*)(F.ws + WS_MOD), 6144);
    if (blockIdx.x == 0) { const float* l = A.in[10]; float* LB = (float*)(F.ws + WS_LB);
        for (int c = F.tid; c < 512; c += NWAVES * 64) LB[c] = 1.0f / (1.0f + __expf(l[512 + c] - l[c])); }
    __syncthreads();
    LAS float* scr = (LAS float*)(F.lds + 49152 + F.wave * 8448);
    const int gw = blockIdx.x * NWAVES + F.wave, NGW = F.G * NWAVES;
    constexpr int I_IN = 16 * 152, I_Q = 4 * 32, I_BA = 8 * 32, I_BR = 8 * 32, I_O = 16 * 32, I_GU = 16 * 176, I_D = 44 * 32;
    constexpr int NITEMS = I_IN + I_Q + I_BA + I_BR + I_O + I_GU + I_D;
    for (int it = gw; it < NITEMS; it += NGW) {
        int r = it;
        if (r < I_IN) { transpose_item(A.in[5], NPROJ, 1024, (bf16*)(F.ws + WS_WIN), nullptr, scr, r, 152, F.lane, SrcWin{A.in[5]}); continue; } r -= I_IN;
        if (r < I_Q) { transpose_item(nullptr, 512, 256, (bf16*)(F.ws + WS_WQ), A.in[6], scr, r, 32, F.lane, SrcWq{A.in[7], A.in[8]}); continue; } r -= I_Q;
        if (r < I_BA) { transpose_item(nullptr, 1024, 512, (bf16*)(F.ws + WS_WBA), nullptr, scr, r, 32, F.lane, SrcId{A.in[12]}); continue; } r -= I_BA;
        if (r < I_BR) { transpose_item(nullptr, 1024, 512, (bf16*)(F.ws + WS_WBR), nullptr, scr, r, 32, F.lane, SrcId{A.in[13]}); continue; } r -= I_BR;
        if (r < I_O) { transpose_item(nullptr, 1024, 1024, (bf16*)(F.ws + WS_WOUT), nullptr, scr, r, 32, F.lane, SrcId{A.in[14]}); continue; } r -= I_O;
        if (r < I_GU) { transpose_item(nullptr, FF, 1024, (bf16*)(F.ws + WS_WGU), nullptr, scr, r, 176, F.lane, SrcGu{A.in[16], A.in[17]}); continue; } r -= I_GU;
        transpose_item(nullptr, 1024, FF, (bf16*)(F.ws + WS_WD), nullptr, scr, r, 32, F.lane, SrcId{A.in[18]});
    }
}

__device__ __forceinline__ void p1_norm(Frame& F, const Args& A) {
    const float* MOD = (const float*)(F.ws + WS_MOD);
    { float* CW2 = (float*)(F.ws + WS_CW2); const int g = blockIdx.x * (NWAVES * 64) + F.tid;
      if (g < 8192) { const int b = g >> 10, c = g & 1023; CW2[g] = A.in[15][c] * (1.0f + MOD[b * 6144 + 4096 + c]); } }
    { LAS float* sh2 = (LAS float*)(F.lds);
      for (int i = F.tid; i < 8192; i += NWAVES * 64) sh2[i] = MOD[(i >> 10) * 6144 + 3072 + (i & 1023)];
      __syncthreads();
      gemv8(F, sh2, 22, 256, FF, SrcGu{A.in[16], A.in[17]}, nullptr, (float*)(F.ws + WS_BGU), NGU); }
    const int gw = blockIdx.x * NWAVES + F.wave, NGW = F.G * NWAVES; bf16* XN = (bf16*)(F.ws + WS_XN);
    for (int m = gw; m < M; m += NGW) {
        const int b = m >> 13;
        const GAS f32x4* xr = (const GAS f32x4*)(A.in[0] + (size_t)m * D) + F.lane;
        f32x4 v[4]; float s = 0.f;
#pragma unroll
        for (int j = 0; j < 4; ++j) { v[j] = xr[64 * j]; s += (v[j].x * v[j].x + v[j].y * v[j].y) + (v[j].z * v[j].z + v[j].w * v[j].w); }
        const float r = 1.0f / sqrtf(wave_sum(s) * (1.0f / D) + EPS);
        GAS unsigned long long* o8 = (GAS unsigned long long*)(XN + (size_t)m * D) + F.lane;
#pragma unroll
        for (int j = 0; j < 4; ++j) { const int c = 4 * F.lane + 256 * j;
            const f32x4 w = *(const f32x4*)(A.in[4] + c), sc = *(const f32x4*)(MOD + b * 6144 + 1024 + c), sh = *(const f32x4*)(MOD + b * 6144 + c);
            const f32x4 y = v[j] * r * w * (sc + 1.0f) + sh;
            o8[64 * j] = (unsigned long long)pk2(y.x, y.y) | ((unsigned long long)pk2(y.z, y.w) << 32); }
    }
}

constexpr int H_QC = 0, H_QB = 17408, H_K = 34816, H_KT = 78336, H_VT = 96768, H_PM = 115200, H_ST = 124416, H_BT = 159232, H_AL = 161280;
constexpr int HS128 = 272, HS64 = 144;
__device__ __forceinline__ unsigned short f2bfs(float f) { return (unsigned short)f2bf(f); }
__device__ __forceinline__ void hgrn_h1_unit(Frame& F, int unit) {
    const int b = unit >> 5, h = (unit >> 3) & 3, n = unit & 7;
    const int tid = F.tid, lane = F.lane, w = F.wave, c = tid & 127, bi = tid >> 7, l15 = lane & 15, l4 = lane >> 4;
    const size_t rowbase = (size_t)(b * SEQ + n * 1024) * 512 + h * 128;
    const bf16* RQ = (const bf16*)(F.ws + WS_RQ) + rowbase; const bf16* RGL = (const bf16*)(F.ws + WS_RGL) + rowbase; const bf16* RI = (const bf16*)(F.ws + WS_RI) + rowbase;
    bf16* OLOC = (bf16*)(F.ws + WS_OLOC) + rowbase; bf16* QHAT = (bf16*)(F.ws + WS_QHAT) + rowbase;
    LAS unsigned char* L = F.lds; LAS float* BT = (LAS float*)(L + H_BT); LAS float* AL = (LAS float*)(L + H_AL);
    f32x4 acc[8];
#pragma unroll
    for (int vb = 0; vb < 8; ++vb) acc[vb] = (f32x4){0.f, 0.f, 0.f, 0.f};
    float asup = 0.f;
    for (int i = tid; i < 64 * HS64 / 4; i += NWAVES * 64) ((LAS unsigned*)(L + H_PM))[i] = 0u;
#pragma unroll 1
    for (int ci = 0; ci < 16; ++ci) {
        const size_t r0 = (size_t)(ci * 64 + bi * 16) * 512 + c;
        float gq[16], qq[16], al[16]; unsigned vp[8];
#pragma unroll
        for (int r = 0; r < 16; ++r) { gq[r] = bf1(RGL[r0 + (size_t)r * 512]); qq[r] = bf1(RQ[r0 + (size_t)r * 512]); }
#pragma unroll
        for (int r = 0; r < 8; ++r) vp[r] = (unsigned)RI[r0 + (size_t)(2 * r) * 512] | ((unsigned)RI[r0 + (size_t)(2 * r + 1) * 512] << 16);
        { float run = 0.f;
#pragma unroll
          for (int r = 0; r < 16; ++r) { run += gq[r]; al[r] = run; }
          BT[bi * 128 + c] = run; }
        if (ci > 0) {
#pragma unroll
            for (int vb = 0; vb < 8; ++vb) { v2u o; o.x = pk2(acc[vb][0], acc[vb][1]); o.y = pk2(acc[vb][2], acc[vb][3]);
                *(LAS v2u*)(L + H_ST + (16 * vb + l15) * HS128 + (16 * w + 4 * l4) * 2) = o; } }
        *(LAS v4u*)(L + H_VT + c * HS64 + bi * 32) = (v4u){vp[0], vp[1], vp[2], vp[3]}; *(LAS v4u*)(L + H_VT + c * HS64 + bi * 32 + 16) = (v4u){vp[4], vp[5], vp[6], vp[7]};
        __syncthreads();
        const float b0 = BT[c], b1 = BT[128 + c], b2 = BT[256 + c], b3 = BT[384 + c];
        const float ab1 = b0, ab2 = b0 + b1, ab3 = ab2 + b2, alast = ab3 + b3;
        const float ab = bi == 0 ? 0.f : bi == 1 ? ab1 : bi == 2 ? ab2 : ab3;
        if (bi == 0) AL[c] = alast;
        unsigned kp[8];
#pragma unroll
        for (int r = 0; r < 16; ++r) { const int t = bi * 16 + r; const float Av = ab + al[r];
            *(LAS unsigned short*)(L + H_QC + t * HS128 + c * 2) = f2bfs(qq[r] * __expf(Av));
            QHAT[r0 + (size_t)r * 512] = f2bfs(qq[r] * __expf(Av + asup));
            *(LAS unsigned short*)(L + H_QB + t * HS128 + c * 2) = f2bfs(qq[r] * __expf(al[r]));
            const float kk = 1.0f - __expf(gq[r]);
            const unsigned ke = f2bf(kk * __expf(alast - Av)); if (r & 1) kp[r >> 1] |= ke << 16; else kp[r >> 1] = ke;
            if (bi <= 0) *(LAS unsigned short*)(L + H_K + (0 + t) * HS128 + c * 2) = f2bfs(kk * __expf(0.f - Av));
            if (bi <= 1) *(LAS unsigned short*)(L + H_K + (16 + t) * HS128 + c * 2) = f2bfs(kk * __expf(ab1 - Av));
            if (bi <= 2) *(LAS unsigned short*)(L + H_K + (48 + t) * HS128 + c * 2) = f2bfs(kk * __expf(ab2 - Av));
            *(LAS unsigned short*)(L + H_K + (96 + t) * HS128 + c * 2) = f2bfs(kk * __expf(ab3 - Av)); }
        *(LAS v4u*)(L + H_KT + c * HS64 + bi * 32) = (v4u){kp[0], kp[1], kp[2], kp[3]}; *(LAS v4u*)(L + H_KT + c * HS64 + bi * 32 + 16) = (v4u){kp[4], kp[5], kp[6], kp[7]};
        asup += alast;
        __syncthreads();
#pragma unroll
        for (int rep = 0; rep < 2; ++rep) { const int tile = w + 8 * rep;
            if (tile < 10) { const int i = tile < 1 ? 0 : tile < 3 ? 1 : tile < 6 ? 2 : 3, j = tile - (i * (i + 1)) / 2;
                const LAS unsigned char* ap = L + H_QB + (16 * i + l15) * HS128 + l4 * 16; const LAS unsigned char* bp = L + H_K + (8 * i * (i + 1) + 16 * j + l15) * HS128 + l4 * 16;
                f32x4 p = (f32x4){0.f, 0.f, 0.f, 0.f};
#pragma unroll
                for (int ks = 0; ks < 4; ++ks) p = __builtin_amdgcn_mfma_f32_16x16x32_bf16(*(const LAS bf16x8*)(ap + ks * 64), *(const LAS bf16x8*)(bp + ks * 64), p, 0, 0, 0);
#pragma unroll
                for (int r = 0; r < 4; ++r) { const float pv = (i == j && l15 > 4 * l4 + r) ? 0.f : p[r];
                    *(LAS unsigned short*)(L + H_PM + (16 * i + 4 * l4 + r) * HS64 + (16 * j + l15) * 2) = f2bfs(pv); } } }
        __syncthreads();
#pragma unroll
        for (int tb = 0; tb < 4; ++tb) { f32x4 o = (f32x4){0.f, 0.f, 0.f, 0.f};
#pragma unroll
            for (int ks = 0; ks < 2; ++ks) if (32 * ks < 16 * (tb + 1))
                o = __builtin_amdgcn_mfma_f32_16x16x32_bf16(*(const LAS bf16x8*)(L + H_VT + (16 * w + l15) * HS64 + l4 * 16 + ks * 64), *(const LAS bf16x8*)(L + H_PM + (16 * tb + l15) * HS64 + l4 * 16 + ks * 64), o, 0, 0, 0);
            if (ci > 0) {
#pragma unroll
                for (int ks = 0; ks < 4; ++ks)
                    o = __builtin_amdgcn_mfma_f32_16x16x32_bf16(*(const LAS bf16x8*)(L + H_ST + (16 * w + l15) * HS128 + l4 * 16 + ks * 64), *(const LAS bf16x8*)(L + H_QC + (16 * tb + l15) * HS128 + l4 * 16 + ks * 64), o, 0, 0, 0); }
            v2u ov; ov.x = pk2(o[0], o[1]); ov.y = pk2(o[2], o[3]);
            *(v2u*)(OLOC + (size_t)(ci * 64 + 16 * tb + l15) * 512 + 16 * w + 4 * l4) = ov; }
        { const f32x4 dv = *(const LAS f32x4*)(AL + 16 * w + 4 * l4); const f32x4 d = (f32x4){__expf(dv[0]), __expf(dv[1]), __expf(dv[2]), __expf(dv[3])};
          const bf16x8 ka0 = *(const LAS bf16x8*)(L + H_KT + (16 * w + l15) * HS64 + l4 * 16), ka1 = *(const LAS bf16x8*)(L + H_KT + (16 * w + l15) * HS64 + l4 * 16 + 64);
#pragma unroll
          for (int vb = 0; vb < 8; ++vb) { f32x4 s = acc[vb] * d;
              s = __builtin_amdgcn_mfma_f32_16x16x32_bf16(ka0, *(const LAS bf16x8*)(L + H_VT + (16 * vb + l15) * HS64 + l4 * 16), s, 0, 0, 0);
              s = __builtin_amdgcn_mfma_f32_16x16x32_bf16(ka1, *(const LAS bf16x8*)(L + H_VT + (16 * vb + l15) * HS64 + l4 * 16 + 64), s, 0, 0, 0);
              acc[vb] = s; } }
        __syncthreads();
    }
    f32x4* U = (f32x4*)(F.ws + WS_U);
#pragma unroll
    for (int vb = 0; vb < 8; ++vb) U[(size_t)((unit * 8 + w) * 8 + vb) * 64 + lane] = acc[vb];
    if (bi == 0) ((float*)(F.ws + WS_DS))[unit * 128 + c] = __expf(asup);
}
__device__ __forceinline__ void hgrn_h3_unit(Frame& F, const Args& A, int unit) {
    const int b = unit >> 5, h = (unit >> 3) & 3, n = unit & 7;
    const int lane = F.lane, w = F.wave, l15 = lane & 15, l4 = lane >> 4;
    LAS unsigned char* L = F.lds;
    const f32x4* U = (const f32x4*)(F.ws + WS_U); const float* DS = (const float*)(F.ws + WS_DS);
    f32x4 S[8];
#pragma unroll
    for (int vb = 0; vb < 8; ++vb) S[vb] = (f32x4){0.f, 0.f, 0.f, 0.f};
    for (int m = 0; m < n; ++m) { const int um = unit - n + m; const f32x4 d = *(const f32x4*)(DS + um * 128 + 16 * w + 4 * l4);
#pragma unroll
        for (int vb = 0; vb < 8; ++vb) S[vb] = S[vb] * d + U[(size_t)((um * 8 + w) * 8 + vb) * 64 + lane]; }
#pragma unroll
    for (int vb = 0; vb < 8; ++vb) { v2u o; o.x = pk2(S[vb][0], S[vb][1]); o.y = pk2(S[vb][2], S[vb][3]);
        *(LAS v2u*)(L + H_ST + (16 * vb + l15) * HS128 + (16 * w + 4 * l4) * 2) = o; }
    __syncthreads();
    const size_t rowbase = (size_t)(b * SEQ + n * 1024 + 128 * w) * 512 + h * 128;
    const bf16* QHAT = (const bf16*)(F.ws + WS_QHAT) + rowbase; const bf16* OLOC = (const bf16*)(F.ws + WS_OLOC) + rowbase;
    const bf16* RGS = (const bf16*)(F.ws + WS_RGS) + rowbase; bf16* REC = (bf16*)(F.ws + WS_REC) + rowbase;
    f32x4 rw[8];
#pragma unroll
    for (int vb = 0; vb < 8; ++vb) rw[vb] = *(const f32x4*)(A.in[11] + 16 * vb + 4 * l4);
#pragma unroll 1
    for (int tb = 0; tb < 8; ++tb) { const size_t tr = (size_t)(16 * tb + l15) * 512;
        bf16x8 qh[4];
#pragma unroll
        for (int ks = 0; ks < 4; ++ks) qh[ks] = *(const bf16x8*)(QHAT + tr + 32 * ks + 8 * l4);
        f32x4 o[8]; float ss = 0.f;
#pragma unroll
        for (int vb = 0; vb < 8; ++vb) { f32x4 a = (f32x4){0.f, 0.f, 0.f, 0.f};
            if (n > 0) {
#pragma unroll
                for (int ks = 0; ks < 4; ++ks) a = __builtin_amdgcn_mfma_f32_16x16x32_bf16(*(const LAS bf16x8*)(L + H_ST + (16 * vb + l15) * HS128 + l4 * 16 + ks * 64), qh[ks], a, 0, 0, 0); }
            const v2u ol = *(const v2u*)(OLOC + tr + 16 * vb + 4 * l4);
            a[0] += bflo(ol.x); a[1] += bfhi(ol.x); a[2] += bflo(ol.y); a[3] += bfhi(ol.y);
            o[vb] = a; ss += (a[0] * a[0] + a[1] * a[1]) + (a[2] * a[2] + a[3] * a[3]); }
        ss += __shfl_xor(ss, 16); ss += __shfl_xor(ss, 32);
        const float r = 1.0f / sqrtf(ss * (1.0f / 128.0f) + EPS);
#pragma unroll
        for (int vb = 0; vb < 8; ++vb) { const v2u g = *(const v2u*)(RGS + tr + 16 * vb + 4 * l4); const f32x4 y = o[vb] * r * rw[vb];
            v2u ov; ov.x = pk2(y[0] * bflo(g.x), y[1] * bfhi(g.x)); ov.y = pk2(y[2] * bflo(g.y), y[3] * bfhi(g.y));
            *(v2u*)(REC + tr + 16 * vb + 4 * l4) = ov; }
    }
    __syncthreads();
}

__device__ __forceinline__ unsigned f2key(float x) {
    const _Float16 hh = (_Float16)x; const unsigned bits = (unsigned)__builtin_bit_cast(unsigned short, hh);
    return (bits & 0x8000u) ? (~bits & 0xffffu) : (bits | 0x8000u);
}
constexpr int DSA_VIMG = 73728;
constexpr int DSA_CAND = 147456, DSA_CAPC = 448;
typedef unsigned u32x4p __attribute__((ext_vector_type(4)));
__device__ __forceinline__ void dsa_unit(Frame& F, int b, int t0) {
    const int lane = F.lane, w = F.wave, qc = lane & 31, hf = lane >> 5;
    const bf16* KI = (const bf16*)(F.ws + WS_KI) + (size_t)b * SEQ * 64;
    const bf16* QI = (const bf16*)(F.ws + WS_QI) + (size_t)(b * SEQ + t0) * 512;
    const float* WI = (const float*)(F.ws + WS_WI) + (size_t)(b * SEQ + t0) * 8;
    unsigned short* scr = (unsigned short*)(F.ws + WS_SCR) + (size_t)blockIdx.x * (32 * 8192);
    const int nkb = t0 / 32 + 1;
    LAS unsigned* hist = (LAS unsigned*)(F.lds);
    for (int i = F.tid; i < 4096; i += NWAVES * 64) ((LAS v4u*)hist)[i] = (v4u){0u, 0u, 0u, 0u};
    __syncthreads();
#ifndef NO_PASS1
    {
        const int l15 = lane & 15, l4 = lane >> 4, qg = w >> 2, ql = 16 * qg + l15;
        bf16x8 qf[8][2]; float wv[8];
#pragma unroll
        for (int h = 0; h < 8; ++h) { wv[h] = WI[ql * 8 + h];
#pragma unroll
            for (int ks = 0; ks < 2; ++ks) qf[h][ks] = *(const bf16x8*)(QI + (size_t)ql * 512 + h * 64 + ks * 32 + l4 * 8); }
        const int lim = t0 + ql - 4 * l4;
        float wh[8];
#pragma unroll
        for (int h = 0; h < 8; ++h) wh[h] = 0.5f * wv[h];
        const int nb16 = 2 * nkb;
#define P1_LOAD(K0, K1, KB) do { const int row_ = (KB) * 16 + l15; const bf16* kp_ = KI + (size_t)(row_ < SEQ - 1 ? row_ : SEQ - 1) * 64 + l4 * 8; K0 = *(const bf16x8*)(kp_); K1 = *(const bf16x8*)(kp_ + 32); } while (0)
#define P1_COMPUTE(K0, K1, KB) do { const int s0_ = (KB) * 16; f32x4 sc_ = (f32x4){0.f, 0.f, 0.f, 0.f}; \
            _Pragma("unroll") for (int h = 0; h < 8; ++h) { f32x4 a_ = (f32x4){0.f, 0.f, 0.f, 0.f}; \
                a_ = __builtin_amdgcn_mfma_f32_16x16x32_bf16(K0, qf[h][0], a_, 0, 0, 0); a_ = __builtin_amdgcn_mfma_f32_16x16x32_bf16(K1, qf[h][1], a_, 0, 0, 0); \
                _Pragma("unroll") for (int r = 0; r < 4; ++r) { sc_[r] = __builtin_fmaf(wh[h], a_[r], sc_[r]); sc_[r] = __builtin_fmaf(wh[h], __builtin_fabsf(a_[r]), sc_[r]); } } \
            unsigned kk_[4]; \
            _Pragma("unroll") for (int r = 0; r < 4; ++r) { const bool causal_ = s0_ + r <= lim; const unsigned key_ = f2key(sc_[r]); kk_[r] = causal_ ? key_ : 0u; \
                if (causal_) __hip_atomic_fetch_add(hist + ql * 512 + (key_ >> 7), 1u, __ATOMIC_RELAXED, __HIP_MEMORY_SCOPE_WORKGROUP); } \
            v2u o_; o_.x = kk_[0] | (kk_[1] << 16); o_.y = kk_[2] | (kk_[3] << 16); \
            *(v2u*)(scr + (size_t)ql * 8192 + s0_ + 4 * l4) = o_; } while (0)
        bf16x8 ka0, ka1, kb0, kb1;
        int kb = (w & 3);
        P1_LOAD(ka0, ka1, kb);
#pragma unroll 1
        for (; kb < nb16; kb += 8) {
            P1_LOAD(kb0, kb1, kb + 4);
            P1_COMPUTE(ka0, ka1, kb);
            P1_LOAD(ka0, ka1, kb + 8);
            if (kb + 4 < nb16) P1_COMPUTE(kb0, kb1, kb + 4);
        }
#undef P1_LOAD
#undef P1_COMPUTE
    }
#endif
    __syncthreads();
    LAS unsigned short* idxl = (LAS unsigned short*)(F.lds + 65536) + w * 256;
    const LAS float* rb = (const LAS float*)(F.lds + 69632); const LAS int* lut = (const LAS int*)(F.lds + 70656);
    const bf16* KV = (const bf16*)(F.ws + WS_KV) + (size_t)b * SEQ * 256;
    const int nk = nkb * 32, ndw = nk >> 1;
#pragma unroll 1
    for (int qq = 0; qq < 4; ++qq) {
        const int ql = w * 4 + qq, t = t0 + ql, nvalid = t + 1, nsel = nvalid < 256 ? nvalid : 256;
        const unsigned* rowd = (const unsigned*)(scr + (size_t)ql * 8192);
        int ln = lane; asm volatile("" : "+v"(ln));
        {
        unsigned rv[64];
#pragma unroll
        for (int j = 0; j < 64; ++j) { const unsigned val = rowd[j * 64 + ln]; rv[j] = (ln < ndw - j * 64) ? val : 0u; }
        unsigned T = 0u; int need = 0; bool done = false;
        const unsigned long long lt = (1ull << ln) - 1ull; const int ln2 = 2 * ln;
        if (nvalid > 256) {
            const LAS unsigned* hq = hist + ql * 512 + 8 * ln;
            const v4u h0 = *(const LAS v4u*)(hq), h1 = *(const LAS v4u*)(hq + 4);
            const unsigned h8[8] = {h0.x, h0.y, h0.z, h0.w, h1.x, h1.y, h1.z, h1.w};
            const unsigned sl = (h0.x + h0.y) + (h0.z + h0.w) + (h1.x + h1.y) + (h1.z + h1.w);
            unsigned S = sl;
#pragma unroll
            for (int d = 1; d < 64; d <<= 1) { const unsigned tt = __shfl_down(S, d); if (ln + d < 64) S += tt; }
            const int Lb = __popcll(__ballot(S >= 256u)) - 1;
            unsigned cum = S - sl, caL = 0u, cbL = 0u; int Bi = 0; bool found = false;
#pragma unroll
            for (int i = 7; i >= 0; --i) { if (!found && cum + h8[i] >= 256u) { Bi = i; caL = cum; cbL = h8[i]; found = true; } if (!found) cum += h8[i]; }
            const int B = 8 * Lb + __shfl(Bi, Lb); const int ca = (int)__shfl(caL, Lb), cb = (int)__shfl(cbL, Lb);
            if (cb <= DSA_CAPC) {
                LAS unsigned* cand = (LAS unsigned*)(F.lds + DSA_CAND) + w * DSA_CAPC;
                const unsigned Tg = (unsigned)(B + 1) << 7, Te = (unsigned)B << 7;
                int gbase = 0, ebase = 0;
#pragma unroll
                for (int g = 0; g < 8; ++g) if (g * 1024 < nk) {
#pragma unroll
                    for (int j = 8 * g; j < 8 * g + 8; ++j) { const unsigned lo = rv[j] & 0xffffu, hi = rv[j] >> 16;
                        const bool gl = lo >= Tg, gh = hi >= Tg, el = lo >= Te && !gl, eh = hi >= Te && !gh;
                        const unsigned long long mgl = __ballot(gl), mgh = __ballot(gh), mel = __ballot(el), meh = __ballot(eh);
                        if ((mgl | mgh | mel | meh) != 0ull) {
                            const int pgl = gbase + __popcll(mgl & lt) + __popcll(mgh & lt), pgh = pgl + (gl ? 1 : 0);
                            const int pel = ebase + __popcll(mel & lt) + __popcll(meh & lt), peh = pel + (el ? 1 : 0);
                            const unsigned i0 = (unsigned)(ln2 + 128 * j);
                            if (gl && pgl < 256) idxl[pgl] = (unsigned short)i0; if (gh && pgh < 256) idxl[pgh] = (unsigned short)(i0 + 1u);
                            if (el && pel < DSA_CAPC) cand[pel] = (lo << 16) | (65535u - i0); if (eh && peh < DSA_CAPC) cand[peh] = (hi << 16) | (65534u - i0);
                            gbase += __popcll(mgl) + __popcll(mgh); ebase += __popcll(mel) + __popcll(meh); }
                        __builtin_amdgcn_sched_barrier(0); } }
                LDS_WAIT(); asm volatile("" ::: "memory");
                const int needc = 256 - ca; unsigned pref = (unsigned)B << 23;
#pragma unroll 1
                for (int bit = 22; bit >= 0; --bit) { const unsigned c = pref | (1u << bit); int cnt = 0;
                    for (int i = ln; i < cb; i += 64) cnt += (cand[i] >= c) ? 1 : 0;
#pragma unroll
                    for (int o = 1; o < 64; o <<= 1) cnt += __shfl_xor(cnt, o);
                    if (cnt >= needc) pref = c; }
                int base = ca;
                for (int i0 = 0; i0 < cb; i0 += 64) { const int i = i0 + ln; const unsigned cv = i < cb ? cand[i] : 0u; const bool sl2 = i < cb && cv >= pref;
                    const unsigned long long m = __ballot(sl2); const int pos = base + __popcll(m & lt);
                    if (sl2 && pos < 256) idxl[pos] = (unsigned short)(65535u - (cv & 0xffffu)); base += __popcll(m); }
                done = true;
            } else {
#pragma unroll 1
                for (int bit = 15; bit >= 0; --bit) { const unsigned cand2 = T | (1u << bit); int c = 0;
#pragma unroll
                    for (int g = 0; g < 8; ++g) if (g * 1024 < nk) {
#pragma unroll
                        for (int j = 8 * g; j < 8 * g + 8; ++j) { c += ((rv[j] & 0xffffu) >= cand2) ? 1 : 0; c += ((rv[j] >> 16) >= cand2) ? 1 : 0; } }
#pragma unroll
                    for (int o = 1; o < 64; o <<= 1) c += __shfl_xor(c, o);
                    if (c >= 256) T = cand2; }
                int c = 0;
#pragma unroll
                for (int g = 0; g < 8; ++g) if (g * 1024 < nk) {
#pragma unroll
                    for (int j = 8 * g; j < 8 * g + 8; ++j) { c += ((rv[j] & 0xffffu) > T) ? 1 : 0; c += ((rv[j] >> 16) > T) ? 1 : 0; } }
#pragma unroll
                for (int o = 1; o < 64; o <<= 1) c += __shfl_xor(c, o);
                need = 256 - c;
            }
        }
        if (!done) {
            int base = 0, tiebase = 0;
#pragma unroll
            for (int g = 0; g < 8; ++g) if (g * 1024 < nk) {
#pragma unroll
                for (int j = 8 * g; j < 8 * g + 8; ++j) { const unsigned lo = rv[j] & 0xffffu, hi = rv[j] >> 16;
                    const bool el = lo == T, eh = hi == T; const unsigned long long mel = __ballot(el), meh = __ballot(eh);
                    const int trl = tiebase + __popcll(mel & lt) + __popcll(meh & lt), trh = trl + (el ? 1 : 0);
                    const bool sl = lo > T || (el && trl < need), sh = hi > T || (eh && trh < need);
                    const unsigned long long msl = __ballot(sl), msh = __ballot(sh);
                    const int pl = base + __popcll(msl & lt) + __popcll(msh & lt), ph = pl + (sl ? 1 : 0);
                    if (sl && pl < 256) idxl[pl] = (unsigned short)(ln2 + 128 * j); if (sh && ph < 256) idxl[ph] = (unsigned short)(ln2 + 128 * j + 1);
                    base += __popcll(msl) + __popcll(msh); tiebase += __popcll(mel) + __popcll(meh); __builtin_amdgcn_sched_barrier(0); } }
        }
        }
        LDS_WAIT(); asm volatile("" ::: "memory");
#ifdef EXP_ATT2
#pragma unroll 1
        for (int rep_ = 0; rep_ < 2; ++rep_)
#endif
        {
            const int l15 = lane & 15, l4 = lane >> 4;
#pragma unroll
            for (int jj = 0; jj < 4; ++jj) { const int j = lane + 64 * jj; if (j >= nsel) idxl[j] = 0; }
            LDS_WAIT(); asm volatile("" ::: "memory");
            const bf16* qrow = (const bf16*)(F.ws + WS_Q) + (size_t)(b * SEQ + t) * 512 + (l15 & 7) * 64 + 8 * l4;
            bf16x8 bq[2][2];
#pragma unroll
            for (int g = 0; g < 2; ++g)
#pragma unroll
                for (int ks = 0; ks < 2; ++ks) { bf16x8 v = *(const bf16x8*)(qrow + 32 * ks); if ((l15 >> 2) != g) v = (bf16x8){0, 0, 0, 0, 0, 0, 0, 0}; bq[g][ks] = v; }
            f32x4 sa[16];
#pragma unroll
            for (int half = 0; half < 4; ++half) {
                bf16x8 ka[4][4];
#pragma unroll
                for (int bl = 0; bl < 4; ++bl) { const bf16* kr = KV + (size_t)idxl[16 * (4 * half + bl) + l15] * 256 + 8 * l4;
#pragma unroll
                    for (int i = 0; i < 4; ++i) ka[bl][i] = *(const bf16x8*)(kr + 32 * i); }
#pragma unroll
                for (int bl = 0; bl < 4; ++bl) { f32x4 acc = (f32x4){0.f, 0.f, 0.f, 0.f};
                    acc = __builtin_amdgcn_mfma_f32_16x16x32_bf16(ka[bl][0], bq[0][0], acc, 0, 0, 0); acc = __builtin_amdgcn_mfma_f32_16x16x32_bf16(ka[bl][1], bq[0][1], acc, 0, 0, 0);
                    acc = __builtin_amdgcn_mfma_f32_16x16x32_bf16(ka[bl][2], bq[1][0], acc, 0, 0, 0); acc = __builtin_amdgcn_mfma_f32_16x16x32_bf16(ka[bl][3], bq[1][1], acc, 0, 0, 0);
                    sa[4 * half + bl] = acc; } }
            v4u vbuf[8];
#pragma unroll
            for (int i = 0; i < 8; ++i) vbuf[i] = *(const v4u*)(KV + (size_t)idxl[4 * i + l4] * 256 + 128 + l15 * 8);
            float mx = -INFINITY;
#pragma unroll
            for (int blk = 0; blk < 16; ++blk)
#pragma unroll
                for (int r = 0; r < 4; ++r) { const int j = 16 * blk + 4 * l4 + r; const int dist = t - (int)idxl[j]; const int bk = dist < 128 ? lut[dist] : 31;
                    const float v = (j < nsel) ? sa[blk][r] + rb[bk * 8 + (l15 & 7)] : -INFINITY; sa[blk][r] = v; mx = fmaxf(mx, v); }
            mx = fmaxf(mx, __shfl_xor(mx, 16)); mx = fmaxf(mx, __shfl_xor(mx, 32));
            float su = 0.f;
#pragma unroll
            for (int blk = 0; blk < 16; ++blk)
#pragma unroll
                for (int r = 0; r < 4; ++r) { const float e = __expf(sa[blk][r] - mx); sa[blk][r] = e; su += e; }
            su += __shfl_xor(su, 16); su += __shfl_xor(su, 32);
            const float inv = 1.0f / su;
            f32x4 oa[2][4];
#pragma unroll
            for (int g = 0; g < 2; ++g)
#pragma unroll
                for (int c = 0; c < 4; ++c) oa[g][c] = (f32x4){0.f, 0.f, 0.f, 0.f};
            LAS unsigned char* vimg = F.lds + DSA_VIMG + w * 9216;
            const unsigned traddr = (unsigned)(size_t)(vimg + (4 * l4 + (l15 >> 2)) * 144 + (l15 & 3) * 8);
#pragma unroll
            for (int ks = 0; ks < 8; ++ks) {
#pragma unroll
                for (int i = 0; i < 8; ++i) *(LAS v4u*)(vimg + (l15 >> 3) * 4608 + (4 * i + l4) * 144 + (l15 & 7) * 16) = vbuf[i];
                if (ks + 1 < 8) {
#pragma unroll
                    for (int i = 0; i < 8; ++i) vbuf[i] = *(const v4u*)(KV + (size_t)idxl[32 * (ks + 1) + 4 * i + l4] * 256 + 128 + l15 * 8); }
                LDS_WAIT(); asm volatile("" ::: "memory");
                u32x4p pa; pa.x = pk2(sa[2 * ks][0], sa[2 * ks][1]); pa.y = pk2(sa[2 * ks][2], sa[2 * ks][3]); pa.z = pk2(sa[2 * ks + 1][0], sa[2 * ks + 1][1]); pa.w = pk2(sa[2 * ks + 1][2], sa[2 * ks + 1][3]);
                const bf16x8 pfrag = __builtin_bit_cast(bf16x8, pa);
#pragma unroll
                for (int g = 0; g < 2; ++g)
#pragma unroll
                    for (int c = 0; c < 4; ++c) { v2u lo, hi;
                        asm volatile("ds_read_b64_tr_b16 %0, %2 offset:%3\n\tds_read_b64_tr_b16 %1, %2 offset:%4\n\ts_waitcnt lgkmcnt(0)" : "=&v"(lo), "=&v"(hi) : "v"(traddr), "n"(g * 4608 + c * 32), "n"(g * 4608 + c * 32 + 16 * 144) : "memory");
                        u32x4p bb; bb.x = lo.x; bb.y = lo.y; bb.z = hi.x; bb.w = hi.y;
                        oa[g][c] = __builtin_amdgcn_mfma_f32_16x16x32_bf16(pfrag, __builtin_bit_cast(bf16x8, bb), oa[g][c], 0, 0, 0); }
                asm volatile("" ::: "memory");
            }
            bf16* orow = (bf16*)(F.ws + WS_ATT) + (size_t)(b * SEQ + t) * 512;
#pragma unroll
            for (int r = 0; r < 4; ++r) { const float i0 = __shfl(inv, r), i1 = __shfl(inv, 4 + r);
                if (l4 < 2) {
#pragma unroll
                    for (int c = 0; c < 4; ++c) { const float v = l4 == 0 ? oa[0][c][r] * i0 : oa[1][c][r] * i1; orow[(4 * l4 + r) * 64 + 16 * c + l15] = (bf16)f2bf(v); } } }
        }
        LDS_WAIT(); asm volatile("" ::: "memory");
    }
    __syncthreads();
}

__device__ __forceinline__ void p4_mixers(Frame& F, const Args& A) {
    for (int u = blockIdx.x; u < 256; u += F.G) hgrn_h1_unit(F, u);
    __syncthreads();
    { LAS float* rb = (LAS float*)(F.lds + 69632); LAS int* lut = (LAS int*)(F.lds + 70656);
      if (F.tid < 256) rb[F.tid] = A.in[9][F.tid];
      if (F.tid < 128) { const int n = F.tid; int v = n; if (n >= 16) { v = 16 + (int)(__logf((float)n * (1.0f / 16.0f)) * (16.0f / 2.0794415416798357f)); v = v < 31 ? v : 31; } lut[n] = v; }
      __syncthreads(); }
#ifdef EXP_DSA2
#pragma unroll 1
    for (int rep3_ = 0; rep3_ < 2; ++rep3_)
#endif
    for (int u = blockIdx.x; u < 2048; u += F.G) { const int b = u & 7, qb = 255 - (u >> 3); dsa_unit(F, b, qb * 32); }
}

__device__ __forceinline__ void p5_rec(Frame& F, const Args& A) { for (int u = blockIdx.x; u < 256; u += F.G) hgrn_h3_unit(F, A, u); }

__device__ __forceinline__ void p10_final(Frame& F, const Args& A) {
    const int gw = blockIdx.x * NWAVES + F.wave, NGW = F.G * NWAVES; const float* SS = (const float*)(F.ws + WS_X2SS);
    for (int m = gw; m < M; m += NGW) {
        float s = F.lane < 16 ? SS[(size_t)m * 16 + F.lane] : 0.f; s = wave_sum(s);
        const float r = 1.0f / sqrtf(s * (1.0f / D) + EPS);
        GAS f32x4* xr = (GAS f32x4*)(F.out + (size_t)m * D) + F.lane;
#pragma unroll
        for (int j = 0; j < 4; ++j) { const f32x4 w = *(const f32x4*)(A.in[19] + 4 * F.lane + 256 * j); xr[64 * j] = xr[64 * j] * r * w; }
    }
}

__global__ void __launch_bounds__(NWAVES * 64, 2) fwd_kernel(Args args) {
    extern __shared__ __attribute__((aligned(16))) unsigned char lds[];
    Frame F;
    F.lds = (LAS unsigned char*)lds;
    F.MISC = (volatile LAS unsigned*)(F.lds + MISC_OFF);
    F.tid = threadIdx.x; F.lane = F.tid & 63; F.wave = __builtin_amdgcn_readfirstlane(F.tid >> 6);
    F.G = gridDim.x;
    F.ws = args.ws; F.ctl = (gu32*)(args.ws + WS_CTL); F.out = args.out;
    for (int u = F.tid; u < (LDS_BYTES - LDSCTL_OFF) / 4; u += NWAVES * 64) ((LAS unsigned*)(F.lds + LDSCTL_OFF))[u] = 0u;
    __syncthreads();
    XcdBarrier bar; bar.bar = (unsigned*)(F.ctl + CW_BAR); bar.x = 0; bar.st = nullptr;
    if (N_LAUNCHES == 1) bar = xcd_barrier_post((unsigned*)(F.ctl + CW_BAR), F.MISC + 8);
#define GRID_BAR() do { if (N_LAUNCHES == 1) xcd_barrier(bar); } while (0)
    const int lo = args.ph_lo, hi = args.ph_hi;
#ifdef ONLY_PHASE
#define IN(k) ((k) == ONLY_PHASE && lo <= (k) && (k) < hi)
#else
#define IN(k) (lo <= (k) && (k) < hi)
#endif
#define BOTH(k) (IN(k) && IN((k) + 1))
    const float* MOD = (const float*)(F.ws + WS_MOD);

    if (IN(0)) { p0_prologue(F, args); if (BOTH(0)) GRID_BAR(); }
    if (IN(1)) { p1_norm(F, args); if (BOTH(1)) GRID_BAR(); }
    if (IN(2)) {
        pg8::Gemm g{(const bf16*)(F.ws + WS_XN), (const bf16*)(F.ws + WS_WIN), M, NPROJ_PAD, 1024}; pg8::StaticOrder S; S.init(M, NPROJ_PAD, F.G, (int)blockIdx.x);
        pg8::EpiInProj E{(bf16*)(F.ws + WS_CQ), (bf16*)(F.ws + WS_KV), (bf16*)(F.ws + WS_KI), (bf16*)(F.ws + WS_RQ), (bf16*)F.out,
                         (float*)(F.ws + WS_WI), (float*)(F.ws + WS_CQSS), (const float*)(F.ws + WS_LB)};
        pg8::gemm_phase<pg8::EpiInProj, pg8::StaticOrder, PG8_ALIGN, PG8_SP2>(F.lds + RING_OFF, g, S, E);
        if (BOTH(2)) GRID_BAR();
    }
    if (IN(3)) {
        pg8::Gemm g{(const bf16*)(F.ws + WS_CQ), (const bf16*)(F.ws + WS_WQ), M, 1024, 256}; pg8::StaticOrder S; S.init(M, 1024, F.G, (int)blockIdx.x);
        pg8::EpiQ E{(bf16*)(F.ws + WS_Q), (const float*)(F.ws + WS_CQSS)};
        pg8::gemm_phase<pg8::EpiQ, pg8::StaticOrder, PG8_ALIGN, PG8_SP2>(F.lds + RING_OFF, g, S, E);
        if (BOTH(3)) GRID_BAR();
    }
    if (IN(4)) { p4_mixers(F, args); if (BOTH(4)) GRID_BAR(); }
    if (IN(5)) { p5_rec(F, args); if (BOTH(5)) GRID_BAR(); }
    if (IN(6)) {
        pg8::StaticOrder S; S.init(M, 1024, F.G, (int)blockIdx.x);
        { pg8::Gemm g{(const bf16*)(F.ws + WS_ATT), (const bf16*)(F.ws + WS_WBA), M, 1024, 512}; pg8::EpiBranch<0> E{(bf16*)(F.ws + WS_MIX), (const bf16*)F.out};
          pg8::gemm_phase<pg8::EpiBranch<0>, pg8::StaticOrder, PG8_ALIGN, PG8_SP2>(F.lds + RING_OFF, g, S, E); }
        { pg8::Gemm g{(const bf16*)(F.ws + WS_REC), (const bf16*)(F.ws + WS_WBR), M, 1024, 512}; pg8::EpiBranch<1> E{(bf16*)(F.ws + WS_MIX), (const bf16*)F.out};
          pg8::gemm_phase<pg8::EpiBranch<1>, pg8::StaticOrder, PG8_ALIGN, PG8_SP2>(F.lds + RING_OFF, g, S, E); }
        if (BOTH(6)) GRID_BAR();
    }
    if (IN(7)) {
        pg8::Gemm g{(const bf16*)(F.ws + WS_MIX), (const bf16*)(F.ws + WS_WOUT), M, 1024, 1024}; pg8::StaticOrder S; S.init(M, 1024, F.G, (int)blockIdx.x);
        pg8::EpiOut E{args.in[0], (float*)(F.ws + WS_X1), (bf16*)(F.ws + WS_XS), (float*)(F.ws + WS_X1SS), MOD, (const float*)(F.ws + WS_CW2)};
        pg8::gemm_phase<pg8::EpiOut, pg8::StaticOrder, PG8_ALIGN, PG8_SP2>(F.lds + RING_OFF, g, S, E);
        if (BOTH(7)) GRID_BAR();
    }
    if (IN(8)) {
        pg8::Gemm g{(const bf16*)(F.ws + WS_XS), (const bf16*)(F.ws + WS_WGU), M, NGU, 1024}; pg8::StaticOrder S; S.init(M, NGU, F.G, (int)blockIdx.x);
        pg8::EpiGateUp E{(bf16*)(F.ws + WS_HID), (const float*)(F.ws + WS_X1SS), (const float*)(F.ws + WS_BGU)};
        pg8::gemm_phase<pg8::EpiGateUp, pg8::StaticOrder, PG8_ALIGN, PG8_SP2>(F.lds + RING_OFF, g, S, E);
        if (BOTH(8)) GRID_BAR();
    }
    if (IN(9)) {
        pg8::Gemm g{(const bf16*)(F.ws + WS_HID), (const bf16*)(F.ws + WS_WD), M, 1024, FF}; pg8::StaticOrder S; S.init(M, 1024, F.G, (int)blockIdx.x);
        pg8::EpiDown E{(const float*)(F.ws + WS_X1), F.out, (float*)(F.ws + WS_X2SS), MOD};
        pg8::gemm_phase<pg8::EpiDown, pg8::StaticOrder, PG8_ALIGN, PG8_SP2>(F.lds + RING_OFF, g, S, E);
        if (BOTH(9)) GRID_BAR();
    }
    if (IN(10)) p10_final(F, args);
#undef IN
#undef BOTH
}

extern "C" void kernel_launch(void* const* d_in, const int* in_sizes, int n_in, void* d_out, int out_size, void* d_ws, size_t ws_size, hipStream_t stream) {
    static int grid = 0;
    if (grid == 0) {
        if (n_in != 20 || in_sizes[0] != M * D || out_size != M * D || ws_size < WS_END) { fprintf(stderr, "kernel_launch: unexpected shapes (n_in %d, in0 %d, out %d, ws %zu); nothing launched\n", n_in, n_in > 0 ? in_sizes[0] : -1, out_size, ws_size); grid = -1; return; }
        int dev = 0, cus = 0, per_cu = 0;
        if (hipGetDevice(&dev) != hipSuccess || hipDeviceGetAttribute(&cus, hipDeviceAttributeMultiprocessorCount, dev) != hipSuccess) { grid = -1; return; }
        if (hipFuncSetAttribute((const void*)fwd_kernel, hipFuncAttributeMaxDynamicSharedMemorySize, LDS_BYTES) != hipSuccess) { fprintf(stderr, "kernel_launch: hipFuncSetAttribute failed\n"); grid = -1; return; }
        if (hipOccupancyMaxActiveBlocksPerMultiprocessor(&per_cu, (const void*)fwd_kernel, NWAVES * 64, LDS_BYTES) != hipSuccess || per_cu < 1)
            fprintf(stderr, "kernel_launch: note: occupancy query reports %d workgroups per CU\n", per_cu);
        (void)hipGetLastError();
        grid = cus;
    }
    if (grid < 0) return;
    if (hipMemsetAsync((char*)d_ws + WS_CTL, 0, CTL_ZERO_BYTES, stream) != hipSuccess) { fprintf(stderr, "kernel_launch: memset failed\n"); return; }
    Args a{};
    for (int i = 0; i < 20; ++i) a.in[i] = (const float*)d_in[i];
    a.out = (float*)d_out; a.ws = (unsigned char*)d_ws;
    for (int li = 0; li < N_LAUNCHES; ++li) {
        a.ph_lo = (N_LAUNCHES == 1) ? 0 : li; a.ph_hi = (N_LAUNCHES == 1) ? N_PHASES : li + 1;
        hipLaunchKernelGGL(fwd_kernel, dim3(grid), dim3(NWAVES * 64), LDS_BYTES, stream, a);
        const hipError_t le = hipPeekAtLastError();
        if (le != hipSuccess) { fprintf(stderr, "kernel_launch: launch %d failed: %s\n", li, hipGetErrorName(le)); break; }
    }
}
```

```cpp
#include <hip/hip_runtime.h>
#include <cstdio>
#include <cstdint>
namespace pg8 {
#define PG8_LAS __attribute__((address_space(3)))
typedef unsigned short bf16_t;
typedef short bf16x8 __attribute__((ext_vector_type(8)));
typedef float f32x4 __attribute__((ext_vector_type(4)));
typedef unsigned u32x4 __attribute__((ext_vector_type(4)));
constexpr int BM = 256, BK = 64, HALF = 128, HTB = HALF * BK * 2  , STAGE_BYTES = 8 * HTB, NXCD = 8, WGM = 8;

__host__ __device__ __forceinline__ int lds_byte(int r, int c) { const int st = (r >> 4) * 2 + (c >> 5), rr = r & 15, cc = c & 31, ob = rr * 64 + cc * 2; return st * 1024 + (ob ^ (((ob >> 9) & 1) << 5)); }
__host__ __device__ __forceinline__ void stage_rc(int b, int& R, int& C) { const int st = b / 1024, sb = b % 1024, swz = sb ^ (((sb >> 9) & 1) << 5); R = (st >> 1) * 16 + swz / 64; C = (st & 1) * 32 + (swz % 64) / 2; }
__host__ __device__ __forceinline__ int perm32(int rho) { const int n = rho >> 4, i = rho & 15; return 8 * (i >> 2) + 4 * n + (i & 3); }

struct Unit { int pm, pn; };
struct Gemm { const bf16_t* A; const bf16_t* Bt; int M, N, K; };

struct StaticOrder {
    int nM, nN, nwg, G, c;
    __host__ __device__ void init(int M, int N, int G_, int c_) { nM = M / BM; nN = N / BM; nwg = nM * nN; G = G_; c = c_; }
    __host__ __device__ bool next(int i, Unit& u) const {
        const long L = (long)i * G + c; if (L >= nwg) return false;
        int wgid = (int)L; { const int q = nwg / NXCD, r = nwg % NXCD, xcd = wgid % NXCD, off = wgid / NXCD; wgid = (xcd < r ? xcd * (q + 1) : r * (q + 1) + (xcd - r) * q) + off; }
        const int nig = WGM * nN, gid = wgid / nig, fm = gid * WGM, gsz = (nM - fm) < WGM ? (nM - fm) : WGM;
        u.pm = fm + ((wgid % nig) % gsz); u.pn = (wgid % nig) / gsz; return true;
    }
    __device__ __forceinline__ void a_ready(const Unit&) const {}
    __device__ __forceinline__ void done(const Unit&) const {}
};

__device__ __forceinline__ unsigned cvt_pk_bf16(float lo, float hi) { unsigned r; asm volatile("v_cvt_pk_bf16_f32 %0, %1, %2" : "=v"(r) : "v"(lo), "v"(hi)); return r; }
__device__ __forceinline__ float fsigmoid(float x) { return __builtin_amdgcn_rcpf(1.0f + __expf(-x)); }
__device__ __forceinline__ float fsilu(float x) { return x * fsigmoid(x); }
__device__ __forceinline__ u32x4 pack8(const f32x4 a, const f32x4 b) { u32x4 w; w.x = cvt_pk_bf16(a[0], a[1]); w.y = cvt_pk_bf16(a[2], a[3]); w.z = cvt_pk_bf16(b[0], b[1]); w.w = cvt_pk_bf16(b[2], b[3]); return w; }
__device__ __forceinline__ float bf_lo(unsigned u) { return __builtin_bit_cast(float, u << 16); }
__device__ __forceinline__ float bf_hi(unsigned u) { return __builtin_bit_cast(float, u & 0xffff0000u); }

struct EpiInProj {
    static constexpr bool PERM = true, AFTER_DRAIN = false;
    bf16_t *CQ, *KV, *KI, *RQ, *GATES; float *WI, *CQSS; const float* LB;
    __device__ __forceinline__ void operator()(const f32x4 (&acc)[2][2][4][2], const Unit& u, int wr, int wc, int fr, int fq) const {
        const int row0 = u.pm * BM + wr * 64 + fr, pn = u.pn, cl = wc * 32 + 8 * fq;
        if (pn == 0) {
#pragma unroll
            for (int ai = 0; ai < 2; ++ai)
#pragma unroll
                for (int m = 0; m < 4; ++m) { const int row = row0 + ai * HALF + m * 16; float s = 0.f;
#pragma unroll
                    for (int bj = 0; bj < 2; ++bj) { const f32x4 a = acc[ai][bj][m][0], b = acc[ai][bj][m][1];
                        s += (a[0] * a[0] + a[1] * a[1]) + (a[2] * a[2] + a[3] * a[3]) + (b[0] * b[0] + b[1] * b[1]) + (b[2] * b[2] + b[3] * b[3]);
                        *(u32x4*)(CQ + (size_t)row * 256 + cl + bj * HALF) = pack8(a, b); }
                    s += __shfl_xor(s, 16); s += __shfl_xor(s, 32);
                    if (fq == 0) CQSS[(size_t)row * 4 + wc] = s; }
        } else if (pn == 1) {
#pragma unroll
            for (int ai = 0; ai < 2; ++ai)
#pragma unroll
                for (int m = 0; m < 4; ++m) { const int row = row0 + ai * HALF + m * 16;
#pragma unroll
                    for (int bj = 0; bj < 2; ++bj) *(u32x4*)(KV + (size_t)row * 256 + cl + bj * HALF) = pack8(acc[ai][bj][m][0], acc[ai][bj][m][1]); }
        } else if (pn == 2) {
#pragma unroll
            for (int ai = 0; ai < 2; ++ai)
#pragma unroll
                for (int m = 0; m < 4; ++m) { const int row = row0 + ai * HALF + m * 16;
                    if (wc < 2) *(u32x4*)(KI + (size_t)row * 64 + cl) = pack8(acc[ai][0][m][0], acc[ai][0][m][1]);
                    else if (wc == 2 && fq == 0) { *(f32x4*)(WI + (size_t)row * 8) = acc[ai][0][m][0]; *(f32x4*)(WI + (size_t)row * 8 + 4) = acc[ai][0][m][1]; } }
        } else if (pn <= 10) {
            const int kind = (pn - 3) >> 1, cb = ((pn - 3) & 1) * 256 + cl;
            bf16_t* dst = RQ + (size_t)kind * (size_t)(32u << 20);
#pragma unroll
            for (int bj = 0; bj < 2; ++bj) {
                f32x4 l0 = (f32x4){0.f, 0.f, 0.f, 0.f}, l1 = l0;
                if (kind == 1) { l0 = *(const f32x4*)(LB + cb + bj * HALF); l1 = *(const f32x4*)(LB + cb + bj * HALF + 4); }
#pragma unroll
                for (int ai = 0; ai < 2; ++ai)
#pragma unroll
                    for (int m = 0; m < 4; ++m) { const int row = row0 + ai * HALF + m * 16; f32x4 a = acc[ai][bj][m][0], b = acc[ai][bj][m][1];
                        if (kind == 0 || kind == 3) {
#pragma unroll
                            for (int j = 0; j < 4; ++j) { a[j] = fsilu(a[j]); b[j] = fsilu(b[j]); } }
                        else if (kind == 1) {
#pragma unroll
                            for (int j = 0; j < 4; ++j) { a[j] = __logf(l0[j] + (1.0f - l0[j]) * fsigmoid(a[j])); b[j] = __logf(l1[j] + (1.0f - l1[j]) * fsigmoid(b[j])); } }
                        *(u32x4*)(dst + (size_t)row * 512 + cb + bj * HALF) = pack8(a, b); }
            }
        } else {
            const int cb = (pn - 11) * 256 + cl;
#pragma unroll
            for (int ai = 0; ai < 2; ++ai)
#pragma unroll
                for (int m = 0; m < 4; ++m) { const int row = row0 + ai * HALF + m * 16;
#pragma unroll
                    for (int bj = 0; bj < 2; ++bj) { f32x4 a = acc[ai][bj][m][0], b = acc[ai][bj][m][1];
#pragma unroll
                        for (int j = 0; j < 4; ++j) { a[j] = fsigmoid(a[j]); b[j] = fsigmoid(b[j]); }
                        *(u32x4*)(GATES + (size_t)row * 2048 + cb + bj * HALF) = pack8(a, b); } }
        }
    }
};

struct EpiQ {
    static constexpr bool PERM = true, AFTER_DRAIN = false;
    bf16_t *Q; const float* CQSS;
    __device__ __forceinline__ void operator()(const f32x4 (&acc)[2][2][4][2], const Unit& u, int wr, int wc, int fr, int fq) const {
        const int row0 = u.pm * BM + wr * 64 + fr, pn = u.pn, cl = (pn & 1) * 256 + wc * 32 + 8 * fq;
        bf16_t* dst = Q + (pn < 2 ? (size_t)0 : (size_t)(32u << 20));
        const float sc = pn < 2 ? 0.125f : 1.0f;
#pragma unroll
        for (int ai = 0; ai < 2; ++ai)
#pragma unroll
            for (int m = 0; m < 4; ++m) { const int row = row0 + ai * HALF + m * 16;
                const f32x4 ss = *(const f32x4*)(CQSS + (size_t)row * 4);
                const float r = __builtin_amdgcn_rsqf(((ss[0] + ss[1]) + (ss[2] + ss[3])) * (1.0f / 256.0f) + 1e-6f) * sc;
#pragma unroll
                for (int bj = 0; bj < 2; ++bj) *(u32x4*)(dst + (size_t)row * 512 + cl + bj * HALF) = pack8(acc[ai][bj][m][0] * r, acc[ai][bj][m][1] * r); }
    }
};

template <int MODE> struct EpiBranch {
    static constexpr bool PERM = true, AFTER_DRAIN = false;
    bf16_t* MIX; const bf16_t* GATES;
    __device__ __forceinline__ void operator()(const f32x4 (&acc)[2][2][4][2], const Unit& u, int wr, int wc, int fr, int fq) const {
        const int row0 = u.pm * BM + wr * 64 + fr, cl = u.pn * 256 + wc * 32 + 8 * fq;
#pragma unroll
        for (int ai = 0; ai < 2; ++ai)
#pragma unroll
            for (int m = 0; m < 4; ++m) { const int row = row0 + ai * HALF + m * 16;
#pragma unroll
                for (int bj = 0; bj < 2; ++bj) { const int c = cl + bj * HALF;
                    const u32x4 g = *(const u32x4*)(GATES + (size_t)row * 2048 + MODE * 1024 + c);
                    f32x4 a = acc[ai][bj][m][0], b = acc[ai][bj][m][1];
                    a[0] *= bf_lo(g.x); a[1] *= bf_hi(g.x); a[2] *= bf_lo(g.y); a[3] *= bf_hi(g.y); b[0] *= bf_lo(g.z); b[1] *= bf_hi(g.z); b[2] *= bf_lo(g.w); b[3] *= bf_hi(g.w);
                    if (MODE == 1) { const u32x4 p = *(const u32x4*)(MIX + (size_t)row * 1024 + c);
                        a[0] += bf_lo(p.x); a[1] += bf_hi(p.x); a[2] += bf_lo(p.y); a[3] += bf_hi(p.y); b[0] += bf_lo(p.z); b[1] += bf_hi(p.z); b[2] += bf_lo(p.w); b[3] += bf_hi(p.w); }
                    *(u32x4*)(MIX + (size_t)row * 1024 + c) = pack8(a, b); } }
    }
};

struct EpiOut {
    static constexpr bool PERM = true, AFTER_DRAIN = false;
    const float* X; float* X1; bf16_t* XS; float* X1SS; const float* MOD; const float* CW2;
    __device__ __forceinline__ void operator()(const f32x4 (&acc)[2][2][4][2], const Unit& u, int wr, int wc, int fr, int fq) const {
        const int row0 = u.pm * BM + wr * 64 + fr, cl = u.pn * 256 + wc * 32 + 8 * fq, b = u.pm >> 5;
#pragma unroll
        for (int ai = 0; ai < 2; ++ai)
#pragma unroll
            for (int m = 0; m < 4; ++m) { const int row = row0 + ai * HALF + m * 16; float s = 0.f;
#pragma unroll
                for (int bj = 0; bj < 2; ++bj) { const int c = cl + bj * HALF;
                    const float* xp = X + (size_t)row * 1024 + c; const float* gp = MOD + b * 6144 + 2048 + c; const float* cp = CW2 + b * 1024 + c;
                    const f32x4 v0 = *(const f32x4*)(xp) + *(const f32x4*)(gp) * acc[ai][bj][m][0], v1 = *(const f32x4*)(xp + 4) + *(const f32x4*)(gp + 4) * acc[ai][bj][m][1];
                    *(f32x4*)(X1 + (size_t)row * 1024 + c) = v0; *(f32x4*)(X1 + (size_t)row * 1024 + c + 4) = v1;
                    s += (v0[0] * v0[0] + v0[1] * v0[1]) + (v0[2] * v0[2] + v0[3] * v0[3]) + (v1[0] * v1[0] + v1[1] * v1[1]) + (v1[2] * v1[2] + v1[3] * v1[3]);
                    *(u32x4*)(XS + (size_t)row * 1024 + c) = pack8(v0 * *(const f32x4*)(cp), v1 * *(const f32x4*)(cp + 4)); }
                s += __shfl_xor(s, 16); s += __shfl_xor(s, 32);
                if (fq == 0) X1SS[(size_t)row * 16 + u.pn * 4 + wc] = s; }
    }
};

struct EpiGateUp {
    static constexpr bool PERM = true, AFTER_DRAIN = false;
    bf16_t* HID; const float* X1SS; const float* BGU;
    __device__ __forceinline__ void operator()(const f32x4 (&acc)[2][2][4][2], const Unit& u, int wr, int wc, int fr, int fq) const {
        const int row0 = u.pm * BM + wr * 64 + fr, cl = wc * 32 + 8 * fq, b = u.pm >> 5;
        const float* bp = BGU + b * 5632 + u.pn * 256 + cl;
        const f32x4 bg0 = *(const f32x4*)(bp), bg1 = *(const f32x4*)(bp + 4), bu0 = *(const f32x4*)(bp + 128), bu1 = *(const f32x4*)(bp + 132);
#pragma unroll
        for (int ai = 0; ai < 2; ++ai)
#pragma unroll
            for (int m = 0; m < 4; ++m) { const int row = row0 + ai * HALF + m * 16;
                float s = 0.f;
#pragma unroll
                for (int q = 0; q < 4; ++q) { const f32x4 t = *(const f32x4*)(X1SS + (size_t)row * 16 + 4 * q); s += (t[0] + t[1]) + (t[2] + t[3]); }
                const float r = __builtin_amdgcn_rsqf(s * (1.0f / 1024.0f) + 1e-6f);
                f32x4 g0 = acc[ai][0][m][0] * r + bg0, g1 = acc[ai][0][m][1] * r + bg1; const f32x4 u0 = acc[ai][1][m][0] * r + bu0, u1 = acc[ai][1][m][1] * r + bu1;
#pragma unroll
                for (int j = 0; j < 4; ++j) { g0[j] = fsilu(g0[j]) * u0[j]; g1[j] = fsilu(g1[j]) * u1[j]; }
                *(u32x4*)(HID + (size_t)row * 2816 + u.pn * 128 + cl) = pack8(g0, g1); }
    }
};

struct EpiDown {
    static constexpr bool PERM = true, AFTER_DRAIN = false;
    const float* X1; float* OUT; float* X2SS; const float* MOD;
    __device__ __forceinline__ void operator()(const f32x4 (&acc)[2][2][4][2], const Unit& u, int wr, int wc, int fr, int fq) const {
        const int row0 = u.pm * BM + wr * 64 + fr, cl = u.pn * 256 + wc * 32 + 8 * fq, b = u.pm >> 5;
#pragma unroll
        for (int ai = 0; ai < 2; ++ai)
#pragma unroll
            for (int m = 0; m < 4; ++m) { const int row = row0 + ai * HALF + m * 16; float s = 0.f;
#pragma unroll
                for (int bj = 0; bj < 2; ++bj)
#pragma unroll
                    for (int n = 0; n < 2; ++n) { const int c = cl + bj * HALF + 4 * n;
                        const f32x4 v = *(const f32x4*)(X1 + (size_t)row * 1024 + c) + *(const f32x4*)(MOD + b * 6144 + 5120 + c) * acc[ai][bj][m][n];
                        *(f32x4*)(OUT + (size_t)row * 1024 + c) = v; s += (v[0] * v[0] + v[1] * v[1]) + (v[2] * v[2] + v[3] * v[3]); }
                s += __shfl_xor(s, 16); s += __shfl_xor(s, 32);
                if (fq == 0) X2SS[(size_t)row * 16 + u.pn * 4 + wc] = s; }
    }
};


struct EpiPlain {
    static constexpr bool PERM = true, AFTER_DRAIN = false;
    bf16_t* O;
    __device__ __forceinline__ void operator()(const f32x4 (&acc)[2][2][4][2], const Unit& u, int wr, int wc, int fr, int fq) const {
        const int row0 = u.pm * BM + wr * 64 + fr, cl = wc * 32 + 8 * fq;
#pragma unroll
        for (int ai = 0; ai < 2; ++ai)
#pragma unroll
            for (int m = 0; m < 4; ++m) { const int row = row0 + ai * HALF + m * 16;
#pragma unroll
                for (int bj = 0; bj < 2; ++bj) *(u32x4*)(O + (size_t)row * 256 + cl + bj * HALF) = pack8(acc[ai][bj][m][0], acc[ai][bj][m][1]); }
    }
};
template <class Epi, class Sched, bool ALIGN_EPI = false, bool SP2 = false>
__device__ __forceinline__ void gemm_phase(PG8_LAS unsigned char* lds, const Gemm g, const Sched& S, const Epi& E) {
    const int tid = threadIdx.x, wid = __builtin_amdgcn_readfirstlane(tid >> 6), lane = tid & 63, wr = wid >> 2, wc = wid & 3, fr = lane & 15, fq = lane >> 4;
    const int K = g.K, nt = K / BK;
    unsigned voffA[2], voffB[2];
#pragma unroll
    for (int i = 0; i < 2; ++i) { int R, C; stage_rc(tid * 16 + i * 8192, R, C); const int Rb = Epi::PERM ? ((R & ~31) + perm32(R & 31)) : R;
        voffA[i] = (unsigned)(R * K + C) * 2u; voffB[i] = (unsigned)(Rb * K + C) * 2u; }
    const size_t kstep = (size_t)(BK * 2);
    const size_t hstep = (size_t)HALF * K * 2;
    const size_t tstep = 2 * hstep;
    const unsigned ldsw = (unsigned)wid * 1024u;
    const int aoff = lds_byte(wr * 64 + fr, fq * 8), boff = lds_byte(wc * 32 + fr, fq * 8);
#define PG8_SA(b, h) (((b) * 2 + (h)) * HTB)
#define PG8_SB(b, h) ((4 + (b) * 2 + (h)) * HTB)
#define PG8_STAGE(bufoff, gbase, voff) do { _Pragma("unroll") for (int _i = 0; _i < 2; ++_i) \
        __builtin_amdgcn_global_load_lds((const unsigned*)((const char*)(gbase) + (voff)[_i]), (PG8_LAS unsigned*)(lds + (bufoff) + ldsw + _i * 8192), 16, 0, 0); } while (0)
#define PG8_LDA(dst, b, h) do { _Pragma("unroll") for (int m = 0; m < 4; ++m) _Pragma("unroll") for (int k = 0; k < 2; ++k) dst[m][k] = *(const PG8_LAS bf16x8*)(lds + PG8_SA(b, h) + aoff + m * 2048 + k * 1024); } while (0)
#define PG8_LDB(dst, b, h) do { _Pragma("unroll") for (int n = 0; n < 2; ++n) _Pragma("unroll") for (int k = 0; k < 2; ++k) dst[n][k] = *(const PG8_LAS bf16x8*)(lds + PG8_SB(b, h) + boff + n * 2048 + k * 1024); } while (0)
#define PG8_MMA(ai, bj, At, Bt) do { __builtin_amdgcn_s_setprio(1); _Pragma("unroll") for (int m = 0; m < 4; ++m) _Pragma("unroll") for (int n = 0; n < 2; ++n) _Pragma("unroll") for (int k = 0; k < 2; ++k) \
        acc[ai][bj][m][n] = __builtin_amdgcn_mfma_f32_16x16x32_bf16(Bt[n][k], At[m][k], acc[ai][bj][m][n], 0, 0, 0); __builtin_amdgcn_s_setprio(0); } while (0)
#define PG8_WAIT_V(n) asm volatile("s_waitcnt vmcnt(" #n ")" ::: "memory")
#define PG8_WAIT_L(n) asm volatile("s_waitcnt lgkmcnt(" #n ")" ::: "memory")
#define PG8_BAR __builtin_amdgcn_s_barrier()
#define PG8_SCHED __builtin_amdgcn_sched_barrier(0)
    Unit cur, nxt; int ui = 0;
    if (!S.next(0, cur)) return;
    f32x4 acc[2][2][4][2];
#pragma unroll
    for (int a = 0; a < 2; ++a)
#pragma unroll
        for (int b = 0; b < 2; ++b)
#pragma unroll
            for (int m = 0; m < 4; ++m)
#pragma unroll
                for (int n = 0; n < 2; ++n) acc[a][b][m][n] = (f32x4){0.f, 0.f, 0.f, 0.f};
    bf16x8 At[4][2], B0[2][2], B1[2][2];
    const char* cA = (const char*)g.A + (size_t)cur.pm * tstep; const char* cB = (const char*)g.Bt + (size_t)cur.pn * tstep;
    S.a_ready(cur);
    if constexpr (SP2) {
        PG8_STAGE(PG8_SB(0, 0), cB, voffB); PG8_STAGE(PG8_SB(0, 1), cB + hstep, voffB); PG8_STAGE(PG8_SA(0, 0), cA, voffA); PG8_STAGE(PG8_SA(0, 1), cA + hstep, voffA);
        if (wr == 1) PG8_BAR;
        PG8_WAIT_V(2); PG8_BAR;
        PG8_STAGE(PG8_SB(1, 0), cB + kstep, voffB); PG8_STAGE(PG8_SA(1, 0), cA + kstep, voffA); PG8_STAGE(PG8_SB(1, 1), cB + hstep + kstep, voffB);
        PG8_WAIT_V(6); PG8_BAR;
    } else {
        PG8_STAGE(PG8_SB(0, 0), cB, voffB); PG8_STAGE(PG8_SA(0, 0), cA, voffA); PG8_STAGE(PG8_SB(0, 1), cB + hstep, voffB); PG8_STAGE(PG8_SA(0, 1), cA + hstep, voffA);
        if (wr == 1) PG8_BAR;
        PG8_WAIT_V(4); PG8_BAR;
        PG8_STAGE(PG8_SB(1, 0), cB + kstep, voffB); PG8_STAGE(PG8_SA(1, 0), cA + kstep, voffA); PG8_STAGE(PG8_SB(1, 1), cB + hstep + kstep, voffB);
        PG8_WAIT_V(6); PG8_BAR;
    }
    for (;;) {
        const bool has_next = S.next(ui + 1, nxt);
        const char* nA = has_next ? (const char*)g.A + (size_t)nxt.pm * tstep : cA; const char* nB = has_next ? (const char*)g.Bt + (size_t)nxt.pn * tstep : cB;
        for (int t = 0; t < nt; t += 2) {
            const bool last = (t == nt - 2);
            const char* a1 = cA + (size_t)(t + 1) * kstep;
            const char* a2 = last ? nA : cA + (size_t)(t + 2) * kstep; const char* b2 = last ? nB : cB + (size_t)(t + 2) * kstep;
            const char* a3 = a2 + kstep; const char* b3 = b2 + kstep;
            if (last && has_next) S.a_ready(nxt);
            if constexpr (SP2) {
            PG8_LDB(B0, 0, 0); PG8_LDB(B1, 0, 1); PG8_SCHED; PG8_LDA(At, 0, 0); PG8_STAGE(PG8_SA(1, 1), a1 + hstep, voffA);
            PG8_WAIT_V(8); PG8_WAIT_L(0); PG8_BAR; PG8_MMA(0, 0, At, B0); PG8_MMA(0, 1, At, B1); PG8_BAR; PG8_SCHED;
            PG8_LDA(At, 0, 1); PG8_STAGE(PG8_SB(0, 0), b2, voffB); PG8_STAGE(PG8_SB(0, 1), b2 + hstep, voffB); PG8_STAGE(PG8_SA(0, 0), a2, voffA);
            PG8_WAIT_V(8); PG8_WAIT_L(0); PG8_BAR; PG8_MMA(1, 0, At, B0); PG8_MMA(1, 1, At, B1); PG8_BAR; PG8_SCHED;
            PG8_LDB(B0, 1, 0); PG8_LDB(B1, 1, 1); PG8_SCHED; PG8_LDA(At, 1, 0); PG8_STAGE(PG8_SA(0, 1), a2 + hstep, voffA);
            PG8_WAIT_V(8); PG8_WAIT_L(0); PG8_BAR; PG8_MMA(0, 0, At, B0); PG8_MMA(0, 1, At, B1); PG8_BAR; PG8_SCHED;
            PG8_LDA(At, 1, 1); PG8_STAGE(PG8_SB(1, 0), b3, voffB); PG8_STAGE(PG8_SB(1, 1), b3 + hstep, voffB); PG8_STAGE(PG8_SA(1, 0), a3, voffA);
            PG8_WAIT_V(8); PG8_WAIT_L(0); PG8_BAR; PG8_MMA(1, 0, At, B0); PG8_MMA(1, 1, At, B1); PG8_BAR; PG8_SCHED;
            } else {
            PG8_LDB(B0, 0, 0); PG8_SCHED; PG8_LDA(At, 0, 0); PG8_STAGE(PG8_SA(1, 1), a1 + hstep, voffA);
            PG8_WAIT_L(8); PG8_BAR; PG8_WAIT_L(0); PG8_MMA(0, 0, At, B0); PG8_BAR; PG8_SCHED;
            PG8_LDB(B1, 0, 1); PG8_STAGE(PG8_SB(0, 0), b2, voffB);
            PG8_BAR; PG8_WAIT_L(0); PG8_MMA(0, 1, At, B1); PG8_BAR;
            PG8_LDA(At, 0, 1); PG8_STAGE(PG8_SA(0, 0), a2, voffA);
            PG8_BAR; PG8_WAIT_L(0); PG8_MMA(1, 0, At, B0); PG8_BAR; PG8_SCHED;
            PG8_STAGE(PG8_SB(0, 1), b2 + hstep, voffB);
            PG8_WAIT_V(6); PG8_BAR; PG8_MMA(1, 1, At, B1); PG8_BAR;
            PG8_LDB(B0, 1, 0); PG8_SCHED; PG8_LDA(At, 1, 0); PG8_STAGE(PG8_SA(0, 1), a2 + hstep, voffA);
            PG8_WAIT_L(8); PG8_BAR; PG8_WAIT_L(0); PG8_MMA(0, 0, At, B0); PG8_BAR; PG8_SCHED;
            PG8_LDB(B1, 1, 1); PG8_STAGE(PG8_SB(1, 0), b3, voffB);
            PG8_BAR; PG8_WAIT_L(0); PG8_MMA(0, 1, At, B1); PG8_BAR;
            PG8_LDA(At, 1, 1); PG8_STAGE(PG8_SA(1, 0), a3, voffA);
            PG8_BAR; PG8_WAIT_L(0); PG8_MMA(1, 0, At, B0); PG8_BAR; PG8_SCHED;
            PG8_STAGE(PG8_SB(1, 1), b3 + hstep, voffB);
            PG8_WAIT_V(6); PG8_BAR; PG8_MMA(1, 1, At, B1); PG8_BAR;
            }
        }
        if constexpr (ALIGN_EPI) { if (wr == 0) PG8_BAR; }
        if constexpr (!Epi::AFTER_DRAIN) { E(acc, cur, wr, wc, fr, fq); S.done(cur); }
        if (!has_next) break;
#pragma unroll
        for (int a = 0; a < 2; ++a)
#pragma unroll
            for (int b = 0; b < 2; ++b)
#pragma unroll
                for (int m = 0; m < 4; ++m)
#pragma unroll
                    for (int n = 0; n < 2; ++n) acc[a][b][m][n] = (f32x4){0.f, 0.f, 0.f, 0.f};
        cur = nxt; cA = nA; cB = nB; ++ui;
        if constexpr (ALIGN_EPI) { if (wr == 1) PG8_BAR; }
    }
    PG8_WAIT_V(0);
    if constexpr (!ALIGN_EPI) { if (wr == 0) PG8_BAR; }
    PG8_BAR;
    if constexpr (Epi::AFTER_DRAIN) { E.fused(acc, cur, wr, wc, fr, fq, lds, wid, lane); S.done(cur); }
#undef PG8_SA
#undef PG8_SB
#undef PG8_STAGE
#undef PG8_LDA
#undef PG8_LDB
#undef PG8_MMA
#undef PG8_WAIT_V
#undef PG8_WAIT_L
#undef PG8_BAR
#undef PG8_SCHED
}
}
#ifndef PG8_SP2
#define PG8_SP2 true
#endif
#ifndef PG8_ALIGN
#define PG8_ALIGN true
#endif

constexpr int NWAVES = 8;
#ifndef MK_N_LAUNCHES
#define MK_N_LAUNCHES 1
#endif
constexpr int N_PHASES = 11;
constexpr int N_LAUNCHES = MK_N_LAUNCHES;
static_assert(N_LAUNCHES == 1 || N_LAUNCHES == N_PHASES, "MK_N_LAUNCHES is 1 or N_PHASES");

constexpr int NB = 8, SEQ = 8192, D = 1024, M = NB * SEQ;
constexpr int NPROJ = 4680, NPROJ_PAD = 4864, FF = 2816, NGU = 2 * FF;
constexpr float EPS = 1e-6f;

constexpr size_t MiB = 1u << 20;
constexpr size_t WS_CTL = 0, CTL_ZERO_BYTES = 1 * MiB;
constexpr size_t WS_MOD = 1 * MiB;
constexpr size_t WS_LB = WS_MOD + 256 * 1024;
constexpr size_t WS_CW2 = WS_MOD + 320 * 1024;
constexpr size_t WS_BGU = WS_MOD + 512 * 1024;
constexpr size_t WS_WIN = 3 * MiB, WS_WQ = 13 * MiB, WS_WBA = 14 * MiB, WS_WBR = 15 * MiB, WS_WOUT = 16 * MiB, WS_WGU = 18 * MiB, WS_WD = 29 * MiB;
constexpr size_t WS_CQSS = 35 * MiB, WS_X1SS = 36 * MiB, WS_X2SS = 40 * MiB;
constexpr size_t WS_XN = 64 * MiB;
constexpr size_t WS_CQ = 192 * MiB, WS_KV = 224 * MiB, WS_KI = 256 * MiB, WS_WI = 264 * MiB;
constexpr size_t WS_RQ = 272 * MiB, WS_RGL = 336 * MiB, WS_RI = 400 * MiB, WS_RGS = 464 * MiB;
constexpr size_t WS_Q = 528 * MiB, WS_QI = 592 * MiB;
constexpr size_t WS_ATT = 64 * MiB, WS_REC = 128 * MiB;
constexpr size_t WS_SCR = 656 * MiB;
constexpr size_t WS_OLOC = 784 * MiB, WS_QHAT = 848 * MiB, WS_U = 912 * MiB, WS_DS = 928 * MiB;
constexpr size_t WS_MIX = 896 * MiB;
constexpr size_t WS_X1 = 64 * MiB, WS_XS = 320 * MiB, WS_HID = 448 * MiB;
constexpr size_t WS_END = 1024 * MiB;
static_assert(WS_RGL == WS_RQ + 64 * MiB && WS_RI == WS_RQ + 128 * MiB && WS_RGS == WS_RQ + 192 * MiB && WS_QI == WS_Q + 64 * MiB, "epilogue pointer arithmetic");
static_assert(WS_HID + (size_t)M * FF * 2 <= WS_END && WS_DS + 256 * 128 * 4 <= WS_END, "map");

constexpr int CW_TMO = 0, CW_CODE = 1;
constexpr int CW_BAR = 4096;

constexpr int RING_OFF = 0, RING_BYTES = 131072;
constexpr int LDS_BYTES = 163840;
constexpr int LDSCTL_OFF = LDS_BYTES - 1024, MISC_OFF = LDSCTL_OFF + 320;
static_assert(MISC_OFF + 128 <= LDS_BYTES, "LDS map");

#define GAS __attribute__((address_space(1)))
#define LAS __attribute__((address_space(3)))
typedef unsigned short bf16;
typedef unsigned v4u __attribute__((ext_vector_type(4)));
typedef unsigned v2u __attribute__((ext_vector_type(2)));
typedef float f32x4 __attribute__((ext_vector_type(4)));
typedef float f32x16 __attribute__((ext_vector_type(16)));
typedef short bf16x8 __attribute__((ext_vector_type(8)));
typedef GAS unsigned gu32;
#define RLX_AGENT __ATOMIC_RELAXED, __HIP_MEMORY_SCOPE_AGENT
#define LDS_WAIT() asm volatile("s_waitcnt lgkmcnt(0)" ::: "memory")
#define VM_WAIT() asm volatile("s_waitcnt vmcnt(0)" ::: "memory")
__device__ __forceinline__ unsigned f2bf(float f) { unsigned u = __builtin_bit_cast(unsigned, f); return (u + 0x7fffu + ((u >> 16) & 1u)) >> 16; }
__device__ __forceinline__ unsigned pk2(float lo, float hi) { return f2bf(lo) | (f2bf(hi) << 16); }
__device__ __forceinline__ float bflo(unsigned u) { return __builtin_bit_cast(float, u << 16); }
__device__ __forceinline__ float bfhi(unsigned u) { return __builtin_bit_cast(float, u & 0xffff0000u); }
__device__ __forceinline__ float bf1(bf16 h) { return __builtin_bit_cast(float, (unsigned)h << 16); }

#define XB_TMO      128
#define XB_XCNT(j)  (256  + 64 * (j))
#define XB_XSUB(j)  (1280 + 64 * (j))
#define XB_XGEN(j)  (2304 + 64 * (j))
#define XB_TOP      3328
#define XB_TOPGEN   3392
#define XCD_BAR_WORDS 3456
#define XB_SPIN_CAP (1u << 23)

__device__ __forceinline__ unsigned xb_ld(unsigned* p)              { return __hip_atomic_load(p, __ATOMIC_RELAXED, __HIP_MEMORY_SCOPE_AGENT); }
__device__ __forceinline__ unsigned xb_add(unsigned* p, unsigned v) { return __hip_atomic_fetch_add(p, v, __ATOMIC_RELAXED, __HIP_MEMORY_SCOPE_AGENT); }
__device__ __forceinline__ unsigned xb_xcc_id() { return (unsigned)__builtin_amdgcn_s_getreg((3 << 11) | 20) & 0xFu; }
#define XB_SPIN(cond, bar) do { unsigned _sp = 0; while (cond) { __builtin_amdgcn_s_sleep(1); \
    if ((++_sp & 255u) == 0u) { if (xb_ld(&(bar)[XB_TMO])) break; if (_sp > XB_SPIN_CAP) { atomicAdd(&(bar)[XB_TMO], 1u); break; } } } } while (0)

struct XcdBarrier { unsigned* bar; unsigned x; volatile LAS unsigned* st; };

__device__ __forceinline__ XcdBarrier xcd_barrier_post(unsigned* bar, volatile LAS unsigned* st) {
    XcdBarrier b; b.bar = bar; b.x = xb_xcc_id(); b.st = st;
    if (threadIdx.x == 0) (void)xb_add(&bar[XB_XCNT(b.x)], 1u);
    return b;
}
__device__ __forceinline__ void xcd_barrier_complete(unsigned* bar, unsigned x, unsigned& nloc, unsigned& nx) {
    const unsigned G = gridDim.x * gridDim.y * gridDim.z;
    unsigned sum, cnt, mine, sp = 0u;
    for (;;) {
        sum = 0u; cnt = 0u; mine = 0u;
#pragma unroll
        for (unsigned j = 0; j < 16; ++j) { const unsigned c = xb_ld(&bar[XB_XCNT(j)]); sum += c; cnt += (c > 0u) ? 1u : 0u; mine = (j == x) ? c : mine; }
        if (sum == G) break;
        __builtin_amdgcn_s_sleep(1);
        if ((++sp & 255u) == 0u) { if (xb_ld(&bar[XB_TMO])) break; if (sp > XB_SPIN_CAP) { atomicAdd(&bar[XB_TMO], 1u); break; } }
    }
    nloc = mine > 0u ? mine : 1u; nx = cnt > 0u ? cnt : 1u;
}
__device__ __forceinline__ void xcd_barrier(const XcdBarrier& b) {
    asm volatile("s_waitcnt vmcnt(0)" ::: "memory");
    __syncthreads();
    if (threadIdx.x == 0) {
        unsigned* bar = b.bar;
        __builtin_amdgcn_s_waitcnt(0);
        unsigned nloc = b.st[0], nx = b.st[1];
        if (nloc == 0u) { xcd_barrier_complete(bar, b.x, nloc, nx); b.st[0] = nloc; b.st[1] = nx; }
        const unsigned old = xb_add(&bar[XB_XSUB(b.x)], 1u);
        const unsigned gen = old / nloc;
        if (old + 1u == (gen + 1u) * nloc) {
            __builtin_amdgcn_fence(__ATOMIC_RELEASE, "agent");
            asm volatile("s_waitcnt vmcnt(0)" ::: "memory");
            const unsigned og = xb_add(&bar[XB_TOP], 1u);
            const unsigned tg = og / nx;
            if (og + 1u == (tg + 1u) * nx) xb_add(&bar[XB_TOPGEN], 1u);
            else XB_SPIN(xb_ld(&bar[XB_TOPGEN]) == tg, bar);
            __builtin_amdgcn_fence(__ATOMIC_ACQUIRE, "agent");
            xb_add(&bar[XB_XGEN(b.x)], 1u);
            asm volatile("s_waitcnt vmcnt(0)" ::: "memory");
        } else {
            XB_SPIN(xb_ld(&bar[XB_XGEN(b.x)]) == gen, bar);
            __builtin_amdgcn_fence(__ATOMIC_ACQUIRE, "agent");
            asm volatile("s_waitcnt vmcnt(0)" ::: "memory");
        }
    }
    __syncthreads();
}

struct Frame {
    LAS unsigned char* lds;
    volatile LAS unsigned* MISC;
    gu32* ctl;
    unsigned char* ws;
    int tid, lane, wave;
    int G;
    float* out;
};
__device__ __forceinline__ float wave_sum(float v) {
#pragma unroll
    for (int o = 1; o < 64; o <<= 1) v += __shfl_xor(v, o);
    return v;
}
__device__ __forceinline__ float wave_max(float v) {
#pragma unroll
    for (int o = 1; o < 64; o <<= 1) v = fmaxf(v, __shfl_xor(v, o));
    return v;
}

template <class SrcCol>
__device__ __forceinline__ void transpose_item(const float* W, int ldw, int K, bf16* WT, const float* ks, LAS float* scr, int item, int nblk, int lane, SrcCol src) {
    const int kb = item / nblk, nb = item % nblk, k0 = 64 * kb, n0 = 32 * nb;
    const float* Wp; const int sc = src(n0 + (lane & 31), Wp);
#pragma unroll 8
    for (int i = 0; i < 32; ++i) { const int kk = 2 * i + (lane >> 5); float v = 0.f; if (sc >= 0) { v = Wp[(size_t)(k0 + kk) * ldw + sc]; if (ks) v *= ks[k0 + kk]; } scr[kk * 33 + (lane & 31)] = v; }
    LDS_WAIT(); asm volatile("" ::: "memory");
    const int c = lane & 7;
#pragma unroll
    for (int j = 0; j < 4; ++j) { const int n = (lane >> 3) + 8 * j; const LAS float* s = scr + (8 * c) * 33 + n;
        v4u o; o.x = pk2(s[0 * 33], s[1 * 33]); o.y = pk2(s[2 * 33], s[3 * 33]); o.z = pk2(s[4 * 33], s[5 * 33]); o.w = pk2(s[6 * 33], s[7 * 33]);
        *(GAS v4u*)(WT + (size_t)(n0 + n) * K + k0 + 8 * c) = o; }
    LDS_WAIT(); asm volatile("" ::: "memory");
}
struct Args { const float* in[20]; float* out; unsigned char* ws; int ph_lo, ph_hi; };
template <class SrcCol>
__device__ __forceinline__ void gemv8(Frame& F, const LAS float* vec, int cpg, int ngrp, int ldw, SrcCol src, const float* bias, float* out, int ldo) {
    LAS float* red = (LAS float*)(F.lds + 32768);
    for (int jb = blockIdx.x; jb < ngrp; jb += F.G) {
        const int col = F.tid & 31, kg = F.tid >> 5; float a[8];
#pragma unroll
        for (int b = 0; b < 8; ++b) a[b] = 0.f;
        const float* Wp = nullptr; int sc = -1;
        if (col < cpg) sc = src(jb * cpg + col, Wp);
        if (sc >= 0) for (int k = kg * 64; k < kg * 64 + 64; ++k) { const float w = Wp[(size_t)k * ldw + sc];
#pragma unroll
            for (int b = 0; b < 8; ++b) a[b] += vec[b * 1024 + k] * w; }
#pragma unroll
        for (int b = 0; b < 8; ++b) red[(kg * 8 + b) * 32 + col] = a[b];
        __syncthreads();
        if (F.tid < 256) { const int b = F.tid >> 5, c2 = F.tid & 31;
            if (c2 < cpg) { float s = 0.f; for (int k2 = 0; k2 < 16; ++k2) s += red[(k2 * 8 + b) * 32 + c2]; const int jj = jb * cpg + c2; out[b * ldo + jj] = s + (bias ? bias[jj] : 0.f); } }
        __syncthreads();
    }
}
struct SrcWin { const float* W; __device__ __forceinline__ int operator()(int d, const float*& Wp) const { Wp = W; return d < 584 ? d : (d < 768 ? -1 : d - 184); } };
__device__ __forceinline__ const float* psel(const float* a, const float* b, bool takeb) { const unsigned long long x = (unsigned long long)a, y = (unsigned long long)b, m = takeb ? ~0ull : 0ull; return (const float*)(x ^ ((x ^ y) & m)); }
struct SrcWq { const float *Wa, *Wb; __device__ __forceinline__ int operator()(int d, const float*& Wp) const { Wp = psel(Wa, Wb, d >= 512); return d & 511; } };
struct SrcId { const float* W; __device__ __forceinline__ int operator()(int d, const float*& Wp) const { Wp = W; return d; } };
struct SrcGu { const float *Wg, *Wu; __device__ __forceinline__ int operator()(int d, const float*& Wp) const { const int t = d >> 8, w = d & 255; Wp = psel(Wg, Wu, w >= 128); return t * 128 + (w & 127); } };

__device__ __forceinline__ void p0_prologue(Frame& F, const Args& A) {
    LAS float* cact = (LAS float*)(F.lds);
    for (int i = F.tid; i < 8192; i += NWAVES * 64) { const float v = A.in[1][i]; cact[i] = v / (1.0f + __expf(-v)); }
    __syncthreads();
    gemv8(F, cact, 24, 256, 6144, SrcId{A.in[2]}, A.in[3], (float*)(F.ws + WS_MOD), 6144);
    if (blockIdx.x == 0) { const float* l = A.in[10]; float* LB = (float*)(F.ws + WS_LB);
        for (int c = F.tid; c < 512; c += NWAVES * 64) LB[c] = 1.0f / (1.0f + __expf(l[512 + c] - l[c])); }
    __syncthreads();
    LAS float* scr = (LAS float*)(F.lds + 49152 + F.wave * 8448);
    const int gw = blockIdx.x * NWAVES + F.wave, NGW = F.G * NWAVES;
    constexpr int I_IN = 16 * 152, I_Q = 4 * 32, I_BA = 8 * 32, I_BR = 8 * 32, I_O = 16 * 32, I_GU = 16 * 176, I_D = 44 * 32;
    constexpr int NITEMS = I_IN + I_Q + I_BA + I_BR + I_O + I_GU + I_D;
    for (int it = gw; it < NITEMS; it += NGW) {
        int r = it;
        if (r < I_IN) { transpose_item(A.in[5], NPROJ, 1024, (bf16*)(F.ws + WS_WIN), nullptr, scr, r, 152, F.lane, SrcWin{A.in[5]}); continue; } r -= I_IN;
        if (r < I_Q) { transpose_item(nullptr, 512, 256, (bf16*)(F.ws + WS_WQ), A.in[6], scr, r, 32, F.lane, SrcWq{A.in[7], A.in[8]}); continue; } r -= I_Q;
        if (r < I_BA) { transpose_item(nullptr, 1024, 512, (bf16*)(F.ws + WS_WBA), nullptr, scr, r, 32, F.lane, SrcId{A.in[12]}); continue; } r -= I_BA;
        if (r < I_BR) { transpose_item(nullptr, 1024, 512, (bf16*)(F.ws + WS_WBR), nullptr, scr, r, 32, F.lane, SrcId{A.in[13]}); continue; } r -= I_BR;
        if (r < I_O) { transpose_item(nullptr, 1024, 1024, (bf16*)(F.ws + WS_WOUT), nullptr, scr, r, 32, F.lane, SrcId{A.in[14]}); continue; } r -= I_O;
        if (r < I_GU) { transpose_item(nullptr, FF, 1024, (bf16*)(F.ws + WS_WGU), nullptr, scr, r, 176, F.lane, SrcGu{A.in[16], A.in[17]}); continue; } r -= I_GU;
        transpose_item(nullptr, 1024, FF, (bf16*)(F.ws + WS_WD), nullptr, scr, r, 32, F.lane, SrcId{A.in[18]});
    }
}

__device__ __forceinline__ void p1_norm(Frame& F, const Args& A) {
    const float* MOD = (const float*)(F.ws + WS_MOD);
    { float* CW2 = (float*)(F.ws + WS_CW2); const int g = blockIdx.x * (NWAVES * 64) + F.tid;
      if (g < 8192) { const int b = g >> 10, c = g & 1023; CW2[g] = A.in[15][c] * (1.0f + MOD[b * 6144 + 4096 + c]); } }
    { LAS float* sh2 = (LAS float*)(F.lds);
      for (int i = F.tid; i < 8192; i += NWAVES * 64) sh2[i] = MOD[(i >> 10) * 6144 + 3072 + (i & 1023)];
      __syncthreads();
      gemv8(F, sh2, 22, 256, FF, SrcGu{A.in[16], A.in[17]}, nullptr, (float*)(F.ws + WS_BGU), NGU); }
    const int gw = blockIdx.x * NWAVES + F.wave, NGW = F.G * NWAVES; bf16* XN = (bf16*)(F.ws + WS_XN);
    for (int m = gw; m < M; m += NGW) {
        const int b = m >> 13;
        const GAS f32x4* xr = (const GAS f32x4*)(A.in[0] + (size_t)m * D) + F.lane;
        f32x4 v[4]; float s = 0.f;
#pragma unroll
        for (int j = 0; j < 4; ++j) { v[j] = xr[64 * j]; s += (v[j].x * v[j].x + v[j].y * v[j].y) + (v[j].z * v[j].z + v[j].w * v[j].w); }
        const float r = 1.0f / sqrtf(wave_sum(s) * (1.0f / D) + EPS);
        GAS unsigned long long* o8 = (GAS unsigned long long*)(XN + (size_t)m * D) + F.lane;
#pragma unroll
        for (int j = 0; j < 4; ++j) { const int c = 4 * F.lane + 256 * j;
            const f32x4 w = *(const f32x4*)(A.in[4] + c), sc = *(const f32x4*)(MOD + b * 6144 + 1024 + c), sh = *(const f32x4*)(MOD + b * 6144 + c);
            const f32x4 y = v[j] * r * w * (sc + 1.0f) + sh;
            o8[64 * j] = (unsigned long long)pk2(y.x, y.y) | ((unsigned long long)pk2(y.z, y.w) << 32); }
    }
}

constexpr int H_QC = 0, H_QB = 17408, H_K = 34816, H_KT = 78336, H_VT = 96768, H_PM = 115200, H_ST = 124416, H_BT = 159232, H_AL = 161280;
constexpr int HS128 = 272, HS64 = 144;
__device__ __forceinline__ unsigned short f2bfs(float f) { return (unsigned short)f2bf(f); }
__device__ __forceinline__ void hgrn_h1_unit(Frame& F, int unit) {
    const int b = unit >> 5, h = (unit >> 3) & 3, n = unit & 7;
    const int tid = F.tid, lane = F.lane, w = F.wave, c = tid & 127, bi = tid >> 7, l15 = lane & 15, l4 = lane >> 4;
    const size_t rowbase = (size_t)(b * SEQ + n * 1024) * 512 + h * 128;
    const bf16* RQ = (const bf16*)(F.ws + WS_RQ) + rowbase; const bf16* RGL = (const bf16*)(F.ws + WS_RGL) + rowbase; const bf16* RI = (const bf16*)(F.ws + WS_RI) + rowbase;
    bf16* OLOC = (bf16*)(F.ws + WS_OLOC) + rowbase; bf16* QHAT = (bf16*)(F.ws + WS_QHAT) + rowbase;
    LAS unsigned char* L = F.lds; LAS float* BT = (LAS float*)(L + H_BT); LAS float* AL = (LAS float*)(L + H_AL);
    f32x4 acc[8];
#pragma unroll
    for (int vb = 0; vb < 8; ++vb) acc[vb] = (f32x4){0.f, 0.f, 0.f, 0.f};
    float asup = 0.f;
    for (int i = tid; i < 64 * HS64 / 4; i += NWAVES * 64) ((LAS unsigned*)(L + H_PM))[i] = 0u;
#pragma unroll 1
    for (int ci = 0; ci < 16; ++ci) {
        const size_t r0 = (size_t)(ci * 64 + bi * 16) * 512 + c;
        float gq[16], qq[16], al[16]; unsigned vp[8];
#pragma unroll
        for (int r = 0; r < 16; ++r) { gq[r] = bf1(RGL[r0 + (size_t)r * 512]); qq[r] = bf1(RQ[r0 + (size_t)r * 512]); }
#pragma unroll
        for (int r = 0; r < 8; ++r) vp[r] = (unsigned)RI[r0 + (size_t)(2 * r) * 512] | ((unsigned)RI[r0 + (size_t)(2 * r + 1) * 512] << 16);
        { float run = 0.f;
#pragma unroll
          for (int r = 0; r < 16; ++r) { run += gq[r]; al[r] = run; }
          BT[bi * 128 + c] = run; }
        if (ci > 0) {
#pragma unroll
            for (int vb = 0; vb < 8; ++vb) { v2u o; o.x = pk2(acc[vb][0], acc[vb][1]); o.y = pk2(acc[vb][2], acc[vb][3]);
                *(LAS v2u*)(L + H_ST + (16 * vb + l15) * HS128 + (16 * w + 4 * l4) * 2) = o; } }
        *(LAS v4u*)(L + H_VT + c * HS64 + bi * 32) = (v4u){vp[0], vp[1], vp[2], vp[3]}; *(LAS v4u*)(L + H_VT + c * HS64 + bi * 32 + 16) = (v4u){vp[4], vp[5], vp[6], vp[7]};
        __syncthreads();
        const float b0 = BT[c], b1 = BT[128 + c], b2 = BT[256 + c], b3 = BT[384 + c];
        const float ab1 = b0, ab2 = b0 + b1, ab3 = ab2 + b2, alast = ab3 + b3;
        const float ab = bi == 0 ? 0.f : bi == 1 ? ab1 : bi == 2 ? ab2 : ab3;
        if (bi == 0) AL[c] = alast;
        unsigned kp[8];
#pragma unroll
        for (int r = 0; r < 16; ++r) { const int t = bi * 16 + r; const float Av = ab + al[r];
            *(LAS unsigned short*)(L + H_QC + t * HS128 + c * 2) = f2bfs(qq[r] * __expf(Av));
            QHAT[r0 + (size_t)r * 512] = f2bfs(qq[r] * __expf(Av + asup));
            *(LAS unsigned short*)(L + H_QB + t * HS128 + c * 2) = f2bfs(qq[r] * __expf(al[r]));
            const float kk = 1.0f - __expf(gq[r]);
            const unsigned ke = f2bf(kk * __expf(alast - Av)); if (r & 1) kp[r >> 1] |= ke << 16; else kp[r >> 1] = ke;
            if (bi <= 0) *(LAS unsigned short*)(L + H_K + (0 + t) * HS128 + c * 2) = f2bfs(kk * __expf(0.f - Av));
            if (bi <= 1) *(LAS unsigned short*)(L + H_K + (16 + t) * HS128 + c * 2) = f2bfs(kk * __expf(ab1 - Av));
            if (bi <= 2) *(LAS unsigned short*)(L + H_K + (48 + t) * HS128 + c * 2) = f2bfs(kk * __expf(ab2 - Av));
            *(LAS unsigned short*)(L + H_K + (96 + t) * HS128 + c * 2) = f2bfs(kk * __expf(ab3 - Av)); }
        *(LAS v4u*)(L + H_KT + c * HS64 + bi * 32) = (v4u){kp[0], kp[1], kp[2], kp[3]}; *(LAS v4u*)(L + H_KT + c * HS64 + bi * 32 + 16) = (v4u){kp[4], kp[5], kp[6], kp[7]};
        asup += alast;
        __syncthreads();
#pragma unroll
        for (int rep = 0; rep < 2; ++rep) { const int tile = w + 8 * rep;
            if (tile < 10) { const int i = tile < 1 ? 0 : tile < 3 ? 1 : tile < 6 ? 2 : 3, j = tile - (i * (i + 1)) / 2;
                const LAS unsigned char* ap = L + H_QB + (16 * i + l15) * HS128 + l4 * 16; const LAS unsigned char* bp = L + H_K + (8 * i * (i + 1) + 16 * j + l15) * HS128 + l4 * 16;
                f32x4 p = (f32x4){0.f, 0.f, 0.f, 0.f};
#pragma unroll
                for (int ks = 0; ks < 4; ++ks) p = __builtin_amdgcn_mfma_f32_16x16x32_bf16(*(const LAS bf16x8*)(ap + ks * 64), *(const LAS bf16x8*)(bp + ks * 64), p, 0, 0, 0);
#pragma unroll
                for (int r = 0; r < 4; ++r) { const float pv = (i == j && l15 > 4 * l4 + r) ? 0.f : p[r];
                    *(LAS unsigned short*)(L + H_PM + (16 * i + 4 * l4 + r) * HS64 + (16 * j + l15) * 2) = f2bfs(pv); } } }
        __syncthreads();
#pragma unroll
        for (int tb = 0; tb < 4; ++tb) { f32x4 o = (f32x4){0.f, 0.f, 0.f, 0.f};
#pragma unroll
            for (int ks = 0; ks < 2; ++ks) if (32 * ks < 16 * (tb + 1))
                o = __builtin_amdgcn_mfma_f32_16x16x32_bf16(*(const LAS bf16x8*)(L + H_VT + (16 * w + l15) * HS64 + l4 * 16 + ks * 64), *(const LAS bf16x8*)(L + H_PM + (16 * tb + l15) * HS64 + l4 * 16 + ks * 64), o, 0, 0, 0);
            if (ci > 0) {
#pragma unroll
                for (int ks = 0; ks < 4; ++ks)
                    o = __builtin_amdgcn_mfma_f32_16x16x32_bf16(*(const LAS bf16x8*)(L + H_ST + (16 * w + l15) * HS128 + l4 * 16 + ks * 64), *(const LAS bf16x8*)(L + H_QC + (16 * tb + l15) * HS128 + l4 * 16 + ks * 64), o, 0, 0, 0); }
            v2u ov; ov.x = pk2(o[0], o[1]); ov.y = pk2(o[2], o[3]);
            *(v2u*)(OLOC + (size_t)(ci * 64 + 16 * tb + l15) * 512 + 16 * w + 4 * l4) = ov; }
        { const f32x4 dv = *(const LAS f32x4*)(AL + 16 * w + 4 * l4); const f32x4 d = (f32x4){__expf(dv[0]), __expf(dv[1]), __expf(dv[2]), __expf(dv[3])};
          const bf16x8 ka0 = *(const LAS bf16x8*)(L + H_KT + (16 * w + l15) * HS64 + l4 * 16), ka1 = *(const LAS bf16x8*)(L + H_KT + (16 * w + l15) * HS64 + l4 * 16 + 64);
#pragma unroll
          for (int vb = 0; vb < 8; ++vb) { f32x4 s = acc[vb] * d;
              s = __builtin_amdgcn_mfma_f32_16x16x32_bf16(ka0, *(const LAS bf16x8*)(L + H_VT + (16 * vb + l15) * HS64 + l4 * 16), s, 0, 0, 0);
              s = __builtin_amdgcn_mfma_f32_16x16x32_bf16(ka1, *(const LAS bf16x8*)(L + H_VT + (16 * vb + l15) * HS64 + l4 * 16 + 64), s, 0, 0, 0);
              acc[vb] = s; } }
        __syncthreads();
    }
    f32x4* U = (f32x4*)(F.ws + WS_U);
#pragma unroll
    for (int vb = 0; vb < 8; ++vb) U[(size_t)((unit * 8 + w) * 8 + vb) * 64 + lane] = acc[vb];
    if (bi == 0) ((float*)(F.ws + WS_DS))[unit * 128 + c] = __expf(asup);
}
__device__ __forceinline__ void hgrn_h3_unit(Frame& F, const Args& A, int unit) {
    const int b = unit >> 5, h = (unit >> 3) & 3, n = unit & 7;
    const int lane = F.lane, w = F.wave, l15 = lane & 15, l4 = lane >> 4;
    LAS unsigned char* L = F.lds;
    const f32x4* U = (const f32x4*)(F.ws + WS_U); const float* DS = (const float*)(F.ws + WS_DS);
    f32x4 S[8];
#pragma unroll
    for (int vb = 0; vb < 8; ++vb) S[vb] = (f32x4){0.f, 0.f, 0.f, 0.f};
    for (int m = 0; m < n; ++m) { const int um = unit - n + m; const f32x4 d = *(const f32x4*)(DS + um * 128 + 16 * w + 4 * l4);
#pragma unroll
        for (int vb = 0; vb < 8; ++vb) S[vb] = S[vb] * d + U[(size_t)((um * 8 + w) * 8 + vb) * 64 + lane]; }
#pragma unroll
    for (int vb = 0; vb < 8; ++vb) { v2u o; o.x = pk2(S[vb][0], S[vb][1]); o.y = pk2(S[vb][2], S[vb][3]);
        *(LAS v2u*)(L + H_ST + (16 * vb + l15) * HS128 + (16 * w + 4 * l4) * 2) = o; }
    __syncthreads();
    const size_t rowbase = (size_t)(b * SEQ + n * 1024 + 128 * w) * 512 + h * 128;
    const bf16* QHAT = (const bf16*)(F.ws + WS_QHAT) + rowbase; const bf16* OLOC = (const bf16*)(F.ws + WS_OLOC) + rowbase;
    const bf16* RGS = (const bf16*)(F.ws + WS_RGS) + rowbase; bf16* REC = (bf16*)(F.ws + WS_REC) + rowbase;
    f32x4 rw[8];
#pragma unroll
    for (int vb = 0; vb < 8; ++vb) rw[vb] = *(const f32x4*)(A.in[11] + 16 * vb + 4 * l4);
#pragma unroll 1
    for (int tb = 0; tb < 8; ++tb) { const size_t tr = (size_t)(16 * tb + l15) * 512;
        bf16x8 qh[4];
#pragma unroll
        for (int ks = 0; ks < 4; ++ks) qh[ks] = *(const bf16x8*)(QHAT + tr + 32 * ks + 8 * l4);
        f32x4 o[8]; float ss = 0.f;
#pragma unroll
        for (int vb = 0; vb < 8; ++vb) { f32x4 a = (f32x4){0.f, 0.f, 0.f, 0.f};
            if (n > 0) {
#pragma unroll
                for (int ks = 0; ks < 4; ++ks) a = __builtin_amdgcn_mfma_f32_16x16x32_bf16(*(const LAS bf16x8*)(L + H_ST + (16 * vb + l15) * HS128 + l4 * 16 + ks * 64), qh[ks], a, 0, 0, 0); }
            const v2u ol = *(const v2u*)(OLOC + tr + 16 * vb + 4 * l4);
            a[0] += bflo(ol.x); a[1] += bfhi(ol.x); a[2] += bflo(ol.y); a[3] += bfhi(ol.y);
            o[vb] = a; ss += (a[0] * a[0] + a[1] * a[1]) + (a[2] * a[2] + a[3] * a[3]); }
        ss += __shfl_xor(ss, 16); ss += __shfl_xor(ss, 32);
        const float r = 1.0f / sqrtf(ss * (1.0f / 128.0f) + EPS);
#pragma unroll
        for (int vb = 0; vb < 8; ++vb) { const v2u g = *(const v2u*)(RGS + tr + 16 * vb + 4 * l4); const f32x4 y = o[vb] * r * rw[vb];
            v2u ov; ov.x = pk2(y[0] * bflo(g.x), y[1] * bfhi(g.x)); ov.y = pk2(y[2] * bflo(g.y), y[3] * bfhi(g.y));
            *(v2u*)(REC + tr + 16 * vb + 4 * l4) = ov; }
    }
    __syncthreads();
}

__device__ __forceinline__ unsigned f2key(float x) {
    const _Float16 hh = (_Float16)x; const unsigned bits = (unsigned)__builtin_bit_cast(unsigned short, hh);
    return (bits & 0x8000u) ? (~bits & 0xffffu) : (bits | 0x8000u);
}
constexpr int DSA_VIMG = 73728;
constexpr int DSA_CAND = 147456, DSA_CAPC = 448;
typedef unsigned u32x4p __attribute__((ext_vector_type(4)));
__device__ __forceinline__ void dsa_unit(Frame& F, int b, int t0) {
    const int lane = F.lane, w = F.wave, qc = lane & 31, hf = lane >> 5;
    const bf16* KI = (const bf16*)(F.ws + WS_KI) + (size_t)b * SEQ * 64;
    const bf16* QI = (const bf16*)(F.ws + WS_QI) + (size_t)(b * SEQ + t0) * 512;
    const float* WI = (const float*)(F.ws + WS_WI) + (size_t)(b * SEQ + t0) * 8;
    unsigned short* scr = (unsigned short*)(F.ws + WS_SCR) + (size_t)blockIdx.x * (32 * 8192);
    const int nkb = t0 / 32 + 1;
    LAS unsigned* hist = (LAS unsigned*)(F.lds);
    for (int i = F.tid; i < 4096; i += NWAVES * 64) ((LAS v4u*)hist)[i] = (v4u){0u, 0u, 0u, 0u};
    __syncthreads();
#ifndef NO_PASS1
    {
        const int l15 = lane & 15, l4 = lane >> 4, qg = w >> 2, ql = 16 * qg + l15;
        bf16x8 qf[8][2]; float wv[8];
#pragma unroll
        for (int h = 0; h < 8; ++h) { wv[h] = WI[ql * 8 + h];
#pragma unroll
            for (int ks = 0; ks < 2; ++ks) qf[h][ks] = *(const bf16x8*)(QI + (size_t)ql * 512 + h * 64 + ks * 32 + l4 * 8); }
        const int lim = t0 + ql - 4 * l4;
        float wh[8];
#pragma unroll
        for (int h = 0; h < 8; ++h) wh[h] = 0.5f * wv[h];
        const int nb16 = 2 * nkb;
#define P1_LOAD(K0, K1, KB) do { const int row_ = (KB) * 16 + l15; const bf16* kp_ = KI + (size_t)(row_ < SEQ - 1 ? row_ : SEQ - 1) * 64 + l4 * 8; K0 = *(const bf16x8*)(kp_); K1 = *(const bf16x8*)(kp_ + 32); } while (0)
#define P1_COMPUTE(K0, K1, KB) do { const int s0_ = (KB) * 16; f32x4 sc_ = (f32x4){0.f, 0.f, 0.f, 0.f}; \
            _Pragma("unroll") for (int h = 0; h < 8; ++h) { f32x4 a_ = (f32x4){0.f, 0.f, 0.f, 0.f}; \
                a_ = __builtin_amdgcn_mfma_f32_16x16x32_bf16(K0, qf[h][0], a_, 0, 0, 0); a_ = __builtin_amdgcn_mfma_f32_16x16x32_bf16(K1, qf[h][1], a_, 0, 0, 0); \
                _Pragma("unroll") for (int r = 0; r < 4; ++r) { sc_[r] = __builtin_fmaf(wh[h], a_[r], sc_[r]); sc_[r] = __builtin_fmaf(wh[h], __builtin_fabsf(a_[r]), sc_[r]); } } \
            unsigned kk_[4]; \
            _Pragma("unroll") for (int r = 0; r < 4; ++r) { const bool causal_ = s0_ + r <= lim; const unsigned key_ = f2key(sc_[r]); kk_[r] = causal_ ? key_ : 0u; \
                if (causal_ && rep5_ == 0) __hip_atomic_fetch_add(hist + ql * 512 + (key_ >> 7), 1u, __ATOMIC_RELAXED, __HIP_MEMORY_SCOPE_WORKGROUP); } \
            v2u o_; o_.x = kk_[0] | (kk_[1] << 16); o_.y = kk_[2] | (kk_[3] << 16); \
            *(v2u*)(scr + (size_t)ql * 8192 + s0_ + 4 * l4) = o_; } while (0)
        { const int rep5_ = 0;
        bf16x8 ka0, ka1, kb0, kb1, kc0, kc1, kd0, kd1;
        int kb = (w & 3);
        P1_LOAD(ka0, ka1, kb); P1_LOAD(kb0, kb1, kb + 4); P1_LOAD(kc0, kc1, kb + 8);
#pragma unroll 1
        for (; kb < nb16; kb += 16) {
            P1_LOAD(kd0, kd1, kb + 12);
            P1_COMPUTE(ka0, ka1, kb);
            P1_LOAD(ka0, ka1, kb + 16);
            if (kb + 4 < nb16) P1_COMPUTE(kb0, kb1, kb + 4);
            P1_LOAD(kb0, kb1, kb + 20);
            if (kb + 8 < nb16) P1_COMPUTE(kc0, kc1, kb + 8);
            P1_LOAD(kc0, kc1, kb + 24);
            if (kb + 12 < nb16) P1_COMPUTE(kd0, kd1, kb + 12);
        }
        }
#undef P1_LOAD
#undef P1_COMPUTE
    }
#endif
    __syncthreads();
    LAS unsigned short* idxl = (LAS unsigned short*)(F.lds + 65536) + w * 256;
    const LAS float* rb = (const LAS float*)(F.lds + 69632); const LAS int* lut = (const LAS int*)(F.lds + 70656);
    const bf16* KV = (const bf16*)(F.ws + WS_KV) + (size_t)b * SEQ * 256;
    const int nk = nkb * 32, ndw = nk >> 1;
#pragma unroll 1
    for (int qq = 0; qq < 4; ++qq) {
        const int ql = w * 4 + qq, t = t0 + ql, nvalid = t + 1, nsel = nvalid < 256 ? nvalid : 256;
        const unsigned* rowd = (const unsigned*)(scr + (size_t)ql * 8192);
        int ln = lane; asm volatile("" : "+v"(ln));
        {
        unsigned rv[64];
#pragma unroll
        for (int j = 0; j < 64; ++j) { const unsigned val = rowd[j * 64 + ln]; rv[j] = (ln < ndw - j * 64) ? val : 0u; }
        unsigned T = 0u; int need = 0; bool done = false;
        const unsigned long long lt = (1ull << ln) - 1ull; const int ln2 = 2 * ln;
        if (nvalid > 256) {
            const LAS unsigned* hq = hist + ql * 512 + 8 * ln;
            const v4u h0 = *(const LAS v4u*)(hq), h1 = *(const LAS v4u*)(hq + 4);
            const unsigned h8[8] = {h0.x, h0.y, h0.z, h0.w, h1.x, h1.y, h1.z, h1.w};
            const unsigned sl = (h0.x + h0.y) + (h0.z + h0.w) + (h1.x + h1.y) + (h1.z + h1.w);
            unsigned S = sl;
#pragma unroll
            for (int d = 1; d < 64; d <<= 1) { const unsigned tt = __shfl_down(S, d); if (ln + d < 64) S += tt; }
            const int Lb = __popcll(__ballot(S >= 256u)) - 1;
            unsigned cum = S - sl, caL = 0u, cbL = 0u; int Bi = 0; bool found = false;
#pragma unroll
            for (int i = 7; i >= 0; --i) { if (!found && cum + h8[i] >= 256u) { Bi = i; caL = cum; cbL = h8[i]; found = true; } if (!found) cum += h8[i]; }
            const int B = 8 * Lb + __shfl(Bi, Lb); const int ca = (int)__shfl(caL, Lb), cb = (int)__shfl(cbL, Lb);
            LAS unsigned short* glst = (LAS unsigned short*)(F.lds + DSA_VIMG + w * 9216);
            LAS unsigned* elst = (LAS unsigned*)(F.lds + DSA_VIMG + w * 9216 + 3072);
            const unsigned Tg = (unsigned)(B + 1) << 7, Te = (unsigned)B << 7;
            int gc = 0, ec = 0;
#pragma unroll
            for (int g = 0; g < 8; ++g) if (g * 1024 < nk) {
#pragma unroll
                for (int j = 8 * g; j < 8 * g + 8; ++j) { const unsigned lo = rv[j] & 0xffffu, hi = rv[j] >> 16; const unsigned i0 = (unsigned)(ln2 + 128 * j);
                    if (lo >= Te) { if (lo >= Tg) { if (gc < 24) glst[gc * 64 + ln] = (unsigned short)i0; ++gc; } else { if (ec < 12) elst[ec * 64 + ln] = (lo << 16) | (65535u - i0); ++ec; } }
                    if (hi >= Te) { if (hi >= Tg) { if (gc < 24) glst[gc * 64 + ln] = (unsigned short)(i0 + 1u); ++gc; } else { if (ec < 12) elst[ec * 64 + ln] = (hi << 16) | (65534u - i0); ++ec; } } } }
            if (__ballot(gc > 24 || ec > 12) == 0ull) {
                LDS_WAIT(); asm volatile("" ::: "memory");
                int incl = gc;
#pragma unroll
                for (int d = 1; d < 64; d <<= 1) { const int tt = __shfl_up(incl, d); if (ln >= d) incl += tt; }
                const int excl = incl - gc;
#pragma unroll 1
                for (int e = 0; e < 24; ++e) { if (__ballot(e < gc) == 0ull) break; if (e < gc) idxl[excl + e] = glst[e * 64 + ln]; }
                unsigned cv[12]; int emax = 0;
#pragma unroll
                for (int e = 0; e < 12; ++e) { cv[e] = (e < ec) ? elst[e * 64 + ln] : 0u; if (__ballot(e < ec) != 0ull) emax = e + 1; }
                const int needc = 256 - ca; unsigned pref = (unsigned)B << 23;
#pragma unroll 1
                for (int bit = 22; bit >= 0; --bit) { const unsigned c = pref | (1u << bit); int cnt = 0;
#pragma unroll
                    for (int e = 0; e < 12; ++e) if (e < emax) cnt += __popcll(__ballot(cv[e] >= c));
                    if (cnt >= needc) pref = c; }
                int base = ca;
#pragma unroll
                for (int e = 0; e < 12; ++e) if (e < emax) { const bool sl2 = cv[e] >= pref; const unsigned long long m = __ballot(sl2); const int pos = base + __popcll(m & lt);
                    if (sl2 && pos < 256) idxl[pos] = (unsigned short)(65535u - (cv[e] & 0xffffu)); base += __popcll(m); }
                done = true;
            } else {
#pragma unroll 1
                for (int bit = 15; bit >= 0; --bit) { const unsigned cand2 = T | (1u << bit); int c = 0;
#pragma unroll
                    for (int g = 0; g < 8; ++g) if (g * 1024 < nk) {
#pragma unroll
                        for (int j = 8 * g; j < 8 * g + 8; ++j) { c += ((rv[j] & 0xffffu) >= cand2) ? 1 : 0; c += ((rv[j] >> 16) >= cand2) ? 1 : 0; } }
#pragma unroll
                    for (int o = 1; o < 64; o <<= 1) c += __shfl_xor(c, o);
                    if (c >= 256) T = cand2; }
                int c = 0;
#pragma unroll
                for (int g = 0; g < 8; ++g) if (g * 1024 < nk) {
#pragma unroll
                    for (int j = 8 * g; j < 8 * g + 8; ++j) { c += ((rv[j] & 0xffffu) > T) ? 1 : 0; c += ((rv[j] >> 16) > T) ? 1 : 0; } }
#pragma unroll
                for (int o = 1; o < 64; o <<= 1) c += __shfl_xor(c, o);
                need = 256 - c;
            }
        }
        if (!done) {
            int base = 0, tiebase = 0;
#pragma unroll
            for (int g = 0; g < 8; ++g) if (g * 1024 < nk) {
#pragma unroll
                for (int j = 8 * g; j < 8 * g + 8; ++j) { const unsigned lo = rv[j] & 0xffffu, hi = rv[j] >> 16;
                    const bool el = lo == T, eh = hi == T; const unsigned long long mel = __ballot(el), meh = __ballot(eh);
                    const int trl = tiebase + __popcll(mel & lt) + __popcll(meh & lt), trh = trl + (el ? 1 : 0);
                    const bool sl = lo > T || (el && trl < need), sh = hi > T || (eh && trh < need);
                    const unsigned long long msl = __ballot(sl), msh = __ballot(sh);
                    const int pl = base + __popcll(msl & lt) + __popcll(msh & lt), ph = pl + (sl ? 1 : 0);
                    if (sl && pl < 256) idxl[pl] = (unsigned short)(ln2 + 128 * j); if (sh && ph < 256) idxl[ph] = (unsigned short)(ln2 + 128 * j + 1);
                    base += __popcll(msl) + __popcll(msh); tiebase += __popcll(mel) + __popcll(meh); __builtin_amdgcn_sched_barrier(0); } }
        }
        }
        LDS_WAIT(); asm volatile("" ::: "memory");
#ifdef EXP_ATT2
#pragma unroll 1
        for (int rep_ = 0; rep_ < 2; ++rep_)
#endif
        {
            int l15 = ln & 15, l4 = ln >> 4; asm volatile("" : "+v"(l15), "+v"(l4));
            const int l4x4 = 4 * l4;
#pragma unroll
            for (int jj = 0; jj < 4; ++jj) { if (ln >= nsel - 64 * jj) idxl[ln + 64 * jj] = 0; }
            LDS_WAIT(); asm volatile("" ::: "memory");
            const bf16* qrow = (const bf16*)(F.ws + WS_Q) + (size_t)(b * SEQ + t) * 512 + (l15 & 7) * 64 + 8 * l4;
            bf16x8 bq[2][2];
#pragma unroll
            for (int g = 0; g < 2; ++g)
#pragma unroll
                for (int ks = 0; ks < 2; ++ks) { bf16x8 v = *(const bf16x8*)(qrow + 32 * ks); if ((l15 >> 2) != g) v = (bf16x8){0, 0, 0, 0, 0, 0, 0, 0}; bq[g][ks] = v; }
            f32x4 sa[16];
#pragma unroll
            for (int half = 0; half < 4; ++half) {
                bf16x8 ka[4][4];
#pragma unroll
                for (int bl = 0; bl < 4; ++bl) { const bf16* kr = KV + (size_t)idxl[16 * (4 * half + bl) + l15] * 256 + 8 * l4;
#pragma unroll
                    for (int i = 0; i < 4; ++i) ka[bl][i] = *(const bf16x8*)(kr + 32 * i); }
#pragma unroll
                for (int bl = 0; bl < 4; ++bl) { f32x4 acc = (f32x4){0.f, 0.f, 0.f, 0.f};
                    acc = __builtin_amdgcn_mfma_f32_16x16x32_bf16(ka[bl][0], bq[0][0], acc, 0, 0, 0); acc = __builtin_amdgcn_mfma_f32_16x16x32_bf16(ka[bl][1], bq[0][1], acc, 0, 0, 0);
                    acc = __builtin_amdgcn_mfma_f32_16x16x32_bf16(ka[bl][2], bq[1][0], acc, 0, 0, 0); acc = __builtin_amdgcn_mfma_f32_16x16x32_bf16(ka[bl][3], bq[1][1], acc, 0, 0, 0);
                    sa[4 * half + bl] = acc; }
                asm volatile("" ::: "memory"); }
            v4u vbuf[2][8];
#pragma unroll
            for (int i = 0; i < 8; ++i) vbuf[0][i] = *(const v4u*)(KV + (size_t)idxl[4 * i + l4] * 256 + 128 + l15 * 8);
            float mx = -INFINITY; const float bias31 = rb[31 * 8 + (l15 & 7)];
#pragma unroll
            for (int blk = 0; blk < 16; ++blk)
#pragma unroll
                for (int r = 0; r < 4; ++r) { const int dist = t - (int)idxl[l4x4 + (16 * blk + r)]; float bias = bias31;
                    if (__ballot(dist < 113) != 0ull) bias = rb[(dist < 128 ? lut[dist] : 31) * 8 + (l15 & 7)];
                    const float v = (l4x4 < nsel - (16 * blk + r)) ? sa[blk][r] + bias : -INFINITY; sa[blk][r] = v; mx = fmaxf(mx, v); }
            mx = fmaxf(mx, __shfl_xor(mx, 16)); mx = fmaxf(mx, __shfl_xor(mx, 32));
            float su = 0.f;
#pragma unroll
            for (int blk = 0; blk < 16; ++blk)
#pragma unroll
                for (int r = 0; r < 4; ++r) { const float e = __expf(sa[blk][r] - mx); sa[blk][r] = e; su += e; }
            su += __shfl_xor(su, 16); su += __shfl_xor(su, 32);
            const float inv = 1.0f / su;
            bf16x8 pf[8];
#pragma unroll
            for (int ks = 0; ks < 8; ++ks) { u32x4p pa; pa.x = pk2(sa[2 * ks][0], sa[2 * ks][1]); pa.y = pk2(sa[2 * ks][2], sa[2 * ks][3]); pa.z = pk2(sa[2 * ks + 1][0], sa[2 * ks + 1][1]); pa.w = pk2(sa[2 * ks + 1][2], sa[2 * ks + 1][3]);
                asm volatile("" : "+v"(pa));
                pf[ks] = __builtin_bit_cast(bf16x8, pa); }
#pragma unroll
            for (int i = 0; i < 8; ++i) vbuf[1][i] = *(const v4u*)(KV + (size_t)idxl[32 + 4 * i + l4] * 256 + 128 + l15 * 8);
            f32x4 oa[2][4];
#pragma unroll
            for (int g = 0; g < 2; ++g)
#pragma unroll
                for (int c = 0; c < 4; ++c) oa[g][c] = (f32x4){0.f, 0.f, 0.f, 0.f};
            LAS unsigned char* vimg = F.lds + DSA_VIMG + w * 9216;
            const unsigned traddr = (unsigned)(size_t)(vimg + (4 * l4 + (l15 >> 2)) * 144 + (l15 & 3) * 8);
#pragma unroll
            for (int ks = 0; ks < 8; ++ks) {
#pragma unroll
                for (int i = 0; i < 8; ++i) *(LAS v4u*)(vimg + (l15 >> 3) * 4608 + (4 * i + l4) * 144 + (l15 & 7) * 16) = vbuf[ks & 1][i];
                if (ks + 2 < 8) {
#pragma unroll
                    for (int i = 0; i < 8; ++i) vbuf[ks & 1][i] = *(const v4u*)(KV + (size_t)idxl[32 * (ks + 2) + 4 * i + l4] * 256 + 128 + l15 * 8); }
                LDS_WAIT(); asm volatile("" ::: "memory");
                v2u tb[16];
                asm volatile("ds_read_b64_tr_b16 %0, %16 offset:0\n\tds_read_b64_tr_b16 %1, %16 offset:2304\n\tds_read_b64_tr_b16 %2, %16 offset:32\n\tds_read_b64_tr_b16 %3, %16 offset:2336\n\t"
                             "ds_read_b64_tr_b16 %4, %16 offset:64\n\tds_read_b64_tr_b16 %5, %16 offset:2368\n\tds_read_b64_tr_b16 %6, %16 offset:96\n\tds_read_b64_tr_b16 %7, %16 offset:2400\n\t"
                             "ds_read_b64_tr_b16 %8, %16 offset:4608\n\tds_read_b64_tr_b16 %9, %16 offset:6912\n\tds_read_b64_tr_b16 %10, %16 offset:4640\n\tds_read_b64_tr_b16 %11, %16 offset:6944\n\t"
                             "ds_read_b64_tr_b16 %12, %16 offset:4672\n\tds_read_b64_tr_b16 %13, %16 offset:6976\n\tds_read_b64_tr_b16 %14, %16 offset:4704\n\tds_read_b64_tr_b16 %15, %16 offset:7008\n\ts_waitcnt lgkmcnt(0)"
                             : "=&v"(tb[0]), "=&v"(tb[1]), "=&v"(tb[2]), "=&v"(tb[3]), "=&v"(tb[4]), "=&v"(tb[5]), "=&v"(tb[6]), "=&v"(tb[7]),
                               "=&v"(tb[8]), "=&v"(tb[9]), "=&v"(tb[10]), "=&v"(tb[11]), "=&v"(tb[12]), "=&v"(tb[13]), "=&v"(tb[14]), "=&v"(tb[15])
                             : "v"(traddr) : "memory");
#pragma unroll
                for (int g = 0; g < 2; ++g)
#pragma unroll
                    for (int c = 0; c < 4; ++c) { u32x4p bb; bb.x = tb[8 * g + 2 * c].x; bb.y = tb[8 * g + 2 * c].y; bb.z = tb[8 * g + 2 * c + 1].x; bb.w = tb[8 * g + 2 * c + 1].y;
                        oa[g][c] = __builtin_amdgcn_mfma_f32_16x16x32_bf16(pf[ks], __builtin_bit_cast(bf16x8, bb), oa[g][c], 0, 0, 0); }
                asm volatile("" ::: "memory");
            }
            bf16* orow = (bf16*)(F.ws + WS_ATT) + (size_t)(b * SEQ + t) * 512;
#pragma unroll
            for (int r = 0; r < 4; ++r) { const float i0 = __shfl(inv, r), i1 = __shfl(inv, 4 + r);
                if (l4 < 2) {
#pragma unroll
                    for (int c = 0; c < 4; ++c) { const float v = l4 == 0 ? oa[0][c][r] * i0 : oa[1][c][r] * i1; orow[(4 * l4 + r) * 64 + 16 * c + l15] = (bf16)f2bf(v); } } }
        }
        LDS_WAIT(); asm volatile("" ::: "memory");
    }
    __syncthreads();
}

__device__ __forceinline__ void p4_mixers(Frame& F, const Args& A) {
    for (int u = blockIdx.x; u < 256; u += F.G) hgrn_h1_unit(F, u);
#ifdef EXP_H12
    __syncthreads();
    for (int u = blockIdx.x; u < 256; u += F.G) hgrn_h1_unit(F, u);
#endif
    __syncthreads();
    { LAS float* rb = (LAS float*)(F.lds + 69632); LAS int* lut = (LAS int*)(F.lds + 70656);
      if (F.tid < 256) rb[F.tid] = A.in[9][F.tid];
      if (F.tid < 128) { const int n = F.tid; int v = n; if (n >= 16) { v = 16 + (int)(__logf((float)n * (1.0f / 16.0f)) * (16.0f / 2.0794415416798357f)); v = v < 31 ? v : 31; } lut[n] = v; }
      __syncthreads(); }
#ifdef EXP_DSA2
#pragma unroll 1
    for (int rep3_ = 0; rep3_ < 2; ++rep3_)
#endif
    for (int u = blockIdx.x, k = 0; u < 2048; u += F.G, ++k) { const int b = u & 7, sl = u >> 3, sm = (k & 1) ? ((sl & ~31) | (31 - (sl & 31))) : sl; dsa_unit(F, b, (255 - sm) * 32); }
}

__device__ __forceinline__ void p5_rec(Frame& F, const Args& A) { for (int u = blockIdx.x; u < 256; u += F.G) hgrn_h3_unit(F, A, u);
#ifdef EXP_H32
    for (int u = blockIdx.x; u < 256; u += F.G) hgrn_h3_unit(F, A, u);
#endif
}

__device__ __forceinline__ void p10_final(Frame& F, const Args& A) {
    const int gw = blockIdx.x * NWAVES + F.wave, NGW = F.G * NWAVES; const float* SS = (const float*)(F.ws + WS_X2SS);
    for (int m = gw; m < M; m += NGW) {
        float s = F.lane < 16 ? SS[(size_t)m * 16 + F.lane] : 0.f; s = wave_sum(s);
        const float r = 1.0f / sqrtf(s * (1.0f / D) + EPS);
        GAS f32x4* xr = (GAS f32x4*)(F.out + (size_t)m * D) + F.lane;
#pragma unroll
        for (int j = 0; j < 4; ++j) { const f32x4 w = *(const f32x4*)(A.in[19] + 4 * F.lane + 256 * j); xr[64 * j] = xr[64 * j] * r * w; }
    }
}

__global__ void __launch_bounds__(NWAVES * 64, 2) fwd_kernel(Args args) {
    extern __shared__ __attribute__((aligned(16))) unsigned char lds[];
    Frame F;
    F.lds = (LAS unsigned char*)lds;
    F.MISC = (volatile LAS unsigned*)(F.lds + MISC_OFF);
    F.tid = threadIdx.x; F.lane = F.tid & 63; F.wave = __builtin_amdgcn_readfirstlane(F.tid >> 6);
    F.G = gridDim.x;
    F.ws = args.ws; F.ctl = (gu32*)(args.ws + WS_CTL); F.out = args.out;
    for (int u = F.tid; u < (LDS_BYTES - LDSCTL_OFF) / 4; u += NWAVES * 64) ((LAS unsigned*)(F.lds + LDSCTL_OFF))[u] = 0u;
    __syncthreads();
    XcdBarrier bar; bar.bar = (unsigned*)(F.ctl + CW_BAR); bar.x = 0; bar.st = nullptr;
    if (N_LAUNCHES == 1) bar = xcd_barrier_post((unsigned*)(F.ctl + CW_BAR), F.MISC + 8);
#define GRID_BAR() do { if (N_LAUNCHES == 1) xcd_barrier(bar); } while (0)
    const int lo = args.ph_lo, hi = args.ph_hi;
#ifdef ONLY_PHASE
#define IN(k) ((k) == ONLY_PHASE && lo <= (k) && (k) < hi)
#else
#define IN(k) (lo <= (k) && (k) < hi)
#endif
#define BOTH(k) (IN(k) && IN((k) + 1))
    const float* MOD = (const float*)(F.ws + WS_MOD);

    if (IN(0)) { p0_prologue(F, args); if (BOTH(0)) GRID_BAR(); }
    if (IN(1)) { p1_norm(F, args); if (BOTH(1)) GRID_BAR(); }
#ifdef EXP_P01
    if (IN(0)) { p0_prologue(F, args); if (BOTH(0)) GRID_BAR(); }
    if (IN(1)) { p1_norm(F, args); if (BOTH(1)) GRID_BAR(); }
#endif
    if (IN(2)) {
        pg8::Gemm g{(const bf16*)(F.ws + WS_XN), (const bf16*)(F.ws + WS_WIN), M, NPROJ_PAD, 1024}; pg8::StaticOrder S; S.init(M, NPROJ_PAD, F.G, (int)blockIdx.x);
        pg8::EpiInProj E{(bf16*)(F.ws + WS_CQ), (bf16*)(F.ws + WS_KV), (bf16*)(F.ws + WS_KI), (bf16*)(F.ws + WS_RQ), (bf16*)F.out,
                         (float*)(F.ws + WS_WI), (float*)(F.ws + WS_CQSS), (const float*)(F.ws + WS_LB)};
        pg8::gemm_phase<pg8::EpiInProj, pg8::StaticOrder, PG8_ALIGN, PG8_SP2>(F.lds + RING_OFF, g, S, E);
#ifdef EXP_IN2
        pg8::gemm_phase<pg8::EpiInProj, pg8::StaticOrder, PG8_ALIGN, PG8_SP2>(F.lds + RING_OFF, g, S, E);
#endif
#ifdef EXP_IN3
        { pg8::EpiPlain E2{(bf16*)(F.ws + WS_SCR)}; pg8::gemm_phase<pg8::EpiPlain, pg8::StaticOrder, PG8_ALIGN, PG8_SP2>(F.lds + RING_OFF, g, S, E2); }
#endif
        if (BOTH(2)) GRID_BAR();
    }
    if (IN(3)) {
        pg8::Gemm g{(const bf16*)(F.ws + WS_CQ), (const bf16*)(F.ws + WS_WQ), M, 1024, 256}; pg8::StaticOrder S; S.init(M, 1024, F.G, (int)blockIdx.x);
        pg8::EpiQ E{(bf16*)(F.ws + WS_Q), (const float*)(F.ws + WS_CQSS)};
        pg8::gemm_phase<pg8::EpiQ, pg8::StaticOrder, PG8_ALIGN, PG8_SP2>(F.lds + RING_OFF, g, S, E);
        if (BOTH(3)) GRID_BAR();
    }
    if (IN(4)) { p4_mixers(F, args); if (BOTH(4)) GRID_BAR(); }
    if (IN(5)) { p5_rec(F, args); if (BOTH(5)) GRID_BAR(); }
    if (IN(6)) {
        pg8::StaticOrder S; S.init(M, 1024, F.G, (int)blockIdx.x);
        { pg8::Gemm g{(const bf16*)(F.ws + WS_ATT), (const bf16*)(F.ws + WS_WBA), M, 1024, 512}; pg8::EpiBranch<0> E{(bf16*)(F.ws + WS_MIX), (const bf16*)F.out};
          pg8::gemm_phase<pg8::EpiBranch<0>, pg8::StaticOrder, PG8_ALIGN, PG8_SP2>(F.lds + RING_OFF, g, S, E); }
        { pg8::Gemm g{(const bf16*)(F.ws + WS_REC), (const bf16*)(F.ws + WS_WBR), M, 1024, 512}; pg8::EpiBranch<1> E{(bf16*)(F.ws + WS_MIX), (const bf16*)F.out};
          pg8::gemm_phase<pg8::EpiBranch<1>, pg8::StaticOrder, PG8_ALIGN, PG8_SP2>(F.lds + RING_OFF, g, S, E); }
        if (BOTH(6)) GRID_BAR();
    }
    if (IN(7)) {
        pg8::Gemm g{(const bf16*)(F.ws + WS_MIX), (const bf16*)(F.ws + WS_WOUT), M, 1024, 1024}; pg8::StaticOrder S; S.init(M, 1024, F.G, (int)blockIdx.x);
        pg8::EpiOut E{args.in[0], (float*)(F.ws + WS_X1), (bf16*)(F.ws + WS_XS), (float*)(F.ws + WS_X1SS), MOD, (const float*)(F.ws + WS_CW2)};
        pg8::gemm_phase<pg8::EpiOut, pg8::StaticOrder, PG8_ALIGN, PG8_SP2>(F.lds + RING_OFF, g, S, E);
        if (BOTH(7)) GRID_BAR();
    }
    if (IN(8)) {
        pg8::Gemm g{(const bf16*)(F.ws + WS_XS), (const bf16*)(F.ws + WS_WGU), M, NGU, 1024}; pg8::StaticOrder S; S.init(M, NGU, F.G, (int)blockIdx.x);
        pg8::EpiGateUp E{(bf16*)(F.ws + WS_HID), (const float*)(F.ws + WS_X1SS), (const float*)(F.ws + WS_BGU)};
        pg8::gemm_phase<pg8::EpiGateUp, pg8::StaticOrder, PG8_ALIGN, PG8_SP2>(F.lds + RING_OFF, g, S, E);
#ifdef EXP_GU2
        pg8::gemm_phase<pg8::EpiGateUp, pg8::StaticOrder, PG8_ALIGN, PG8_SP2>(F.lds + RING_OFF, g, S, E);
#endif
        if (BOTH(8)) GRID_BAR();
    }
    if (IN(9)) {
        pg8::Gemm g{(const bf16*)(F.ws + WS_HID), (const bf16*)(F.ws + WS_WD), M, 1024, FF}; pg8::StaticOrder S; S.init(M, 1024, F.G, (int)blockIdx.x);
        pg8::EpiDown E{(const float*)(F.ws + WS_X1), F.out, (float*)(F.ws + WS_X2SS), MOD};
        pg8::gemm_phase<pg8::EpiDown, pg8::StaticOrder, PG8_ALIGN, PG8_SP2>(F.lds + RING_OFF, g, S, E);
        if (BOTH(9)) GRID_BAR();
    }
    if (IN(10)) p10_final(F, args);
#undef IN
#undef BOTH
}

extern "C" void kernel_launch(void* const* d_in, const int* in_sizes, int n_in, void* d_out, int out_size, void* d_ws, size_t ws_size, hipStream_t stream) {
    static int grid = 0;
    if (grid == 0) {
        if (n_in != 20 || in_sizes[0] != M * D || out_size != M * D || ws_size < WS_END) { fprintf(stderr, "kernel_launch: unexpected shapes (n_in %d, in0 %d, out %d, ws %zu); nothing launched\n", n_in, n_in > 0 ? in_sizes[0] : -1, out_size, ws_size); grid = -1; return; }
        int dev = 0, cus = 0, per_cu = 0;
        if (hipGetDevice(&dev) != hipSuccess || hipDeviceGetAttribute(&cus, hipDeviceAttributeMultiprocessorCount, dev) != hipSuccess) { grid = -1; return; }
        if (hipFuncSetAttribute((const void*)fwd_kernel, hipFuncAttributeMaxDynamicSharedMemorySize, LDS_BYTES) != hipSuccess) { fprintf(stderr, "kernel_launch: hipFuncSetAttribute failed\n"); grid = -1; return; }
        if (hipOccupancyMaxActiveBlocksPerMultiprocessor(&per_cu, (const void*)fwd_kernel, NWAVES * 64, LDS_BYTES) != hipSuccess || per_cu < 1)
            fprintf(stderr, "kernel_launch: note: occupancy query reports %d workgroups per CU\n", per_cu);
        (void)hipGetLastError();
        grid = cus;
    }
    if (grid < 0) return;
    if (hipMemsetAsync((char*)d_ws + WS_CTL, 0, CTL_ZERO_BYTES, stream) != hipSuccess) { fprintf(stderr, "kernel_launch: memset failed\n"); return; }
    Args a{};
    for (int i = 0; i < 20; ++i) a.in[i] = (const float*)d_in[i];
    a.out = (float*)d_out; a.ws = (unsigned char*)d_ws;
    for (int li = 0; li < N_LAUNCHES; ++li) {
        a.ph_lo = (N_LAUNCHES == 1) ? 0 : li; a.ph_hi = (N_LAUNCHES == 1) ? N_PHASES : li + 1;
        hipLaunchKernelGGL(fwd_kernel, dim3(grid), dim3(NWAVES * 64), LDS_BYTES, stream, a);
        const hipError_t le = hipPeekAtLastError();
        if (le != hipSuccess) { fprintf(stderr, "kernel_launch: launch %d failed: %s\n", li, hipGetErrorName(le)); break; }
    }
}
```

```cpp
#include <hip/hip_runtime.h>
#include <cstdio>
#include <cstdint>
namespace pg8 {
#define PG8_LAS __attribute__((address_space(3)))
typedef unsigned short bf16_t;
typedef short bf16x8 __attribute__((ext_vector_type(8)));
typedef float f32x4 __attribute__((ext_vector_type(4)));
typedef unsigned u32x4 __attribute__((ext_vector_type(4)));
constexpr int BM = 256, BK = 64, HALF = 128, HTB = HALF * BK * 2  , STAGE_BYTES = 8 * HTB, NXCD = 8, WGM = 8;

__host__ __device__ __forceinline__ int lds_byte(int r, int c) { const int st = (r >> 4) * 2 + (c >> 5), rr = r & 15, cc = c & 31, ob = rr * 64 + cc * 2; return st * 1024 + (ob ^ (((ob >> 9) & 1) << 5)); }
__host__ __device__ __forceinline__ void stage_rc(int b, int& R, int& C) { const int st = b / 1024, sb = b % 1024, swz = sb ^ (((sb >> 9) & 1) << 5); R = (st >> 1) * 16 + swz / 64; C = (st & 1) * 32 + (swz % 64) / 2; }
__host__ __device__ __forceinline__ int perm32(int rho) { const int n = rho >> 4, i = rho & 15; return 8 * (i >> 2) + 4 * n + (i & 3); }

struct Unit { int pm, pn; };
struct Gemm { const bf16_t* A; const bf16_t* Bt; int M, N, K; };

struct StaticOrder {
    int nM, nN, nwg, G, c;
    __host__ __device__ void init(int M, int N, int G_, int c_) { nM = M / BM; nN = N / BM; nwg = nM * nN; G = G_; c = c_; }
    __host__ __device__ bool next(int i, Unit& u) const {
        const long L = (long)i * G + c; if (L >= nwg) return false;
        int wgid = (int)L; { const int q = nwg / NXCD, r = nwg % NXCD, xcd = wgid % NXCD, off = wgid / NXCD; wgid = (xcd < r ? xcd * (q + 1) : r * (q + 1) + (xcd - r) * q) + off; }
        const int nig = WGM * nN, gid = wgid / nig, fm = gid * WGM, gsz = (nM - fm) < WGM ? (nM - fm) : WGM;
        u.pm = fm + ((wgid % nig) % gsz); u.pn = (wgid % nig) / gsz; return true;
    }
    __device__ __forceinline__ void a_ready(const Unit&) const {}
    __device__ __forceinline__ void done(const Unit&) const {}
};

__device__ __forceinline__ unsigned cvt_pk_bf16(float lo, float hi) { unsigned r; asm volatile("v_cvt_pk_bf16_f32 %0, %1, %2" : "=v"(r) : "v"(lo), "v"(hi)); return r; }
__device__ __forceinline__ float fsigmoid(float x) { return __builtin_amdgcn_rcpf(1.0f + __expf(-x)); }
__device__ __forceinline__ float fsilu(float x) { return x * fsigmoid(x); }
__device__ __forceinline__ u32x4 pack8(const f32x4 a, const f32x4 b) { u32x4 w; w.x = cvt_pk_bf16(a[0], a[1]); w.y = cvt_pk_bf16(a[2], a[3]); w.z = cvt_pk_bf16(b[0], b[1]); w.w = cvt_pk_bf16(b[2], b[3]); return w; }
__device__ __forceinline__ float bf_lo(unsigned u) { return __builtin_bit_cast(float, u << 16); }
__device__ __forceinline__ float bf_hi(unsigned u) { return __builtin_bit_cast(float, u & 0xffff0000u); }

struct EpiInProj {
    static constexpr bool PERM = true, AFTER_DRAIN = false;
    bf16_t *CQ, *KV, *KI, *RQ, *GATES; float *WI, *CQSS; const float* LB;
    __device__ __forceinline__ void operator()(const f32x4 (&acc)[2][2][4][2], const Unit& u, int wr, int wc, int fr, int fq) const {
        const int row0 = u.pm * BM + wr * 64 + fr, pn = u.pn, cl = wc * 32 + 8 * fq;
        if (pn == 0) {
#pragma unroll
            for (int ai = 0; ai < 2; ++ai)
#pragma unroll
                for (int m = 0; m < 4; ++m) { const int row = row0 + ai * HALF + m * 16; float s = 0.f;
#pragma unroll
                    for (int bj = 0; bj < 2; ++bj) { const f32x4 a = acc[ai][bj][m][0], b = acc[ai][bj][m][1];
                        s += (a[0] * a[0] + a[1] * a[1]) + (a[2] * a[2] + a[3] * a[3]) + (b[0] * b[0] + b[1] * b[1]) + (b[2] * b[2] + b[3] * b[3]);
                        *(u32x4*)(CQ + (size_t)row * 256 + cl + bj * HALF) = pack8(a, b); }
                    s += __shfl_xor(s, 16); s += __shfl_xor(s, 32);
                    if (fq == 0) CQSS[(size_t)row * 4 + wc] = s; }
        } else if (pn == 1) {
#pragma unroll
            for (int ai = 0; ai < 2; ++ai)
#pragma unroll
                for (int m = 0; m < 4; ++m) { const int row = row0 + ai * HALF + m * 16;
#pragma unroll
                    for (int bj = 0; bj < 2; ++bj) *(u32x4*)(KV + (size_t)row * 256 + cl + bj * HALF) = pack8(acc[ai][bj][m][0], acc[ai][bj][m][1]); }
        } else if (pn == 2) {
#pragma unroll
            for (int ai = 0; ai < 2; ++ai)
#pragma unroll
                for (int m = 0; m < 4; ++m) { const int row = row0 + ai * HALF + m * 16;
                    if (wc < 2) *(u32x4*)(KI + (size_t)row * 64 + cl) = pack8(acc[ai][0][m][0], acc[ai][0][m][1]);
                    else if (wc == 2 && fq == 0) { *(f32x4*)(WI + (size_t)row * 8) = acc[ai][0][m][0]; *(f32x4*)(WI + (size_t)row * 8 + 4) = acc[ai][0][m][1]; } }
        } else if (pn <= 10) {
            const int kind = (pn - 3) >> 1, cb = ((pn - 3) & 1) * 256 + cl;
            bf16_t* dst = RQ + (size_t)kind * (size_t)(32u << 20);
#pragma unroll
            for (int bj = 0; bj < 2; ++bj) {
                f32x4 l0 = (f32x4){0.f, 0.f, 0.f, 0.f}, l1 = l0;
                if (kind == 1) { l0 = *(const f32x4*)(LB + cb + bj * HALF); l1 = *(const f32x4*)(LB + cb + bj * HALF + 4); }
#pragma unroll
                for (int ai = 0; ai < 2; ++ai)
#pragma unroll
                    for (int m = 0; m < 4; ++m) { const int row = row0 + ai * HALF + m * 16; f32x4 a = acc[ai][bj][m][0], b = acc[ai][bj][m][1];
                        if (kind == 0 || kind == 3) {
#pragma unroll
                            for (int j = 0; j < 4; ++j) { a[j] = fsilu(a[j]); b[j] = fsilu(b[j]); } }
                        else if (kind == 1) {
#pragma unroll
                            for (int j = 0; j < 4; ++j) { a[j] = __logf(l0[j] + (1.0f - l0[j]) * fsigmoid(a[j])); b[j] = __logf(l1[j] + (1.0f - l1[j]) * fsigmoid(b[j])); } }
                        *(u32x4*)(dst + (size_t)row * 512 + cb + bj * HALF) = pack8(a, b); }
            }
        } else {
            const int cb = (pn - 11) * 256 + cl;
#pragma unroll
            for (int ai = 0; ai < 2; ++ai)
#pragma unroll
                for (int m = 0; m < 4; ++m) { const int row = row0 + ai * HALF + m * 16;
#pragma unroll
                    for (int bj = 0; bj < 2; ++bj) { f32x4 a = acc[ai][bj][m][0], b = acc[ai][bj][m][1];
#pragma unroll
                        for (int j = 0; j < 4; ++j) { a[j] = fsigmoid(a[j]); b[j] = fsigmoid(b[j]); }
                        *(u32x4*)(GATES + (size_t)row * 2048 + cb + bj * HALF) = pack8(a, b); } }
        }
    }
};

struct EpiQ {
    static constexpr bool PERM = true, AFTER_DRAIN = false;
    bf16_t *Q; const float* CQSS;
    __device__ __forceinline__ void operator()(const f32x4 (&acc)[2][2][4][2], const Unit& u, int wr, int wc, int fr, int fq) const {
        const int row0 = u.pm * BM + wr * 64 + fr, pn = u.pn, cl = (pn & 1) * 256 + wc * 32 + 8 * fq;
        bf16_t* dst = Q + (pn < 2 ? (size_t)0 : (size_t)(32u << 20));
        const float sc = pn < 2 ? 0.125f : 1.0f;
#pragma unroll
        for (int ai = 0; ai < 2; ++ai)
#pragma unroll
            for (int m = 0; m < 4; ++m) { const int row = row0 + ai * HALF + m * 16;
                const f32x4 ss = *(const f32x4*)(CQSS + (size_t)row * 4);
                const float r = __builtin_amdgcn_rsqf(((ss[0] + ss[1]) + (ss[2] + ss[3])) * (1.0f / 256.0f) + 1e-6f) * sc;
#pragma unroll
                for (int bj = 0; bj < 2; ++bj) *(u32x4*)(dst + (size_t)row * 512 + cl + bj * HALF) = pack8(acc[ai][bj][m][0] * r, acc[ai][bj][m][1] * r); }
    }
};

template <int MODE> struct EpiBranch {
    static constexpr bool PERM = true, AFTER_DRAIN = false;
    bf16_t* MIX; const bf16_t* GATES;
    __device__ __forceinline__ void operator()(const f32x4 (&acc)[2][2][4][2], const Unit& u, int wr, int wc, int fr, int fq) const {
        const int row0 = u.pm * BM + wr * 64 + fr, cl = u.pn * 256 + wc * 32 + 8 * fq;
#pragma unroll
        for (int ai = 0; ai < 2; ++ai)
#pragma unroll
            for (int m = 0; m < 4; ++m) { const int row = row0 + ai * HALF + m * 16;
#pragma unroll
                for (int bj = 0; bj < 2; ++bj) { const int c = cl + bj * HALF;
                    const u32x4 g = *(const u32x4*)(GATES + (size_t)row * 2048 + MODE * 1024 + c);
                    f32x4 a = acc[ai][bj][m][0], b = acc[ai][bj][m][1];
                    a[0] *= bf_lo(g.x); a[1] *= bf_hi(g.x); a[2] *= bf_lo(g.y); a[3] *= bf_hi(g.y); b[0] *= bf_lo(g.z); b[1] *= bf_hi(g.z); b[2] *= bf_lo(g.w); b[3] *= bf_hi(g.w);
                    if (MODE == 1) { const u32x4 p = *(const u32x4*)(MIX + (size_t)row * 1024 + c);
                        a[0] += bf_lo(p.x); a[1] += bf_hi(p.x); a[2] += bf_lo(p.y); a[3] += bf_hi(p.y); b[0] += bf_lo(p.z); b[1] += bf_hi(p.z); b[2] += bf_lo(p.w); b[3] += bf_hi(p.w); }
                    *(u32x4*)(MIX + (size_t)row * 1024 + c) = pack8(a, b); } }
    }
};

struct EpiOut {
    static constexpr bool PERM = true, AFTER_DRAIN = false;
    const float* X; float* X1; bf16_t* XS; float* X1SS; const float* MOD; const float* CW2;
    __device__ __forceinline__ void operator()(const f32x4 (&acc)[2][2][4][2], const Unit& u, int wr, int wc, int fr, int fq) const {
        const int row0 = u.pm * BM + wr * 64 + fr, cl = u.pn * 256 + wc * 32 + 8 * fq, b = u.pm >> 5;
#pragma unroll
        for (int ai = 0; ai < 2; ++ai)
#pragma unroll
            for (int m = 0; m < 4; ++m) { const int row = row0 + ai * HALF + m * 16; float s = 0.f;
#pragma unroll
                for (int bj = 0; bj < 2; ++bj) { const int c = cl + bj * HALF;
                    const float* xp = X + (size_t)row * 1024 + c; const float* gp = MOD + b * 6144 + 2048 + c; const float* cp = CW2 + b * 1024 + c;
                    const f32x4 v0 = *(const f32x4*)(xp) + *(const f32x4*)(gp) * acc[ai][bj][m][0], v1 = *(const f32x4*)(xp + 4) + *(const f32x4*)(gp + 4) * acc[ai][bj][m][1];
                    *(f32x4*)(X1 + (size_t)row * 1024 + c) = v0; *(f32x4*)(X1 + (size_t)row * 1024 + c + 4) = v1;
                    s += (v0[0] * v0[0] + v0[1] * v0[1]) + (v0[2] * v0[2] + v0[3] * v0[3]) + (v1[0] * v1[0] + v1[1] * v1[1]) + (v1[2] * v1[2] + v1[3] * v1[3]);
                    *(u32x4*)(XS + (size_t)row * 1024 + c) = pack8(v0 * *(const f32x4*)(cp), v1 * *(const f32x4*)(cp + 4)); }
                s += __shfl_xor(s, 16); s += __shfl_xor(s, 32);
                if (fq == 0) X1SS[(size_t)row * 16 + u.pn * 4 + wc] = s; }
    }
};

struct EpiGateUp {
    static constexpr bool PERM = true, AFTER_DRAIN = false;
    bf16_t* HID; const float* X1SS; const float* BGU;
    const PG8_LAS float* BL; int bl;
    const PG8_LAS float* R2L; int g0, pm7;
    __device__ __forceinline__ void operator()(const f32x4 (&acc)[2][2][4][2], const Unit& u, int wr, int wc, int fr, int fq) const {
        const int row0 = u.pm * BM + wr * 64 + fr, cl = wc * 32 + 8 * fq, b = u.pm >> 5;
        const int slot = (u.pm >> 3) - g0; const bool cached = slot >= 0 && slot < 4 && (u.pm & 7) == pm7;
        f32x4 bg0, bg1, bu0, bu1;
        if (b == bl) { const PG8_LAS float* bp = BL + u.pn * 256 + cl; bg0 = *(const PG8_LAS f32x4*)(bp); bg1 = *(const PG8_LAS f32x4*)(bp + 4); bu0 = *(const PG8_LAS f32x4*)(bp + 128); bu1 = *(const PG8_LAS f32x4*)(bp + 132); }
        else { const float* bp = BGU + b * 5632 + u.pn * 256 + cl; bg0 = *(const f32x4*)(bp); bg1 = *(const f32x4*)(bp + 4); bu0 = *(const f32x4*)(bp + 128); bu1 = *(const f32x4*)(bp + 132); }
#pragma unroll
        for (int ai = 0; ai < 2; ++ai)
#pragma unroll
            for (int m = 0; m < 4; ++m) { const int row = row0 + ai * HALF + m * 16;
                float r = R2L[(cached ? slot : 0) * 256 + wr * 64 + fr + ai * HALF + m * 16];
                if (!cached) { float s = 0.f;
#pragma unroll
                    for (int q = 0; q < 4; ++q) { const f32x4 t = *(const f32x4*)(X1SS + (size_t)row * 16 + 4 * q); s += (t[0] + t[1]) + (t[2] + t[3]); }
                    r = __builtin_amdgcn_rsqf(s * (1.0f / 1024.0f) + 1e-6f); }
                f32x4 g0v = acc[ai][0][m][0] * r + bg0, g1v = acc[ai][0][m][1] * r + bg1; const f32x4 u0 = acc[ai][1][m][0] * r + bu0, u1 = acc[ai][1][m][1] * r + bu1;
#pragma unroll
                for (int j = 0; j < 4; ++j) { g0v[j] = fsilu(g0v[j]) * u0[j]; g1v[j] = fsilu(g1v[j]) * u1[j]; }
                *(u32x4*)(HID + (size_t)row * 2816 + u.pn * 128 + cl) = pack8(g0v, g1v); }
    }
};

struct EpiDown {
    static constexpr bool PERM = true, AFTER_DRAIN = false;
    const float* X1; float* OUT; float* X2SS; const float* MOD;
    __device__ __forceinline__ void operator()(const f32x4 (&acc)[2][2][4][2], const Unit& u, int wr, int wc, int fr, int fq) const {
        const int row0 = u.pm * BM + wr * 64 + fr, cl = u.pn * 256 + wc * 32 + 8 * fq, b = u.pm >> 5;
#pragma unroll
        for (int ai = 0; ai < 2; ++ai)
#pragma unroll
            for (int m = 0; m < 4; ++m) { const int row = row0 + ai * HALF + m * 16; float s = 0.f;
#pragma unroll
                for (int bj = 0; bj < 2; ++bj)
#pragma unroll
                    for (int n = 0; n < 2; ++n) { const int c = cl + bj * HALF + 4 * n;
                        const f32x4 v = *(const f32x4*)(X1 + (size_t)row * 1024 + c) + *(const f32x4*)(MOD + b * 6144 + 5120 + c) * acc[ai][bj][m][n];
                        *(f32x4*)(OUT + (size_t)row * 1024 + c) = v; s += (v[0] * v[0] + v[1] * v[1]) + (v[2] * v[2] + v[3] * v[3]); }
                s += __shfl_xor(s, 16); s += __shfl_xor(s, 32);
                if (fq == 0) X2SS[(size_t)row * 16 + u.pn * 4 + wc] = s; }
    }
};


template <class Epi, class Sched, bool ALIGN_EPI = false, bool SP2 = false>
__device__ __forceinline__ void gemm_phase(PG8_LAS unsigned char* lds, const Gemm g, const Sched& S, const Epi& E) {
    const int tid = threadIdx.x, wid = __builtin_amdgcn_readfirstlane(tid >> 6), lane = tid & 63, wr = wid >> 2, wc = wid & 3, fr = lane & 15, fq = lane >> 4;
    const int K = g.K, nt = K / BK;
    unsigned voffA[2], voffB[2];
#pragma unroll
    for (int i = 0; i < 2; ++i) { int R, C; stage_rc(tid * 16 + i * 8192, R, C); const int Rb = Epi::PERM ? ((R & ~31) + perm32(R & 31)) : R;
        voffA[i] = (unsigned)(R * K + C) * 2u; voffB[i] = (unsigned)(Rb * K + C) * 2u; }
    const size_t kstep = (size_t)(BK * 2);
    const size_t hstep = (size_t)HALF * K * 2;
    const size_t tstep = 2 * hstep;
    const unsigned ldsw = (unsigned)wid * 1024u;
    const int aoff = lds_byte(wr * 64 + fr, fq * 8), boff = lds_byte(wc * 32 + fr, fq * 8);
#define PG8_SA(b, h) (((b) * 2 + (h)) * HTB)
#define PG8_SB(b, h) ((4 + (b) * 2 + (h)) * HTB)
#define PG8_STAGE(bufoff, gbase, voff) do { _Pragma("unroll") for (int _i = 0; _i < 2; ++_i) \
        __builtin_amdgcn_global_load_lds((const unsigned*)((const char*)(gbase) + (voff)[_i]), (PG8_LAS unsigned*)(lds + (bufoff) + ldsw + _i * 8192), 16, 0, 0); } while (0)
#define PG8_LDA(dst, b, h) do { _Pragma("unroll") for (int m = 0; m < 4; ++m) _Pragma("unroll") for (int k = 0; k < 2; ++k) dst[m][k] = *(const PG8_LAS bf16x8*)(lds + PG8_SA(b, h) + aoff + m * 2048 + k * 1024); } while (0)
#define PG8_LDB(dst, b, h) do { _Pragma("unroll") for (int n = 0; n < 2; ++n) _Pragma("unroll") for (int k = 0; k < 2; ++k) dst[n][k] = *(const PG8_LAS bf16x8*)(lds + PG8_SB(b, h) + boff + n * 2048 + k * 1024); } while (0)
#define PG8_MMA(ai, bj, At, Bt) do { __builtin_amdgcn_s_setprio(1); _Pragma("unroll") for (int m = 0; m < 4; ++m) _Pragma("unroll") for (int n = 0; n < 2; ++n) _Pragma("unroll") for (int k = 0; k < 2; ++k) \
        acc[ai][bj][m][n] = __builtin_amdgcn_mfma_f32_16x16x32_bf16(Bt[n][k], At[m][k], acc[ai][bj][m][n], 0, 0, 0); __builtin_amdgcn_s_setprio(0); } while (0)
#define PG8_WAIT_V(n) asm volatile("s_waitcnt vmcnt(" #n ")" ::: "memory")
#define PG8_WAIT_L(n) asm volatile("s_waitcnt lgkmcnt(" #n ")" ::: "memory")
#define PG8_BAR __builtin_amdgcn_s_barrier()
#define PG8_SCHED __builtin_amdgcn_sched_barrier(0)
    Unit cur, nxt; int ui = 0;
    if (!S.next(0, cur)) return;
    f32x4 acc[2][2][4][2];
#pragma unroll
    for (int a = 0; a < 2; ++a)
#pragma unroll
        for (int b = 0; b < 2; ++b)
#pragma unroll
            for (int m = 0; m < 4; ++m)
#pragma unroll
                for (int n = 0; n < 2; ++n) acc[a][b][m][n] = (f32x4){0.f, 0.f, 0.f, 0.f};
    bf16x8 At[4][2], B0[2][2], B1[2][2];
    const char* cA = (const char*)g.A + (size_t)cur.pm * tstep; const char* cB = (const char*)g.Bt + (size_t)cur.pn * tstep;
    S.a_ready(cur);
    if constexpr (SP2) {
        PG8_STAGE(PG8_SB(0, 0), cB, voffB); PG8_STAGE(PG8_SB(0, 1), cB + hstep, voffB); PG8_STAGE(PG8_SA(0, 0), cA, voffA); PG8_STAGE(PG8_SA(0, 1), cA + hstep, voffA);
        if (wr == 1) PG8_BAR;
        PG8_WAIT_V(2); PG8_BAR;
        PG8_STAGE(PG8_SB(1, 0), cB + kstep, voffB); PG8_STAGE(PG8_SA(1, 0), cA + kstep, voffA); PG8_STAGE(PG8_SB(1, 1), cB + hstep + kstep, voffB);
        PG8_WAIT_V(6); PG8_BAR;
    } else {
        PG8_STAGE(PG8_SB(0, 0), cB, voffB); PG8_STAGE(PG8_SA(0, 0), cA, voffA); PG8_STAGE(PG8_SB(0, 1), cB + hstep, voffB); PG8_STAGE(PG8_SA(0, 1), cA + hstep, voffA);
        if (wr == 1) PG8_BAR;
        PG8_WAIT_V(4); PG8_BAR;
        PG8_STAGE(PG8_SB(1, 0), cB + kstep, voffB); PG8_STAGE(PG8_SA(1, 0), cA + kstep, voffA); PG8_STAGE(PG8_SB(1, 1), cB + hstep + kstep, voffB);
        PG8_WAIT_V(6); PG8_BAR;
    }
    for (;;) {
        const bool has_next = S.next(ui + 1, nxt);
        const char* nA = has_next ? (const char*)g.A + (size_t)nxt.pm * tstep : cA; const char* nB = has_next ? (const char*)g.Bt + (size_t)nxt.pn * tstep : cB;
        for (int t = 0; t < nt; t += 2) {
            const bool last = (t == nt - 2);
            const char* a1 = cA + (size_t)(t + 1) * kstep;
            const char* a2 = last ? nA : cA + (size_t)(t + 2) * kstep; const char* b2 = last ? nB : cB + (size_t)(t + 2) * kstep;
            const char* a3 = a2 + kstep; const char* b3 = b2 + kstep;
            if (last && has_next) S.a_ready(nxt);
            if constexpr (SP2) {
            PG8_LDB(B0, 0, 0); PG8_LDB(B1, 0, 1); PG8_SCHED; PG8_LDA(At, 0, 0); PG8_STAGE(PG8_SA(1, 1), a1 + hstep, voffA);
            PG8_WAIT_V(8); PG8_WAIT_L(0); PG8_BAR; PG8_MMA(0, 0, At, B0); PG8_MMA(0, 1, At, B1); PG8_BAR; PG8_SCHED;
            PG8_LDA(At, 0, 1); PG8_STAGE(PG8_SB(0, 0), b2, voffB); PG8_STAGE(PG8_SB(0, 1), b2 + hstep, voffB); PG8_STAGE(PG8_SA(0, 0), a2, voffA);
            PG8_WAIT_V(8); PG8_WAIT_L(0); PG8_BAR; PG8_MMA(1, 0, At, B0); PG8_MMA(1, 1, At, B1); PG8_BAR; PG8_SCHED;
            PG8_LDB(B0, 1, 0); PG8_LDB(B1, 1, 1); PG8_SCHED; PG8_LDA(At, 1, 0); PG8_STAGE(PG8_SA(0, 1), a2 + hstep, voffA);
            PG8_WAIT_V(8); PG8_WAIT_L(0); PG8_BAR; PG8_MMA(0, 0, At, B0); PG8_MMA(0, 1, At, B1); PG8_BAR; PG8_SCHED;
            PG8_LDA(At, 1, 1); PG8_STAGE(PG8_SB(1, 0), b3, voffB); PG8_STAGE(PG8_SB(1, 1), b3 + hstep, voffB); PG8_STAGE(PG8_SA(1, 0), a3, voffA);
            PG8_WAIT_V(8); PG8_WAIT_L(0); PG8_BAR; PG8_MMA(1, 0, At, B0); PG8_MMA(1, 1, At, B1); PG8_BAR; PG8_SCHED;
            } else {
            PG8_LDB(B0, 0, 0); PG8_SCHED; PG8_LDA(At, 0, 0); PG8_STAGE(PG8_SA(1, 1), a1 + hstep, voffA);
            PG8_WAIT_L(8); PG8_BAR; PG8_WAIT_L(0); PG8_MMA(0, 0, At, B0); PG8_BAR; PG8_SCHED;
            PG8_LDB(B1, 0, 1); PG8_STAGE(PG8_SB(0, 0), b2, voffB);
            PG8_BAR; PG8_WAIT_L(0); PG8_MMA(0, 1, At, B1); PG8_BAR;
            PG8_LDA(At, 0, 1); PG8_STAGE(PG8_SA(0, 0), a2, voffA);
            PG8_BAR; PG8_WAIT_L(0); PG8_MMA(1, 0, At, B0); PG8_BAR; PG8_SCHED;
            PG8_STAGE(PG8_SB(0, 1), b2 + hstep, voffB);
            PG8_WAIT_V(6); PG8_BAR; PG8_MMA(1, 1, At, B1); PG8_BAR;
            PG8_LDB(B0, 1, 0); PG8_SCHED; PG8_LDA(At, 1, 0); PG8_STAGE(PG8_SA(0, 1), a2 + hstep, voffA);
            PG8_WAIT_L(8); PG8_BAR; PG8_WAIT_L(0); PG8_MMA(0, 0, At, B0); PG8_BAR; PG8_SCHED;
            PG8_LDB(B1, 1, 1); PG8_STAGE(PG8_SB(1, 0), b3, voffB);
            PG8_BAR; PG8_WAIT_L(0); PG8_MMA(0, 1, At, B1); PG8_BAR;
            PG8_LDA(At, 1, 1); PG8_STAGE(PG8_SA(1, 0), a3, voffA);
            PG8_BAR; PG8_WAIT_L(0); PG8_MMA(1, 0, At, B0); PG8_BAR; PG8_SCHED;
            PG8_STAGE(PG8_SB(1, 1), b3 + hstep, voffB);
            PG8_WAIT_V(6); PG8_BAR; PG8_MMA(1, 1, At, B1); PG8_BAR;
            }
        }
        if constexpr (ALIGN_EPI) { if (wr == 0) PG8_BAR; }
        if constexpr (!Epi::AFTER_DRAIN) { E(acc, cur, wr, wc, fr, fq); S.done(cur); }
        if (!has_next) break;
#pragma unroll
        for (int a = 0; a < 2; ++a)
#pragma unroll
            for (int b = 0; b < 2; ++b)
#pragma unroll
                for (int m = 0; m < 4; ++m)
#pragma unroll
                    for (int n = 0; n < 2; ++n) acc[a][b][m][n] = (f32x4){0.f, 0.f, 0.f, 0.f};
        cur = nxt; cA = nA; cB = nB; ++ui;
        if constexpr (ALIGN_EPI) { if (wr == 1) PG8_BAR; }
    }
    PG8_WAIT_V(0);
    if constexpr (!ALIGN_EPI) { if (wr == 0) PG8_BAR; }
    PG8_BAR;
    if constexpr (Epi::AFTER_DRAIN) { E.fused(acc, cur, wr, wc, fr, fq, lds, wid, lane); S.done(cur); }
#undef PG8_SA
#undef PG8_SB
#undef PG8_STAGE
#undef PG8_LDA
#undef PG8_LDB
#undef PG8_MMA
#undef PG8_WAIT_V
#undef PG8_WAIT_L
#undef PG8_BAR
#undef PG8_SCHED
}
}
#ifndef PG8_SP2
#define PG8_SP2 true
#endif
#ifndef PG8_ALIGN
#define PG8_ALIGN true
#endif

constexpr int NWAVES = 8;
#ifndef MK_N_LAUNCHES
#define MK_N_LAUNCHES 1
#endif
constexpr int N_PHASES = 11;
constexpr int N_LAUNCHES = MK_N_LAUNCHES;
static_assert(N_LAUNCHES == 1 || N_LAUNCHES == N_PHASES, "MK_N_LAUNCHES is 1 or N_PHASES");

constexpr int NB = 8, SEQ = 8192, D = 1024, M = NB * SEQ;
constexpr int NPROJ = 4680, NPROJ_PAD = 4864, FF = 2816, NGU = 2 * FF;
constexpr float EPS = 1e-6f;

constexpr size_t MiB = 1u << 20;
constexpr size_t WS_CTL = 0, CTL_ZERO_BYTES = 1 * MiB;
constexpr size_t WS_MOD = 1 * MiB;
constexpr size_t WS_LB = WS_MOD + 256 * 1024;
constexpr size_t WS_CW2 = WS_MOD + 320 * 1024;
constexpr size_t WS_BGU = WS_MOD + 512 * 1024;
constexpr size_t WS_WIN = 3 * MiB, WS_WQ = 13 * MiB, WS_WBA = 14 * MiB, WS_WBR = 15 * MiB, WS_WOUT = 16 * MiB, WS_WGU = 18 * MiB, WS_WD = 29 * MiB;
constexpr size_t WS_CQSS = 35 * MiB, WS_X1SS = 36 * MiB, WS_X2SS = 40 * MiB;
constexpr size_t WS_XN = 64 * MiB;
constexpr size_t WS_CQ = 192 * MiB, WS_KV = 224 * MiB, WS_KI = 256 * MiB, WS_WI = 264 * MiB;
constexpr size_t WS_RQ = 272 * MiB, WS_RGL = 336 * MiB, WS_RI = 400 * MiB, WS_RGS = 464 * MiB;
constexpr size_t WS_Q = 528 * MiB, WS_QI = 592 * MiB;
constexpr size_t WS_ATT = 64 * MiB, WS_REC = 128 * MiB;
constexpr size_t WS_SCR = 656 * MiB;
constexpr size_t WS_OLOC = 784 * MiB, WS_QHAT = 848 * MiB, WS_U = 912 * MiB, WS_DS = 928 * MiB;
constexpr size_t WS_MIX = 896 * MiB;
constexpr size_t WS_X1 = 64 * MiB, WS_XS = 320 * MiB, WS_HID = 448 * MiB;
constexpr size_t WS_END = 1024 * MiB;
static_assert(WS_RGL == WS_RQ + 64 * MiB && WS_RI == WS_RQ + 128 * MiB && WS_RGS == WS_RQ + 192 * MiB && WS_QI == WS_Q + 64 * MiB, "epilogue pointer arithmetic");
static_assert(WS_HID + (size_t)M * FF * 2 <= WS_END && WS_DS + 256 * 128 * 4 <= WS_END, "map");

constexpr int CW_TMO = 0, CW_CODE = 1;
constexpr int CW_BAR = 4096;

constexpr int RING_OFF = 0, RING_BYTES = 131072;
constexpr int LDS_BYTES = 163840;
constexpr int LDSCTL_OFF = LDS_BYTES - 1024, MISC_OFF = LDSCTL_OFF + 320;
static_assert(MISC_OFF + 128 <= LDS_BYTES, "LDS map");

#define GAS __attribute__((address_space(1)))
#define LAS __attribute__((address_space(3)))
typedef unsigned short bf16;
typedef unsigned v4u __attribute__((ext_vector_type(4)));
typedef unsigned v2u __attribute__((ext_vector_type(2)));
typedef float f32x4 __attribute__((ext_vector_type(4)));
typedef float f32x16 __attribute__((ext_vector_type(16)));
typedef short bf16x8 __attribute__((ext_vector_type(8)));
typedef GAS unsigned gu32;
#define RLX_AGENT __ATOMIC_RELAXED, __HIP_MEMORY_SCOPE_AGENT
#define LDS_WAIT() asm volatile("s_waitcnt lgkmcnt(0)" ::: "memory")
#define VM_WAIT() asm volatile("s_waitcnt vmcnt(0)" ::: "memory")
__device__ __forceinline__ unsigned f2bf(float f) { unsigned u = __builtin_bit_cast(unsigned, f); return (u + 0x7fffu + ((u >> 16) & 1u)) >> 16; }
__device__ __forceinline__ unsigned pk2(float lo, float hi) { return f2bf(lo) | (f2bf(hi) << 16); }
__device__ __forceinline__ float bflo(unsigned u) { return __builtin_bit_cast(float, u << 16); }
__device__ __forceinline__ float bfhi(unsigned u) { return __builtin_bit_cast(float, u & 0xffff0000u); }
__device__ __forceinline__ float bf1(bf16 h) { return __builtin_bit_cast(float, (unsigned)h << 16); }

#define XB_TMO      128
#define XB_XCNT(j)  (256  + 64 * (j))
#define XB_XSUB(j)  (1280 + 64 * (j))
#define XB_XGEN(j)  (2304 + 64 * (j))
#define XB_TOP      3328
#define XB_TOPGEN   3392
#define XCD_BAR_WORDS 3456
#define XB_SPIN_CAP (1u << 23)

__device__ __forceinline__ unsigned xb_ld(unsigned* p)              { return __hip_atomic_load(p, __ATOMIC_RELAXED, __HIP_MEMORY_SCOPE_AGENT); }
__device__ __forceinline__ unsigned xb_add(unsigned* p, unsigned v) { return __hip_atomic_fetch_add(p, v, __ATOMIC_RELAXED, __HIP_MEMORY_SCOPE_AGENT); }
__device__ __forceinline__ unsigned xb_xcc_id() { return (unsigned)__builtin_amdgcn_s_getreg((3 << 11) | 20) & 0xFu; }
#define XB_SPIN(cond, bar) do { unsigned _sp = 0; while (cond) { __builtin_amdgcn_s_sleep(1); \
    if ((++_sp & 255u) == 0u) { if (xb_ld(&(bar)[XB_TMO])) break; if (_sp > XB_SPIN_CAP) { atomicAdd(&(bar)[XB_TMO], 1u); break; } } } } while (0)

struct XcdBarrier { unsigned* bar; unsigned x; volatile LAS unsigned* st; };

__device__ __forceinline__ XcdBarrier xcd_barrier_post(unsigned* bar, volatile LAS unsigned* st) {
    XcdBarrier b; b.bar = bar; b.x = xb_xcc_id(); b.st = st;
    if (threadIdx.x == 0) (void)xb_add(&bar[XB_XCNT(b.x)], 1u);
    return b;
}
__device__ __forceinline__ void xcd_barrier_complete(unsigned* bar, unsigned x, unsigned& nloc, unsigned& nx) {
    const unsigned G = gridDim.x * gridDim.y * gridDim.z;
    unsigned sum, cnt, mine, sp = 0u;
    for (;;) {
        sum = 0u; cnt = 0u; mine = 0u;
#pragma unroll
        for (unsigned j = 0; j < 16; ++j) { const unsigned c = xb_ld(&bar[XB_XCNT(j)]); sum += c; cnt += (c > 0u) ? 1u : 0u; mine = (j == x) ? c : mine; }
        if (sum == G) break;
        __builtin_amdgcn_s_sleep(1);
        if ((++sp & 255u) == 0u) { if (xb_ld(&bar[XB_TMO])) break; if (sp > XB_SPIN_CAP) { atomicAdd(&bar[XB_TMO], 1u); break; } }
    }
    nloc = mine > 0u ? mine : 1u; nx = cnt > 0u ? cnt : 1u;
}
__device__ __forceinline__ void xcd_barrier(const XcdBarrier& b) {
    asm volatile("s_waitcnt vmcnt(0)" ::: "memory");
    __syncthreads();
    if (threadIdx.x == 0) {
        unsigned* bar = b.bar;
        __builtin_amdgcn_s_waitcnt(0);
        unsigned nloc = b.st[0], nx = b.st[1];
        if (nloc == 0u) { xcd_barrier_complete(bar, b.x, nloc, nx); b.st[0] = nloc; b.st[1] = nx; }
        const unsigned old = xb_add(&bar[XB_XSUB(b.x)], 1u);
        const unsigned gen = old / nloc;
        if (old + 1u == (gen + 1u) * nloc) {
            __builtin_amdgcn_fence(__ATOMIC_RELEASE, "agent");
            asm volatile("s_waitcnt vmcnt(0)" ::: "memory");
            const unsigned og = xb_add(&bar[XB_TOP], 1u);
            const unsigned tg = og / nx;
            if (og + 1u == (tg + 1u) * nx) xb_add(&bar[XB_TOPGEN], 1u);
            else XB_SPIN(xb_ld(&bar[XB_TOPGEN]) == tg, bar);
            __builtin_amdgcn_fence(__ATOMIC_ACQUIRE, "agent");
            xb_add(&bar[XB_XGEN(b.x)], 1u);
            asm volatile("s_waitcnt vmcnt(0)" ::: "memory");
        } else {
            XB_SPIN(xb_ld(&bar[XB_XGEN(b.x)]) == gen, bar);
            __builtin_amdgcn_fence(__ATOMIC_ACQUIRE, "agent");
            asm volatile("s_waitcnt vmcnt(0)" ::: "memory");
        }
    }
    __syncthreads();
}

struct Frame {
    LAS unsigned char* lds;
    volatile LAS unsigned* MISC;
    gu32* ctl;
    unsigned char* ws;
    int tid, lane, wave;
    int G;
    float* out;
};
__device__ __forceinline__ float wave_sum(float v) {
#pragma unroll
    for (int o = 1; o < 64; o <<= 1) v += __shfl_xor(v, o);
    return v;
}
__device__ __forceinline__ float wave_max(float v) {
#pragma unroll
    for (int o = 1; o < 64; o <<= 1) v = fmaxf(v, __shfl_xor(v, o));
    return v;
}

template <class SrcCol>
__device__ __forceinline__ void transpose_item(const float* W, int ldw, int K, bf16* WT, const float* ks, LAS float* scr, int item, int nblk, int lane, SrcCol src) {
    const int kb = item / nblk, nb = item % nblk, k0 = 64 * kb, n0 = 32 * nb;
    const float* Wp; const int sc = src(n0 + (lane & 31), Wp);
#pragma unroll 8
    for (int i = 0; i < 32; ++i) { const int kk = 2 * i + (lane >> 5); float v = 0.f; if (sc >= 0) { v = Wp[(size_t)(k0 + kk) * ldw + sc]; if (ks) v *= ks[k0 + kk]; } scr[kk * 33 + (lane & 31)] = v; }
    LDS_WAIT(); asm volatile("" ::: "memory");
    const int c = lane & 7;
#pragma unroll
    for (int j = 0; j < 4; ++j) { const int n = (lane >> 3) + 8 * j; const LAS float* s = scr + (8 * c) * 33 + n;
        v4u o; o.x = pk2(s[0 * 33], s[1 * 33]); o.y = pk2(s[2 * 33], s[3 * 33]); o.z = pk2(s[4 * 33], s[5 * 33]); o.w = pk2(s[6 * 33], s[7 * 33]);
        *(GAS v4u*)(WT + (size_t)(n0 + n) * K + k0 + 8 * c) = o; }
    LDS_WAIT(); asm volatile("" ::: "memory");
}
struct Args { const float* in[20]; float* out; unsigned char* ws; int ph_lo, ph_hi; };
template <class SrcCol>
__device__ __forceinline__ void gemv8(Frame& F, const LAS float* vec, int cpg, int ngrp, int ldw, SrcCol src, const float* bias, float* out, int ldo) {
    LAS float* red = (LAS float*)(F.lds + 32768);
    for (int jb = blockIdx.x; jb < ngrp; jb += F.G) {
        const int col = F.tid & 31, kg = F.tid >> 5; float a[8];
#pragma unroll
        for (int b = 0; b < 8; ++b) a[b] = 0.f;
        const float* Wp = nullptr; int sc = -1;
        if (col < cpg) sc = src(jb * cpg + col, Wp);
        if (sc >= 0) for (int k = kg * 64; k < kg * 64 + 64; ++k) { const float w = Wp[(size_t)k * ldw + sc];
#pragma unroll
            for (int b = 0; b < 8; ++b) a[b] += vec[b * 1024 + k] * w; }
#pragma unroll
        for (int b = 0; b < 8; ++b) red[(kg * 8 + b) * 32 + col] = a[b];
        __syncthreads();
        if (F.tid < 256) { const int b = F.tid >> 5, c2 = F.tid & 31;
            if (c2 < cpg) { float s = 0.f; for (int k2 = 0; k2 < 16; ++k2) s += red[(k2 * 8 + b) * 32 + c2]; const int jj = jb * cpg + c2; out[b * ldo + jj] = s + (bias ? bias[jj] : 0.f); } }
        __syncthreads();
    }
}
struct SrcWin { const float* W; __device__ __forceinline__ int operator()(int d, const float*& Wp) const { Wp = W; return d < 584 ? d : (d < 768 ? -1 : d - 184); } };
__device__ __forceinline__ const float* psel(const float* a, const float* b, bool takeb) { const unsigned long long x = (unsigned long long)a, y = (unsigned long long)b, m = takeb ? ~0ull : 0ull; return (const float*)(x ^ ((x ^ y) & m)); }
struct SrcWq { const float *Wa, *Wb; __device__ __forceinline__ int operator()(int d, const float*& Wp) const { Wp = psel(Wa, Wb, d >= 512); return d & 511; } };
struct SrcId { const float* W; __device__ __forceinline__ int operator()(int d, const float*& Wp) const { Wp = W; return d; } };
struct SrcGu { const float *Wg, *Wu; __device__ __forceinline__ int operator()(int d, const float*& Wp) const { const int t = d >> 8, w = d & 255; Wp = psel(Wg, Wu, w >= 128); return t * 128 + (w & 127); } };

__device__ __forceinline__ void p0_prologue(Frame& F, const Args& A) {
    LAS float* cact = (LAS float*)(F.lds);
    for (int i = F.tid; i < 8192; i += NWAVES * 64) { const float v = A.in[1][i]; cact[i] = v / (1.0f + __expf(-v)); }
    __syncthreads();
    gemv8(F, cact, 24, 256, 6144, SrcId{A.in[2]}, A.in[3], (float*)(F.ws + WS_MOD), 6144);
    if (blockIdx.x == 0) { const float* l = A.in[10]; float* LB = (float*)(F.ws + WS_LB);
        for (int c = F.tid; c < 512; c += NWAVES * 64) LB[c] = 1.0f / (1.0f + __expf(l[512 + c] - l[c])); }
    __syncthreads();
    LAS float* scr = (LAS float*)(F.lds + 49152 + F.wave * 8448);
    const int gw = blockIdx.x * NWAVES + F.wave, NGW = F.G * NWAVES;
    constexpr int I_IN = 16 * 152, I_Q = 4 * 32, I_BA = 8 * 32, I_BR = 8 * 32, I_O = 16 * 32, I_GU = 16 * 176, I_D = 44 * 32;
    constexpr int NITEMS = I_IN + I_Q + I_BA + I_BR + I_O + I_GU + I_D;
    for (int it = gw; it < NITEMS; it += NGW) {
        int r = it;
        if (r < I_IN) { transpose_item(A.in[5], NPROJ, 1024, (bf16*)(F.ws + WS_WIN), nullptr, scr, r, 152, F.lane, SrcWin{A.in[5]}); continue; } r -= I_IN;
        if (r < I_Q) { transpose_item(nullptr, 512, 256, (bf16*)(F.ws + WS_WQ), A.in[6], scr, r, 32, F.lane, SrcWq{A.in[7], A.in[8]}); continue; } r -= I_Q;
        if (r < I_BA) { transpose_item(nullptr, 1024, 512, (bf16*)(F.ws + WS_WBA), nullptr, scr, r, 32, F.lane, SrcId{A.in[12]}); continue; } r -= I_BA;
        if (r < I_BR) { transpose_item(nullptr, 1024, 512, (bf16*)(F.ws + WS_WBR), nullptr, scr, r, 32, F.lane, SrcId{A.in[13]}); continue; } r -= I_BR;
        if (r < I_O) { transpose_item(nullptr, 1024, 1024, (bf16*)(F.ws + WS_WOUT), nullptr, scr, r, 32, F.lane, SrcId{A.in[14]}); continue; } r -= I_O;
        if (r < I_GU) { transpose_item(nullptr, FF, 1024, (bf16*)(F.ws + WS_WGU), nullptr, scr, r, 176, F.lane, SrcGu{A.in[16], A.in[17]}); continue; } r -= I_GU;
        transpose_item(nullptr, 1024, FF, (bf16*)(F.ws + WS_WD), nullptr, scr, r, 32, F.lane, SrcId{A.in[18]});
    }
}

__device__ __forceinline__ void p1_norm(Frame& F, const Args& A) {
    const float* MOD = (const float*)(F.ws + WS_MOD);
    { float* CW2 = (float*)(F.ws + WS_CW2); const int g = blockIdx.x * (NWAVES * 64) + F.tid;
      if (g < 8192) { const int b = g >> 10, c = g & 1023; CW2[g] = A.in[15][c] * (1.0f + MOD[b * 6144 + 4096 + c]); } }
    { LAS float* sh2 = (LAS float*)(F.lds);
      for (int i = F.tid; i < 8192; i += NWAVES * 64) sh2[i] = MOD[(i >> 10) * 6144 + 3072 + (i & 1023)];
      __syncthreads();
      gemv8(F, sh2, 22, 256, FF, SrcGu{A.in[16], A.in[17]}, nullptr, (float*)(F.ws + WS_BGU), NGU); }
    const int gw = blockIdx.x * NWAVES + F.wave, NGW = F.G * NWAVES; bf16* XN = (bf16*)(F.ws + WS_XN);
    for (int m0 = gw; m0 < M; m0 += 4 * NGW) {
        f32x4 v[4][4]; float r[4];
#pragma unroll
        for (int k = 0; k < 4; ++k) { const int m = m0 + k * NGW < M ? m0 + k * NGW : m0; const GAS f32x4* xr = (const GAS f32x4*)(A.in[0] + (size_t)m * D) + F.lane;
#pragma unroll
            for (int j = 0; j < 4; ++j) v[k][j] = xr[64 * j]; }
#pragma unroll
        for (int k = 0; k < 4; ++k) { float s = 0.f;
#pragma unroll
            for (int j = 0; j < 4; ++j) s += (v[k][j].x * v[k][j].x + v[k][j].y * v[k][j].y) + (v[k][j].z * v[k][j].z + v[k][j].w * v[k][j].w);
            r[k] = 1.0f / sqrtf(wave_sum(s) * (1.0f / D) + EPS); }
#pragma unroll
        for (int k = 0; k < 4; ++k) { const int m = m0 + k * NGW; if (m < M) { const int b = m >> 13;
            GAS unsigned long long* o8 = (GAS unsigned long long*)(XN + (size_t)m * D) + F.lane;
#pragma unroll
            for (int j = 0; j < 4; ++j) { const int c = 4 * F.lane + 256 * j;
                const f32x4 w = *(const f32x4*)(A.in[4] + c), sc = *(const f32x4*)(MOD + b * 6144 + 1024 + c), sh = *(const f32x4*)(MOD + b * 6144 + c);
                const f32x4 y = v[k][j] * r[k] * w * (sc + 1.0f) + sh;
                o8[64 * j] = (unsigned long long)pk2(y.x, y.y) | ((unsigned long long)pk2(y.z, y.w) << 32); } } }
    }
}

constexpr int H_QC = 0, H_QB = 17408, H_K = 34816, H_KT = 78336, H_VT = 96768, H_PM = 115200, H_ST = 124416, H_BT = 159232, H_AL = 161280;
constexpr int HS128 = 272, HS64 = 144;
__device__ __forceinline__ unsigned short f2bfs(float f) { return (unsigned short)f2bf(f); }
__device__ __forceinline__ void hgrn_h1_unit(Frame& F, int unit) {
    const int b = unit >> 5, h = (unit >> 3) & 3, n = unit & 7;
    const int tid = F.tid, lane = F.lane, w = F.wave, c = tid & 127, bi = tid >> 7, l15 = lane & 15, l4 = lane >> 4;
    const size_t rowbase = (size_t)(b * SEQ + n * 1024) * 512 + h * 128;
    const bf16* RQ = (const bf16*)(F.ws + WS_RQ) + rowbase; const bf16* RGL = (const bf16*)(F.ws + WS_RGL) + rowbase; const bf16* RI = (const bf16*)(F.ws + WS_RI) + rowbase;
    bf16* OLOC = (bf16*)(F.ws + WS_OLOC) + rowbase; bf16* QHAT = (bf16*)(F.ws + WS_QHAT) + rowbase;
    LAS unsigned char* L = F.lds; LAS float* BT = (LAS float*)(L + H_BT); LAS float* AL = (LAS float*)(L + H_AL);
    f32x4 acc[8];
#pragma unroll
    for (int vb = 0; vb < 8; ++vb) acc[vb] = (f32x4){0.f, 0.f, 0.f, 0.f};
    float asup = 0.f;
    for (int i = tid; i < 64 * HS64 / 4; i += NWAVES * 64) ((LAS unsigned*)(L + H_PM))[i] = 0u;
    unsigned short gr[16], qr[16], vr[16];
#define H1_LOAD(CI) do { const size_t r0_ = (size_t)((CI) * 64 + bi * 16) * 512 + c; \
        _Pragma("unroll") for (int r = 0; r < 16; ++r) { gr[r] = RGL[r0_ + (size_t)r * 512]; qr[r] = RQ[r0_ + (size_t)r * 512]; vr[r] = RI[r0_ + (size_t)r * 512]; } } while (0)
    H1_LOAD(0);
#pragma unroll 1
    for (int ci = 0; ci < 16; ++ci) {
        const size_t r0 = (size_t)(ci * 64 + bi * 16) * 512 + c;
        float eg[16], qq[16], el[16];
        { float run = 0.f, prod = 1.f;
#pragma unroll
          for (int r = 0; r < 16; ++r) { const float g = bf1(gr[r]); run += g; eg[r] = __expf(g); prod *= eg[r]; el[r] = prod; qq[r] = bf1(qr[r]); }
          BT[bi * 128 + c] = run; }
        if (ci > 0) {
#pragma unroll
            for (int vb = 0; vb < 8; ++vb) { v2u o; o.x = pk2(acc[vb][0], acc[vb][1]); o.y = pk2(acc[vb][2], acc[vb][3]);
                *(LAS v2u*)(L + H_ST + (16 * vb + l15) * HS128 + (16 * w + 4 * l4) * 2) = o; } }
        { v4u v0, v1; v0.x = vr[0] | ((unsigned)vr[1] << 16); v0.y = vr[2] | ((unsigned)vr[3] << 16); v0.z = vr[4] | ((unsigned)vr[5] << 16); v0.w = vr[6] | ((unsigned)vr[7] << 16);
          v1.x = vr[8] | ((unsigned)vr[9] << 16); v1.y = vr[10] | ((unsigned)vr[11] << 16); v1.z = vr[12] | ((unsigned)vr[13] << 16); v1.w = vr[14] | ((unsigned)vr[15] << 16);
          *(LAS v4u*)(L + H_VT + c * HS64 + bi * 32) = v0; *(LAS v4u*)(L + H_VT + c * HS64 + bi * 32 + 16) = v1; }
        __syncthreads();
        const float b0 = BT[c], b1 = BT[128 + c], b2 = BT[256 + c], b3 = BT[384 + c];
        const float ab1 = b0, ab2 = b0 + b1, ab3 = ab2 + b2, alast = ab3 + b3;
        const float ab = bi == 0 ? 0.f : bi == 1 ? ab1 : bi == 2 ? ab2 : ab3;
        if (bi == 0) AL[c] = alast;
        const float eAb = __expf(ab), eSup = __expf(asup), fEnd = __expf(alast - ab);
        const float fK0 = __expf(0.f - ab), fK1 = __expf(ab1 - ab), fK2 = __expf(ab2 - ab), fK3 = __expf(ab3 - ab);
        unsigned kp[8];
#pragma unroll
        for (int r = 0; r < 16; ++r) { const int t = bi * 16 + r;
            const float qb = qq[r] * el[r], qc = qb * eAb, kk = 1.0f - eg[r], ki = kk * __builtin_amdgcn_rcpf(el[r]);
            *(LAS unsigned short*)(L + H_QC + t * HS128 + c * 2) = f2bfs(qc);
            QHAT[r0 + (size_t)r * 512] = f2bfs(qc * eSup);
            *(LAS unsigned short*)(L + H_QB + t * HS128 + c * 2) = f2bfs(qb);
            const unsigned ke = f2bf(ki * fEnd); if (r & 1) kp[r >> 1] |= ke << 16; else kp[r >> 1] = ke;
            if (bi <= 0) *(LAS unsigned short*)(L + H_K + (0 + t) * HS128 + c * 2) = f2bfs(ki * fK0);
            if (bi <= 1) *(LAS unsigned short*)(L + H_K + (16 + t) * HS128 + c * 2) = f2bfs(ki * fK1);
            if (bi <= 2) *(LAS unsigned short*)(L + H_K + (48 + t) * HS128 + c * 2) = f2bfs(ki * fK2);
            *(LAS unsigned short*)(L + H_K + (96 + t) * HS128 + c * 2) = f2bfs(ki * fK3); }
        *(LAS v4u*)(L + H_KT + c * HS64 + bi * 32) = (v4u){kp[0], kp[1], kp[2], kp[3]}; *(LAS v4u*)(L + H_KT + c * HS64 + bi * 32 + 16) = (v4u){kp[4], kp[5], kp[6], kp[7]};
        asup += alast;
        if (ci + 1 < 16) H1_LOAD(ci + 1);
        __syncthreads();
#pragma unroll
        for (int rep = 0; rep < 2; ++rep) { const int tile = w + 8 * rep;
            if (tile < 10) { const int i = tile < 1 ? 0 : tile < 3 ? 1 : tile < 6 ? 2 : 3, j = tile - (i * (i + 1)) / 2;
                const LAS unsigned char* ap = L + H_QB + (16 * i + l15) * HS128 + l4 * 16; const LAS unsigned char* bp = L + H_K + (8 * i * (i + 1) + 16 * j + l15) * HS128 + l4 * 16;
                f32x4 p = (f32x4){0.f, 0.f, 0.f, 0.f};
#pragma unroll
                for (int ks = 0; ks < 4; ++ks) p = __builtin_amdgcn_mfma_f32_16x16x32_bf16(*(const LAS bf16x8*)(ap + ks * 64), *(const LAS bf16x8*)(bp + ks * 64), p, 0, 0, 0);
#pragma unroll
                for (int r = 0; r < 4; ++r) { const float pv = (i == j && l15 > 4 * l4 + r) ? 0.f : p[r];
                    *(LAS unsigned short*)(L + H_PM + (16 * i + 4 * l4 + r) * HS64 + (16 * j + l15) * 2) = f2bfs(pv); } } }
        __syncthreads();
#pragma unroll
        for (int tb = 0; tb < 4; ++tb) { f32x4 o = (f32x4){0.f, 0.f, 0.f, 0.f};
#pragma unroll
            for (int ks = 0; ks < 2; ++ks) if (32 * ks < 16 * (tb + 1))
                o = __builtin_amdgcn_mfma_f32_16x16x32_bf16(*(const LAS bf16x8*)(L + H_VT + (16 * w + l15) * HS64 + l4 * 16 + ks * 64), *(const LAS bf16x8*)(L + H_PM + (16 * tb + l15) * HS64 + l4 * 16 + ks * 64), o, 0, 0, 0);
            if (ci > 0) {
#pragma unroll
                for (int ks = 0; ks < 4; ++ks)
                    o = __builtin_amdgcn_mfma_f32_16x16x32_bf16(*(const LAS bf16x8*)(L + H_ST + (16 * w + l15) * HS128 + l4 * 16 + ks * 64), *(const LAS bf16x8*)(L + H_QC + (16 * tb + l15) * HS128 + l4 * 16 + ks * 64), o, 0, 0, 0); }
            v2u ov; ov.x = pk2(o[0], o[1]); ov.y = pk2(o[2], o[3]);
            *(v2u*)(OLOC + (size_t)(ci * 64 + 16 * tb + l15) * 512 + 16 * w + 4 * l4) = ov; }
        { const f32x4 dv = *(const LAS f32x4*)(AL + 16 * w + 4 * l4); const f32x4 d = (f32x4){__expf(dv[0]), __expf(dv[1]), __expf(dv[2]), __expf(dv[3])};
          const bf16x8 ka0 = *(const LAS bf16x8*)(L + H_KT + (16 * w + l15) * HS64 + l4 * 16), ka1 = *(const LAS bf16x8*)(L + H_KT + (16 * w + l15) * HS64 + l4 * 16 + 64);
#pragma unroll
          for (int vb = 0; vb < 8; ++vb) { f32x4 s = acc[vb] * d;
              s = __builtin_amdgcn_mfma_f32_16x16x32_bf16(ka0, *(const LAS bf16x8*)(L + H_VT + (16 * vb + l15) * HS64 + l4 * 16), s, 0, 0, 0);
              s = __builtin_amdgcn_mfma_f32_16x16x32_bf16(ka1, *(const LAS bf16x8*)(L + H_VT + (16 * vb + l15) * HS64 + l4 * 16 + 64), s, 0, 0, 0);
              acc[vb] = s; } }
        __syncthreads();
    }
#undef H1_LOAD
    f32x4* U = (f32x4*)(F.ws + WS_U);
#pragma unroll
    for (int vb = 0; vb < 8; ++vb) U[(size_t)((unit * 8 + w) * 8 + vb) * 64 + lane] = acc[vb];
    if (bi == 0) ((float*)(F.ws + WS_DS))[unit * 128 + c] = __expf(asup);
}
__device__ __forceinline__ void hgrn_h3_unit(Frame& F, const Args& A, int unit) {
    const int b = unit >> 5, h = (unit >> 3) & 3, n = unit & 7;
    const int lane = F.lane, w = F.wave, l15 = lane & 15, l4 = lane >> 4;
    LAS unsigned char* L = F.lds;
    const f32x4* U = (const f32x4*)(F.ws + WS_U); const float* DS = (const float*)(F.ws + WS_DS);
    f32x4 S[8];
#pragma unroll
    for (int vb = 0; vb < 8; ++vb) S[vb] = (f32x4){0.f, 0.f, 0.f, 0.f};
    for (int m = 0; m < n; ++m) { const int um = unit - n + m; const f32x4 d = *(const f32x4*)(DS + um * 128 + 16 * w + 4 * l4);
#pragma unroll
        for (int vb = 0; vb < 8; ++vb) S[vb] = S[vb] * d + U[(size_t)((um * 8 + w) * 8 + vb) * 64 + lane]; }
#pragma unroll
    for (int vb = 0; vb < 8; ++vb) { v2u o; o.x = pk2(S[vb][0], S[vb][1]); o.y = pk2(S[vb][2], S[vb][3]);
        *(LAS v2u*)(L + H_ST + (16 * vb + l15) * HS128 + (16 * w + 4 * l4) * 2) = o; }
    __syncthreads();
    const size_t rowbase = (size_t)(b * SEQ + n * 1024 + 128 * w) * 512 + h * 128;
    const bf16* QHAT = (const bf16*)(F.ws + WS_QHAT) + rowbase; const bf16* OLOC = (const bf16*)(F.ws + WS_OLOC) + rowbase;
    const bf16* RGS = (const bf16*)(F.ws + WS_RGS) + rowbase; bf16* REC = (bf16*)(F.ws + WS_REC) + rowbase;
    f32x4 rw[8];
#pragma unroll
    for (int vb = 0; vb < 8; ++vb) rw[vb] = *(const f32x4*)(A.in[11] + 16 * vb + 4 * l4);
#pragma unroll 1
    for (int tb = 0; tb < 8; ++tb) { const size_t tr = (size_t)(16 * tb + l15) * 512;
        bf16x8 qh[4];
#pragma unroll
        for (int ks = 0; ks < 4; ++ks) qh[ks] = *(const bf16x8*)(QHAT + tr + 32 * ks + 8 * l4);
        f32x4 o[8]; float ss = 0.f;
#pragma unroll
        for (int vb = 0; vb < 8; ++vb) { f32x4 a = (f32x4){0.f, 0.f, 0.f, 0.f};
            if (n > 0) {
#pragma unroll
                for (int ks = 0; ks < 4; ++ks) a = __builtin_amdgcn_mfma_f32_16x16x32_bf16(*(const LAS bf16x8*)(L + H_ST + (16 * vb + l15) * HS128 + l4 * 16 + ks * 64), qh[ks], a, 0, 0, 0); }
            const v2u ol = *(const v2u*)(OLOC + tr + 16 * vb + 4 * l4);
            a[0] += bflo(ol.x); a[1] += bfhi(ol.x); a[2] += bflo(ol.y); a[3] += bfhi(ol.y);
            o[vb] = a; ss += (a[0] * a[0] + a[1] * a[1]) + (a[2] * a[2] + a[3] * a[3]); }
        ss += __shfl_xor(ss, 16); ss += __shfl_xor(ss, 32);
        const float r = 1.0f / sqrtf(ss * (1.0f / 128.0f) + EPS);
#pragma unroll
        for (int vb = 0; vb < 8; ++vb) { const v2u g = *(const v2u*)(RGS + tr + 16 * vb + 4 * l4); const f32x4 y = o[vb] * r * rw[vb];
            v2u ov; ov.x = pk2(y[0] * bflo(g.x), y[1] * bfhi(g.x)); ov.y = pk2(y[2] * bflo(g.y), y[3] * bfhi(g.y));
            *(v2u*)(REC + tr + 16 * vb + 4 * l4) = ov; }
    }
    __syncthreads();
}

__device__ __forceinline__ unsigned f2key(float x) {
    const _Float16 hh = (_Float16)x; const unsigned bits = (unsigned)__builtin_bit_cast(unsigned short, hh);
    return (bits & 0x8000u) ? (~bits & 0xffffu) : (bits | 0x8000u);
}
constexpr int DSA_VIMG = 73728;
constexpr int DSA_CAND = 147456, DSA_CAPC = 448;
typedef unsigned u32x4p __attribute__((ext_vector_type(4)));
__device__ __forceinline__ void dsa_unit(Frame& F, int b, int t0) {
    const int lane = F.lane, w = F.wave, qc = lane & 31, hf = lane >> 5;
    const bf16* KI = (const bf16*)(F.ws + WS_KI) + (size_t)b * SEQ * 64;
    const bf16* QI = (const bf16*)(F.ws + WS_QI) + (size_t)(b * SEQ + t0) * 512;
    const float* WI = (const float*)(F.ws + WS_WI) + (size_t)(b * SEQ + t0) * 8;
    unsigned short* scr = (unsigned short*)(F.ws + WS_SCR) + (size_t)blockIdx.x * (32 * 8192);
    const int nkb = t0 / 32 + 1;
    LAS unsigned* hist = (LAS unsigned*)(F.lds);
    for (int i = F.tid; i < 4096; i += NWAVES * 64) ((LAS v4u*)hist)[i] = (v4u){0u, 0u, 0u, 0u};
    __syncthreads();
    {
        const int l15 = lane & 15, l4 = lane >> 4, qg = w >> 2, ql = 16 * qg + l15;
        bf16x8 qf[8][2]; float wv[8];
#pragma unroll
        for (int h = 0; h < 8; ++h) { wv[h] = WI[ql * 8 + h];
#pragma unroll
            for (int ks = 0; ks < 2; ++ks) qf[h][ks] = *(const bf16x8*)(QI + (size_t)ql * 512 + h * 64 + ks * 32 + l4 * 8); }
        const int lim = t0 + ql - 4 * l4;
        float wh[8];
#pragma unroll
        for (int h = 0; h < 8; ++h) wh[h] = 0.5f * wv[h];
        const int nb16 = 2 * nkb;
#define P1_LOAD(K0, K1, KB) do { const int row_ = (KB) * 16 + l15; const bf16* kp_ = KI + (size_t)(row_ < SEQ - 1 ? row_ : SEQ - 1) * 64 + l4 * 8; K0 = *(const bf16x8*)(kp_); K1 = *(const bf16x8*)(kp_ + 32); } while (0)
#define P1_COMPUTE(K0, K1, KB) do { const int s0_ = (KB) * 16; f32x4 sc_ = (f32x4){0.f, 0.f, 0.f, 0.f}; \
            _Pragma("unroll") for (int h = 0; h < 8; ++h) { f32x4 a_ = (f32x4){0.f, 0.f, 0.f, 0.f}; \
                a_ = __builtin_amdgcn_mfma_f32_16x16x32_bf16(K0, qf[h][0], a_, 0, 0, 0); a_ = __builtin_amdgcn_mfma_f32_16x16x32_bf16(K1, qf[h][1], a_, 0, 0, 0); \
                _Pragma("unroll") for (int r = 0; r < 4; ++r) { sc_[r] = __builtin_fmaf(wh[h], a_[r], sc_[r]); sc_[r] = __builtin_fmaf(wh[h], __builtin_fabsf(a_[r]), sc_[r]); } } \
            unsigned kk_[4]; \
            _Pragma("unroll") for (int r = 0; r < 4; ++r) { const bool causal_ = s0_ + r <= lim; const unsigned key_ = f2key(sc_[r]); kk_[r] = causal_ ? key_ : 0u; \
                if (causal_) __hip_atomic_fetch_add(hist + ql * 512 + (key_ >> 7), 1u, __ATOMIC_RELAXED, __HIP_MEMORY_SCOPE_WORKGROUP); } \
            v2u o_; o_.x = kk_[0] | (kk_[1] << 16); o_.y = kk_[2] | (kk_[3] << 16); \
            *(v2u*)(scr + (size_t)ql * 8192 + s0_ + 4 * l4) = o_; } while (0)
        {
        bf16x8 ka0, ka1, kb0, kb1, kc0, kc1, kd0, kd1;
        int kb = (w & 3);
        P1_LOAD(ka0, ka1, kb); P1_LOAD(kb0, kb1, kb + 4); P1_LOAD(kc0, kc1, kb + 8);
#pragma unroll 1
        for (; kb < nb16; kb += 16) {
            P1_LOAD(kd0, kd1, kb + 12);
            P1_COMPUTE(ka0, ka1, kb);
            P1_LOAD(ka0, ka1, kb + 16);
            if (kb + 4 < nb16) P1_COMPUTE(kb0, kb1, kb + 4);
            P1_LOAD(kb0, kb1, kb + 20);
            if (kb + 8 < nb16) P1_COMPUTE(kc0, kc1, kb + 8);
            P1_LOAD(kc0, kc1, kb + 24);
            if (kb + 12 < nb16) P1_COMPUTE(kd0, kd1, kb + 12);
        }
        }
#undef P1_LOAD
#undef P1_COMPUTE
    }
    __syncthreads();
    LAS unsigned short* idxl = (LAS unsigned short*)(F.lds + 65536) + w * 256;
    const LAS float* rb = (const LAS float*)(F.lds + 69632); const LAS int* lut = (const LAS int*)(F.lds + 70656);
    const bf16* KV = (const bf16*)(F.ws + WS_KV) + (size_t)b * SEQ * 256;
    const int nk = nkb * 32, ndw = nk >> 1;
#pragma unroll 1
    for (int qq = 0; qq < 4; ++qq) {
        const int ql = w * 4 + qq, t = t0 + ql, nvalid = t + 1, nsel = nvalid < 256 ? nvalid : 256;
        const unsigned* rowd = (const unsigned*)(scr + (size_t)ql * 8192);
        int ln = lane; asm volatile("" : "+v"(ln));
        {
        unsigned rv[64];
#pragma unroll
        for (int j = 0; j < 64; ++j) { const unsigned val = rowd[j * 64 + ln]; rv[j] = (ln < ndw - j * 64) ? val : 0u; }
        unsigned T = 0u; int need = 0; bool done = false;
        const unsigned long long lt = (1ull << ln) - 1ull; const int ln2 = 2 * ln;
        if (nvalid > 256) {
            const LAS unsigned* hq = hist + ql * 512 + 8 * ln;
            const v4u h0 = *(const LAS v4u*)(hq), h1 = *(const LAS v4u*)(hq + 4);
            const unsigned h8[8] = {h0.x, h0.y, h0.z, h0.w, h1.x, h1.y, h1.z, h1.w};
            const unsigned sl = (h0.x + h0.y) + (h0.z + h0.w) + (h1.x + h1.y) + (h1.z + h1.w);
            unsigned S = sl;
#pragma unroll
            for (int d = 1; d < 64; d <<= 1) { const unsigned tt = __shfl_down(S, d); if (ln + d < 64) S += tt; }
            const int Lb = __popcll(__ballot(S >= 256u)) - 1;
            unsigned cum = S - sl, caL = 0u, cbL = 0u; int Bi = 0; bool found = false;
#pragma unroll
            for (int i = 7; i >= 0; --i) { if (!found && cum + h8[i] >= 256u) { Bi = i; caL = cum; cbL = h8[i]; found = true; } if (!found) cum += h8[i]; }
            const int B = 8 * Lb + __shfl(Bi, Lb); const int ca = (int)__shfl(caL, Lb), cb = (int)__shfl(cbL, Lb);
            LAS unsigned short* glst = (LAS unsigned short*)(F.lds + DSA_VIMG + w * 9216);
            LAS unsigned* elst = (LAS unsigned*)(F.lds + DSA_VIMG + w * 9216 + 3072);
            const unsigned Tg = (unsigned)(B + 1) << 7, Te = (unsigned)B << 7;
            int gc = 0, ec = 0;
#pragma unroll
            for (int g = 0; g < 8; ++g) if (g * 1024 < nk) {
#pragma unroll
                for (int j = 8 * g; j < 8 * g + 8; ++j) { const unsigned lo = rv[j] & 0xffffu, hi = rv[j] >> 16; const unsigned i0 = (unsigned)(ln2 + 128 * j);
                    if (lo >= Te) { if (lo >= Tg) { if (gc < 24) glst[gc * 64 + ln] = (unsigned short)i0; ++gc; } else { if (ec < 12) elst[ec * 64 + ln] = (lo << 16) | (65535u - i0); ++ec; } }
                    if (hi >= Te) { if (hi >= Tg) { if (gc < 24) glst[gc * 64 + ln] = (unsigned short)(i0 + 1u); ++gc; } else { if (ec < 12) elst[ec * 64 + ln] = (hi << 16) | (65534u - i0); ++ec; } } } }
            if (__ballot(gc > 24 || ec > 12) == 0ull) {
                LDS_WAIT(); asm volatile("" ::: "memory");
                int incl = gc;
#pragma unroll
                for (int d = 1; d < 64; d <<= 1) { const int tt = __shfl_up(incl, d); if (ln >= d) incl += tt; }
                const int excl = incl - gc;
#pragma unroll 1
                for (int e = 0; e < 24; ++e) { if (__ballot(e < gc) == 0ull) break; if (e < gc) idxl[excl + e] = glst[e * 64 + ln]; }
                unsigned cv[12]; int emax = 0;
#pragma unroll
                for (int e = 0; e < 12; ++e) { cv[e] = (e < ec) ? elst[e * 64 + ln] : 0u; if (__ballot(e < ec) != 0ull) emax = e + 1; }
                const int needc = 256 - ca; unsigned pref = (unsigned)B << 23;
#pragma unroll 1
                for (int bit = 22; bit >= 0; --bit) { const unsigned c = pref | (1u << bit); int cnt = 0;
#pragma unroll
                    for (int e = 0; e < 12; ++e) if (e < emax) cnt += __popcll(__ballot(cv[e] >= c));
                    if (cnt >= needc) pref = c; }
                int base = ca;
#pragma unroll
                for (int e = 0; e < 12; ++e) if (e < emax) { const bool sl2 = cv[e] >= pref; const unsigned long long m = __ballot(sl2); const int pos = base + __popcll(m & lt);
                    if (sl2 && pos < 256) idxl[pos] = (unsigned short)(65535u - (cv[e] & 0xffffu)); base += __popcll(m); }
                done = true;
            } else {
#pragma unroll 1
                for (int bit = 15; bit >= 0; --bit) { const unsigned cand2 = T | (1u << bit); int c = 0;
#pragma unroll
                    for (int g = 0; g < 8; ++g) if (g * 1024 < nk) {
#pragma unroll
                        for (int j = 8 * g; j < 8 * g + 8; ++j) { c += ((rv[j] & 0xffffu) >= cand2) ? 1 : 0; c += ((rv[j] >> 16) >= cand2) ? 1 : 0; } }
#pragma unroll
                    for (int o = 1; o < 64; o <<= 1) c += __shfl_xor(c, o);
                    if (c >= 256) T = cand2; }
                int c = 0;
#pragma unroll
                for (int g = 0; g < 8; ++g) if (g * 1024 < nk) {
#pragma unroll
                    for (int j = 8 * g; j < 8 * g + 8; ++j) { c += ((rv[j] & 0xffffu) > T) ? 1 : 0; c += ((rv[j] >> 16) > T) ? 1 : 0; } }
#pragma unroll
                for (int o = 1; o < 64; o <<= 1) c += __shfl_xor(c, o);
                need = 256 - c;
            }
        }
        if (!done) {
            int base = 0, tiebase = 0;
#pragma unroll
            for (int g = 0; g < 8; ++g) if (g * 1024 < nk) {
#pragma unroll
                for (int j = 8 * g; j < 8 * g + 8; ++j) { const unsigned lo = rv[j] & 0xffffu, hi = rv[j] >> 16;
                    const bool el = lo == T, eh = hi == T; const unsigned long long mel = __ballot(el), meh = __ballot(eh);
                    const int trl = tiebase + __popcll(mel & lt) + __popcll(meh & lt), trh = trl + (el ? 1 : 0);
                    const bool sl = lo > T || (el && trl < need), sh = hi > T || (eh && trh < need);
                    const unsigned long long msl = __ballot(sl), msh = __ballot(sh);
                    const int pl = base + __popcll(msl & lt) + __popcll(msh & lt), ph = pl + (sl ? 1 : 0);
                    if (sl && pl < 256) idxl[pl] = (unsigned short)(ln2 + 128 * j); if (sh && ph < 256) idxl[ph] = (unsigned short)(ln2 + 128 * j + 1);
                    base += __popcll(msl) + __popcll(msh); tiebase += __popcll(mel) + __popcll(meh); __builtin_amdgcn_sched_barrier(0); } }
        }
        }
        LDS_WAIT(); asm volatile("" ::: "memory");
        {
            int l15 = ln & 15, l4 = ln >> 4; asm volatile("" : "+v"(l15), "+v"(l4));
            const int l4x4 = 4 * l4;
#pragma unroll
            for (int jj = 0; jj < 4; ++jj) { if (ln >= nsel - 64 * jj) idxl[ln + 64 * jj] = 0; }
            LDS_WAIT(); asm volatile("" ::: "memory");
            const bf16* qrow = (const bf16*)(F.ws + WS_Q) + (size_t)(b * SEQ + t) * 512 + (l15 & 7) * 64 + 8 * l4;
            bf16x8 bq[2][2];
#pragma unroll
            for (int g = 0; g < 2; ++g)
#pragma unroll
                for (int ks = 0; ks < 2; ++ks) { bf16x8 v = *(const bf16x8*)(qrow + 32 * ks); if ((l15 >> 2) != g) v = (bf16x8){0, 0, 0, 0, 0, 0, 0, 0}; bq[g][ks] = v; }
            f32x4 sa[16];
#pragma unroll
            for (int half = 0; half < 4; ++half) {
                bf16x8 ka[4][4];
#pragma unroll
                for (int bl = 0; bl < 4; ++bl) { const bf16* kr = KV + (size_t)idxl[16 * (4 * half + bl) + l15] * 256 + 8 * l4;
#pragma unroll
                    for (int i = 0; i < 4; ++i) ka[bl][i] = *(const bf16x8*)(kr + 32 * i); }
#pragma unroll
                for (int bl = 0; bl < 4; ++bl) { f32x4 acc = (f32x4){0.f, 0.f, 0.f, 0.f};
                    acc = __builtin_amdgcn_mfma_f32_16x16x32_bf16(ka[bl][0], bq[0][0], acc, 0, 0, 0); acc = __builtin_amdgcn_mfma_f32_16x16x32_bf16(ka[bl][1], bq[0][1], acc, 0, 0, 0);
                    acc = __builtin_amdgcn_mfma_f32_16x16x32_bf16(ka[bl][2], bq[1][0], acc, 0, 0, 0); acc = __builtin_amdgcn_mfma_f32_16x16x32_bf16(ka[bl][3], bq[1][1], acc, 0, 0, 0);
                    sa[4 * half + bl] = acc; }
                asm volatile("" ::: "memory"); }
            v4u vbuf[2][8];
#pragma unroll
            for (int i = 0; i < 8; ++i) vbuf[0][i] = *(const v4u*)(KV + (size_t)idxl[4 * i + l4] * 256 + 128 + l15 * 8);
            float mx = -INFINITY; const float bias31 = rb[31 * 8 + (l15 & 7)];
#pragma unroll
            for (int blk = 0; blk < 16; ++blk)
#pragma unroll
                for (int r = 0; r < 4; ++r) { const int dist = t - (int)idxl[l4x4 + (16 * blk + r)]; float bias = bias31;
                    if (__ballot(dist < 113) != 0ull) bias = rb[(dist < 128 ? lut[dist] : 31) * 8 + (l15 & 7)];
                    const float v = (l4x4 < nsel - (16 * blk + r)) ? sa[blk][r] + bias : -INFINITY; sa[blk][r] = v; mx = fmaxf(mx, v); }
            mx = fmaxf(mx, __shfl_xor(mx, 16)); mx = fmaxf(mx, __shfl_xor(mx, 32));
            float su = 0.f;
#pragma unroll
            for (int blk = 0; blk < 16; ++blk)
#pragma unroll
                for (int r = 0; r < 4; ++r) { const float e = __expf(sa[blk][r] - mx); sa[blk][r] = e; su += e; }
            su += __shfl_xor(su, 16); su += __shfl_xor(su, 32);
            const float inv = 1.0f / su;
            bf16x8 pf[8];
#pragma unroll
            for (int ks = 0; ks < 8; ++ks) { u32x4p pa; pa.x = pk2(sa[2 * ks][0], sa[2 * ks][1]); pa.y = pk2(sa[2 * ks][2], sa[2 * ks][3]); pa.z = pk2(sa[2 * ks + 1][0], sa[2 * ks + 1][1]); pa.w = pk2(sa[2 * ks + 1][2], sa[2 * ks + 1][3]);
                asm volatile("" : "+v"(pa));
                pf[ks] = __builtin_bit_cast(bf16x8, pa); }
#pragma unroll
            for (int i = 0; i < 8; ++i) vbuf[1][i] = *(const v4u*)(KV + (size_t)idxl[32 + 4 * i + l4] * 256 + 128 + l15 * 8);
            f32x4 oa[2][4];
#pragma unroll
            for (int g = 0; g < 2; ++g)
#pragma unroll
                for (int c = 0; c < 4; ++c) oa[g][c] = (f32x4){0.f, 0.f, 0.f, 0.f};
            LAS unsigned char* vimg = F.lds + DSA_VIMG + w * 9216;
            const unsigned traddr = (unsigned)(size_t)(vimg + (4 * l4 + (l15 >> 2)) * 144 + (l15 & 3) * 8);
#pragma unroll
            for (int ks = 0; ks < 8; ++ks) {
#pragma unroll
                for (int i = 0; i < 8; ++i) *(LAS v4u*)(vimg + (l15 >> 3) * 4608 + (4 * i + l4) * 144 + (l15 & 7) * 16) = vbuf[ks & 1][i];
                if (ks + 2 < 8) {
#pragma unroll
                    for (int i = 0; i < 8; ++i) vbuf[ks & 1][i] = *(const v4u*)(KV + (size_t)idxl[32 * (ks + 2) + 4 * i + l4] * 256 + 128 + l15 * 8); }
                LDS_WAIT(); asm volatile("" ::: "memory");
                v2u tb[16];
                asm volatile("ds_read_b64_tr_b16 %0, %16 offset:0\n\tds_read_b64_tr_b16 %1, %16 offset:2304\n\tds_read_b64_tr_b16 %2, %16 offset:32\n\tds_read_b64_tr_b16 %3, %16 offset:2336\n\t"
                             "ds_read_b64_tr_b16 %4, %16 offset:64\n\tds_read_b64_tr_b16 %5, %16 offset:2368\n\tds_read_b64_tr_b16 %6, %16 offset:96\n\tds_read_b64_tr_b16 %7, %16 offset:2400\n\t"
                             "ds_read_b64_tr_b16 %8, %16 offset:4608\n\tds_read_b64_tr_b16 %9, %16 offset:6912\n\tds_read_b64_tr_b16 %10, %16 offset:4640\n\tds_read_b64_tr_b16 %11, %16 offset:6944\n\t"
                             "ds_read_b64_tr_b16 %12, %16 offset:4672\n\tds_read_b64_tr_b16 %13, %16 offset:6976\n\tds_read_b64_tr_b16 %14, %16 offset:4704\n\tds_read_b64_tr_b16 %15, %16 offset:7008\n\ts_waitcnt lgkmcnt(0)"
                             : "=&v"(tb[0]), "=&v"(tb[1]), "=&v"(tb[2]), "=&v"(tb[3]), "=&v"(tb[4]), "=&v"(tb[5]), "=&v"(tb[6]), "=&v"(tb[7]),
                               "=&v"(tb[8]), "=&v"(tb[9]), "=&v"(tb[10]), "=&v"(tb[11]), "=&v"(tb[12]), "=&v"(tb[13]), "=&v"(tb[14]), "=&v"(tb[15])
                             : "v"(traddr) : "memory");
#pragma unroll
                for (int g = 0; g < 2; ++g)
#pragma unroll
                    for (int c = 0; c < 4; ++c) { u32x4p bb; bb.x = tb[8 * g + 2 * c].x; bb.y = tb[8 * g + 2 * c].y; bb.z = tb[8 * g + 2 * c + 1].x; bb.w = tb[8 * g + 2 * c + 1].y;
                        oa[g][c] = __builtin_amdgcn_mfma_f32_16x16x32_bf16(pf[ks], __builtin_bit_cast(bf16x8, bb), oa[g][c], 0, 0, 0); }
                asm volatile("" ::: "memory");
            }
            bf16* orow = (bf16*)(F.ws + WS_ATT) + (size_t)(b * SEQ + t) * 512;
#pragma unroll
            for (int r = 0; r < 4; ++r) { const float i0 = __shfl(inv, r), i1 = __shfl(inv, 4 + r);
                if (l4 < 2) {
#pragma unroll
                    for (int c = 0; c < 4; ++c) { const float v = l4 == 0 ? oa[0][c][r] * i0 : oa[1][c][r] * i1; orow[(4 * l4 + r) * 64 + 16 * c + l15] = (bf16)f2bf(v); } } }
        }
        LDS_WAIT(); asm volatile("" ::: "memory");
    }
    __syncthreads();
}

__device__ __forceinline__ void p4_mixers(Frame& F, const Args& A) {
    for (int u = blockIdx.x; u < 256; u += F.G) hgrn_h1_unit(F, u);
    __syncthreads();
    { LAS float* rb = (LAS float*)(F.lds + 69632); LAS int* lut = (LAS int*)(F.lds + 70656);
      if (F.tid < 256) rb[F.tid] = A.in[9][F.tid];
      if (F.tid < 128) { const int n = F.tid; int v = n; if (n >= 16) { v = 16 + (int)(__logf((float)n * (1.0f / 16.0f)) * (16.0f / 2.0794415416798357f)); v = v < 31 ? v : 31; } lut[n] = v; }
      __syncthreads(); }
    for (int u = blockIdx.x, k = 0; u < 2048; u += F.G, ++k) { const int b = u & 7, sl = u >> 3, sm = (k & 1) ? ((sl & ~31) | (31 - (sl & 31))) : sl; dsa_unit(F, b, (255 - sm) * 32); }
}

__device__ __forceinline__ void p5_rec(Frame& F, const Args& A) { for (int u = blockIdx.x; u < 256; u += F.G) hgrn_h3_unit(F, A, u);
}

__device__ __forceinline__ void p10_final(Frame& F, const Args& A) {
    const int gw = blockIdx.x * NWAVES + F.wave, NGW = F.G * NWAVES; const float* SS = (const float*)(F.ws + WS_X2SS);
    f32x4 wv[4];
#pragma unroll
    for (int j = 0; j < 4; ++j) wv[j] = *(const f32x4*)(A.in[19] + 4 * F.lane + 256 * j);
    for (int m0 = gw; m0 < M; m0 += 4 * NGW) {
        f32x4 v[4][4]; float ss[4];
#pragma unroll
        for (int k = 0; k < 4; ++k) { const int m = m0 + k * NGW < M ? m0 + k * NGW : m0; ss[k] = F.lane < 16 ? SS[(size_t)m * 16 + F.lane] : 0.f;
            const GAS f32x4* xr = (const GAS f32x4*)(F.out + (size_t)m * D) + F.lane;
#pragma unroll
            for (int j = 0; j < 4; ++j) v[k][j] = xr[64 * j]; }
#pragma unroll
        for (int k = 0; k < 4; ++k) { const int m = m0 + k * NGW; const float r = 1.0f / sqrtf(wave_sum(ss[k]) * (1.0f / D) + EPS);
            if (m < M) { GAS f32x4* xo = (GAS f32x4*)(F.out + (size_t)m * D) + F.lane;
#pragma unroll
                for (int j = 0; j < 4; ++j) xo[64 * j] = v[k][j] * r * wv[j]; } }
    }
}

__global__ void __launch_bounds__(NWAVES * 64, 2) fwd_kernel(Args args) {
    extern __shared__ __attribute__((aligned(16))) unsigned char lds[];
    Frame F;
    F.lds = (LAS unsigned char*)lds;
    F.MISC = (volatile LAS unsigned*)(F.lds + MISC_OFF);
    F.tid = threadIdx.x; F.lane = F.tid & 63; F.wave = __builtin_amdgcn_readfirstlane(F.tid >> 6);
    F.G = gridDim.x;
    F.ws = args.ws; F.ctl = (gu32*)(args.ws + WS_CTL); F.out = args.out;
    for (int u = F.tid; u < (LDS_BYTES - LDSCTL_OFF) / 4; u += NWAVES * 64) ((LAS unsigned*)(F.lds + LDSCTL_OFF))[u] = 0u;
    __syncthreads();
    XcdBarrier bar; bar.bar = (unsigned*)(F.ctl + CW_BAR); bar.x = 0; bar.st = nullptr;
    if (N_LAUNCHES == 1) bar = xcd_barrier_post((unsigned*)(F.ctl + CW_BAR), F.MISC + 8);
#define GRID_BAR() do { if (N_LAUNCHES == 1) xcd_barrier(bar); } while (0)
    const int lo = args.ph_lo, hi = args.ph_hi;
#ifdef ONLY_PHASE
#define IN(k) ((k) == ONLY_PHASE && lo <= (k) && (k) < hi)
#else
#define IN(k) (lo <= (k) && (k) < hi)
#endif
#define BOTH(k) (IN(k) && IN((k) + 1))
    const float* MOD = (const float*)(F.ws + WS_MOD);

    if (IN(0)) { p0_prologue(F, args); if (BOTH(0)) GRID_BAR(); }
    if (IN(1)) { p1_norm(F, args); if (BOTH(1)) GRID_BAR(); }
    if (IN(2)) {
        pg8::Gemm g{(const bf16*)(F.ws + WS_XN), (const bf16*)(F.ws + WS_WIN), M, NPROJ_PAD, 1024}; pg8::StaticOrder S; S.init(M, NPROJ_PAD, F.G, (int)blockIdx.x);
        pg8::EpiInProj E{(bf16*)(F.ws + WS_CQ), (bf16*)(F.ws + WS_KV), (bf16*)(F.ws + WS_KI), (bf16*)(F.ws + WS_RQ), (bf16*)F.out,
                         (float*)(F.ws + WS_WI), (float*)(F.ws + WS_CQSS), (const float*)(F.ws + WS_LB)};
        pg8::gemm_phase<pg8::EpiInProj, pg8::StaticOrder, PG8_ALIGN, PG8_SP2>(F.lds + RING_OFF, g, S, E);
        if (BOTH(2)) GRID_BAR();
    }
    if (IN(3)) {
        pg8::Gemm g{(const bf16*)(F.ws + WS_CQ), (const bf16*)(F.ws + WS_WQ), M, 1024, 256}; pg8::StaticOrder S; S.init(M, 1024, F.G, (int)blockIdx.x);
        pg8::EpiQ E{(bf16*)(F.ws + WS_Q), (const float*)(F.ws + WS_CQSS)};
        pg8::gemm_phase<pg8::EpiQ, pg8::StaticOrder, PG8_ALIGN, PG8_SP2>(F.lds + RING_OFF, g, S, E);
        if (BOTH(3)) GRID_BAR();
    }
    if (IN(4)) { p4_mixers(F, args); if (BOTH(4)) GRID_BAR(); }
    if (IN(5)) { p5_rec(F, args); if (BOTH(5)) GRID_BAR(); }
    if (IN(6)) {
        pg8::StaticOrder S; S.init(M, 1024, F.G, (int)blockIdx.x);
        { pg8::Gemm g{(const bf16*)(F.ws + WS_ATT), (const bf16*)(F.ws + WS_WBA), M, 1024, 512}; pg8::EpiBranch<0> E{(bf16*)(F.ws + WS_MIX), (const bf16*)F.out};
          pg8::gemm_phase<pg8::EpiBranch<0>, pg8::StaticOrder, PG8_ALIGN, PG8_SP2>(F.lds + RING_OFF, g, S, E); }
        { pg8::Gemm g{(const bf16*)(F.ws + WS_REC), (const bf16*)(F.ws + WS_WBR), M, 1024, 512}; pg8::EpiBranch<1> E{(bf16*)(F.ws + WS_MIX), (const bf16*)F.out};
          pg8::gemm_phase<pg8::EpiBranch<1>, pg8::StaticOrder, PG8_ALIGN, PG8_SP2>(F.lds + RING_OFF, g, S, E); }
        if (BOTH(6)) GRID_BAR();
    }
    if (IN(7)) {
        pg8::Gemm g{(const bf16*)(F.ws + WS_MIX), (const bf16*)(F.ws + WS_WOUT), M, 1024, 1024}; pg8::StaticOrder S; S.init(M, 1024, F.G, (int)blockIdx.x);
        pg8::EpiOut E{args.in[0], (float*)(F.ws + WS_X1), (bf16*)(F.ws + WS_XS), (float*)(F.ws + WS_X1SS), MOD, (const float*)(F.ws + WS_CW2)};
        pg8::gemm_phase<pg8::EpiOut, pg8::StaticOrder, PG8_ALIGN, PG8_SP2>(F.lds + RING_OFF, g, S, E);
        if (BOTH(7)) GRID_BAR();
    }
    if (IN(8)) {
        pg8::Gemm g{(const bf16*)(F.ws + WS_XS), (const bf16*)(F.ws + WS_WGU), M, NGU, 1024}; pg8::StaticOrder S; S.init(M, NGU, F.G, (int)blockIdx.x);
        int pm0 = 0; { const int nN_ = NGU / 256, nwg_ = (M / 256) * nN_; int wg_ = (int)blockIdx.x;
            if (wg_ < nwg_) { const int q_ = nwg_ / 8, r_ = nwg_ % 8, x_ = wg_ % 8, o_ = wg_ / 8; wg_ = (x_ < r_ ? x_ * (q_ + 1) : r_ * (q_ + 1) + (x_ - r_) * q_) + o_;
                const int nig_ = 8 * nN_, fm_ = (wg_ / nig_) * 8, gsz_ = (M / 256 - fm_) < 8 ? (M / 256 - fm_) : 8; pm0 = fm_ + ((wg_ % nig_) % gsz_); } }
        const int g0 = pm0 >> 3, pm7 = pm0 & 7;
        { LAS float* R2L = (LAS float*)(F.lds + RING_BYTES); const float* SS = (const float*)(F.ws + WS_X1SS);
          for (int i = F.tid; i < 1024; i += NWAVES * 64) { const int pm = 8 * (g0 + (i >> 8)) + pm7; float r = 0.f;
              if (pm < M / 256) { const float* p = SS + (size_t)(pm * 256 + (i & 255)) * 16; float s2 = 0.f;
#pragma unroll
                  for (int q = 0; q < 4; ++q) { const f32x4 t = *(const f32x4*)(p + 4 * q); s2 += (t[0] + t[1]) + (t[2] + t[3]); }
                  r = __builtin_amdgcn_rsqf(s2 * (1.0f / 1024.0f) + 1e-6f); }
              R2L[i] = r; }
          LAS float* BL = (LAS float*)(F.lds + RING_BYTES + 4096); const float* bsrc = (const float*)(F.ws + WS_BGU) + (pm0 >> 5) * NGU;
          for (int i = F.tid; i < NGU / 4; i += NWAVES * 64) ((LAS f32x4*)BL)[i] = ((const f32x4*)bsrc)[i];
          __syncthreads(); }
        pg8::EpiGateUp E{(bf16*)(F.ws + WS_HID), (const float*)(F.ws + WS_X1SS), (const float*)(F.ws + WS_BGU), (const LAS float*)(F.lds + RING_BYTES + 4096), pm0 >> 5, (const LAS float*)(F.lds + RING_BYTES), g0, pm7};
        pg8::gemm_phase<pg8::EpiGateUp, pg8::StaticOrder, PG8_ALIGN, PG8_SP2>(F.lds + RING_OFF, g, S, E);
        if (BOTH(8)) GRID_BAR();
    }
    if (IN(9)) {
        pg8::Gemm g{(const bf16*)(F.ws + WS_HID), (const bf16*)(F.ws + WS_WD), M, 1024, FF}; pg8::StaticOrder S; S.init(M, 1024, F.G, (int)blockIdx.x);
        pg8::EpiDown E{(const float*)(F.ws + WS_X1), F.out, (float*)(F.ws + WS_X2SS), MOD};
        pg8::gemm_phase<pg8::EpiDown, pg8::StaticOrder, PG8_ALIGN, PG8_SP2>(F.lds + RING_OFF, g, S, E);
        if (BOTH(9)) GRID_BAR();
    }
    if (IN(10)) p10_final(F, args);
#undef IN
#undef BOTH
}

extern "C" void kernel_launch(void* const* d_in, const int* in_sizes, int n_in, void* d_out, int out_size, void* d_ws, size_t ws_size, hipStream_t stream) {
    static int grid = 0;
    if (grid == 0) {
        if (n_in != 20 || in_sizes[0] != M * D || out_size != M * D || ws_size < WS_END) { fprintf(stderr, "kernel_launch: unexpected shapes (n_in %d, in0 %d, out %d, ws %zu); nothing launched\n", n_in, n_in > 0 ? in_sizes[0] : -1, out_size, ws_size); grid = -1; return; }
        int dev = 0, cus = 0, per_cu = 0;
        if (hipGetDevice(&dev) != hipSuccess || hipDeviceGetAttribute(&cus, hipDeviceAttributeMultiprocessorCount, dev) != hipSuccess) { grid = -1; return; }
        if (hipFuncSetAttribute((const void*)fwd_kernel, hipFuncAttributeMaxDynamicSharedMemorySize, LDS_BYTES) != hipSuccess) { fprintf(stderr, "kernel_launch: hipFuncSetAttribute failed\n"); grid = -1; return; }
        if (hipOccupancyMaxActiveBlocksPerMultiprocessor(&per_cu, (const void*)fwd_kernel, NWAVES * 64, LDS_BYTES) != hipSuccess || per_cu < 1)
            fprintf(stderr, "kernel_launch: note: occupancy query reports %d workgroups per CU\n", per_cu);
        (void)hipGetLastError();
        grid = cus;
    }
    if (grid < 0) return;
    if (hipMemsetAsync((char*)d_ws + WS_CTL, 0, CTL_ZERO_BYTES, stream) != hipSuccess) { fprintf(stderr, "kernel_launch: memset failed\n"); return; }
    Args a{};
    for (int i = 0; i < 20; ++i) a.in[i] = (const float*)d_in[i];
    a.out = (float*)d_out; a.ws = (unsigned char*)d_ws;
    for (int li = 0; li < N_LAUNCHES; ++li) {
        a.ph_lo = (N_LAUNCHES == 1) ? 0 : li; a.ph_hi = (N_LAUNCHES == 1) ? N_PHASES : li + 1;
        hipLaunchKernelGGL(fwd_kernel, dim3(grid), dim3(NWAVES * 64), LDS_BYTES, stream, a);
        const hipError_t le = hipPeekAtLastError();
        if (le != hipSuccess) { fprintf(stderr, "kernel_launch: launch %d failed: %s\n", li, hipGetErrorName(le)); break; }
    }
}
```

```cpp
#include <hip/hip_runtime.h>
#include <cstdio>
#include <cstdint>
namespace pg8 {
#define PG8_LAS __attribute__((address_space(3)))
typedef unsigned short bf16_t;
typedef short bf16x8 __attribute__((ext_vector_type(8)));
typedef float f32x4 __attribute__((ext_vector_type(4)));
typedef unsigned u32x4 __attribute__((ext_vector_type(4)));
constexpr int BM = 256, BK = 64, HALF = 128, HTB = HALF * BK * 2  , STAGE_BYTES = 8 * HTB, NXCD = 8, WGM = 8;

__host__ __device__ __forceinline__ int lds_byte(int r, int c) { const int st = (r >> 4) * 2 + (c >> 5), rr = r & 15, cc = c & 31, ob = rr * 64 + cc * 2; return st * 1024 + (ob ^ (((ob >> 9) & 1) << 5)); }
__host__ __device__ __forceinline__ void stage_rc(int b, int& R, int& C) { const int st = b / 1024, sb = b % 1024, swz = sb ^ (((sb >> 9) & 1) << 5); R = (st >> 1) * 16 + swz / 64; C = (st & 1) * 32 + (swz % 64) / 2; }
__host__ __device__ __forceinline__ int perm32(int rho) { const int n = rho >> 4, i = rho & 15; return 8 * (i >> 2) + 4 * n + (i & 3); }

struct Unit { int pm, pn; };
struct Gemm { const bf16_t* A; const bf16_t* Bt; int M, N, K; };

struct StaticOrder {
    int nM, nN, nwg, G, c;
    __host__ __device__ void init(int M, int N, int G_, int c_) { nM = M / BM; nN = N / BM; nwg = nM * nN; G = G_; c = c_; }
    __host__ __device__ bool next(int i, Unit& u) const {
        const long L = (long)i * G + c; if (L >= nwg) return false;
        int wgid = (int)L; { const int q = nwg / NXCD, r = nwg % NXCD, xcd = wgid % NXCD, off = wgid / NXCD; wgid = (xcd < r ? xcd * (q + 1) : r * (q + 1) + (xcd - r) * q) + off; }
        const int nig = WGM * nN, gid = wgid / nig, fm = gid * WGM, gsz = (nM - fm) < WGM ? (nM - fm) : WGM;
        u.pm = fm + ((wgid % nig) % gsz); u.pn = (wgid % nig) / gsz; return true;
    }
    __device__ __forceinline__ void a_ready(const Unit&) const {}
    __device__ __forceinline__ void done(const Unit&) const {}
};

__device__ __forceinline__ unsigned cvt_pk_bf16(float lo, float hi) { unsigned r; asm volatile("v_cvt_pk_bf16_f32 %0, %1, %2" : "=v"(r) : "v"(lo), "v"(hi)); return r; }
__device__ __forceinline__ float fsigmoid(float x) { return __builtin_amdgcn_rcpf(1.0f + __expf(-x)); }
__device__ __forceinline__ float fsilu(float x) { return x * fsigmoid(x); }
__device__ __forceinline__ u32x4 pack8(const f32x4 a, const f32x4 b) { u32x4 w; w.x = cvt_pk_bf16(a[0], a[1]); w.y = cvt_pk_bf16(a[2], a[3]); w.z = cvt_pk_bf16(b[0], b[1]); w.w = cvt_pk_bf16(b[2], b[3]); return w; }
__device__ __forceinline__ float bf_lo(unsigned u) { return __builtin_bit_cast(float, u << 16); }
__device__ __forceinline__ float bf_hi(unsigned u) { return __builtin_bit_cast(float, u & 0xffff0000u); }

struct EpiInProj {
    static constexpr bool PERM = true, AFTER_DRAIN = false, CHAIN = false;
    bf16_t *CQ, *KV, *KI, *RQ, *GATES; float *WI, *CQSS; const float* LB;
    __device__ __forceinline__ void operator()(const f32x4 (&acc)[2][2][4][2], const Unit& u, int wr, int wc, int fr, int fq) const {
        const int row0 = u.pm * BM + wr * 64 + fr, pn = u.pn, cl = wc * 32 + 8 * fq;
        if (pn == 0) {
#pragma unroll
            for (int ai = 0; ai < 2; ++ai)
#pragma unroll
                for (int m = 0; m < 4; ++m) { const int row = row0 + ai * HALF + m * 16; float s = 0.f;
#pragma unroll
                    for (int bj = 0; bj < 2; ++bj) { const f32x4 a = acc[ai][bj][m][0], b = acc[ai][bj][m][1];
                        s += (a[0] * a[0] + a[1] * a[1]) + (a[2] * a[2] + a[3] * a[3]) + (b[0] * b[0] + b[1] * b[1]) + (b[2] * b[2] + b[3] * b[3]);
                        *(u32x4*)(CQ + (size_t)row * 256 + cl + bj * HALF) = pack8(a, b); }
                    s += __shfl_xor(s, 16); s += __shfl_xor(s, 32);
                    if (fq == 0) CQSS[(size_t)row * 4 + wc] = s; }
        } else if (pn == 1) {
#pragma unroll
            for (int ai = 0; ai < 2; ++ai)
#pragma unroll
                for (int m = 0; m < 4; ++m) { const int row = row0 + ai * HALF + m * 16;
#pragma unroll
                    for (int bj = 0; bj < 2; ++bj) *(u32x4*)(KV + (size_t)row * 256 + cl + bj * HALF) = pack8(acc[ai][bj][m][0], acc[ai][bj][m][1]); }
        } else if (pn == 2) {
#pragma unroll
            for (int ai = 0; ai < 2; ++ai)
#pragma unroll
                for (int m = 0; m < 4; ++m) { const int row = row0 + ai * HALF + m * 16;
                    if (wc < 2) *(u32x4*)(KI + (size_t)row * 64 + cl) = pack8(acc[ai][0][m][0], acc[ai][0][m][1]);
                    else if (wc == 2 && fq == 0) { *(f32x4*)(WI + (size_t)row * 8) = acc[ai][0][m][0]; *(f32x4*)(WI + (size_t)row * 8 + 4) = acc[ai][0][m][1]; } }
        } else if (pn <= 10) {
            const int kind = (pn - 3) >> 1, cb = ((pn - 3) & 1) * 256 + cl;
            bf16_t* dst = RQ + (size_t)kind * (size_t)(32u << 20);
#pragma unroll
            for (int bj = 0; bj < 2; ++bj) {
                f32x4 l0 = (f32x4){0.f, 0.f, 0.f, 0.f}, l1 = l0;
                if (kind == 1) { l0 = *(const f32x4*)(LB + cb + bj * HALF); l1 = *(const f32x4*)(LB + cb + bj * HALF + 4); }
#pragma unroll
                for (int ai = 0; ai < 2; ++ai)
#pragma unroll
                    for (int m = 0; m < 4; ++m) { const int row = row0 + ai * HALF + m * 16; f32x4 a = acc[ai][bj][m][0], b = acc[ai][bj][m][1];
                        if (kind == 0 || kind == 3) {
#pragma unroll
                            for (int j = 0; j < 4; ++j) { a[j] = fsilu(a[j]); b[j] = fsilu(b[j]); } }
                        else if (kind == 1) {
#pragma unroll
                            for (int j = 0; j < 4; ++j) { a[j] = __logf(l0[j] + (1.0f - l0[j]) * fsigmoid(a[j])); b[j] = __logf(l1[j] + (1.0f - l1[j]) * fsigmoid(b[j])); } }
                        *(u32x4*)(dst + (size_t)row * 512 + cb + bj * HALF) = pack8(a, b); }
            }
        } else {
            const int cb = (pn - 11) * 256 + cl;
#pragma unroll
            for (int ai = 0; ai < 2; ++ai)
#pragma unroll
                for (int m = 0; m < 4; ++m) { const int row = row0 + ai * HALF + m * 16;
#pragma unroll
                    for (int bj = 0; bj < 2; ++bj) { f32x4 a = acc[ai][bj][m][0], b = acc[ai][bj][m][1];
#pragma unroll
                        for (int j = 0; j < 4; ++j) { a[j] = fsigmoid(a[j]); b[j] = fsigmoid(b[j]); }
                        *(u32x4*)(GATES + (size_t)row * 2048 + cb + bj * HALF) = pack8(a, b); } }
        }
    }
};

struct EpiQ {
    static constexpr bool PERM = true, AFTER_DRAIN = false, CHAIN = false;
    bf16_t *Q; const float* CQSS;
    __device__ __forceinline__ void operator()(const f32x4 (&acc)[2][2][4][2], const Unit& u, int wr, int wc, int fr, int fq) const {
        const int row0 = u.pm * BM + wr * 64 + fr, pn = u.pn, cl = (pn & 1) * 256 + wc * 32 + 8 * fq;
        bf16_t* dst = Q + (pn < 2 ? (size_t)0 : (size_t)(32u << 20));
        const float sc = pn < 2 ? 0.125f : 1.0f;
#pragma unroll
        for (int ai = 0; ai < 2; ++ai)
#pragma unroll
            for (int m = 0; m < 4; ++m) { const int row = row0 + ai * HALF + m * 16;
                const f32x4 ss = *(const f32x4*)(CQSS + (size_t)row * 4);
                const float r = __builtin_amdgcn_rsqf(((ss[0] + ss[1]) + (ss[2] + ss[3])) * (1.0f / 256.0f) + 1e-6f) * sc;
#pragma unroll
                for (int bj = 0; bj < 2; ++bj) *(u32x4*)(dst + (size_t)row * 512 + cl + bj * HALF) = pack8(acc[ai][bj][m][0] * r, acc[ai][bj][m][1] * r); }
    }
};

template <int MODE> struct EpiBranch {
    static constexpr bool PERM = true, AFTER_DRAIN = false, CHAIN = false;
    bf16_t* MIX; const bf16_t* GATES;
    __device__ __forceinline__ void operator()(const f32x4 (&acc)[2][2][4][2], const Unit& u, int wr, int wc, int fr, int fq) const {
        const int row0 = u.pm * BM + wr * 64 + fr, cl = u.pn * 256 + wc * 32 + 8 * fq;
#pragma unroll
        for (int ai = 0; ai < 2; ++ai)
#pragma unroll
            for (int m = 0; m < 4; ++m) { const int row = row0 + ai * HALF + m * 16;
#pragma unroll
                for (int bj = 0; bj < 2; ++bj) { const int c = cl + bj * HALF;
                    const u32x4 g = *(const u32x4*)(GATES + (size_t)row * 2048 + MODE * 1024 + c);
                    f32x4 a = acc[ai][bj][m][0], b = acc[ai][bj][m][1];
                    a[0] *= bf_lo(g.x); a[1] *= bf_hi(g.x); a[2] *= bf_lo(g.y); a[3] *= bf_hi(g.y); b[0] *= bf_lo(g.z); b[1] *= bf_hi(g.z); b[2] *= bf_lo(g.w); b[3] *= bf_hi(g.w);
                    if (MODE == 1) { const u32x4 p = *(const u32x4*)(MIX + (size_t)row * 1024 + c);
                        a[0] += bf_lo(p.x); a[1] += bf_hi(p.x); a[2] += bf_lo(p.y); a[3] += bf_hi(p.y); b[0] += bf_lo(p.z); b[1] += bf_hi(p.z); b[2] += bf_lo(p.w); b[3] += bf_hi(p.w); }
                    *(u32x4*)(MIX + (size_t)row * 1024 + c) = pack8(a, b); } }
    }
};

struct EpiOut {
    static constexpr bool PERM = true, AFTER_DRAIN = false, CHAIN = false;
    const float* X; bf16_t* X1; bf16_t* XS; float* X1SS; const float* MOD; const float* CW2;
    __device__ __forceinline__ void operator()(const f32x4 (&acc)[2][2][4][2], const Unit& u, int wr, int wc, int fr, int fq) const {
        const int row0 = u.pm * BM + wr * 64 + fr, cl = u.pn * 256 + wc * 32 + 8 * fq, b = u.pm >> 5;
#pragma unroll
        for (int ai = 0; ai < 2; ++ai)
#pragma unroll
            for (int m = 0; m < 4; ++m) { const int row = row0 + ai * HALF + m * 16; float s = 0.f;
#pragma unroll
                for (int bj = 0; bj < 2; ++bj) { const int c = cl + bj * HALF;
                    const float* xp = X + (size_t)row * 1024 + c; const float* gp = MOD + b * 6144 + 2048 + c; const float* cp = CW2 + b * 1024 + c;
                    const f32x4 v0 = *(const f32x4*)(xp) + *(const f32x4*)(gp) * acc[ai][bj][m][0], v1 = *(const f32x4*)(xp + 4) + *(const f32x4*)(gp + 4) * acc[ai][bj][m][1];
                    *(u32x4*)(X1 + (size_t)row * 1024 + c) = pack8(v0, v1);
                    s += (v0[0] * v0[0] + v0[1] * v0[1]) + (v0[2] * v0[2] + v0[3] * v0[3]) + (v1[0] * v1[0] + v1[1] * v1[1]) + (v1[2] * v1[2] + v1[3] * v1[3]);
                    *(u32x4*)(XS + (size_t)row * 1024 + c) = pack8(v0 * *(const f32x4*)(cp), v1 * *(const f32x4*)(cp + 4)); }
                s += __shfl_xor(s, 16); s += __shfl_xor(s, 32);
                if (fq == 0) X1SS[(size_t)row * 16 + u.pn * 4 + wc] = s; }
    }
};

struct EpiGateUp {
    static constexpr bool PERM = true, AFTER_DRAIN = false, CHAIN = false;
    bf16_t* HID; const float* X1SS; const float* BGU;
    const PG8_LAS float* BL; int bl;
    const PG8_LAS float* R2L; int g0, pm7;
    __device__ __forceinline__ void operator()(const f32x4 (&acc)[2][2][4][2], const Unit& u, int wr, int wc, int fr, int fq) const {
        const int row0 = u.pm * BM + wr * 64 + fr, cl = wc * 32 + 8 * fq, b = u.pm >> 5;
        const int slot = (u.pm >> 3) - g0; const bool cached = slot >= 0 && slot < 4 && (u.pm & 7) == pm7;
        f32x4 bg0, bg1, bu0, bu1;
        if (b == bl) { const PG8_LAS float* bp = BL + u.pn * 256 + cl; bg0 = *(const PG8_LAS f32x4*)(bp); bg1 = *(const PG8_LAS f32x4*)(bp + 4); bu0 = *(const PG8_LAS f32x4*)(bp + 128); bu1 = *(const PG8_LAS f32x4*)(bp + 132); }
        else { const float* bp = BGU + b * 5632 + u.pn * 256 + cl; bg0 = *(const f32x4*)(bp); bg1 = *(const f32x4*)(bp + 4); bu0 = *(const f32x4*)(bp + 128); bu1 = *(const f32x4*)(bp + 132); }
#pragma unroll
        for (int ai = 0; ai < 2; ++ai)
#pragma unroll
            for (int m = 0; m < 4; ++m) { const int row = row0 + ai * HALF + m * 16;
                float r = R2L[(cached ? slot : 0) * 256 + wr * 64 + fr + ai * HALF + m * 16];
                if (!cached) { float s = 0.f;
#pragma unroll
                    for (int q = 0; q < 4; ++q) { const f32x4 t = *(const f32x4*)(X1SS + (size_t)row * 16 + 4 * q); s += (t[0] + t[1]) + (t[2] + t[3]); }
                    r = __builtin_amdgcn_rsqf(s * (1.0f / 1024.0f) + 1e-6f); }
                f32x4 g0v = acc[ai][0][m][0] * r + bg0, g1v = acc[ai][0][m][1] * r + bg1; const f32x4 u0 = acc[ai][1][m][0] * r + bu0, u1 = acc[ai][1][m][1] * r + bu1;
#pragma unroll
                for (int j = 0; j < 4; ++j) { g0v[j] = fsilu(g0v[j]) * u0[j]; g1v[j] = fsilu(g1v[j]) * u1[j]; }
                *(u32x4*)(HID + (size_t)row * 2816 + u.pn * 128 + cl) = pack8(g0v, g1v); }
    }
};

struct EpiDown {
    static constexpr bool PERM = true, AFTER_DRAIN = false, CHAIN = false;
    const bf16_t* X1; float* OUT; float* X2SS; const float* MOD;
    __device__ __forceinline__ void operator()(const f32x4 (&acc)[2][2][4][2], const Unit& u, int wr, int wc, int fr, int fq) const {
        const int row0 = u.pm * BM + wr * 64 + fr, cl = u.pn * 256 + wc * 32 + 8 * fq, b = u.pm >> 5;
#pragma unroll
        for (int ai = 0; ai < 2; ++ai)
#pragma unroll
            for (int m = 0; m < 4; ++m) { const int row = row0 + ai * HALF + m * 16; float s = 0.f;
#pragma unroll
                for (int bj = 0; bj < 2; ++bj) { const int c = cl + bj * HALF;
                    const u32x4 xb = *(const u32x4*)(X1 + (size_t)row * 1024 + c);
                    const f32x4 x0 = (f32x4){bf_lo(xb.x), bf_hi(xb.x), bf_lo(xb.y), bf_hi(xb.y)}, x1 = (f32x4){bf_lo(xb.z), bf_hi(xb.z), bf_lo(xb.w), bf_hi(xb.w)};
                    const f32x4 v0 = x0 + *(const f32x4*)(MOD + b * 6144 + 5120 + c) * acc[ai][bj][m][0], v1 = x1 + *(const f32x4*)(MOD + b * 6144 + 5120 + c + 4) * acc[ai][bj][m][1];
                    *(f32x4*)(OUT + (size_t)row * 1024 + c) = v0; *(f32x4*)(OUT + (size_t)row * 1024 + c + 4) = v1;
                    s += (v0[0] * v0[0] + v0[1] * v0[1]) + (v0[2] * v0[2] + v0[3] * v0[3]) + (v1[0] * v1[0] + v1[1] * v1[1]) + (v1[2] * v1[2] + v1[3] * v1[3]); }
                s += __shfl_xor(s, 16); s += __shfl_xor(s, 32);
                if (fq == 0) X2SS[(size_t)row * 16 + u.pn * 4 + wc] = s; }
    }
};


struct ChainOrder : StaticOrder {
    __device__ bool next(int i, Unit& u) const { Unit t; if (!StaticOrder::next(i >> 1, t)) return false; u.pm = t.pm + ((i & 1) ? 256 : 0); u.pn = t.pn + ((i & 1) ? 4 : 0); return true; }
};
struct EpiBranchChain {
    static constexpr bool PERM = true, AFTER_DRAIN = false, CHAIN = true;
    bf16_t* MIX; const bf16_t* GATES;
    __device__ __forceinline__ bool chain(f32x4 (&acc)[2][2][4][2], const Unit& u, int wr, int wc, int fr, int fq) const {
        const bool second = u.pm >= 256; const int pm = second ? u.pm - 256 : u.pm, pn = second ? u.pn - 4 : u.pn;
        const int row0 = pm * BM + wr * 64 + fr, cl = pn * 256 + wc * 32 + 8 * fq;
#pragma unroll
        for (int ai = 0; ai < 2; ++ai)
#pragma unroll
            for (int m = 0; m < 4; ++m) { const int row = row0 + ai * HALF + m * 16;
#pragma unroll
                for (int bj = 0; bj < 2; ++bj) { const int c = cl + bj * HALF;
                    const u32x4 gr = *(const u32x4*)(GATES + (size_t)row * 2048 + 1024 + c);
                    float r[8] = {bf_lo(gr.x), bf_hi(gr.x), bf_lo(gr.y), bf_hi(gr.y), bf_lo(gr.z), bf_hi(gr.z), bf_lo(gr.w), bf_hi(gr.w)};
#pragma unroll
                    for (int j = 0; j < 8; ++j) r[j] = fmaxf(r[j], 1e-30f);
                    if (!second) { const u32x4 ga = *(const u32x4*)(GATES + (size_t)row * 2048 + c);
                        const float a[8] = {bf_lo(ga.x), bf_hi(ga.x), bf_lo(ga.y), bf_hi(ga.y), bf_lo(ga.z), bf_hi(ga.z), bf_lo(ga.w), bf_hi(ga.w)};
#pragma unroll
                        for (int j = 0; j < 4; ++j) { acc[ai][bj][m][0][j] *= a[j] * __builtin_amdgcn_rcpf(r[j]); acc[ai][bj][m][1][j] *= a[4 + j] * __builtin_amdgcn_rcpf(r[4 + j]); } }
                    else { f32x4 v0 = acc[ai][bj][m][0], v1 = acc[ai][bj][m][1];
#pragma unroll
                        for (int j = 0; j < 4; ++j) { v0[j] *= r[j]; v1[j] *= r[4 + j]; }
                        *(u32x4*)(MIX + (size_t)row * 1024 + c) = pack8(v0, v1); } } }
        return !second;
    }
};
template <class Epi, class Sched, bool ALIGN_EPI = false, bool SP2 = false>
__device__ __forceinline__ void gemm_phase(PG8_LAS unsigned char* lds, const Gemm g, const Sched& S, const Epi& E) {
    const int tid = threadIdx.x, wid = __builtin_amdgcn_readfirstlane(tid >> 6), lane = tid & 63, wr = wid >> 2, wc = wid & 3, fr = lane & 15, fq = lane >> 4;
    const int K = g.K, nt = K / BK;
    unsigned voffA[2], voffB[2];
#pragma unroll
    for (int i = 0; i < 2; ++i) { int R, C; stage_rc(tid * 16 + i * 8192, R, C); const int Rb = Epi::PERM ? ((R & ~31) + perm32(R & 31)) : R;
        voffA[i] = (unsigned)(R * K + C) * 2u; voffB[i] = (unsigned)(Rb * K + C) * 2u; }
    const size_t kstep = (size_t)(BK * 2);
    const size_t hstep = (size_t)HALF * K * 2;
    const size_t tstep = 2 * hstep;
    const unsigned ldsw = (unsigned)wid * 1024u;
    const int aoff = lds_byte(wr * 64 + fr, fq * 8), boff = lds_byte(wc * 32 + fr, fq * 8);
#define PG8_SA(b, h) (((b) * 2 + (h)) * HTB)
#define PG8_SB(b, h) ((4 + (b) * 2 + (h)) * HTB)
#define PG8_STAGE(bufoff, gbase, voff) do { _Pragma("unroll") for (int _i = 0; _i < 2; ++_i) \
        __builtin_amdgcn_global_load_lds((const unsigned*)((const char*)(gbase) + (voff)[_i]), (PG8_LAS unsigned*)(lds + (bufoff) + ldsw + _i * 8192), 16, 0, 0); } while (0)
#define PG8_LDA(dst, b, h) do { _Pragma("unroll") for (int m = 0; m < 4; ++m) _Pragma("unroll") for (int k = 0; k < 2; ++k) dst[m][k] = *(const PG8_LAS bf16x8*)(lds + PG8_SA(b, h) + aoff + m * 2048 + k * 1024); } while (0)
#define PG8_LDB(dst, b, h) do { _Pragma("unroll") for (int n = 0; n < 2; ++n) _Pragma("unroll") for (int k = 0; k < 2; ++k) dst[n][k] = *(const PG8_LAS bf16x8*)(lds + PG8_SB(b, h) + boff + n * 2048 + k * 1024); } while (0)
#define PG8_MMA(ai, bj, At, Bt) do { __builtin_amdgcn_s_setprio(1); _Pragma("unroll") for (int m = 0; m < 4; ++m) _Pragma("unroll") for (int n = 0; n < 2; ++n) _Pragma("unroll") for (int k = 0; k < 2; ++k) \
        acc[ai][bj][m][n] = __builtin_amdgcn_mfma_f32_16x16x32_bf16(Bt[n][k], At[m][k], acc[ai][bj][m][n], 0, 0, 0); __builtin_amdgcn_s_setprio(0); } while (0)
#define PG8_WAIT_V(n) asm volatile("s_waitcnt vmcnt(" #n ")" ::: "memory")
#define PG8_WAIT_L(n) asm volatile("s_waitcnt lgkmcnt(" #n ")" ::: "memory")
#define PG8_BAR __builtin_amdgcn_s_barrier()
#define PG8_SCHED __builtin_amdgcn_sched_barrier(0)
    Unit cur, nxt; int ui = 0;
    if (!S.next(0, cur)) return;
    f32x4 acc[2][2][4][2];
#pragma unroll
    for (int a = 0; a < 2; ++a)
#pragma unroll
        for (int b = 0; b < 2; ++b)
#pragma unroll
            for (int m = 0; m < 4; ++m)
#pragma unroll
                for (int n = 0; n < 2; ++n) acc[a][b][m][n] = (f32x4){0.f, 0.f, 0.f, 0.f};
    bf16x8 At[4][2], B0[2][2], B1[2][2];
    const char* cA = (const char*)g.A + (size_t)cur.pm * tstep; const char* cB = (const char*)g.Bt + (size_t)cur.pn * tstep;
    S.a_ready(cur);
    if constexpr (SP2) {
        PG8_STAGE(PG8_SB(0, 0), cB, voffB); PG8_STAGE(PG8_SB(0, 1), cB + hstep, voffB); PG8_STAGE(PG8_SA(0, 0), cA, voffA); PG8_STAGE(PG8_SA(0, 1), cA + hstep, voffA);
        if (wr == 1) PG8_BAR;
        PG8_WAIT_V(2); PG8_BAR;
        PG8_STAGE(PG8_SB(1, 0), cB + kstep, voffB); PG8_STAGE(PG8_SA(1, 0), cA + kstep, voffA); PG8_STAGE(PG8_SB(1, 1), cB + hstep + kstep, voffB);
        PG8_WAIT_V(6); PG8_BAR;
    } else {
        PG8_STAGE(PG8_SB(0, 0), cB, voffB); PG8_STAGE(PG8_SA(0, 0), cA, voffA); PG8_STAGE(PG8_SB(0, 1), cB + hstep, voffB); PG8_STAGE(PG8_SA(0, 1), cA + hstep, voffA);
        if (wr == 1) PG8_BAR;
        PG8_WAIT_V(4); PG8_BAR;
        PG8_STAGE(PG8_SB(1, 0), cB + kstep, voffB); PG8_STAGE(PG8_SA(1, 0), cA + kstep, voffA); PG8_STAGE(PG8_SB(1, 1), cB + hstep + kstep, voffB);
        PG8_WAIT_V(6); PG8_BAR;
    }
    for (;;) {
        const bool has_next = S.next(ui + 1, nxt);
        const char* nA = has_next ? (const char*)g.A + (size_t)nxt.pm * tstep : cA; const char* nB = has_next ? (const char*)g.Bt + (size_t)nxt.pn * tstep : cB;
        for (int t = 0; t < nt; t += 2) {
            const bool last = (t == nt - 2);
            const char* a1 = cA + (size_t)(t + 1) * kstep;
            const char* a2 = last ? nA : cA + (size_t)(t + 2) * kstep; const char* b2 = last ? nB : cB + (size_t)(t + 2) * kstep;
            const char* a3 = a2 + kstep; const char* b3 = b2 + kstep;
            if (last && has_next) S.a_ready(nxt);
            if constexpr (SP2) {
            PG8_LDB(B0, 0, 0); PG8_LDB(B1, 0, 1); PG8_SCHED; PG8_LDA(At, 0, 0); PG8_STAGE(PG8_SA(1, 1), a1 + hstep, voffA);
            PG8_WAIT_V(8); PG8_WAIT_L(0); PG8_BAR; PG8_MMA(0, 0, At, B0); PG8_MMA(0, 1, At, B1); PG8_BAR; PG8_SCHED;
            PG8_LDA(At, 0, 1); PG8_STAGE(PG8_SB(0, 0), b2, voffB); PG8_STAGE(PG8_SB(0, 1), b2 + hstep, voffB); PG8_STAGE(PG8_SA(0, 0), a2, voffA);
            PG8_WAIT_V(8); PG8_WAIT_L(0); PG8_BAR; PG8_MMA(1, 0, At, B0); PG8_MMA(1, 1, At, B1); PG8_BAR; PG8_SCHED;
            PG8_LDB(B0, 1, 0); PG8_LDB(B1, 1, 1); PG8_SCHED; PG8_LDA(At, 1, 0); PG8_STAGE(PG8_SA(0, 1), a2 + hstep, voffA);
            PG8_WAIT_V(8); PG8_WAIT_L(0); PG8_BAR; PG8_MMA(0, 0, At, B0); PG8_MMA(0, 1, At, B1); PG8_BAR; PG8_SCHED;
            PG8_LDA(At, 1, 1); PG8_STAGE(PG8_SB(1, 0), b3, voffB); PG8_STAGE(PG8_SB(1, 1), b3 + hstep, voffB); PG8_STAGE(PG8_SA(1, 0), a3, voffA);
            PG8_WAIT_V(8); PG8_WAIT_L(0); PG8_BAR; PG8_MMA(1, 0, At, B0); PG8_MMA(1, 1, At, B1); PG8_BAR; PG8_SCHED;
            } else {
            PG8_LDB(B0, 0, 0); PG8_SCHED; PG8_LDA(At, 0, 0); PG8_STAGE(PG8_SA(1, 1), a1 + hstep, voffA);
            PG8_WAIT_L(8); PG8_BAR; PG8_WAIT_L(0); PG8_MMA(0, 0, At, B0); PG8_BAR; PG8_SCHED;
            PG8_LDB(B1, 0, 1); PG8_STAGE(PG8_SB(0, 0), b2, voffB);
            PG8_BAR; PG8_WAIT_L(0); PG8_MMA(0, 1, At, B1); PG8_BAR;
            PG8_LDA(At, 0, 1); PG8_STAGE(PG8_SA(0, 0), a2, voffA);
            PG8_BAR; PG8_WAIT_L(0); PG8_MMA(1, 0, At, B0); PG8_BAR; PG8_SCHED;
            PG8_STAGE(PG8_SB(0, 1), b2 + hstep, voffB);
            PG8_WAIT_V(6); PG8_BAR; PG8_MMA(1, 1, At, B1); PG8_BAR;
            PG8_LDB(B0, 1, 0); PG8_SCHED; PG8_LDA(At, 1, 0); PG8_STAGE(PG8_SA(0, 1), a2 + hstep, voffA);
            PG8_WAIT_L(8); PG8_BAR; PG8_WAIT_L(0); PG8_MMA(0, 0, At, B0); PG8_BAR; PG8_SCHED;
            PG8_LDB(B1, 1, 1); PG8_STAGE(PG8_SB(1, 0), b3, voffB);
            PG8_BAR; PG8_WAIT_L(0); PG8_MMA(0, 1, At, B1); PG8_BAR;
            PG8_LDA(At, 1, 1); PG8_STAGE(PG8_SA(1, 0), a3, voffA);
            PG8_BAR; PG8_WAIT_L(0); PG8_MMA(1, 0, At, B0); PG8_BAR; PG8_SCHED;
            PG8_STAGE(PG8_SB(1, 1), b3 + hstep, voffB);
            PG8_WAIT_V(6); PG8_BAR; PG8_MMA(1, 1, At, B1); PG8_BAR;
            }
        }
        if constexpr (ALIGN_EPI) { if (wr == 0) PG8_BAR; }
        bool keep_acc = false;
        if constexpr (Epi::CHAIN) { keep_acc = E.chain(acc, cur, wr, wc, fr, fq); S.done(cur); }
        else if constexpr (!Epi::AFTER_DRAIN) { E(acc, cur, wr, wc, fr, fq); S.done(cur); }
        if (!has_next) break;
        if (!keep_acc)
#pragma unroll
        for (int a = 0; a < 2; ++a)
#pragma unroll
            for (int b = 0; b < 2; ++b)
#pragma unroll
                for (int m = 0; m < 4; ++m)
#pragma unroll
                    for (int n = 0; n < 2; ++n) acc[a][b][m][n] = (f32x4){0.f, 0.f, 0.f, 0.f};
        cur = nxt; cA = nA; cB = nB; ++ui;
        if constexpr (ALIGN_EPI) { if (wr == 1) PG8_BAR; }
    }
    PG8_WAIT_V(0);
    if constexpr (!ALIGN_EPI) { if (wr == 0) PG8_BAR; }
    PG8_BAR;
    if constexpr (Epi::AFTER_DRAIN) { E.fused(acc, cur, wr, wc, fr, fq, lds, wid, lane); S.done(cur); }
#undef PG8_SA
#undef PG8_SB
#undef PG8_STAGE
#undef PG8_LDA
#undef PG8_LDB
#undef PG8_MMA
#undef PG8_WAIT_V
#undef PG8_WAIT_L
#undef PG8_BAR
#undef PG8_SCHED
}
}
#ifndef PG8_SP2
#define PG8_SP2 true
#endif
#ifndef PG8_ALIGN
#define PG8_ALIGN true
#endif

constexpr int NWAVES = 8;
#ifndef MK_N_LAUNCHES
#define MK_N_LAUNCHES 1
#endif
constexpr int N_PHASES = 11;
constexpr int N_LAUNCHES = MK_N_LAUNCHES;
static_assert(N_LAUNCHES == 1 || N_LAUNCHES == N_PHASES, "MK_N_LAUNCHES is 1 or N_PHASES");

constexpr int NB = 8, SEQ = 8192, D = 1024, M = NB * SEQ;
constexpr int NPROJ = 4680, NPROJ_PAD = 4864, FF = 2816, NGU = 2 * FF;
constexpr float EPS = 1e-6f;

constexpr size_t MiB = 1u << 20;
constexpr size_t WS_CTL = 0, CTL_ZERO_BYTES = 1 * MiB;
constexpr size_t WS_MOD = 1 * MiB;
constexpr size_t WS_LB = WS_MOD + 256 * 1024;
constexpr size_t WS_CW2 = WS_MOD + 320 * 1024;
constexpr size_t WS_BGU = WS_MOD + 512 * 1024;
constexpr size_t WS_WIN = 3 * MiB, WS_WQ = 13 * MiB, WS_WBA = 14 * MiB, WS_WBR = 15 * MiB, WS_WOUT = 16 * MiB, WS_WGU = 18 * MiB, WS_WD = 29 * MiB;
constexpr size_t WS_CQSS = 35 * MiB, WS_X1SS = 36 * MiB, WS_X2SS = 40 * MiB;
constexpr size_t WS_XN = 64 * MiB;
constexpr size_t WS_CQ = 192 * MiB, WS_KV = 224 * MiB, WS_KI = 256 * MiB, WS_WI = 264 * MiB;
constexpr size_t WS_RQ = 272 * MiB, WS_RGL = 336 * MiB, WS_RI = 400 * MiB, WS_RGS = 464 * MiB;
constexpr size_t WS_Q = 528 * MiB, WS_QI = 592 * MiB;
constexpr size_t WS_ATT = 64 * MiB, WS_REC = 128 * MiB;
constexpr size_t WS_SCR = 656 * MiB;
constexpr size_t WS_OLOC = 784 * MiB, WS_QHAT = 848 * MiB, WS_U = 912 * MiB, WS_DS = 928 * MiB;
constexpr size_t WS_MIX = 896 * MiB;
constexpr size_t WS_X1 = 64 * MiB, WS_XS = 320 * MiB, WS_HID = 448 * MiB;
constexpr size_t WS_END = 1024 * MiB;
static_assert(WS_REC == WS_ATT + 64 * MiB && WS_WBR == WS_WBA + 1 * MiB, "the chained branch GEMM views [attn ; rec] and [Wa ; Wr] as one operand each");
static_assert(WS_RGL == WS_RQ + 64 * MiB && WS_RI == WS_RQ + 128 * MiB && WS_RGS == WS_RQ + 192 * MiB && WS_QI == WS_Q + 64 * MiB, "epilogue pointer arithmetic");
static_assert(WS_HID + (size_t)M * FF * 2 <= WS_END && WS_DS + 256 * 128 * 4 <= WS_END, "map");

constexpr int CW_TMO = 0, CW_CODE = 1;
constexpr int CW_BAR = 4096;

constexpr int RING_OFF = 0, RING_BYTES = 131072;
constexpr int LDS_BYTES = 163840;
constexpr int LDSCTL_OFF = LDS_BYTES - 1024, MISC_OFF = LDSCTL_OFF + 320;
static_assert(MISC_OFF + 128 <= LDS_BYTES, "LDS map");

#define GAS __attribute__((address_space(1)))
#define LAS __attribute__((address_space(3)))
typedef unsigned short bf16;
typedef unsigned v4u __attribute__((ext_vector_type(4)));
typedef unsigned v2u __attribute__((ext_vector_type(2)));
typedef float f32x4 __attribute__((ext_vector_type(4)));
typedef float f32x16 __attribute__((ext_vector_type(16)));
typedef short bf16x8 __attribute__((ext_vector_type(8)));
typedef GAS unsigned gu32;
#define RLX_AGENT __ATOMIC_RELAXED, __HIP_MEMORY_SCOPE_AGENT
#define LDS_WAIT() asm volatile("s_waitcnt lgkmcnt(0)" ::: "memory")
#define VM_WAIT() asm volatile("s_waitcnt vmcnt(0)" ::: "memory")
typedef float f32x2_t __attribute__((ext_vector_type(2)));
typedef __bf16 bf16x2_t __attribute__((ext_vector_type(2)));
__device__ __forceinline__ unsigned pk2(float lo, float hi) { const f32x2_t v = {lo, hi}; const bf16x2_t b = __builtin_convertvector(v, bf16x2_t); return __builtin_bit_cast(unsigned, b); }
__device__ __forceinline__ unsigned f2bf(float f) { return pk2(f, 0.f) & 0xffffu; }
__device__ __forceinline__ float bflo(unsigned u) { return __builtin_bit_cast(float, u << 16); }
__device__ __forceinline__ float bfhi(unsigned u) { return __builtin_bit_cast(float, u & 0xffff0000u); }
__device__ __forceinline__ float bf1(bf16 h) { return __builtin_bit_cast(float, (unsigned)h << 16); }

#define XB_TMO      128
#define XB_XCNT(j)  (256  + 64 * (j))
#define XB_XSUB(j)  (1280 + 64 * (j))
#define XB_XGEN(j)  (2304 + 64 * (j))
#define XB_TOP      3328
#define XB_TOPGEN   3392
#define XCD_BAR_WORDS 3456
#define XB_SPIN_CAP (1u << 23)

__device__ __forceinline__ unsigned xb_ld(unsigned* p)              { return __hip_atomic_load(p, __ATOMIC_RELAXED, __HIP_MEMORY_SCOPE_AGENT); }
__device__ __forceinline__ unsigned xb_add(unsigned* p, unsigned v) { return __hip_atomic_fetch_add(p, v, __ATOMIC_RELAXED, __HIP_MEMORY_SCOPE_AGENT); }
__device__ __forceinline__ unsigned xb_xcc_id() { return (unsigned)__builtin_amdgcn_s_getreg((3 << 11) | 20) & 0xFu; }
#define XB_SPIN(cond, bar) do { unsigned _sp = 0; while (cond) { __builtin_amdgcn_s_sleep(1); \
    if ((++_sp & 255u) == 0u) { if (xb_ld(&(bar)[XB_TMO])) break; if (_sp > XB_SPIN_CAP) { atomicAdd(&(bar)[XB_TMO], 1u); break; } } } } while (0)

struct XcdBarrier { unsigned* bar; unsigned x; volatile LAS unsigned* st; };

__device__ __forceinline__ XcdBarrier xcd_barrier_post(unsigned* bar, volatile LAS unsigned* st) {
    XcdBarrier b; b.bar = bar; b.x = xb_xcc_id(); b.st = st;
    if (threadIdx.x == 0) (void)xb_add(&bar[XB_XCNT(b.x)], 1u);
    return b;
}
__device__ __forceinline__ void xcd_barrier_complete(unsigned* bar, unsigned x, unsigned& nloc, unsigned& nx) {
    const unsigned G = gridDim.x * gridDim.y * gridDim.z;
    unsigned sum, cnt, mine, sp = 0u;
    for (;;) {
        sum = 0u; cnt = 0u; mine = 0u;
#pragma unroll
        for (unsigned j = 0; j < 16; ++j) { const unsigned c = xb_ld(&bar[XB_XCNT(j)]); sum += c; cnt += (c > 0u) ? 1u : 0u; mine = (j == x) ? c : mine; }
        if (sum == G) break;
        __builtin_amdgcn_s_sleep(1);
        if ((++sp & 255u) == 0u) { if (xb_ld(&bar[XB_TMO])) break; if (sp > XB_SPIN_CAP) { atomicAdd(&bar[XB_TMO], 1u); break; } }
    }
    nloc = mine > 0u ? mine : 1u; nx = cnt > 0u ? cnt : 1u;
}
__device__ __forceinline__ void xcd_barrier(const XcdBarrier& b) {
    asm volatile("s_waitcnt vmcnt(0)" ::: "memory");
    __syncthreads();
    if (threadIdx.x == 0) {
        unsigned* bar = b.bar;
        __builtin_amdgcn_s_waitcnt(0);
        unsigned nloc = b.st[0], nx = b.st[1];
        if (nloc == 0u) { xcd_barrier_complete(bar, b.x, nloc, nx); b.st[0] = nloc; b.st[1] = nx; }
        const unsigned old = xb_add(&bar[XB_XSUB(b.x)], 1u);
        const unsigned gen = old / nloc;
        if (old + 1u == (gen + 1u) * nloc) {
            __builtin_amdgcn_fence(__ATOMIC_RELEASE, "agent");
            asm volatile("s_waitcnt vmcnt(0)" ::: "memory");
            const unsigned og = xb_add(&bar[XB_TOP], 1u);
            const unsigned tg = og / nx;
            if (og + 1u == (tg + 1u) * nx) xb_add(&bar[XB_TOPGEN], 1u);
            else XB_SPIN(xb_ld(&bar[XB_TOPGEN]) == tg, bar);
            __builtin_amdgcn_fence(__ATOMIC_ACQUIRE, "agent");
            xb_add(&bar[XB_XGEN(b.x)], 1u);
            asm volatile("s_waitcnt vmcnt(0)" ::: "memory");
        } else {
            XB_SPIN(xb_ld(&bar[XB_XGEN(b.x)]) == gen, bar);
            __builtin_amdgcn_fence(__ATOMIC_ACQUIRE, "agent");
            asm volatile("s_waitcnt vmcnt(0)" ::: "memory");
        }
    }
    __syncthreads();
}

struct Frame {
    LAS unsigned char* lds;
    volatile LAS unsigned* MISC;
    gu32* ctl;
    unsigned char* ws;
    int tid, lane, wave;
    int G;
    float* out;
};
__device__ __forceinline__ float wave_sum(float v) {
#pragma unroll
    for (int o = 1; o < 64; o <<= 1) v += __shfl_xor(v, o);
    return v;
}
__device__ __forceinline__ float wave_max(float v) {
#pragma unroll
    for (int o = 1; o < 64; o <<= 1) v = fmaxf(v, __shfl_xor(v, o));
    return v;
}

template <class SrcCol>
__device__ __forceinline__ void transpose_item(const float* W, int ldw, int K, bf16* WT, const float* ks, LAS float* scr, int item, int nblk, int lane, SrcCol src) {
    const int kb = item / nblk, nb = item % nblk, k0 = 64 * kb, n0 = 32 * nb;
    const float* Wp; const int sc = src(n0 + (lane & 31), Wp);
#pragma unroll 8
    for (int i = 0; i < 32; ++i) { const int kk = 2 * i + (lane >> 5); float v = 0.f; if (sc >= 0) { v = Wp[(size_t)(k0 + kk) * ldw + sc]; if (ks) v *= ks[k0 + kk]; } scr[kk * 33 + (lane & 31)] = v; }
    LDS_WAIT(); asm volatile("" ::: "memory");
    const int c = lane & 7;
#pragma unroll
    for (int j = 0; j < 4; ++j) { const int n = (lane >> 3) + 8 * j; const LAS float* s = scr + (8 * c) * 33 + n;
        v4u o; o.x = pk2(s[0 * 33], s[1 * 33]); o.y = pk2(s[2 * 33], s[3 * 33]); o.z = pk2(s[4 * 33], s[5 * 33]); o.w = pk2(s[6 * 33], s[7 * 33]);
        *(GAS v4u*)(WT + (size_t)(n0 + n) * K + k0 + 8 * c) = o; }
    LDS_WAIT(); asm volatile("" ::: "memory");
}
struct Args { const float* in[20]; float* out; unsigned char* ws; int ph_lo, ph_hi; };
template <class SrcCol>
__device__ __forceinline__ void gemv8(Frame& F, const LAS float* vec, int cpg, int ngrp, int ldw, SrcCol src, const float* bias, float* out, int ldo) {
    LAS float* red = (LAS float*)(F.lds + 32768);
    for (int jb = blockIdx.x; jb < ngrp; jb += F.G) {
        const int col = F.tid & 31, kg = F.tid >> 5; float a[8];
#pragma unroll
        for (int b = 0; b < 8; ++b) a[b] = 0.f;
        const float* Wp = nullptr; int sc = -1;
        if (col < cpg) sc = src(jb * cpg + col, Wp);
        if (sc >= 0) for (int k = kg * 64; k < kg * 64 + 64; ++k) { const float w = Wp[(size_t)k * ldw + sc];
#pragma unroll
            for (int b = 0; b < 8; ++b) a[b] += vec[b * 1024 + k] * w; }
#pragma unroll
        for (int b = 0; b < 8; ++b) red[(kg * 8 + b) * 32 + col] = a[b];
        __syncthreads();
        if (F.tid < 256) { const int b = F.tid >> 5, c2 = F.tid & 31;
            if (c2 < cpg) { float s = 0.f; for (int k2 = 0; k2 < 16; ++k2) s += red[(k2 * 8 + b) * 32 + c2]; const int jj = jb * cpg + c2; out[b * ldo + jj] = s + (bias ? bias[jj] : 0.f); } }
        __syncthreads();
    }
}
struct SrcWin { const float* W; __device__ __forceinline__ int operator()(int d, const float*& Wp) const { Wp = W; return d < 584 ? d : (d < 768 ? -1 : d - 184); } };
__device__ __forceinline__ const float* psel(const float* a, const float* b, bool takeb) { const unsigned long long x = (unsigned long long)a, y = (unsigned long long)b, m = takeb ? ~0ull : 0ull; return (const float*)(x ^ ((x ^ y) & m)); }
struct SrcWq { const float *Wa, *Wb; __device__ __forceinline__ int operator()(int d, const float*& Wp) const { Wp = psel(Wa, Wb, d >= 512); return d & 511; } };
struct SrcId { const float* W; __device__ __forceinline__ int operator()(int d, const float*& Wp) const { Wp = W; return d; } };
struct SrcGu { const float *Wg, *Wu; __device__ __forceinline__ int operator()(int d, const float*& Wp) const { const int t = d >> 8, w = d & 255; Wp = psel(Wg, Wu, w >= 128); return t * 128 + (w & 127); } };

__device__ __forceinline__ void p0_prologue(Frame& F, const Args& A) {
    LAS float* cact = (LAS float*)(F.lds);
    for (int i = F.tid; i < 8192; i += NWAVES * 64) { const float v = A.in[1][i]; cact[i] = v / (1.0f + __expf(-v)); }
    __syncthreads();
    gemv8(F, cact, 24, 256, 6144, SrcId{A.in[2]}, A.in[3], (float*)(F.ws + WS_MOD), 6144);
    if (blockIdx.x == 0) { const float* l = A.in[10]; float* LB = (float*)(F.ws + WS_LB);
        for (int c = F.tid; c < 512; c += NWAVES * 64) LB[c] = 1.0f / (1.0f + __expf(l[512 + c] - l[c])); }
    __syncthreads();
    LAS float* scr = (LAS float*)(F.lds + 49152 + F.wave * 8448);
    const int gw = blockIdx.x * NWAVES + F.wave, NGW = F.G * NWAVES;
    constexpr int I_IN = 16 * 152, I_Q = 4 * 32, I_BA = 8 * 32, I_BR = 8 * 32, I_O = 16 * 32, I_GU = 16 * 176, I_D = 44 * 32;
    constexpr int NITEMS = I_IN + I_Q + I_BA + I_BR + I_O + I_GU + I_D;
    for (int it = gw; it < NITEMS; it += NGW) {
        int r = it;
        if (r < I_IN) { transpose_item(A.in[5], NPROJ, 1024, (bf16*)(F.ws + WS_WIN), nullptr, scr, r, 152, F.lane, SrcWin{A.in[5]}); continue; } r -= I_IN;
        if (r < I_Q) { transpose_item(nullptr, 512, 256, (bf16*)(F.ws + WS_WQ), A.in[6], scr, r, 32, F.lane, SrcWq{A.in[7], A.in[8]}); continue; } r -= I_Q;
        if (r < I_BA) { transpose_item(nullptr, 1024, 512, (bf16*)(F.ws + WS_WBA), nullptr, scr, r, 32, F.lane, SrcId{A.in[12]}); continue; } r -= I_BA;
        if (r < I_BR) { transpose_item(nullptr, 1024, 512, (bf16*)(F.ws + WS_WBR), nullptr, scr, r, 32, F.lane, SrcId{A.in[13]}); continue; } r -= I_BR;
        if (r < I_O) { transpose_item(nullptr, 1024, 1024, (bf16*)(F.ws + WS_WOUT), nullptr, scr, r, 32, F.lane, SrcId{A.in[14]}); continue; } r -= I_O;
        if (r < I_GU) { transpose_item(nullptr, FF, 1024, (bf16*)(F.ws + WS_WGU), nullptr, scr, r, 176, F.lane, SrcGu{A.in[16], A.in[17]}); continue; } r -= I_GU;
        transpose_item(nullptr, 1024, FF, (bf16*)(F.ws + WS_WD), nullptr, scr, r, 32, F.lane, SrcId{A.in[18]});
    }
}

__device__ __forceinline__ void p1_norm(Frame& F, const Args& A) {
    const float* MOD = (const float*)(F.ws + WS_MOD);
    { float* CW2 = (float*)(F.ws + WS_CW2); const int g = blockIdx.x * (NWAVES * 64) + F.tid;
      if (g < 8192) { const int b = g >> 10, c = g & 1023; CW2[g] = A.in[15][c] * (1.0f + MOD[b * 6144 + 4096 + c]); } }
    { LAS float* sh2 = (LAS float*)(F.lds);
      for (int i = F.tid; i < 8192; i += NWAVES * 64) sh2[i] = MOD[(i >> 10) * 6144 + 3072 + (i & 1023)];
      __syncthreads();
      gemv8(F, sh2, 22, 256, FF, SrcGu{A.in[16], A.in[17]}, nullptr, (float*)(F.ws + WS_BGU), NGU); }
    const int gw = blockIdx.x * NWAVES + F.wave, NGW = F.G * NWAVES; bf16* XN = (bf16*)(F.ws + WS_XN);
    for (int m0 = gw; m0 < M; m0 += 4 * NGW) {
        f32x4 v[4][4]; float r[4];
#pragma unroll
        for (int k = 0; k < 4; ++k) { const int m = m0 + k * NGW < M ? m0 + k * NGW : m0; const GAS f32x4* xr = (const GAS f32x4*)(A.in[0] + (size_t)m * D) + F.lane;
#pragma unroll
            for (int j = 0; j < 4; ++j) v[k][j] = xr[64 * j]; }
#pragma unroll
        for (int k = 0; k < 4; ++k) { float s = 0.f;
#pragma unroll
            for (int j = 0; j < 4; ++j) s += (v[k][j].x * v[k][j].x + v[k][j].y * v[k][j].y) + (v[k][j].z * v[k][j].z + v[k][j].w * v[k][j].w);
            r[k] = 1.0f / sqrtf(wave_sum(s) * (1.0f / D) + EPS); }
#pragma unroll
        for (int k = 0; k < 4; ++k) { const int m = m0 + k * NGW; if (m < M) { const int b = m >> 13;
            GAS unsigned long long* o8 = (GAS unsigned long long*)(XN + (size_t)m * D) + F.lane;
#pragma unroll
            for (int j = 0; j < 4; ++j) { const int c = 4 * F.lane + 256 * j;
                const f32x4 w = *(const f32x4*)(A.in[4] + c), sc = *(const f32x4*)(MOD + b * 6144 + 1024 + c), sh = *(const f32x4*)(MOD + b * 6144 + c);
                const f32x4 y = v[k][j] * r[k] * w * (sc + 1.0f) + sh;
                o8[64 * j] = (unsigned long long)pk2(y.x, y.y) | ((unsigned long long)pk2(y.z, y.w) << 32); } } }
    }
}

constexpr int H_QC = 0, H_QB = 17408, H_K = 34816, H_KT = 78336, H_VT = 96768, H_PM = 115200, H_ST = 124416, H_BT = 159232, H_AL = 161280;
constexpr int HS128 = 272, HS64 = 144;
__device__ __forceinline__ unsigned short f2bfs(float f) { return (unsigned short)f2bf(f); }
__device__ __forceinline__ void hgrn_h1_unit(Frame& F, int unit) {
    const int b = unit >> 5, h = (unit >> 3) & 3, n = unit & 7;
    const int tid = F.tid, lane = F.lane, w = F.wave, c = tid & 127, bi = tid >> 7, l15 = lane & 15, l4 = lane >> 4;
    const size_t rowbase = (size_t)(b * SEQ + n * 1024) * 512 + h * 128;
    const bf16* RQ = (const bf16*)(F.ws + WS_RQ) + rowbase; const bf16* RGL = (const bf16*)(F.ws + WS_RGL) + rowbase; const bf16* RI = (const bf16*)(F.ws + WS_RI) + rowbase;
    bf16* OLOC = (bf16*)(F.ws + WS_OLOC) + rowbase; bf16* QHAT = (bf16*)(F.ws + WS_QHAT) + rowbase;
    LAS unsigned char* L = F.lds; LAS float* BT = (LAS float*)(L + H_BT); LAS float* AL = (LAS float*)(L + H_AL);
    f32x4 acc[8];
#pragma unroll
    for (int vb = 0; vb < 8; ++vb) acc[vb] = (f32x4){0.f, 0.f, 0.f, 0.f};
    float asup = 0.f;
    for (int i = tid; i < 64 * HS64 / 4; i += NWAVES * 64) ((LAS unsigned*)(L + H_PM))[i] = 0u;
    unsigned short gr[16], qr[16], vr[16];
#define H1_LOAD(CI) do { const size_t r0_ = (size_t)((CI) * 64 + bi * 16) * 512 + c; \
        _Pragma("unroll") for (int r = 0; r < 16; ++r) { gr[r] = RGL[r0_ + (size_t)r * 512]; qr[r] = RQ[r0_ + (size_t)r * 512]; vr[r] = RI[r0_ + (size_t)r * 512]; } } while (0)
    H1_LOAD(0);
#pragma unroll 1
    for (int ci = 0; ci < 16; ++ci) {
        const size_t r0 = (size_t)(ci * 64 + bi * 16) * 512 + c;
        float eg[16], qq[16], el[16];
        { float run = 0.f, prod = 1.f;
#pragma unroll
          for (int r = 0; r < 16; ++r) { const float g = bf1(gr[r]); run += g; eg[r] = __expf(g); prod *= eg[r]; el[r] = prod; qq[r] = bf1(qr[r]); }
          BT[bi * 128 + c] = run; }
        if (ci > 0) {
#pragma unroll
            for (int vb = 0; vb < 8; ++vb) { v2u o; o.x = pk2(acc[vb][0], acc[vb][1]); o.y = pk2(acc[vb][2], acc[vb][3]);
                *(LAS v2u*)(L + H_ST + (16 * vb + l15) * HS128 + (16 * w + 4 * l4) * 2) = o; } }
        { v4u v0, v1; v0.x = vr[0] | ((unsigned)vr[1] << 16); v0.y = vr[2] | ((unsigned)vr[3] << 16); v0.z = vr[4] | ((unsigned)vr[5] << 16); v0.w = vr[6] | ((unsigned)vr[7] << 16);
          v1.x = vr[8] | ((unsigned)vr[9] << 16); v1.y = vr[10] | ((unsigned)vr[11] << 16); v1.z = vr[12] | ((unsigned)vr[13] << 16); v1.w = vr[14] | ((unsigned)vr[15] << 16);
          *(LAS v4u*)(L + H_VT + c * HS64 + bi * 32) = v0; *(LAS v4u*)(L + H_VT + c * HS64 + bi * 32 + 16) = v1; }
        __syncthreads();
        const float b0 = BT[c], b1 = BT[128 + c], b2 = BT[256 + c], b3 = BT[384 + c];
        const float ab1 = b0, ab2 = b0 + b1, ab3 = ab2 + b2, alast = ab3 + b3;
        const float ab = bi == 0 ? 0.f : bi == 1 ? ab1 : bi == 2 ? ab2 : ab3;
        if (bi == 0) AL[c] = alast;
        const float eAb = __expf(ab), eSup = __expf(asup), fEnd = __expf(alast - ab);
        const float fK0 = __expf(0.f - ab), fK1 = __expf(ab1 - ab), fK2 = __expf(ab2 - ab), fK3 = __expf(ab3 - ab);
        unsigned kp[8];
#pragma unroll
        for (int r = 0; r < 16; ++r) { const int t = bi * 16 + r;
            const float qb = qq[r] * el[r], qc = qb * eAb, kk = 1.0f - eg[r], ki = kk * __builtin_amdgcn_rcpf(el[r]);
            *(LAS unsigned short*)(L + H_QC + t * HS128 + c * 2) = f2bfs(qc);
            QHAT[r0 + (size_t)r * 512] = f2bfs(qc * eSup);
            *(LAS unsigned short*)(L + H_QB + t * HS128 + c * 2) = f2bfs(qb);
            const unsigned ke = f2bf(ki * fEnd); if (r & 1) kp[r >> 1] |= ke << 16; else kp[r >> 1] = ke;
            if (bi <= 0) *(LAS unsigned short*)(L + H_K + (0 + t) * HS128 + c * 2) = f2bfs(ki * fK0);
            if (bi <= 1) *(LAS unsigned short*)(L + H_K + (16 + t) * HS128 + c * 2) = f2bfs(ki * fK1);
            if (bi <= 2) *(LAS unsigned short*)(L + H_K + (48 + t) * HS128 + c * 2) = f2bfs(ki * fK2);
            *(LAS unsigned short*)(L + H_K + (96 + t) * HS128 + c * 2) = f2bfs(ki * fK3); }
        *(LAS v4u*)(L + H_KT + c * HS64 + bi * 32) = (v4u){kp[0], kp[1], kp[2], kp[3]}; *(LAS v4u*)(L + H_KT + c * HS64 + bi * 32 + 16) = (v4u){kp[4], kp[5], kp[6], kp[7]};
        asup += alast;
        if (ci + 1 < 16) H1_LOAD(ci + 1);
        __syncthreads();
#pragma unroll
        for (int rep = 0; rep < 2; ++rep) { const int tile = w + 8 * rep;
            if (tile < 10) { const int i = tile < 1 ? 0 : tile < 3 ? 1 : tile < 6 ? 2 : 3, j = tile - (i * (i + 1)) / 2;
                const LAS unsigned char* ap = L + H_QB + (16 * i + l15) * HS128 + l4 * 16; const LAS unsigned char* bp = L + H_K + (8 * i * (i + 1) + 16 * j + l15) * HS128 + l4 * 16;
                f32x4 p = (f32x4){0.f, 0.f, 0.f, 0.f};
#pragma unroll
                for (int ks = 0; ks < 4; ++ks) p = __builtin_amdgcn_mfma_f32_16x16x32_bf16(*(const LAS bf16x8*)(ap + ks * 64), *(const LAS bf16x8*)(bp + ks * 64), p, 0, 0, 0);
#pragma unroll
                for (int r = 0; r < 4; ++r) { const float pv = (i == j && l15 > 4 * l4 + r) ? 0.f : p[r];
                    *(LAS unsigned short*)(L + H_PM + (16 * i + 4 * l4 + r) * HS64 + (16 * j + l15) * 2) = f2bfs(pv); } } }
        __syncthreads();
#pragma unroll
        for (int tb = 0; tb < 4; ++tb) { f32x4 o = (f32x4){0.f, 0.f, 0.f, 0.f};
#pragma unroll
            for (int ks = 0; ks < 2; ++ks) if (32 * ks < 16 * (tb + 1))
                o = __builtin_amdgcn_mfma_f32_16x16x32_bf16(*(const LAS bf16x8*)(L + H_VT + (16 * w + l15) * HS64 + l4 * 16 + ks * 64), *(const LAS bf16x8*)(L + H_PM + (16 * tb + l15) * HS64 + l4 * 16 + ks * 64), o, 0, 0, 0);
            if (ci > 0) {
#pragma unroll
                for (int ks = 0; ks < 4; ++ks)
                    o = __builtin_amdgcn_mfma_f32_16x16x32_bf16(*(const LAS bf16x8*)(L + H_ST + (16 * w + l15) * HS128 + l4 * 16 + ks * 64), *(const LAS bf16x8*)(L + H_QC + (16 * tb + l15) * HS128 + l4 * 16 + ks * 64), o, 0, 0, 0); }
            v2u ov; ov.x = pk2(o[0], o[1]); ov.y = pk2(o[2], o[3]);
            *(v2u*)(OLOC + (size_t)(ci * 64 + 16 * tb + l15) * 512 + 16 * w + 4 * l4) = ov; }
        { const f32x4 dv = *(const LAS f32x4*)(AL + 16 * w + 4 * l4); const f32x4 d = (f32x4){__expf(dv[0]), __expf(dv[1]), __expf(dv[2]), __expf(dv[3])};
          const bf16x8 ka0 = *(const LAS bf16x8*)(L + H_KT + (16 * w + l15) * HS64 + l4 * 16), ka1 = *(const LAS bf16x8*)(L + H_KT + (16 * w + l15) * HS64 + l4 * 16 + 64);
#pragma unroll
          for (int vb = 0; vb < 8; ++vb) { f32x4 s = acc[vb] * d;
              s = __builtin_amdgcn_mfma_f32_16x16x32_bf16(ka0, *(const LAS bf16x8*)(L + H_VT + (16 * vb + l15) * HS64 + l4 * 16), s, 0, 0, 0);
              s = __builtin_amdgcn_mfma_f32_16x16x32_bf16(ka1, *(const LAS bf16x8*)(L + H_VT + (16 * vb + l15) * HS64 + l4 * 16 + 64), s, 0, 0, 0);
              acc[vb] = s; } }
        __syncthreads();
    }
#undef H1_LOAD
    f32x4* U = (f32x4*)(F.ws + WS_U);
#pragma unroll
    for (int vb = 0; vb < 8; ++vb) U[(size_t)((unit * 8 + w) * 8 + vb) * 64 + lane] = acc[vb];
    if (bi == 0) ((float*)(F.ws + WS_DS))[unit * 128 + c] = __expf(asup);
}
__device__ __forceinline__ void hgrn_h3_unit(Frame& F, const Args& A, int unit) {
    const int b = unit >> 5, h = (unit >> 3) & 3, n = unit & 7;
    const int lane = F.lane, w = F.wave, l15 = lane & 15, l4 = lane >> 4;
    LAS unsigned char* L = F.lds;
    const f32x4* U = (const f32x4*)(F.ws + WS_U); const float* DS = (const float*)(F.ws + WS_DS);
    f32x4 S[8];
#pragma unroll
    for (int vb = 0; vb < 8; ++vb) S[vb] = (f32x4){0.f, 0.f, 0.f, 0.f};
    for (int m = 0; m < n; ++m) { const int um = unit - n + m; const f32x4 d = *(const f32x4*)(DS + um * 128 + 16 * w + 4 * l4);
#pragma unroll
        for (int vb = 0; vb < 8; ++vb) S[vb] = S[vb] * d + U[(size_t)((um * 8 + w) * 8 + vb) * 64 + lane]; }
#pragma unroll
    for (int vb = 0; vb < 8; ++vb) { v2u o; o.x = pk2(S[vb][0], S[vb][1]); o.y = pk2(S[vb][2], S[vb][3]);
        *(LAS v2u*)(L + H_ST + (16 * vb + l15) * HS128 + (16 * w + 4 * l4) * 2) = o; }
    __syncthreads();
    const size_t rowbase = (size_t)(b * SEQ + n * 1024 + 128 * w) * 512 + h * 128;
    const bf16* QHAT = (const bf16*)(F.ws + WS_QHAT) + rowbase; const bf16* OLOC = (const bf16*)(F.ws + WS_OLOC) + rowbase;
    const bf16* RGS = (const bf16*)(F.ws + WS_RGS) + rowbase; bf16* REC = (bf16*)(F.ws + WS_REC) + rowbase;
    f32x4 rw[8];
#pragma unroll
    for (int vb = 0; vb < 8; ++vb) rw[vb] = *(const f32x4*)(A.in[11] + 16 * vb + 4 * l4);
#pragma unroll 1
    for (int tb = 0; tb < 8; ++tb) { const size_t tr = (size_t)(16 * tb + l15) * 512;
        bf16x8 qh[4];
#pragma unroll
        for (int ks = 0; ks < 4; ++ks) qh[ks] = *(const bf16x8*)(QHAT + tr + 32 * ks + 8 * l4);
        f32x4 o[8]; float ss = 0.f;
#pragma unroll
        for (int vb = 0; vb < 8; ++vb) { f32x4 a = (f32x4){0.f, 0.f, 0.f, 0.f};
            if (n > 0) {
#pragma unroll
                for (int ks = 0; ks < 4; ++ks) a = __builtin_amdgcn_mfma_f32_16x16x32_bf16(*(const LAS bf16x8*)(L + H_ST + (16 * vb + l15) * HS128 + l4 * 16 + ks * 64), qh[ks], a, 0, 0, 0); }
            const v2u ol = *(const v2u*)(OLOC + tr + 16 * vb + 4 * l4);
            a[0] += bflo(ol.x); a[1] += bfhi(ol.x); a[2] += bflo(ol.y); a[3] += bfhi(ol.y);
            o[vb] = a; ss += (a[0] * a[0] + a[1] * a[1]) + (a[2] * a[2] + a[3] * a[3]); }
        ss += __shfl_xor(ss, 16); ss += __shfl_xor(ss, 32);
        const float r = 1.0f / sqrtf(ss * (1.0f / 128.0f) + EPS);
#pragma unroll
        for (int vb = 0; vb < 8; ++vb) { const v2u g = *(const v2u*)(RGS + tr + 16 * vb + 4 * l4); const f32x4 y = o[vb] * r * rw[vb];
            v2u ov; ov.x = pk2(y[0] * bflo(g.x), y[1] * bfhi(g.x)); ov.y = pk2(y[2] * bflo(g.y), y[3] * bfhi(g.y));
            *(v2u*)(REC + tr + 16 * vb + 4 * l4) = ov; }
    }
    __syncthreads();
}

__device__ __forceinline__ unsigned f2key(float x) {
    const _Float16 hh = (_Float16)x; const unsigned bits = (unsigned)__builtin_bit_cast(unsigned short, hh);
    return (bits & 0x8000u) ? (~bits & 0xffffu) : (bits | 0x8000u);
}
#ifdef TSEL
#define TMARK(k) do { if (F.wave == 0) { const unsigned long long now_ = __builtin_amdgcn_s_memrealtime(); if (F.lane == 0) ((LAS unsigned*)(F.lds + LDSCTL_OFF))[k] += (unsigned)(now_ - tprev_); tprev_ = now_; } } while (0)
#else
#define TMARK(k) do {} while (0)
#endif
constexpr int DSA_VIMG = 73728;
constexpr int DSA_QCTR = 73600;
constexpr int DSA_BIAS = 69632;
constexpr int DSA_CAND = 147456, DSA_CAPC = 448;
typedef unsigned u32x4p __attribute__((ext_vector_type(4)));
__device__ __forceinline__ void dsa_unit(Frame& F, int b, int t0) {
    const int lane = F.lane, w = F.wave, qc = lane & 31, hf = lane >> 5;
    const bf16* KI = (const bf16*)(F.ws + WS_KI) + (size_t)b * SEQ * 64;
    const bf16* QI = (const bf16*)(F.ws + WS_QI) + (size_t)(b * SEQ + t0) * 512;
    const float* WI = (const float*)(F.ws + WS_WI) + (size_t)(b * SEQ + t0) * 8;
    unsigned short* scr = (unsigned short*)(F.ws + WS_SCR) + (size_t)blockIdx.x * (32 * 8192);
    const int nkb = t0 / 32 + 1;
#ifdef TSEL
    unsigned long long tprev_ = __builtin_amdgcn_s_memrealtime();
#endif
    LAS unsigned* hist = (LAS unsigned*)(F.lds);
    for (int i = F.tid; i < 4096; i += NWAVES * 64) ((LAS v4u*)hist)[i] = (v4u){0u, 0u, 0u, 0u};
    if (F.tid == 0) *(LAS unsigned*)(F.lds + DSA_QCTR) = 0u;
    __syncthreads();
    TMARK(0);
    {
        const int l15 = lane & 15, l4 = lane >> 4, qg = w >> 2, ql = 16 * qg + l15;
        bf16x8 qf[8][2]; float wv[8];
#pragma unroll
        for (int h = 0; h < 8; ++h) { wv[h] = WI[ql * 8 + h];
#pragma unroll
            for (int ks = 0; ks < 2; ++ks) qf[h][ks] = *(const bf16x8*)(QI + (size_t)ql * 512 + h * 64 + ks * 32 + l4 * 8); }
        const int lim = t0 + ql - 4 * l4;
        float wh[8];
#pragma unroll
        for (int h = 0; h < 8; ++h) wh[h] = 0.5f * wv[h];
        bf16x8 qs[2];
#pragma unroll
        for (int ks = 0; ks < 2; ++ks) { unsigned pk[4];
#pragma unroll
            for (int j = 0; j < 8; j += 2) { float e0 = 0.f, e1 = 0.f;
#pragma unroll
                for (int h = 0; h < 8; ++h) { e0 += wh[h] * bf1((unsigned short)qf[h][ks][j]); e1 += wh[h] * bf1((unsigned short)qf[h][ks][j + 1]); }
                pk[j >> 1] = pk2(e0, e1); }
            qs[ks] = __builtin_bit_cast(bf16x8, (v4u){pk[0], pk[1], pk[2], pk[3]}); }
        const int nb16 = 2 * nkb;
#define P1_LOAD(K0, K1, KB) do { const int row_ = (KB) * 16 + l15; const bf16* kp_ = KI + (size_t)(row_ < SEQ - 1 ? row_ : SEQ - 1) * 64 + l4 * 8; \
            asm volatile("global_load_dwordx4 %0, %2, off\n\tglobal_load_dwordx4 %1, %2, off offset:64" : "=&v"(K0), "=&v"(K1) : "v"(kp_) : "memory"); } while (0)
#define P1_COMPUTE(K0, K1, KB, OUT) do { const int s0_ = (KB) * 16; f32x4 sc_ = (f32x4){0.f, 0.f, 0.f, 0.f}; \
            sc_ = __builtin_amdgcn_mfma_f32_16x16x32_bf16(K0, qs[0], sc_, 0, 0, 0); sc_ = __builtin_amdgcn_mfma_f32_16x16x32_bf16(K1, qs[1], sc_, 0, 0, 0); \
            _Pragma("unroll") for (int h = 0; h < 8; ++h) { f32x4 a_ = (f32x4){0.f, 0.f, 0.f, 0.f}; \
                a_ = __builtin_amdgcn_mfma_f32_16x16x32_bf16(K0, qf[h][0], a_, 0, 0, 0); a_ = __builtin_amdgcn_mfma_f32_16x16x32_bf16(K1, qf[h][1], a_, 0, 0, 0); \
                _Pragma("unroll") for (int r = 0; r < 4; ++r) sc_[r] = __builtin_fmaf(wh[h], __builtin_fabsf(a_[r]), sc_[r]); } \
            unsigned kk_[4]; \
            _Pragma("unroll") for (int r = 0; r < 4; ++r) { const bool causal_ = s0_ + r <= lim; const unsigned key_ = f2key(sc_[r]); kk_[r] = causal_ ? key_ : 0u; \
                if (causal_) __hip_atomic_fetch_add(hist + ql * 512 + (key_ >> 7), 1u, __ATOMIC_RELAXED, __HIP_MEMORY_SCOPE_WORKGROUP); } \
            OUT.x = kk_[0] | (kk_[1] << 16); OUT.y = kk_[2] | (kk_[3] << 16); } while (0)
        {
        bf16x8 c0a, c0b, c1a, c1b, c2a, c2b, c3a, c3b, n0a, n0b, n1a, n1b, n2a, n2b, n3a, n3b;
        LAS unsigned char* stg = F.lds + DSA_VIMG + w * 9216;
        const int rrow = lane >> 3, rch = lane & 7;
        int kb = 4 * (w & 3);
        P1_LOAD(c0a, c0b, kb); P1_LOAD(c1a, c1b, kb + 1); P1_LOAD(c2a, c2b, kb + 2); P1_LOAD(c3a, c3b, kb + 3);
        asm volatile("s_waitcnt vmcnt(0)" : "+v"(c0a), "+v"(c0b), "+v"(c1a), "+v"(c1b), "+v"(c2a), "+v"(c2b), "+v"(c3a), "+v"(c3b) :: "memory");
#pragma unroll 1
        for (; kb < nb16; kb += 16) {
            P1_LOAD(n0a, n0b, kb + 16); P1_LOAD(n1a, n1b, kb + 17); P1_LOAD(n2a, n2b, kb + 18); P1_LOAD(n3a, n3b, kb + 19);
            v2u o0 = (v2u){0u, 0u}, o1 = o0, o2 = o0, o3 = o0;
            P1_COMPUTE(c0a, c0b, kb, o0);
            if (kb + 1 < nb16) P1_COMPUTE(c1a, c1b, kb + 1, o1);
            if (kb + 2 < nb16) P1_COMPUTE(c2a, c2b, kb + 2, o2);
            if (kb + 3 < nb16) P1_COMPUTE(c3a, c3b, kb + 3, o3);
            TMARK(29);
            *(LAS v2u*)(stg + l15 * 144 + 8 * l4) = o0; *(LAS v2u*)(stg + l15 * 144 + 32 + 8 * l4) = o1; *(LAS v2u*)(stg + l15 * 144 + 64 + 8 * l4) = o2; *(LAS v2u*)(stg + l15 * 144 + 96 + 8 * l4) = o3;
            LDS_WAIT(); asm volatile("" ::: "memory");
            { const v4u lo = *(const LAS v4u*)(stg + rrow * 144 + rch * 16), hi = *(const LAS v4u*)(stg + (rrow + 8) * 144 + rch * 16);
              unsigned short* dst = scr + (size_t)(16 * qg + rrow) * 8192 + kb * 16 + rch * 8;
              *(v4u*)dst = lo; *(v4u*)(dst + 8 * 8192) = hi; }
            LDS_WAIT(); asm volatile("" ::: "memory");
            TMARK(27);
            asm volatile("s_waitcnt vmcnt(2)" : "+v"(n0a), "+v"(n0b), "+v"(n1a), "+v"(n1b), "+v"(n2a), "+v"(n2b), "+v"(n3a), "+v"(n3b) :: "memory");
            TMARK(28);
            c0a = n0a; c0b = n0b; c1a = n1a; c1b = n1b; c2a = n2a; c2b = n2b; c3a = n3a; c3b = n3b;
        }
        }
#undef P1_LOAD
#undef P1_COMPUTE
    }
    TMARK(1);
    __syncthreads();
    TMARK(2);
    LAS unsigned short* idxl = (LAS unsigned short*)(F.lds + 65536) + w * 256;
    const LAS float* btab = (const LAS float*)(F.lds + DSA_BIAS);
    const bf16* KV = (const bf16*)(F.ws + WS_KV) + (size_t)b * SEQ * 256;
    const int nk = nkb * 32, ndw = nk >> 1;
    LAS unsigned* qctr = (LAS unsigned*)(F.lds + DSA_QCTR);
#pragma unroll 1
    for (;;) {
        unsigned qi_ = 0u; if (lane == 0) qi_ = __hip_atomic_fetch_add(qctr, 1u, __ATOMIC_RELAXED, __HIP_MEMORY_SCOPE_WORKGROUP);
        qi_ = (unsigned)__builtin_amdgcn_readfirstlane((int)qi_); if (qi_ >= 32u) break;
        const int ql = 31 - (int)qi_, t = t0 + ql, nvalid = t + 1, nsel = nvalid < 256 ? nvalid : 256;
        const unsigned* rowd = (const unsigned*)(scr + (size_t)ql * 8192);
        int ln = lane; asm volatile("" : "+v"(ln));
        {
        unsigned rv[64];
#pragma unroll
        for (int j = 0; j < 64; ++j) { const unsigned val = rowd[j * 64 + ln]; rv[j] = (ln < ndw - j * 64) ? val : 0u; }
#ifdef TSEL
        asm volatile("s_waitcnt vmcnt(0)" ::: "memory"); TMARK(8);
#endif
        unsigned T = 0u; int need = 0; bool done = false;
        const unsigned long long lt = (1ull << ln) - 1ull; const int ln2 = 2 * ln;
        if (nvalid > 256) {
            const LAS unsigned* hq = hist + ql * 512 + 8 * ln;
            const v4u h0 = *(const LAS v4u*)(hq), h1 = *(const LAS v4u*)(hq + 4);
            const unsigned h8[8] = {h0.x, h0.y, h0.z, h0.w, h1.x, h1.y, h1.z, h1.w};
            const unsigned sl = (h0.x + h0.y) + (h0.z + h0.w) + (h1.x + h1.y) + (h1.z + h1.w);
            unsigned S = sl;
#pragma unroll
            for (int d = 1; d < 64; d <<= 1) { const unsigned tt = __shfl_down(S, d); if (ln + d < 64) S += tt; }
            const int Lb = __popcll(__ballot(S >= 256u)) - 1;
            unsigned cum = S - sl, caL = 0u, cbL = 0u; int Bi = 0; bool found = false;
#pragma unroll
            for (int i = 7; i >= 0; --i) { if (!found && cum + h8[i] >= 256u) { Bi = i; caL = cum; cbL = h8[i]; found = true; } if (!found) cum += h8[i]; }
            TMARK(9);
            const int B = 8 * Lb + __shfl(Bi, Lb); const int ca = (int)__shfl(caL, Lb), cb = (int)__shfl(cbL, Lb);
            LAS unsigned short* glst = (LAS unsigned short*)(F.lds + DSA_VIMG + w * 9216);
            LAS unsigned* elst = (LAS unsigned*)(F.lds + DSA_VIMG + w * 9216 + 3200);
            const unsigned Tg = (unsigned)(B + 1) << 7, Te = (unsigned)B << 7;
            int gc = 0, ec = 0;
#define DSA_COLLECT(K16, IDX) do { const unsigned k_ = (K16), i_ = (IDX); const bool g_ = k_ >= Tg, e_ = (k_ >= Te) && !g_; \
                const int gs_ = g_ ? (gc < 24 ? gc : 24) : 24, es_ = e_ ? (ec < 12 ? ec : 12) : 12; \
                glst[gs_ * 64 + ln] = (unsigned short)i_; elst[es_ * 64 + ln] = (k_ << 16) | (65535u - i_); gc += g_ ? 1 : 0; ec += e_ ? 1 : 0; } while (0)
#pragma unroll
            for (int g = 0; g < 8; ++g) if (g * 1024 < nk) {
#pragma unroll
                for (int j = 8 * g; j < 8 * g + 8; ++j) { const unsigned i0 = (unsigned)(ln2 + 128 * j); DSA_COLLECT(rv[j] & 0xffffu, i0); DSA_COLLECT(rv[j] >> 16, i0 + 1u); } }
#undef DSA_COLLECT
            if (__ballot(gc > 24 || ec > 12) == 0ull) {
                LDS_WAIT(); asm volatile("" ::: "memory");
                TMARK(10);
                int incl = gc;
#pragma unroll
                for (int d = 1; d < 64; d <<= 1) { const int tt = __shfl_up(incl, d); if (ln >= d) incl += tt; }
                const int excl = incl - gc;
#pragma unroll 1
                for (int e = 0; e < 24; ++e) { if (__ballot(e < gc) == 0ull) break; if (e < gc) idxl[excl + e] = glst[e * 64 + ln]; }
                TMARK(11);
                unsigned cv[12]; int emax = 0;
#pragma unroll
                for (int e = 0; e < 12; ++e) { cv[e] = (e < ec) ? elst[e * 64 + ln] : 0u; if (__ballot(e < ec) != 0ull) emax = e + 1; }
                const int needc = 256 - ca; unsigned pref = (unsigned)B << 23;
#define DSA_DESCENT(N) _Pragma("unroll 1") for (int bit = 22; bit >= 0; --bit) { const unsigned c = pref | (1u << bit); int cnt = 0; \
                    _Pragma("unroll") for (int e = 0; e < (N); ++e) cnt += __popcll(__ballot(cv[e] >= c)); \
                    if (cnt >= needc) pref = c; }
                if (emax <= 2) { DSA_DESCENT(2) } else if (emax <= 4) { DSA_DESCENT(4) } else { DSA_DESCENT(12) }
#undef DSA_DESCENT
                TMARK(12);
                int base = ca;
#pragma unroll
                for (int e = 0; e < 12; ++e) if (e < emax) { const bool sl2 = cv[e] >= pref; const unsigned long long m = __ballot(sl2); const int pos = base + __popcll(m & lt);
                    if (sl2 && pos < 256) idxl[pos] = (unsigned short)(65535u - (cv[e] & 0xffffu)); base += __popcll(m); }
                done = true;
            } else {
#pragma unroll 1
                for (int bit = 15; bit >= 0; --bit) { const unsigned cand2 = T | (1u << bit); int c = 0;
#pragma unroll
                    for (int g = 0; g < 8; ++g) if (g * 1024 < nk) {
#pragma unroll
                        for (int j = 8 * g; j < 8 * g + 8; ++j) { c += ((rv[j] & 0xffffu) >= cand2) ? 1 : 0; c += ((rv[j] >> 16) >= cand2) ? 1 : 0; } }
#pragma unroll
                    for (int o = 1; o < 64; o <<= 1) c += __shfl_xor(c, o);
                    if (c >= 256) T = cand2; }
                int c = 0;
#pragma unroll
                for (int g = 0; g < 8; ++g) if (g * 1024 < nk) {
#pragma unroll
                    for (int j = 8 * g; j < 8 * g + 8; ++j) { c += ((rv[j] & 0xffffu) > T) ? 1 : 0; c += ((rv[j] >> 16) > T) ? 1 : 0; } }
#pragma unroll
                for (int o = 1; o < 64; o <<= 1) c += __shfl_xor(c, o);
                need = 256 - c;
            }
        }
        if (!done) {
            int base = 0, tiebase = 0;
#pragma unroll
            for (int g = 0; g < 8; ++g) if (g * 1024 < nk) {
#pragma unroll
                for (int j = 8 * g; j < 8 * g + 8; ++j) { const unsigned lo = rv[j] & 0xffffu, hi = rv[j] >> 16;
                    const bool el = lo == T, eh = hi == T; const unsigned long long mel = __ballot(el), meh = __ballot(eh);
                    const int trl = tiebase + __popcll(mel & lt) + __popcll(meh & lt), trh = trl + (el ? 1 : 0);
                    const bool sl = lo > T || (el && trl < need), sh = hi > T || (eh && trh < need);
                    const unsigned long long msl = __ballot(sl), msh = __ballot(sh);
                    const int pl = base + __popcll(msl & lt) + __popcll(msh & lt), ph = pl + (sl ? 1 : 0);
                    if (sl && pl < 256) idxl[pl] = (unsigned short)(ln2 + 128 * j); if (sh && ph < 256) idxl[ph] = (unsigned short)(ln2 + 128 * j + 1);
                    base += __popcll(msl) + __popcll(msh); tiebase += __popcll(mel) + __popcll(meh); __builtin_amdgcn_sched_barrier(0); } }
        }
        }
        LDS_WAIT(); asm volatile("" ::: "memory");
        TMARK(3);
        {
            int l15 = ln & 15, l4 = ln >> 4; asm volatile("" : "+v"(l15), "+v"(l4));
            const int l4x4 = 4 * l4;
#pragma unroll
            for (int jj = 0; jj < 4; ++jj) { if (ln >= nsel - 64 * jj) idxl[ln + 64 * jj] = 0; }
            LDS_WAIT(); asm volatile("" ::: "memory");
            unsigned short kidx[16]; v2u sidx[16];
#pragma unroll
            for (int blk = 0; blk < 16; ++blk) { kidx[blk] = idxl[16 * blk + l15]; sidx[blk] = *(const LAS v2u*)(idxl + 16 * blk + l4x4); }
            unsigned short vidx0[8];
#pragma unroll
            for (int i = 0; i < 8; ++i) vidx0[i] = idxl[4 * i + l4];
            LDS_WAIT(); asm volatile("" ::: "memory");
            const bf16* qrow = (const bf16*)(F.ws + WS_Q) + (size_t)(b * SEQ + t) * 512 + (l15 & 7) * 64 + 8 * l4;
            bf16x8 bq[2][2];
#pragma unroll
            for (int g = 0; g < 2; ++g)
#pragma unroll
                for (int ks = 0; ks < 2; ++ks) { bf16x8 v = *(const bf16x8*)(qrow + 32 * ks); if ((l15 >> 2) != g) v = (bf16x8){0, 0, 0, 0, 0, 0, 0, 0}; bq[g][ks] = v; }
            f32x4 sa[16];
#pragma unroll
            for (int half = 0; half < 4; ++half) {
                bf16x8 ka[4][4];
#pragma unroll
                for (int bl = 0; bl < 4; ++bl) { const bf16* kr = KV + (size_t)kidx[4 * half + bl] * 256 + 8 * l4;
#pragma unroll
                    for (int i = 0; i < 4; ++i) ka[bl][i] = *(const bf16x8*)(kr + 32 * i); }
#pragma unroll
                for (int bl = 0; bl < 4; ++bl) { f32x4 acc = (f32x4){0.f, 0.f, 0.f, 0.f};
                    acc = __builtin_amdgcn_mfma_f32_16x16x32_bf16(ka[bl][0], bq[0][0], acc, 0, 0, 0); acc = __builtin_amdgcn_mfma_f32_16x16x32_bf16(ka[bl][1], bq[0][1], acc, 0, 0, 0);
                    acc = __builtin_amdgcn_mfma_f32_16x16x32_bf16(ka[bl][2], bq[1][0], acc, 0, 0, 0); acc = __builtin_amdgcn_mfma_f32_16x16x32_bf16(ka[bl][3], bq[1][1], acc, 0, 0, 0);
                    sa[4 * half + bl] = acc; }
                asm volatile("" ::: "memory"); }
            v4u vbuf[2][8];
#pragma unroll
            for (int i = 0; i < 8; ++i) vbuf[0][i] = *(const v4u*)(KV + (size_t)vidx0[i] * 256 + 128 + l15 * 8);
            TMARK(13);
            float mx = -INFINITY; const LAS float* bt = btab + (l15 & 7);
#pragma unroll
            for (int blk = 0; blk < 16; ++blk)
#pragma unroll
                for (int r = 0; r < 4; ++r) { const unsigned sw = (r < 2) ? sidx[blk].x : sidx[blk].y; const int dist = t - (int)((r & 1) ? (sw >> 16) : (sw & 0xffffu));
                    const float bias = bt[(dist < 113 ? dist : 113) * 8];
                    const float v = (l4x4 < nsel - (16 * blk + r)) ? sa[blk][r] + bias : -INFINITY; sa[blk][r] = v; mx = fmaxf(mx, v); }
            mx = fmaxf(mx, __shfl_xor(mx, 16)); mx = fmaxf(mx, __shfl_xor(mx, 32));
            float su = 0.f;
#pragma unroll
            for (int blk = 0; blk < 16; ++blk)
#pragma unroll
                for (int r = 0; r < 4; ++r) { const float e = __expf(sa[blk][r] - mx); sa[blk][r] = e; su += e; }
            su += __shfl_xor(su, 16); su += __shfl_xor(su, 32);
            const float inv = 1.0f / su;
            TMARK(14);
            bf16x8 pf[8];
#pragma unroll
            for (int ks = 0; ks < 8; ++ks) { u32x4p pa; pa.x = pk2(sa[2 * ks][0], sa[2 * ks][1]); pa.y = pk2(sa[2 * ks][2], sa[2 * ks][3]); pa.z = pk2(sa[2 * ks + 1][0], sa[2 * ks + 1][1]); pa.w = pk2(sa[2 * ks + 1][2], sa[2 * ks + 1][3]);
                asm volatile("" : "+v"(pa));
                pf[ks] = __builtin_bit_cast(bf16x8, pa); }
            { unsigned short vi[8];
#pragma unroll
              for (int i = 0; i < 8; ++i) vi[i] = idxl[32 + 4 * i + l4];
              LDS_WAIT(); asm volatile("" ::: "memory");
#pragma unroll
              for (int i = 0; i < 8; ++i) vbuf[1][i] = *(const v4u*)(KV + (size_t)vi[i] * 256 + 128 + l15 * 8); }
            f32x4 oa[2][4];
#pragma unroll
            for (int g = 0; g < 2; ++g)
#pragma unroll
                for (int c = 0; c < 4; ++c) oa[g][c] = (f32x4){0.f, 0.f, 0.f, 0.f};
            LAS unsigned char* vimg = F.lds + DSA_VIMG + w * 9216;
            const unsigned traddr = (unsigned)(size_t)(vimg + (4 * l4 + (l15 >> 2)) * 144 + (l15 & 3) * 8);
#pragma unroll
            for (int ks = 0; ks < 8; ++ks) {
#pragma unroll
                for (int i = 0; i < 8; ++i) *(LAS v4u*)(vimg + (l15 >> 3) * 4608 + (4 * i + l4) * 144 + (l15 & 7) * 16) = vbuf[ks & 1][i];
                if (ks + 2 < 8) { unsigned short vi[8];
#pragma unroll
                    for (int i = 0; i < 8; ++i) vi[i] = idxl[32 * (ks + 2) + 4 * i + l4];
                    LDS_WAIT(); asm volatile("" ::: "memory");
#pragma unroll
                    for (int i = 0; i < 8; ++i) vbuf[ks & 1][i] = *(const v4u*)(KV + (size_t)vi[i] * 256 + 128 + l15 * 8); }
                LDS_WAIT(); asm volatile("" ::: "memory");
                v2u tb[16];
                asm volatile("ds_read_b64_tr_b16 %0, %16 offset:0\n\tds_read_b64_tr_b16 %1, %16 offset:2304\n\tds_read_b64_tr_b16 %2, %16 offset:32\n\tds_read_b64_tr_b16 %3, %16 offset:2336\n\t"
                             "ds_read_b64_tr_b16 %4, %16 offset:64\n\tds_read_b64_tr_b16 %5, %16 offset:2368\n\tds_read_b64_tr_b16 %6, %16 offset:96\n\tds_read_b64_tr_b16 %7, %16 offset:2400\n\t"
                             "ds_read_b64_tr_b16 %8, %16 offset:4608\n\tds_read_b64_tr_b16 %9, %16 offset:6912\n\tds_read_b64_tr_b16 %10, %16 offset:4640\n\tds_read_b64_tr_b16 %11, %16 offset:6944\n\t"
                             "ds_read_b64_tr_b16 %12, %16 offset:4672\n\tds_read_b64_tr_b16 %13, %16 offset:6976\n\tds_read_b64_tr_b16 %14, %16 offset:4704\n\tds_read_b64_tr_b16 %15, %16 offset:7008\n\ts_waitcnt lgkmcnt(0)"
                             : "=&v"(tb[0]), "=&v"(tb[1]), "=&v"(tb[2]), "=&v"(tb[3]), "=&v"(tb[4]), "=&v"(tb[5]), "=&v"(tb[6]), "=&v"(tb[7]),
                               "=&v"(tb[8]), "=&v"(tb[9]), "=&v"(tb[10]), "=&v"(tb[11]), "=&v"(tb[12]), "=&v"(tb[13]), "=&v"(tb[14]), "=&v"(tb[15])
                             : "v"(traddr) : "memory");
#pragma unroll
                for (int g = 0; g < 2; ++g)
#pragma unroll
                    for (int c = 0; c < 4; ++c) { u32x4p bb; bb.x = tb[8 * g + 2 * c].x; bb.y = tb[8 * g + 2 * c].y; bb.z = tb[8 * g + 2 * c + 1].x; bb.w = tb[8 * g + 2 * c + 1].y;
                        oa[g][c] = __builtin_amdgcn_mfma_f32_16x16x32_bf16(pf[ks], __builtin_bit_cast(bf16x8, bb), oa[g][c], 0, 0, 0); }
                asm volatile("" ::: "memory");
            }
            TMARK(15);
            bf16* orow = (bf16*)(F.ws + WS_ATT) + (size_t)(b * SEQ + t) * 512;
#pragma unroll
            for (int r = 0; r < 4; ++r) { const float i0 = __shfl(inv, r), i1 = __shfl(inv, 4 + r);
                if (l4 < 2) {
#pragma unroll
                    for (int c = 0; c < 4; ++c) { const float v = l4 == 0 ? oa[0][c][r] * i0 : oa[1][c][r] * i1; orow[(4 * l4 + r) * 64 + 16 * c + l15] = (bf16)f2bf(v); } } }
        }
        LDS_WAIT(); asm volatile("" ::: "memory");
        TMARK(4);
    }
    __syncthreads();
    TMARK(5);
}

__device__ __forceinline__ void p4_mixers(Frame& F, const Args& A) {
    for (int u = blockIdx.x; u < 256; u += F.G) hgrn_h1_unit(F, u);
    __syncthreads();
    { LAS float* bt = (LAS float*)(F.lds + DSA_BIAS);
      for (int i = F.tid; i < 114 * 8; i += NWAVES * 64) { const int n = i >> 3; int v = n; if (n >= 16) { v = 16 + (int)(__logf((float)n * (1.0f / 16.0f)) * (16.0f / 2.0794415416798357f)); v = v < 31 ? v : 31; }
          bt[i] = A.in[9][v * 8 + (i & 7)]; }
      __syncthreads(); }
    for (int u = blockIdx.x, k = 0; u < 2048; u += F.G, ++k) { const int b = u & 7, sl = u >> 3, sm = (k & 1) ? ((sl & ~31) | (31 - (sl & 31))) : sl; dsa_unit(F, b, (255 - sm) * 32); }
}

__device__ __forceinline__ void p5_rec(Frame& F, const Args& A) { for (int u = blockIdx.x; u < 256; u += F.G) hgrn_h3_unit(F, A, u);
}

__device__ __forceinline__ void p10_final(Frame& F, const Args& A) {
    const int gw = blockIdx.x * NWAVES + F.wave, NGW = F.G * NWAVES; const float* SS = (const float*)(F.ws + WS_X2SS);
    f32x4 wv[4];
#pragma unroll
    for (int j = 0; j < 4; ++j) wv[j] = *(const f32x4*)(A.in[19] + 4 * F.lane + 256 * j);
    for (int m0 = gw; m0 < M; m0 += 4 * NGW) {
        f32x4 v[4][4]; float ss[4];
#pragma unroll
        for (int k = 0; k < 4; ++k) { const int m = m0 + k * NGW < M ? m0 + k * NGW : m0; ss[k] = F.lane < 16 ? SS[(size_t)m * 16 + F.lane] : 0.f;
            const GAS f32x4* xr = (const GAS f32x4*)(F.out + (size_t)m * D) + F.lane;
#pragma unroll
            for (int j = 0; j < 4; ++j) v[k][j] = xr[64 * j]; }
#pragma unroll
        for (int k = 0; k < 4; ++k) { const int m = m0 + k * NGW; const float r = 1.0f / sqrtf(wave_sum(ss[k]) * (1.0f / D) + EPS);
            if (m < M) { GAS f32x4* xo = (GAS f32x4*)(F.out + (size_t)m * D) + F.lane;
#pragma unroll
                for (int j = 0; j < 4; ++j) xo[64 * j] = v[k][j] * r * wv[j]; } }
    }
}

__global__ void __launch_bounds__(NWAVES * 64, 2) fwd_kernel(Args args) {
    extern __shared__ __attribute__((aligned(16))) unsigned char lds[];
    Frame F;
    F.lds = (LAS unsigned char*)lds;
    F.MISC = (volatile LAS unsigned*)(F.lds + MISC_OFF);
    F.tid = threadIdx.x; F.lane = F.tid & 63; F.wave = __builtin_amdgcn_readfirstlane(F.tid >> 6);
    F.G = gridDim.x;
    F.ws = args.ws; F.ctl = (gu32*)(args.ws + WS_CTL); F.out = args.out;
    for (int u = F.tid; u < (LDS_BYTES - LDSCTL_OFF) / 4; u += NWAVES * 64) ((LAS unsigned*)(F.lds + LDSCTL_OFF))[u] = 0u;
    __syncthreads();
    XcdBarrier bar; bar.bar = (unsigned*)(F.ctl + CW_BAR); bar.x = 0; bar.st = nullptr;
    if (N_LAUNCHES == 1) bar = xcd_barrier_post((unsigned*)(F.ctl + CW_BAR), F.MISC + 8);
#ifdef TSEL
    unsigned long long tph_ = __builtin_amdgcn_s_memrealtime(); int phk_ = 0;
#define GRID_BAR() do { if (N_LAUNCHES == 1) { const unsigned long long t1_ = __builtin_amdgcn_s_memrealtime(); xcd_barrier(bar); const unsigned long long t2_ = __builtin_amdgcn_s_memrealtime(); \
        if (F.tid == 0) { ((LAS unsigned*)(F.lds + LDSCTL_OFF))[16 + phk_] += (unsigned)(t1_ - tph_); ((LAS unsigned*)(F.lds + LDSCTL_OFF))[40 + phk_] += (unsigned)(t2_ - t1_); } tph_ = t2_; ++phk_; } } while (0)
#else
#define GRID_BAR() do { if (N_LAUNCHES == 1) xcd_barrier(bar); } while (0)
#endif
    const int lo = args.ph_lo, hi = args.ph_hi;
#ifdef ONLY_PHASE
#define IN(k) ((k) == ONLY_PHASE && lo <= (k) && (k) < hi)
#else
#define IN(k) (lo <= (k) && (k) < hi)
#endif
#define BOTH(k) (IN(k) && IN((k) + 1))
    const float* MOD = (const float*)(F.ws + WS_MOD);

    if (IN(0)) { p0_prologue(F, args); if (BOTH(0)) GRID_BAR(); }
    if (IN(1)) { p1_norm(F, args); if (BOTH(1)) GRID_BAR(); }
    if (IN(2)) {
        pg8::Gemm g{(const bf16*)(F.ws + WS_XN), (const bf16*)(F.ws + WS_WIN), M, NPROJ_PAD, 1024}; pg8::StaticOrder S; S.init(M, NPROJ_PAD, F.G, (int)blockIdx.x);
        pg8::EpiInProj E{(bf16*)(F.ws + WS_CQ), (bf16*)(F.ws + WS_KV), (bf16*)(F.ws + WS_KI), (bf16*)(F.ws + WS_RQ), (bf16*)F.out,
                         (float*)(F.ws + WS_WI), (float*)(F.ws + WS_CQSS), (const float*)(F.ws + WS_LB)};
        pg8::gemm_phase<pg8::EpiInProj, pg8::StaticOrder, PG8_ALIGN, PG8_SP2>(F.lds + RING_OFF, g, S, E);
        if (BOTH(2)) GRID_BAR();
    }
    if (IN(3)) {
        pg8::Gemm g{(const bf16*)(F.ws + WS_CQ), (const bf16*)(F.ws + WS_WQ), M, 1024, 256}; pg8::StaticOrder S; S.init(M, 1024, F.G, (int)blockIdx.x);
        pg8::EpiQ E{(bf16*)(F.ws + WS_Q), (const float*)(F.ws + WS_CQSS)};
        pg8::gemm_phase<pg8::EpiQ, pg8::StaticOrder, PG8_ALIGN, PG8_SP2>(F.lds + RING_OFF, g, S, E);
        if (BOTH(3)) GRID_BAR();
    }
#ifdef TSEL
    if (IN(4)) { const unsigned long long ta_ = __builtin_amdgcn_s_memrealtime(); p4_mixers(F, args); unsigned long long tb_ = __builtin_amdgcn_s_memrealtime(); if (F.tid == 0) ((LAS unsigned*)(F.lds + LDSCTL_OFF))[7] += (unsigned)(tb_ - ta_); if (BOTH(4)) GRID_BAR(); if (F.tid == 0) ((LAS unsigned*)(F.lds + LDSCTL_OFF))[6] += (unsigned)(__builtin_amdgcn_s_memrealtime() - tb_); }
#else
    if (IN(4)) { p4_mixers(F, args); if (BOTH(4)) GRID_BAR(); }
#endif
    if (IN(5)) { p5_rec(F, args); if (BOTH(5)) GRID_BAR(); }
    if (IN(6)) {
        pg8::ChainOrder S; S.init(M, 1024, F.G, (int)blockIdx.x);
        pg8::Gemm g{(const bf16*)(F.ws + WS_ATT), (const bf16*)(F.ws + WS_WBA), 2 * M, 2048, 512}; pg8::EpiBranchChain E{(bf16*)(F.ws + WS_MIX), (const bf16*)F.out};
        pg8::gemm_phase<pg8::EpiBranchChain, pg8::ChainOrder, PG8_ALIGN, PG8_SP2>(F.lds + RING_OFF, g, S, E);
        if (BOTH(6)) GRID_BAR();
    }
    if (IN(7)) {
        pg8::Gemm g{(const bf16*)(F.ws + WS_MIX), (const bf16*)(F.ws + WS_WOUT), M, 1024, 1024}; pg8::StaticOrder S; S.init(M, 1024, F.G, (int)blockIdx.x);
        pg8::EpiOut E{args.in[0], (bf16*)(F.ws + WS_X1), (bf16*)(F.ws + WS_XS), (float*)(F.ws + WS_X1SS), MOD, (const float*)(F.ws + WS_CW2)};
        pg8::gemm_phase<pg8::EpiOut, pg8::StaticOrder, PG8_ALIGN, PG8_SP2>(F.lds + RING_OFF, g, S, E);
        if (BOTH(7)) GRID_BAR();
    }
    if (IN(8)) {
        pg8::Gemm g{(const bf16*)(F.ws + WS_XS), (const bf16*)(F.ws + WS_WGU), M, NGU, 1024}; pg8::StaticOrder S; S.init(M, NGU, F.G, (int)blockIdx.x);
        int pm0 = 0; { const int nN_ = NGU / 256, nwg_ = (M / 256) * nN_; int wg_ = (int)blockIdx.x;
            if (wg_ < nwg_) { const int q_ = nwg_ / 8, r_ = nwg_ % 8, x_ = wg_ % 8, o_ = wg_ / 8; wg_ = (x_ < r_ ? x_ * (q_ + 1) : r_ * (q_ + 1) + (x_ - r_) * q_) + o_;
                const int nig_ = 8 * nN_, fm_ = (wg_ / nig_) * 8, gsz_ = (M / 256 - fm_) < 8 ? (M / 256 - fm_) : 8; pm0 = fm_ + ((wg_ % nig_) % gsz_); } }
        const int g0 = pm0 >> 3, pm7 = pm0 & 7;
        { LAS float* R2L = (LAS float*)(F.lds + RING_BYTES); const float* SS = (const float*)(F.ws + WS_X1SS);
          for (int i = F.tid; i < 1024; i += NWAVES * 64) { const int pm = 8 * (g0 + (i >> 8)) + pm7; float r = 0.f;
              if (pm < M / 256) { const float* p = SS + (size_t)(pm * 256 + (i & 255)) * 16; float s2 = 0.f;
#pragma unroll
                  for (int q = 0; q < 4; ++q) { const f32x4 t = *(const f32x4*)(p + 4 * q); s2 += (t[0] + t[1]) + (t[2] + t[3]); }
                  r = __builtin_amdgcn_rsqf(s2 * (1.0f / 1024.0f) + 1e-6f); }
              R2L[i] = r; }
          LAS float* BL = (LAS float*)(F.lds + RING_BYTES + 4096); const float* bsrc = (const float*)(F.ws + WS_BGU) + (pm0 >> 5) * NGU;
          for (int i = F.tid; i < NGU / 4; i += NWAVES * 64) ((LAS f32x4*)BL)[i] = ((const f32x4*)bsrc)[i];
          __syncthreads(); }
        pg8::EpiGateUp E{(bf16*)(F.ws + WS_HID), (const float*)(F.ws + WS_X1SS), (const float*)(F.ws + WS_BGU), (const LAS float*)(F.lds + RING_BYTES + 4096), pm0 >> 5, (const LAS float*)(F.lds + RING_BYTES), g0, pm7};
        pg8::gemm_phase<pg8::EpiGateUp, pg8::StaticOrder, PG8_ALIGN, PG8_SP2>(F.lds + RING_OFF, g, S, E);
        if (BOTH(8)) GRID_BAR();
    }
    if (IN(9)) {
        pg8::Gemm g{(const bf16*)(F.ws + WS_HID), (const bf16*)(F.ws + WS_WD), M, 1024, FF}; pg8::StaticOrder S; S.init(M, 1024, F.G, (int)blockIdx.x);
        pg8::EpiDown E{(const bf16*)(F.ws + WS_X1), F.out, (float*)(F.ws + WS_X2SS), MOD};
        pg8::gemm_phase<pg8::EpiDown, pg8::StaticOrder, PG8_ALIGN, PG8_SP2>(F.lds + RING_OFF, g, S, E);
        if (BOTH(9)) GRID_BAR();
    }
    if (IN(10)) p10_final(F, args);
#ifdef TSEL
    if (F.tid == 0) ((LAS unsigned*)(F.lds + LDSCTL_OFF))[16 + phk_] += (unsigned)(__builtin_amdgcn_s_memrealtime() - tph_);
    __syncthreads();
    if (blockIdx.x == 0 && F.tid == 0) { const unsigned ticks = ((LAS unsigned*)(F.lds + LDSCTL_OFF))[TSEL]; const unsigned long long t0_ = __builtin_amdgcn_s_memrealtime(); while (__builtin_amdgcn_s_memrealtime() - t0_ < (unsigned long long)ticks) __builtin_amdgcn_s_sleep(8); }
#endif
#undef IN
#undef BOTH
}

extern "C" void kernel_launch(void* const* d_in, const int* in_sizes, int n_in, void* d_out, int out_size, void* d_ws, size_t ws_size, hipStream_t stream) {
    static int grid = 0;
    if (grid == 0) {
        if (n_in != 20 || in_sizes[0] != M * D || out_size != M * D || ws_size < WS_END) { fprintf(stderr, "kernel_launch: unexpected shapes (n_in %d, in0 %d, out %d, ws %zu); nothing launched\n", n_in, n_in > 0 ? in_sizes[0] : -1, out_size, ws_size); grid = -1; return; }
        int dev = 0, cus = 0, per_cu = 0;
        if (hipGetDevice(&dev) != hipSuccess || hipDeviceGetAttribute(&cus, hipDeviceAttributeMultiprocessorCount, dev) != hipSuccess) { grid = -1; return; }
        if (hipFuncSetAttribute((const void*)fwd_kernel, hipFuncAttributeMaxDynamicSharedMemorySize, LDS_BYTES) != hipSuccess) { fprintf(stderr, "kernel_launch: hipFuncSetAttribute failed\n"); grid = -1; return; }
        if (hipOccupancyMaxActiveBlocksPerMultiprocessor(&per_cu, (const void*)fwd_kernel, NWAVES * 64, LDS_BYTES) != hipSuccess || per_cu < 1)
            fprintf(stderr, "kernel_launch: note: occupancy query reports %d workgroups per CU\n", per_cu);
        (void)hipGetLastError();
        grid = cus;
    }
    if (grid < 0) return;
    if (hipMemsetAsync((char*)d_ws + WS_CTL, 0, CTL_ZERO_BYTES, stream) != hipSuccess) { fprintf(stderr, "kernel_launch: memset failed\n"); return; }
    Args a{};
    for (int i = 0; i < 20; ++i) a.in[i] = (const float*)d_in[i];
    a.out = (float*)d_out; a.ws = (unsigned char*)d_ws;
    for (int li = 0; li < N_LAUNCHES; ++li) {
        a.ph_lo = (N_LAUNCHES == 1) ? 0 : li; a.ph_hi = (N_LAUNCHES == 1) ? N_PHASES : li + 1;
        hipLaunchKernelGGL(fwd_kernel, dim3(grid), dim3(NWAVES * 64), LDS_BYTES, stream, a);
        const hipError_t le = hipPeekAtLastError();
        if (le != hipSuccess) { fprintf(stderr, "kernel_launch: launch %d failed: %s\n", li, hipGetErrorName(le)); break; }
    }
}
```

```cpp
#include <hip/hip_runtime.h>
#include <cstdio>
#include <cstdint>
namespace pg8 {
#define PG8_LAS __attribute__((address_space(3)))
typedef unsigned short bf16_t;
typedef short bf16x8 __attribute__((ext_vector_type(8)));
typedef float f32x4 __attribute__((ext_vector_type(4)));
typedef unsigned u32x4 __attribute__((ext_vector_type(4)));
constexpr int BM = 256, BK = 64, HALF = 128, HTB = HALF * BK * 2  , STAGE_BYTES = 8 * HTB, NXCD = 8, WGM = 8;

__host__ __device__ __forceinline__ int lds_byte(int r, int c) { const int st = (r >> 4) * 2 + (c >> 5), rr = r & 15, cc = c & 31, ob = rr * 64 + cc * 2; return st * 1024 + (ob ^ (((ob >> 9) & 1) << 5)); }
__host__ __device__ __forceinline__ void stage_rc(int b, int& R, int& C) { const int st = b / 1024, sb = b % 1024, swz = sb ^ (((sb >> 9) & 1) << 5); R = (st >> 1) * 16 + swz / 64; C = (st & 1) * 32 + (swz % 64) / 2; }
__host__ __device__ __forceinline__ int perm32(int rho) { const int n = rho >> 4, i = rho & 15; return 8 * (i >> 2) + 4 * n + (i & 3); }

struct Unit { int pm, pn; };
struct Gemm { const bf16_t* A; const bf16_t* Bt; int M, N, K; };

struct StaticOrder {
    int nM, nN, nwg, G, c;
    __host__ __device__ void init(int M, int N, int G_, int c_) { nM = M / BM; nN = N / BM; nwg = nM * nN; G = G_; c = c_; }
    __host__ __device__ bool next(int i, Unit& u) const {
        const long L = (long)i * G + c; if (L >= nwg) return false;
        int wgid = (int)L; { const int q = nwg / NXCD, r = nwg % NXCD, xcd = wgid % NXCD, off = wgid / NXCD; wgid = (xcd < r ? xcd * (q + 1) : r * (q + 1) + (xcd - r) * q) + off; }
        const int nig = WGM * nN, gid = wgid / nig, fm = gid * WGM, gsz = (nM - fm) < WGM ? (nM - fm) : WGM;
        u.pm = fm + ((wgid % nig) % gsz); u.pn = (wgid % nig) / gsz; return true;
    }
    __device__ __forceinline__ void a_ready(const Unit&) const {}
    __device__ __forceinline__ void done(const Unit&) const {}
};

__device__ __forceinline__ unsigned cvt_pk_bf16(float lo, float hi) { unsigned r; asm volatile("v_cvt_pk_bf16_f32 %0, %1, %2" : "=v"(r) : "v"(lo), "v"(hi)); return r; }
__device__ __forceinline__ float fsigmoid(float x) { return __builtin_amdgcn_rcpf(1.0f + __expf(-x)); }
__device__ __forceinline__ float fsilu(float x) { return x * fsigmoid(x); }
__device__ __forceinline__ u32x4 pack8(const f32x4 a, const f32x4 b) { u32x4 w; w.x = cvt_pk_bf16(a[0], a[1]); w.y = cvt_pk_bf16(a[2], a[3]); w.z = cvt_pk_bf16(b[0], b[1]); w.w = cvt_pk_bf16(b[2], b[3]); return w; }
__device__ __forceinline__ float bf_lo(unsigned u) { return __builtin_bit_cast(float, u << 16); }
__device__ __forceinline__ float bf_hi(unsigned u) { return __builtin_bit_cast(float, u & 0xffff0000u); }

struct EpiInProj {
    static constexpr bool PERM = true, AFTER_DRAIN = false, CHAIN = false;
    bf16_t *CQ, *KV, *KI, *RQ, *GATES; float *WI, *CQSS; const float* LB;
    __device__ __forceinline__ void operator()(const f32x4 (&acc)[2][2][4][2], const Unit& u, int wr, int wc, int fr, int fq) const {
        const int row0 = u.pm * BM + wr * 64 + fr, pn = u.pn, cl = wc * 32 + 8 * fq;
        if (pn == 0) {
#pragma unroll
            for (int ai = 0; ai < 2; ++ai)
#pragma unroll
                for (int m = 0; m < 4; ++m) { const int row = row0 + ai * HALF + m * 16; float s = 0.f;
#pragma unroll
                    for (int bj = 0; bj < 2; ++bj) { const f32x4 a = acc[ai][bj][m][0], b = acc[ai][bj][m][1];
                        s += (a[0] * a[0] + a[1] * a[1]) + (a[2] * a[2] + a[3] * a[3]) + (b[0] * b[0] + b[1] * b[1]) + (b[2] * b[2] + b[3] * b[3]);
                        *(u32x4*)(CQ + (size_t)row * 256 + cl + bj * HALF) = pack8(a, b); }
                    s += __shfl_xor(s, 16); s += __shfl_xor(s, 32);
                    if (fq == 0) CQSS[(size_t)row * 4 + wc] = s; }
        } else if (pn == 1) {
#pragma unroll
            for (int ai = 0; ai < 2; ++ai)
#pragma unroll
                for (int m = 0; m < 4; ++m) { const int row = row0 + ai * HALF + m * 16;
#pragma unroll
                    for (int bj = 0; bj < 2; ++bj) *(u32x4*)(KV + (size_t)row * 256 + cl + bj * HALF) = pack8(acc[ai][bj][m][0], acc[ai][bj][m][1]); }
        } else if (pn == 2) {
#pragma unroll
            for (int ai = 0; ai < 2; ++ai)
#pragma unroll
                for (int m = 0; m < 4; ++m) { const int row = row0 + ai * HALF + m * 16;
                    if (wc < 2) *(u32x4*)(KI + (size_t)row * 64 + cl) = pack8(acc[ai][0][m][0], acc[ai][0][m][1]);
                    else if (wc == 2 && fq == 0) { *(f32x4*)(WI + (size_t)row * 8) = acc[ai][0][m][0]; *(f32x4*)(WI + (size_t)row * 8 + 4) = acc[ai][0][m][1]; } }
        } else if (pn <= 10) {
            const int kind = (pn - 3) >> 1, cb = ((pn - 3) & 1) * 256 + cl;
            bf16_t* dst = RQ + (size_t)kind * (size_t)(32u << 20);
#pragma unroll
            for (int bj = 0; bj < 2; ++bj) {
                f32x4 l0 = (f32x4){0.f, 0.f, 0.f, 0.f}, l1 = l0;
                if (kind == 1) { l0 = *(const f32x4*)(LB + cb + bj * HALF); l1 = *(const f32x4*)(LB + cb + bj * HALF + 4); }
#pragma unroll
                for (int ai = 0; ai < 2; ++ai)
#pragma unroll
                    for (int m = 0; m < 4; ++m) { const int row = row0 + ai * HALF + m * 16; f32x4 a = acc[ai][bj][m][0], b = acc[ai][bj][m][1];
                        if (kind == 0 || kind == 3) {
#pragma unroll
                            for (int j = 0; j < 4; ++j) { a[j] = fsilu(a[j]); b[j] = fsilu(b[j]); } }
                        else if (kind == 1) {
#pragma unroll
                            for (int j = 0; j < 4; ++j) { a[j] = __logf(l0[j] + (1.0f - l0[j]) * fsigmoid(a[j])); b[j] = __logf(l1[j] + (1.0f - l1[j]) * fsigmoid(b[j])); } }
                        *(u32x4*)(dst + (size_t)row * 512 + cb + bj * HALF) = pack8(a, b); }
            }
        } else {
            const int cb = (pn - 11) * 256 + cl;
#pragma unroll
            for (int ai = 0; ai < 2; ++ai)
#pragma unroll
                for (int m = 0; m < 4; ++m) { const int row = row0 + ai * HALF + m * 16;
#pragma unroll
                    for (int bj = 0; bj < 2; ++bj) { f32x4 a = acc[ai][bj][m][0], b = acc[ai][bj][m][1];
#pragma unroll
                        for (int j = 0; j < 4; ++j) { a[j] = fsigmoid(a[j]) * 255.0f + 0.5f; b[j] = fsigmoid(b[j]) * 255.0f + 0.5f; }
                        unsigned lo = (unsigned)a[0] | ((unsigned)a[1] << 8) | ((unsigned)a[2] << 16) | ((unsigned)a[3] << 24), hi = (unsigned)b[0] | ((unsigned)b[1] << 8) | ((unsigned)b[2] << 16) | ((unsigned)b[3] << 24);
                        typedef unsigned u32x2v __attribute__((ext_vector_type(2)));
                        *(u32x2v*)((unsigned char*)GATES + (size_t)row * 2048 + cb + bj * HALF) = (u32x2v){lo, hi}; } }
        }
    }
};

struct EpiQ {
    static constexpr bool PERM = true, AFTER_DRAIN = false, CHAIN = false;
    bf16_t *Q; const float* CQSS;
    __device__ __forceinline__ void operator()(const f32x4 (&acc)[2][2][4][2], const Unit& u, int wr, int wc, int fr, int fq) const {
        const int row0 = u.pm * BM + wr * 64 + fr, pn = u.pn, cl = (pn & 1) * 256 + wc * 32 + 8 * fq;
        bf16_t* dst = Q + (pn < 2 ? (size_t)0 : (size_t)(32u << 20));
        const float sc = pn < 2 ? 0.125f : 1.0f;
#pragma unroll
        for (int ai = 0; ai < 2; ++ai)
#pragma unroll
            for (int m = 0; m < 4; ++m) { const int row = row0 + ai * HALF + m * 16;
                const f32x4 ss = *(const f32x4*)(CQSS + (size_t)row * 4);
                const float r = __builtin_amdgcn_rsqf(((ss[0] + ss[1]) + (ss[2] + ss[3])) * (1.0f / 256.0f) + 1e-6f) * sc;
#pragma unroll
                for (int bj = 0; bj < 2; ++bj) *(u32x4*)(dst + (size_t)row * 512 + cl + bj * HALF) = pack8(acc[ai][bj][m][0] * r, acc[ai][bj][m][1] * r); }
    }
};

template <int MODE> struct EpiBranch {
    static constexpr bool PERM = true, AFTER_DRAIN = false, CHAIN = false;
    bf16_t* MIX; const bf16_t* GATES;
    __device__ __forceinline__ void operator()(const f32x4 (&acc)[2][2][4][2], const Unit& u, int wr, int wc, int fr, int fq) const {
        const int row0 = u.pm * BM + wr * 64 + fr, cl = u.pn * 256 + wc * 32 + 8 * fq;
#pragma unroll
        for (int ai = 0; ai < 2; ++ai)
#pragma unroll
            for (int m = 0; m < 4; ++m) { const int row = row0 + ai * HALF + m * 16;
#pragma unroll
                for (int bj = 0; bj < 2; ++bj) { const int c = cl + bj * HALF;
                    const u32x4 g = *(const u32x4*)(GATES + (size_t)row * 2048 + MODE * 1024 + c);
                    f32x4 a = acc[ai][bj][m][0], b = acc[ai][bj][m][1];
                    a[0] *= bf_lo(g.x); a[1] *= bf_hi(g.x); a[2] *= bf_lo(g.y); a[3] *= bf_hi(g.y); b[0] *= bf_lo(g.z); b[1] *= bf_hi(g.z); b[2] *= bf_lo(g.w); b[3] *= bf_hi(g.w);
                    if (MODE == 1) { const u32x4 p = *(const u32x4*)(MIX + (size_t)row * 1024 + c);
                        a[0] += bf_lo(p.x); a[1] += bf_hi(p.x); a[2] += bf_lo(p.y); a[3] += bf_hi(p.y); b[0] += bf_lo(p.z); b[1] += bf_hi(p.z); b[2] += bf_lo(p.w); b[3] += bf_hi(p.w); }
                    *(u32x4*)(MIX + (size_t)row * 1024 + c) = pack8(a, b); } }
    }
};

struct EpiOut {
    static constexpr bool PERM = true, AFTER_DRAIN = false, CHAIN = false;
    const float* X; bf16_t* X1; bf16_t* XS; float* X1SS; const float* MOD; const float* CW2;
    __device__ __forceinline__ void operator()(const f32x4 (&acc)[2][2][4][2], const Unit& u, int wr, int wc, int fr, int fq) const {
        const int row0 = u.pm * BM + wr * 64 + fr, cl = u.pn * 256 + wc * 32 + 8 * fq, b = u.pm >> 5;
#pragma unroll
        for (int ai = 0; ai < 2; ++ai)
#pragma unroll
            for (int m = 0; m < 4; ++m) { const int row = row0 + ai * HALF + m * 16; float s = 0.f;
#pragma unroll
                for (int bj = 0; bj < 2; ++bj) { const int c = cl + bj * HALF;
                    const float* xp = X + (size_t)row * 1024 + c; const float* gp = MOD + b * 6144 + 2048 + c; const float* cp = CW2 + b * 1024 + c;
                    const f32x4 v0 = *(const f32x4*)(xp) + *(const f32x4*)(gp) * acc[ai][bj][m][0], v1 = *(const f32x4*)(xp + 4) + *(const f32x4*)(gp + 4) * acc[ai][bj][m][1];
                    *(u32x4*)(X1 + (size_t)row * 1024 + c) = pack8(v0, v1);
                    s += (v0[0] * v0[0] + v0[1] * v0[1]) + (v0[2] * v0[2] + v0[3] * v0[3]) + (v1[0] * v1[0] + v1[1] * v1[1]) + (v1[2] * v1[2] + v1[3] * v1[3]);
                    *(u32x4*)(XS + (size_t)row * 1024 + c) = pack8(v0 * *(const f32x4*)(cp), v1 * *(const f32x4*)(cp + 4)); }
                s += __shfl_xor(s, 16); s += __shfl_xor(s, 32);
                if (fq == 0) X1SS[(size_t)row * 16 + u.pn * 4 + wc] = s; }
    }
};

struct EpiGateUp {
    static constexpr bool PERM = true, AFTER_DRAIN = false, CHAIN = false;
    bf16_t* HID; const float* X1SS; const float* BGU;
    const PG8_LAS float* BL; int bl;
    const PG8_LAS float* R2L; int g0, pm7;
    __device__ __forceinline__ void operator()(const f32x4 (&acc)[2][2][4][2], const Unit& u, int wr, int wc, int fr, int fq) const {
        const int row0 = u.pm * BM + wr * 64 + fr, cl = wc * 32 + 8 * fq, b = u.pm >> 5;
        const int slot = (u.pm >> 3) - g0; const bool cached = slot >= 0 && slot < 4 && (u.pm & 7) == pm7;
        f32x4 bg0, bg1, bu0, bu1;
        if (b == bl) { const PG8_LAS float* bp = BL + u.pn * 256 + cl; bg0 = *(const PG8_LAS f32x4*)(bp); bg1 = *(const PG8_LAS f32x4*)(bp + 4); bu0 = *(const PG8_LAS f32x4*)(bp + 128); bu1 = *(const PG8_LAS f32x4*)(bp + 132); }
        else { const float* bp = BGU + b * 5632 + u.pn * 256 + cl; bg0 = *(const f32x4*)(bp); bg1 = *(const f32x4*)(bp + 4); bu0 = *(const f32x4*)(bp + 128); bu1 = *(const f32x4*)(bp + 132); }
#pragma unroll
        for (int ai = 0; ai < 2; ++ai)
#pragma unroll
            for (int m = 0; m < 4; ++m) { const int row = row0 + ai * HALF + m * 16;
                float r = R2L[(cached ? slot : 0) * 256 + wr * 64 + fr + ai * HALF + m * 16];
                if (!cached) { float s = 0.f;
#pragma unroll
                    for (int q = 0; q < 4; ++q) { const f32x4 t = *(const f32x4*)(X1SS + (size_t)row * 16 + 4 * q); s += (t[0] + t[1]) + (t[2] + t[3]); }
                    r = __builtin_amdgcn_rsqf(s * (1.0f / 1024.0f) + 1e-6f); }
                f32x4 g0v = acc[ai][0][m][0] * r + bg0, g1v = acc[ai][0][m][1] * r + bg1; const f32x4 u0 = acc[ai][1][m][0] * r + bu0, u1 = acc[ai][1][m][1] * r + bu1;
#pragma unroll
                for (int j = 0; j < 4; ++j) { g0v[j] = fsilu(g0v[j]) * u0[j]; g1v[j] = fsilu(g1v[j]) * u1[j]; }
                *(u32x4*)(HID + (size_t)row * 2816 + u.pn * 128 + cl) = pack8(g0v, g1v); }
    }
};

struct EpiDown {
    static constexpr bool PERM = true, AFTER_DRAIN = false, CHAIN = false;
    const bf16_t* X1; float* OUT; float* X2SS; const float* MOD;
    __device__ __forceinline__ void operator()(const f32x4 (&acc)[2][2][4][2], const Unit& u, int wr, int wc, int fr, int fq) const {
        const int row0 = u.pm * BM + wr * 64 + fr, cl = u.pn * 256 + wc * 32 + 8 * fq, b = u.pm >> 5;
#pragma unroll
        for (int ai = 0; ai < 2; ++ai)
#pragma unroll
            for (int m = 0; m < 4; ++m) { const int row = row0 + ai * HALF + m * 16; float s = 0.f;
#pragma unroll
                for (int bj = 0; bj < 2; ++bj) { const int c = cl + bj * HALF;
                    const u32x4 xb = *(const u32x4*)(X1 + (size_t)row * 1024 + c);
                    const f32x4 x0 = (f32x4){bf_lo(xb.x), bf_hi(xb.x), bf_lo(xb.y), bf_hi(xb.y)}, x1 = (f32x4){bf_lo(xb.z), bf_hi(xb.z), bf_lo(xb.w), bf_hi(xb.w)};
                    const f32x4 v0 = x0 + *(const f32x4*)(MOD + b * 6144 + 5120 + c) * acc[ai][bj][m][0], v1 = x1 + *(const f32x4*)(MOD + b * 6144 + 5120 + c + 4) * acc[ai][bj][m][1];
                    *(f32x4*)(OUT + (size_t)row * 1024 + c) = v0; *(f32x4*)(OUT + (size_t)row * 1024 + c + 4) = v1;
                    s += (v0[0] * v0[0] + v0[1] * v0[1]) + (v0[2] * v0[2] + v0[3] * v0[3]) + (v1[0] * v1[0] + v1[1] * v1[1]) + (v1[2] * v1[2] + v1[3] * v1[3]); }
                s += __shfl_xor(s, 16); s += __shfl_xor(s, 32);
                if (fq == 0) X2SS[(size_t)row * 16 + u.pn * 4 + wc] = s; }
    }
};


struct ChainOrder : StaticOrder {
    __device__ bool next(int i, Unit& u) const { Unit t; if (!StaticOrder::next(i >> 1, t)) return false; u.pm = t.pm + ((i & 1) ? 256 : 0); u.pn = t.pn + ((i & 1) ? 4 : 0); return true; }
};
struct EpiBranchChain {
    static constexpr bool PERM = true, AFTER_DRAIN = false, CHAIN = true;
    bf16_t* MIX; const bf16_t* GATES;
    __device__ __forceinline__ bool chain(f32x4 (&acc)[2][2][4][2], const Unit& u, int wr, int wc, int fr, int fq) const {
        const bool second = u.pm >= 256; const int pm = second ? u.pm - 256 : u.pm, pn = second ? u.pn - 4 : u.pn;
        const int row0 = pm * BM + wr * 64 + fr, cl = pn * 256 + wc * 32 + 8 * fq;
#pragma unroll
        for (int ai = 0; ai < 2; ++ai)
#pragma unroll
            for (int m = 0; m < 4; ++m) { const int row = row0 + ai * HALF + m * 16;
#pragma unroll
                for (int bj = 0; bj < 2; ++bj) { const int c = cl + bj * HALF;
                    typedef unsigned u32x2v __attribute__((ext_vector_type(2)));
                    const u32x2v gr = *(const u32x2v*)((const unsigned char*)GATES + (size_t)row * 2048 + 1024 + c);
                    float r[8];
#pragma unroll
                    for (int j = 0; j < 4; ++j) { r[j] = (float)((gr.x >> (8 * j)) & 255u) * (1.0f / 255.0f); r[4 + j] = (float)((gr.y >> (8 * j)) & 255u) * (1.0f / 255.0f); }
#pragma unroll
                    for (int j = 0; j < 8; ++j) r[j] = fmaxf(r[j], 1e-30f);
                    if (!second) { const u32x2v ga = *(const u32x2v*)((const unsigned char*)GATES + (size_t)row * 2048 + c);
                        float a[8];
#pragma unroll
                        for (int j = 0; j < 4; ++j) { a[j] = (float)((ga.x >> (8 * j)) & 255u) * (1.0f / 255.0f); a[4 + j] = (float)((ga.y >> (8 * j)) & 255u) * (1.0f / 255.0f); }
#pragma unroll
                        for (int j = 0; j < 4; ++j) { acc[ai][bj][m][0][j] *= a[j] * __builtin_amdgcn_rcpf(r[j]); acc[ai][bj][m][1][j] *= a[4 + j] * __builtin_amdgcn_rcpf(r[4 + j]); } }
                    else { f32x4 v0 = acc[ai][bj][m][0], v1 = acc[ai][bj][m][1];
#pragma unroll
                        for (int j = 0; j < 4; ++j) { v0[j] *= r[j]; v1[j] *= r[4 + j]; }
                        *(u32x4*)(MIX + (size_t)row * 1024 + c) = pack8(v0, v1); } } }
        return !second;
    }
};
template <class Epi, class Sched, bool ALIGN_EPI = false, bool SP2 = false>
__device__ __forceinline__ void gemm_phase(PG8_LAS unsigned char* lds, const Gemm g, const Sched& S, const Epi& E) {
    const int tid = threadIdx.x, wid = __builtin_amdgcn_readfirstlane(tid >> 6), lane = tid & 63, wr = wid >> 2, wc = wid & 3, fr = lane & 15, fq = lane >> 4;
    const int K = g.K, nt = K / BK;
    unsigned voffA[2], voffB[2];
#pragma unroll
    for (int i = 0; i < 2; ++i) { int R, C; stage_rc(tid * 16 + i * 8192, R, C); const int Rb = Epi::PERM ? ((R & ~31) + perm32(R & 31)) : R;
        voffA[i] = (unsigned)(R * K + C) * 2u; voffB[i] = (unsigned)(Rb * K + C) * 2u; }
    const size_t kstep = (size_t)(BK * 2);
    const size_t hstep = (size_t)HALF * K * 2;
    const size_t tstep = 2 * hstep;
    const unsigned ldsw = (unsigned)wid * 1024u;
    const int aoff = lds_byte(wr * 64 + fr, fq * 8), boff = lds_byte(wc * 32 + fr, fq * 8);
#define PG8_SA(b, h) (((b) * 2 + (h)) * HTB)
#define PG8_SB(b, h) ((4 + (b) * 2 + (h)) * HTB)
#define PG8_STAGE(bufoff, gbase, voff) do { _Pragma("unroll") for (int _i = 0; _i < 2; ++_i) \
        __builtin_amdgcn_global_load_lds((const unsigned*)((const char*)(gbase) + (voff)[_i]), (PG8_LAS unsigned*)(lds + (bufoff) + ldsw + _i * 8192), 16, 0, 0); } while (0)
#define PG8_LDA(dst, b, h) do { _Pragma("unroll") for (int m = 0; m < 4; ++m) _Pragma("unroll") for (int k = 0; k < 2; ++k) dst[m][k] = *(const PG8_LAS bf16x8*)(lds + PG8_SA(b, h) + aoff + m * 2048 + k * 1024); } while (0)
#define PG8_LDB(dst, b, h) do { _Pragma("unroll") for (int n = 0; n < 2; ++n) _Pragma("unroll") for (int k = 0; k < 2; ++k) dst[n][k] = *(const PG8_LAS bf16x8*)(lds + PG8_SB(b, h) + boff + n * 2048 + k * 1024); } while (0)
#define PG8_MMA(ai, bj, At, Bt) do { __builtin_amdgcn_s_setprio(1); _Pragma("unroll") for (int m = 0; m < 4; ++m) _Pragma("unroll") for (int n = 0; n < 2; ++n) _Pragma("unroll") for (int k = 0; k < 2; ++k) \
        acc[ai][bj][m][n] = __builtin_amdgcn_mfma_f32_16x16x32_bf16(Bt[n][k], At[m][k], acc[ai][bj][m][n], 0, 0, 0); __builtin_amdgcn_s_setprio(0); } while (0)
#define PG8_WAIT_V(n) asm volatile("s_waitcnt vmcnt(" #n ")" ::: "memory")
#define PG8_WAIT_L(n) asm volatile("s_waitcnt lgkmcnt(" #n ")" ::: "memory")
#define PG8_BAR __builtin_amdgcn_s_barrier()
#define PG8_SCHED __builtin_amdgcn_sched_barrier(0)
    Unit cur, nxt; int ui = 0;
    if (!S.next(0, cur)) return;
    f32x4 acc[2][2][4][2];
#pragma unroll
    for (int a = 0; a < 2; ++a)
#pragma unroll
        for (int b = 0; b < 2; ++b)
#pragma unroll
            for (int m = 0; m < 4; ++m)
#pragma unroll
                for (int n = 0; n < 2; ++n) acc[a][b][m][n] = (f32x4){0.f, 0.f, 0.f, 0.f};
    bf16x8 At[4][2], B0[2][2], B1[2][2];
    const char* cA = (const char*)g.A + (size_t)cur.pm * tstep; const char* cB = (const char*)g.Bt + (size_t)cur.pn * tstep;
    S.a_ready(cur);
    if constexpr (SP2) {
        PG8_STAGE(PG8_SB(0, 0), cB, voffB); PG8_STAGE(PG8_SB(0, 1), cB + hstep, voffB); PG8_STAGE(PG8_SA(0, 0), cA, voffA); PG8_STAGE(PG8_SA(0, 1), cA + hstep, voffA);
        if (wr == 1) PG8_BAR;
        PG8_WAIT_V(2); PG8_BAR;
        PG8_STAGE(PG8_SB(1, 0), cB + kstep, voffB); PG8_STAGE(PG8_SA(1, 0), cA + kstep, voffA); PG8_STAGE(PG8_SB(1, 1), cB + hstep + kstep, voffB);
        PG8_WAIT_V(6); PG8_BAR;
    } else {
        PG8_STAGE(PG8_SB(0, 0), cB, voffB); PG8_STAGE(PG8_SA(0, 0), cA, voffA); PG8_STAGE(PG8_SB(0, 1), cB + hstep, voffB); PG8_STAGE(PG8_SA(0, 1), cA + hstep, voffA);
        if (wr == 1) PG8_BAR;
        PG8_WAIT_V(4); PG8_BAR;
        PG8_STAGE(PG8_SB(1, 0), cB + kstep, voffB); PG8_STAGE(PG8_SA(1, 0), cA + kstep, voffA); PG8_STAGE(PG8_SB(1, 1), cB + hstep + kstep, voffB);
        PG8_WAIT_V(6); PG8_BAR;
    }
    for (;;) {
        const bool has_next = S.next(ui + 1, nxt);
        const char* nA = has_next ? (const char*)g.A + (size_t)nxt.pm * tstep : cA; const char* nB = has_next ? (const char*)g.Bt + (size_t)nxt.pn * tstep : cB;
        for (int t = 0; t < nt; t += 2) {
            const bool last = (t == nt - 2);
            const char* a1 = cA + (size_t)(t + 1) * kstep;
            const char* a2 = last ? nA : cA + (size_t)(t + 2) * kstep; const char* b2 = last ? nB : cB + (size_t)(t + 2) * kstep;
            const char* a3 = a2 + kstep; const char* b3 = b2 + kstep;
            if (last && has_next) S.a_ready(nxt);
            if constexpr (SP2) {
            PG8_LDB(B0, 0, 0); PG8_LDB(B1, 0, 1); PG8_SCHED; PG8_LDA(At, 0, 0); PG8_STAGE(PG8_SA(1, 1), a1 + hstep, voffA);
            PG8_WAIT_V(8); PG8_WAIT_L(0); PG8_BAR; PG8_MMA(0, 0, At, B0); PG8_MMA(0, 1, At, B1); PG8_BAR; PG8_SCHED;
            PG8_LDA(At, 0, 1); PG8_STAGE(PG8_SB(0, 0), b2, voffB); PG8_STAGE(PG8_SB(0, 1), b2 + hstep, voffB); PG8_STAGE(PG8_SA(0, 0), a2, voffA);
            PG8_WAIT_V(8); PG8_WAIT_L(0); PG8_BAR; PG8_MMA(1, 0, At, B0); PG8_MMA(1, 1, At, B1); PG8_BAR; PG8_SCHED;
            PG8_LDB(B0, 1, 0); PG8_LDB(B1, 1, 1); PG8_SCHED; PG8_LDA(At, 1, 0); PG8_STAGE(PG8_SA(0, 1), a2 + hstep, voffA);
            PG8_WAIT_V(8); PG8_WAIT_L(0); PG8_BAR; PG8_MMA(0, 0, At, B0); PG8_MMA(0, 1, At, B1); PG8_BAR; PG8_SCHED;
            PG8_LDA(At, 1, 1); PG8_STAGE(PG8_SB(1, 0), b3, voffB); PG8_STAGE(PG8_SB(1, 1), b3 + hstep, voffB); PG8_STAGE(PG8_SA(1, 0), a3, voffA);
            PG8_WAIT_V(8); PG8_WAIT_L(0); PG8_BAR; PG8_MMA(1, 0, At, B0); PG8_MMA(1, 1, At, B1); PG8_BAR; PG8_SCHED;
            } else {
            PG8_LDB(B0, 0, 0); PG8_SCHED; PG8_LDA(At, 0, 0); PG8_STAGE(PG8_SA(1, 1), a1 + hstep, voffA);
            PG8_WAIT_L(8); PG8_BAR; PG8_WAIT_L(0); PG8_MMA(0, 0, At, B0); PG8_BAR; PG8_SCHED;
            PG8_LDB(B1, 0, 1); PG8_STAGE(PG8_SB(0, 0), b2, voffB);
            PG8_BAR; PG8_WAIT_L(0); PG8_MMA(0, 1, At, B1); PG8_BAR;
            PG8_LDA(At, 0, 1); PG8_STAGE(PG8_SA(0, 0), a2, voffA);
            PG8_BAR; PG8_WAIT_L(0); PG8_MMA(1, 0, At, B0); PG8_BAR; PG8_SCHED;
            PG8_STAGE(PG8_SB(0, 1), b2 + hstep, voffB);
            PG8_WAIT_V(6); PG8_BAR; PG8_MMA(1, 1, At, B1); PG8_BAR;
            PG8_LDB(B0, 1, 0); PG8_SCHED; PG8_LDA(At, 1, 0); PG8_STAGE(PG8_SA(0, 1), a2 + hstep, voffA);
            PG8_WAIT_L(8); PG8_BAR; PG8_WAIT_L(0); PG8_MMA(0, 0, At, B0); PG8_BAR; PG8_SCHED;
            PG8_LDB(B1, 1, 1); PG8_STAGE(PG8_SB(1, 0), b3, voffB);
            PG8_BAR; PG8_WAIT_L(0); PG8_MMA(0, 1, At, B1); PG8_BAR;
            PG8_LDA(At, 1, 1); PG8_STAGE(PG8_SA(1, 0), a3, voffA);
            PG8_BAR; PG8_WAIT_L(0); PG8_MMA(1, 0, At, B0); PG8_BAR; PG8_SCHED;
            PG8_STAGE(PG8_SB(1, 1), b3 + hstep, voffB);
            PG8_WAIT_V(6); PG8_BAR; PG8_MMA(1, 1, At, B1); PG8_BAR;
            }
        }
        if constexpr (ALIGN_EPI) { if (wr == 0) PG8_BAR; }
        bool keep_acc = false;
        if constexpr (Epi::CHAIN) { keep_acc = E.chain(acc, cur, wr, wc, fr, fq); S.done(cur); }
        else if constexpr (!Epi::AFTER_DRAIN) { E(acc, cur, wr, wc, fr, fq); S.done(cur); }
        if (!has_next) break;
        if (!keep_acc)
#pragma unroll
        for (int a = 0; a < 2; ++a)
#pragma unroll
            for (int b = 0; b < 2; ++b)
#pragma unroll
                for (int m = 0; m < 4; ++m)
#pragma unroll
                    for (int n = 0; n < 2; ++n) acc[a][b][m][n] = (f32x4){0.f, 0.f, 0.f, 0.f};
        cur = nxt; cA = nA; cB = nB; ++ui;
        if constexpr (ALIGN_EPI) { if (wr == 1) PG8_BAR; }
    }
    PG8_WAIT_V(0);
    if constexpr (!ALIGN_EPI) { if (wr == 0) PG8_BAR; }
    PG8_BAR;
    if constexpr (Epi::AFTER_DRAIN) { E.fused(acc, cur, wr, wc, fr, fq, lds, wid, lane); S.done(cur); }
#undef PG8_SA
#undef PG8_SB
#undef PG8_STAGE
#undef PG8_LDA
#undef PG8_LDB
#undef PG8_MMA
#undef PG8_WAIT_V
#undef PG8_WAIT_L
#undef PG8_BAR
#undef PG8_SCHED
}
}
#ifndef PG8_SP2
#define PG8_SP2 true
#endif
#ifndef PG8_ALIGN
#define PG8_ALIGN true
#endif

constexpr int NWAVES = 8;
#ifndef MK_N_LAUNCHES
#define MK_N_LAUNCHES 1
#endif
constexpr int N_PHASES = 11;
constexpr int N_LAUNCHES = MK_N_LAUNCHES;
static_assert(N_LAUNCHES == 1 || N_LAUNCHES == N_PHASES, "MK_N_LAUNCHES is 1 or N_PHASES");

constexpr int NB = 8, SEQ = 8192, D = 1024, M = NB * SEQ;
constexpr int NPROJ = 4680, NPROJ_PAD = 4864, FF = 2816, NGU = 2 * FF;
constexpr float EPS = 1e-6f;

constexpr size_t MiB = 1u << 20;
constexpr size_t WS_CTL = 0, CTL_ZERO_BYTES = 1 * MiB;
constexpr size_t WS_MOD = 1 * MiB;
constexpr size_t WS_LB = WS_MOD + 256 * 1024;
constexpr size_t WS_CW2 = WS_MOD + 320 * 1024;
constexpr size_t WS_BGU = WS_MOD + 512 * 1024;
constexpr size_t WS_WIN = 3 * MiB, WS_WQ = 13 * MiB, WS_WBA = 14 * MiB, WS_WBR = 15 * MiB, WS_WOUT = 16 * MiB, WS_WGU = 18 * MiB, WS_WD = 29 * MiB;
constexpr size_t WS_CQSS = 35 * MiB, WS_X1SS = 36 * MiB, WS_X2SS = 40 * MiB;
constexpr size_t WS_XN = 64 * MiB;
constexpr size_t WS_CQ = 192 * MiB, WS_KV = 224 * MiB, WS_KI = 256 * MiB, WS_WI = 264 * MiB;
constexpr size_t WS_RQ = 272 * MiB, WS_RGL = 336 * MiB, WS_RI = 400 * MiB, WS_RGS = 464 * MiB;
constexpr size_t WS_Q = 528 * MiB, WS_QI = 592 * MiB;
constexpr size_t WS_ATT = 64 * MiB, WS_REC = 128 * MiB;
constexpr size_t WS_SCR = 656 * MiB;
constexpr size_t WS_OLOC = 784 * MiB, WS_QHAT = 848 * MiB, WS_U = 912 * MiB, WS_DS = 928 * MiB;
constexpr size_t WS_MIX = 896 * MiB;
constexpr size_t WS_X1 = 64 * MiB, WS_XS = 320 * MiB, WS_HID = 448 * MiB;
constexpr size_t WS_END = 1024 * MiB;
static_assert(WS_REC == WS_ATT + 64 * MiB && WS_WBR == WS_WBA + 1 * MiB, "the chained branch GEMM views [attn ; rec] and [Wa ; Wr] as one operand each");
static_assert(WS_RGL == WS_RQ + 64 * MiB && WS_RI == WS_RQ + 128 * MiB && WS_RGS == WS_RQ + 192 * MiB && WS_QI == WS_Q + 64 * MiB, "epilogue pointer arithmetic");
static_assert(WS_HID + (size_t)M * FF * 2 <= WS_END && WS_DS + 256 * 128 * 4 <= WS_END, "map");

constexpr int CW_TMO = 0, CW_CODE = 1;
constexpr int CW_BAR = 4096;

constexpr int RING_OFF = 0, RING_BYTES = 131072;
constexpr int LDS_BYTES = 163840;
constexpr int LDSCTL_OFF = LDS_BYTES - 1024, MISC_OFF = LDSCTL_OFF + 320;
static_assert(MISC_OFF + 128 <= LDS_BYTES, "LDS map");

#define GAS __attribute__((address_space(1)))
#define LAS __attribute__((address_space(3)))
typedef unsigned short bf16;
typedef unsigned v4u __attribute__((ext_vector_type(4)));
typedef unsigned v2u __attribute__((ext_vector_type(2)));
typedef float f32x4 __attribute__((ext_vector_type(4)));
typedef float f32x16 __attribute__((ext_vector_type(16)));
typedef short bf16x8 __attribute__((ext_vector_type(8)));
typedef GAS unsigned gu32;
#define RLX_AGENT __ATOMIC_RELAXED, __HIP_MEMORY_SCOPE_AGENT
#define LDS_WAIT() asm volatile("s_waitcnt lgkmcnt(0)" ::: "memory")
#define VM_WAIT() asm volatile("s_waitcnt vmcnt(0)" ::: "memory")
typedef float f32x2_t __attribute__((ext_vector_type(2)));
typedef __bf16 bf16x2_t __attribute__((ext_vector_type(2)));
__device__ __forceinline__ unsigned pk2(float lo, float hi) { const f32x2_t v = {lo, hi}; const bf16x2_t b = __builtin_convertvector(v, bf16x2_t); return __builtin_bit_cast(unsigned, b); }
__device__ __forceinline__ unsigned f2bf(float f) { return pk2(f, 0.f) & 0xffffu; }
__device__ __forceinline__ float bflo(unsigned u) { return __builtin_bit_cast(float, u << 16); }
__device__ __forceinline__ float bfhi(unsigned u) { return __builtin_bit_cast(float, u & 0xffff0000u); }
__device__ __forceinline__ float bf1(bf16 h) { return __builtin_bit_cast(float, (unsigned)h << 16); }

#define XB_TMO      128
#define XB_XCNT(j)  (256  + 64 * (j))
#define XB_XSUB(j)  (1280 + 64 * (j))
#define XB_XGEN(j)  (2304 + 64 * (j))
#define XB_TOP      3328
#define XB_TOPGEN   3392
#define XCD_BAR_WORDS 3456
#define XB_SPIN_CAP (1u << 23)

__device__ __forceinline__ unsigned xb_ld(unsigned* p)              { return __hip_atomic_load(p, __ATOMIC_RELAXED, __HIP_MEMORY_SCOPE_AGENT); }
__device__ __forceinline__ unsigned xb_add(unsigned* p, unsigned v) { return __hip_atomic_fetch_add(p, v, __ATOMIC_RELAXED, __HIP_MEMORY_SCOPE_AGENT); }
__device__ __forceinline__ unsigned xb_xcc_id() { return (unsigned)__builtin_amdgcn_s_getreg((3 << 11) | 20) & 0xFu; }
#define XB_SPIN(cond, bar) do { unsigned _sp = 0; while (cond) { __builtin_amdgcn_s_sleep(1); \
    if ((++_sp & 255u) == 0u) { if (xb_ld(&(bar)[XB_TMO])) break; if (_sp > XB_SPIN_CAP) { atomicAdd(&(bar)[XB_TMO], 1u); break; } } } } while (0)

struct XcdBarrier { unsigned* bar; unsigned x; volatile LAS unsigned* st; };

__device__ __forceinline__ XcdBarrier xcd_barrier_post(unsigned* bar, volatile LAS unsigned* st) {
    XcdBarrier b; b.bar = bar; b.x = xb_xcc_id(); b.st = st;
    if (threadIdx.x == 0) (void)xb_add(&bar[XB_XCNT(b.x)], 1u);
    return b;
}
__device__ __forceinline__ void xcd_barrier_complete(unsigned* bar, unsigned x, unsigned& nloc, unsigned& nx) {
    const unsigned G = gridDim.x * gridDim.y * gridDim.z;
    unsigned sum, cnt, mine, sp = 0u;
    for (;;) {
        sum = 0u; cnt = 0u; mine = 0u;
#pragma unroll
        for (unsigned j = 0; j < 16; ++j) { const unsigned c = xb_ld(&bar[XB_XCNT(j)]); sum += c; cnt += (c > 0u) ? 1u : 0u; mine = (j == x) ? c : mine; }
        if (sum == G) break;
        __builtin_amdgcn_s_sleep(1);
        if ((++sp & 255u) == 0u) { if (xb_ld(&bar[XB_TMO])) break; if (sp > XB_SPIN_CAP) { atomicAdd(&bar[XB_TMO], 1u); break; } }
    }
    nloc = mine > 0u ? mine : 1u; nx = cnt > 0u ? cnt : 1u;
}
__device__ __forceinline__ void xcd_barrier(const XcdBarrier& b) {
    asm volatile("s_waitcnt vmcnt(0)" ::: "memory");
    __syncthreads();
    if (threadIdx.x == 0) {
        unsigned* bar = b.bar;
        __builtin_amdgcn_s_waitcnt(0);
        unsigned nloc = b.st[0], nx = b.st[1];
        if (nloc == 0u) { xcd_barrier_complete(bar, b.x, nloc, nx); b.st[0] = nloc; b.st[1] = nx; }
        const unsigned old = xb_add(&bar[XB_XSUB(b.x)], 1u);
        const unsigned gen = old / nloc;
        if (old + 1u == (gen + 1u) * nloc) {
            __builtin_amdgcn_fence(__ATOMIC_RELEASE, "agent");
            asm volatile("s_waitcnt vmcnt(0)" ::: "memory");
            const unsigned og = xb_add(&bar[XB_TOP], 1u);
            const unsigned tg = og / nx;
            if (og + 1u == (tg + 1u) * nx) xb_add(&bar[XB_TOPGEN], 1u);
            else XB_SPIN(xb_ld(&bar[XB_TOPGEN]) == tg, bar);
            __builtin_amdgcn_fence(__ATOMIC_ACQUIRE, "agent");
            xb_add(&bar[XB_XGEN(b.x)], 1u);
            asm volatile("s_waitcnt vmcnt(0)" ::: "memory");
        } else {
            XB_SPIN(xb_ld(&bar[XB_XGEN(b.x)]) == gen, bar);
            __builtin_amdgcn_fence(__ATOMIC_ACQUIRE, "agent");
            asm volatile("s_waitcnt vmcnt(0)" ::: "memory");
        }
    }
    __syncthreads();
}

struct Frame {
    LAS unsigned char* lds;
    volatile LAS unsigned* MISC;
    gu32* ctl;
    unsigned char* ws;
    int tid, lane, wave;
    int G;
    float* out;
};
__device__ __forceinline__ float wave_sum(float v) {
#pragma unroll
    for (int o = 1; o < 64; o <<= 1) v += __shfl_xor(v, o);
    return v;
}
__device__ __forceinline__ float wave_max(float v) {
#pragma unroll
    for (int o = 1; o < 64; o <<= 1) v = fmaxf(v, __shfl_xor(v, o));
    return v;
}

template <class SrcCol>
__device__ __forceinline__ void transpose_item(const float* W, int ldw, int K, bf16* WT, const float* ks, LAS float* scr, int item, int nblk, int lane, SrcCol src) {
    const int kb = item / nblk, nb = item % nblk, k0 = 64 * kb, n0 = 32 * nb;
    const float* Wp; const int sc = src(n0 + (lane & 31), Wp);
#pragma unroll 8
    for (int i = 0; i < 32; ++i) { const int kk = 2 * i + (lane >> 5); float v = 0.f; if (sc >= 0) { v = Wp[(size_t)(k0 + kk) * ldw + sc]; if (ks) v *= ks[k0 + kk]; } scr[kk * 33 + (lane & 31)] = v; }
    LDS_WAIT(); asm volatile("" ::: "memory");
    const int c = lane & 7;
#pragma unroll
    for (int j = 0; j < 4; ++j) { const int n = (lane >> 3) + 8 * j; const LAS float* s = scr + (8 * c) * 33 + n;
        v4u o; o.x = pk2(s[0 * 33], s[1 * 33]); o.y = pk2(s[2 * 33], s[3 * 33]); o.z = pk2(s[4 * 33], s[5 * 33]); o.w = pk2(s[6 * 33], s[7 * 33]);
        *(GAS v4u*)(WT + (size_t)(n0 + n) * K + k0 + 8 * c) = o; }
    LDS_WAIT(); asm volatile("" ::: "memory");
}
struct Args { const float* in[20]; float* out; unsigned char* ws; int ph_lo, ph_hi; };
template <class SrcCol>
__device__ __forceinline__ void gemv8(Frame& F, const LAS float* vec, int cpg, int ngrp, int ldw, SrcCol src, const float* bias, float* out, int ldo) {
    LAS float* red = (LAS float*)(F.lds + 32768);
    for (int jb = blockIdx.x; jb < ngrp; jb += F.G) {
        const int col = F.tid & 31, kg = F.tid >> 5; float a[8];
#pragma unroll
        for (int b = 0; b < 8; ++b) a[b] = 0.f;
        const float* Wp = nullptr; int sc = -1;
        if (col < cpg) sc = src(jb * cpg + col, Wp);
        if (sc >= 0) for (int k = kg * 64; k < kg * 64 + 64; ++k) { const float w = Wp[(size_t)k * ldw + sc];
#pragma unroll
            for (int b = 0; b < 8; ++b) a[b] += vec[b * 1024 + k] * w; }
#pragma unroll
        for (int b = 0; b < 8; ++b) red[(kg * 8 + b) * 32 + col] = a[b];
        __syncthreads();
        if (F.tid < 256) { const int b = F.tid >> 5, c2 = F.tid & 31;
            if (c2 < cpg) { float s = 0.f; for (int k2 = 0; k2 < 16; ++k2) s += red[(k2 * 8 + b) * 32 + c2]; const int jj = jb * cpg + c2; out[b * ldo + jj] = s + (bias ? bias[jj] : 0.f); } }
        __syncthreads();
    }
}
struct SrcWin { const float* W; __device__ __forceinline__ int operator()(int d, const float*& Wp) const { Wp = W; return d < 584 ? d : (d < 768 ? -1 : d - 184); } };
__device__ __forceinline__ const float* psel(const float* a, const float* b, bool takeb) { const unsigned long long x = (unsigned long long)a, y = (unsigned long long)b, m = takeb ? ~0ull : 0ull; return (const float*)(x ^ ((x ^ y) & m)); }
struct SrcWq { const float *Wa, *Wb; __device__ __forceinline__ int operator()(int d, const float*& Wp) const { Wp = psel(Wa, Wb, d >= 512); return d & 511; } };
struct SrcId { const float* W; __device__ __forceinline__ int operator()(int d, const float*& Wp) const { Wp = W; return d; } };
struct SrcGu { const float *Wg, *Wu; __device__ __forceinline__ int operator()(int d, const float*& Wp) const { const int t = d >> 8, w = d & 255; Wp = psel(Wg, Wu, w >= 128); return t * 128 + (w & 127); } };

__device__ __forceinline__ void p0_prologue(Frame& F, const Args& A) {
    LAS float* cact = (LAS float*)(F.lds);
    for (int i = F.tid; i < 8192; i += NWAVES * 64) { const float v = A.in[1][i]; cact[i] = v / (1.0f + __expf(-v)); }
    __syncthreads();
    gemv8(F, cact, 24, 256, 6144, SrcId{A.in[2]}, A.in[3], (float*)(F.ws + WS_MOD), 6144);
    if (blockIdx.x == 0) { const float* l = A.in[10]; float* LB = (float*)(F.ws + WS_LB);
        for (int c = F.tid; c < 512; c += NWAVES * 64) LB[c] = 1.0f / (1.0f + __expf(l[512 + c] - l[c])); }
    __syncthreads();
    LAS float* scr = (LAS float*)(F.lds + 49152 + F.wave * 8448);
    const int gw = blockIdx.x * NWAVES + F.wave, NGW = F.G * NWAVES;
    constexpr int I_IN = 16 * 152, I_Q = 4 * 32, I_BA = 8 * 32, I_BR = 8 * 32, I_O = 16 * 32, I_GU = 16 * 176, I_D = 44 * 32;
    constexpr int NITEMS = I_IN + I_Q + I_BA + I_BR + I_O + I_GU + I_D;
    for (int it = gw; it < NITEMS; it += NGW) {
        int r = it;
        if (r < I_IN) { transpose_item(A.in[5], NPROJ, 1024, (bf16*)(F.ws + WS_WIN), nullptr, scr, r, 152, F.lane, SrcWin{A.in[5]}); continue; } r -= I_IN;
        if (r < I_Q) { transpose_item(nullptr, 512, 256, (bf16*)(F.ws + WS_WQ), A.in[6], scr, r, 32, F.lane, SrcWq{A.in[7], A.in[8]}); continue; } r -= I_Q;
        if (r < I_BA) { transpose_item(nullptr, 1024, 512, (bf16*)(F.ws + WS_WBA), nullptr, scr, r, 32, F.lane, SrcId{A.in[12]}); continue; } r -= I_BA;
        if (r < I_BR) { transpose_item(nullptr, 1024, 512, (bf16*)(F.ws + WS_WBR), nullptr, scr, r, 32, F.lane, SrcId{A.in[13]}); continue; } r -= I_BR;
        if (r < I_O) { transpose_item(nullptr, 1024, 1024, (bf16*)(F.ws + WS_WOUT), nullptr, scr, r, 32, F.lane, SrcId{A.in[14]}); continue; } r -= I_O;
        if (r < I_GU) { transpose_item(nullptr, FF, 1024, (bf16*)(F.ws + WS_WGU), nullptr, scr, r, 176, F.lane, SrcGu{A.in[16], A.in[17]}); continue; } r -= I_GU;
        transpose_item(nullptr, 1024, FF, (bf16*)(F.ws + WS_WD), nullptr, scr, r, 32, F.lane, SrcId{A.in[18]});
    }
}

__device__ __forceinline__ void p1_norm(Frame& F, const Args& A) {
    const float* MOD = (const float*)(F.ws + WS_MOD);
    { float* CW2 = (float*)(F.ws + WS_CW2); const int g = blockIdx.x * (NWAVES * 64) + F.tid;
      if (g < 8192) { const int b = g >> 10, c = g & 1023; CW2[g] = A.in[15][c] * (1.0f + MOD[b * 6144 + 4096 + c]); } }
    { LAS float* sh2 = (LAS float*)(F.lds);
      for (int i = F.tid; i < 8192; i += NWAVES * 64) sh2[i] = MOD[(i >> 10) * 6144 + 3072 + (i & 1023)];
      __syncthreads();
      gemv8(F, sh2, 22, 256, FF, SrcGu{A.in[16], A.in[17]}, nullptr, (float*)(F.ws + WS_BGU), NGU); }
    const int gw = blockIdx.x * NWAVES + F.wave, NGW = F.G * NWAVES; bf16* XN = (bf16*)(F.ws + WS_XN);
    for (int m0 = gw; m0 < M; m0 += 4 * NGW) {
        f32x4 v[4][4]; float r[4];
#pragma unroll
        for (int k = 0; k < 4; ++k) { const int m = m0 + k * NGW < M ? m0 + k * NGW : m0; const GAS f32x4* xr = (const GAS f32x4*)(A.in[0] + (size_t)m * D) + F.lane;
#pragma unroll
            for (int j = 0; j < 4; ++j) v[k][j] = xr[64 * j]; }
#pragma unroll
        for (int k = 0; k < 4; ++k) { float s = 0.f;
#pragma unroll
            for (int j = 0; j < 4; ++j) s += (v[k][j].x * v[k][j].x + v[k][j].y * v[k][j].y) + (v[k][j].z * v[k][j].z + v[k][j].w * v[k][j].w);
            r[k] = 1.0f / sqrtf(wave_sum(s) * (1.0f / D) + EPS); }
#pragma unroll
        for (int k = 0; k < 4; ++k) { const int m = m0 + k * NGW; if (m < M) { const int b = m >> 13;
            GAS unsigned long long* o8 = (GAS unsigned long long*)(XN + (size_t)m * D) + F.lane;
#pragma unroll
            for (int j = 0; j < 4; ++j) { const int c = 4 * F.lane + 256 * j;
                const f32x4 w = *(const f32x4*)(A.in[4] + c), sc = *(const f32x4*)(MOD + b * 6144 + 1024 + c), sh = *(const f32x4*)(MOD + b * 6144 + c);
                const f32x4 y = v[k][j] * r[k] * w * (sc + 1.0f) + sh;
                o8[64 * j] = (unsigned long long)pk2(y.x, y.y) | ((unsigned long long)pk2(y.z, y.w) << 32); } } }
    }
}

constexpr int H_QC = 0, H_QB = 17408, H_K = 34816, H_KT = 78336, H_VT = 96768, H_PM = 115200, H_ST = 124416, H_BT = 159232, H_AL = 161280;
constexpr int HS128 = 272, HS64 = 144;
__device__ __forceinline__ unsigned short f2bfs(float f) { return (unsigned short)f2bf(f); }
__device__ __forceinline__ void hgrn_h1_unit(Frame& F, int unit) {
    const int b = unit >> 5, h = (unit >> 3) & 3, n = unit & 7;
    const int tid = F.tid, lane = F.lane, w = F.wave, c = tid & 127, bi = tid >> 7, l15 = lane & 15, l4 = lane >> 4;
    const size_t rowbase = (size_t)(b * SEQ + n * 1024) * 512 + h * 128;
    const bf16* RQ = (const bf16*)(F.ws + WS_RQ) + rowbase; const bf16* RGL = (const bf16*)(F.ws + WS_RGL) + rowbase; const bf16* RI = (const bf16*)(F.ws + WS_RI) + rowbase;
    bf16* OLOC = (bf16*)(F.ws + WS_OLOC) + rowbase; bf16* QHAT = (bf16*)(F.ws + WS_QHAT) + rowbase;
    LAS unsigned char* L = F.lds; LAS float* BT = (LAS float*)(L + H_BT); LAS float* AL = (LAS float*)(L + H_AL);
    f32x4 acc[8];
#pragma unroll
    for (int vb = 0; vb < 8; ++vb) acc[vb] = (f32x4){0.f, 0.f, 0.f, 0.f};
    float asup = 0.f;
    for (int i = tid; i < 64 * HS64 / 4; i += NWAVES * 64) ((LAS unsigned*)(L + H_PM))[i] = 0u;
    unsigned short gr[16], qr[16], vr[16];
#define H1_LOAD(CI) do { const size_t r0_ = (size_t)((CI) * 64 + bi * 16) * 512 + c; \
        _Pragma("unroll") for (int r = 0; r < 16; ++r) { gr[r] = RGL[r0_ + (size_t)r * 512]; qr[r] = RQ[r0_ + (size_t)r * 512]; vr[r] = RI[r0_ + (size_t)r * 512]; } } while (0)
    H1_LOAD(0);
#pragma unroll 1
    for (int ci = 0; ci < 16; ++ci) {
        const size_t r0 = (size_t)(ci * 64 + bi * 16) * 512 + c;
        float eg[16], qq[16], el[16];
        { float run = 0.f, prod = 1.f;
#pragma unroll
          for (int r = 0; r < 16; ++r) { const float g = bf1(gr[r]); run += g; eg[r] = __expf(g); prod *= eg[r]; el[r] = prod; qq[r] = bf1(qr[r]); }
          BT[bi * 128 + c] = run; }
        if (ci > 0) {
#pragma unroll
            for (int vb = 0; vb < 8; ++vb) { v2u o; o.x = pk2(acc[vb][0], acc[vb][1]); o.y = pk2(acc[vb][2], acc[vb][3]);
                *(LAS v2u*)(L + H_ST + (16 * vb + l15) * HS128 + (16 * w + 4 * l4) * 2) = o; } }
        { v4u v0, v1; v0.x = vr[0] | ((unsigned)vr[1] << 16); v0.y = vr[2] | ((unsigned)vr[3] << 16); v0.z = vr[4] | ((unsigned)vr[5] << 16); v0.w = vr[6] | ((unsigned)vr[7] << 16);
          v1.x = vr[8] | ((unsigned)vr[9] << 16); v1.y = vr[10] | ((unsigned)vr[11] << 16); v1.z = vr[12] | ((unsigned)vr[13] << 16); v1.w = vr[14] | ((unsigned)vr[15] << 16);
          *(LAS v4u*)(L + H_VT + c * HS64 + bi * 32) = v0; *(LAS v4u*)(L + H_VT + c * HS64 + bi * 32 + 16) = v1; }
        __syncthreads();
        const float b0 = BT[c], b1 = BT[128 + c], b2 = BT[256 + c], b3 = BT[384 + c];
        const float ab1 = b0, ab2 = b0 + b1, ab3 = ab2 + b2, alast = ab3 + b3;
        const float ab = bi == 0 ? 0.f : bi == 1 ? ab1 : bi == 2 ? ab2 : ab3;
        if (bi == 0) AL[c] = alast;
        const float eAb = __expf(ab), eSup = __expf(asup), fEnd = __expf(alast - ab);
        const float fK0 = __expf(0.f - ab), fK1 = __expf(ab1 - ab), fK2 = __expf(ab2 - ab), fK3 = __expf(ab3 - ab);
        unsigned kp[8];
#pragma unroll
        for (int r = 0; r < 16; ++r) { const int t = bi * 16 + r;
            const float qb = qq[r] * el[r], qc = qb * eAb, kk = 1.0f - eg[r], ki = kk * __builtin_amdgcn_rcpf(el[r]);
            *(LAS unsigned short*)(L + H_QC + t * HS128 + c * 2) = f2bfs(qc);
            QHAT[r0 + (size_t)r * 512] = f2bfs(qc * eSup);
            *(LAS unsigned short*)(L + H_QB + t * HS128 + c * 2) = f2bfs(qb);
            const unsigned ke = f2bf(ki * fEnd); if (r & 1) kp[r >> 1] |= ke << 16; else kp[r >> 1] = ke;
            if (bi <= 0) *(LAS unsigned short*)(L + H_K + (0 + t) * HS128 + c * 2) = f2bfs(ki * fK0);
            if (bi <= 1) *(LAS unsigned short*)(L + H_K + (16 + t) * HS128 + c * 2) = f2bfs(ki * fK1);
            if (bi <= 2) *(LAS unsigned short*)(L + H_K + (48 + t) * HS128 + c * 2) = f2bfs(ki * fK2);
            *(LAS unsigned short*)(L + H_K + (96 + t) * HS128 + c * 2) = f2bfs(ki * fK3); }
        *(LAS v4u*)(L + H_KT + c * HS64 + bi * 32) = (v4u){kp[0], kp[1], kp[2], kp[3]}; *(LAS v4u*)(L + H_KT + c * HS64 + bi * 32 + 16) = (v4u){kp[4], kp[5], kp[6], kp[7]};
        asup += alast;
        if (ci + 1 < 16) H1_LOAD(ci + 1);
        __syncthreads();
#pragma unroll
        for (int rep = 0; rep < 2; ++rep) { const int tile = w + 8 * rep;
            if (tile < 10) { const int i = tile < 1 ? 0 : tile < 3 ? 1 : tile < 6 ? 2 : 3, j = tile - (i * (i + 1)) / 2;
                const LAS unsigned char* ap = L + H_QB + (16 * i + l15) * HS128 + l4 * 16; const LAS unsigned char* bp = L + H_K + (8 * i * (i + 1) + 16 * j + l15) * HS128 + l4 * 16;
                f32x4 p = (f32x4){0.f, 0.f, 0.f, 0.f};
#pragma unroll
                for (int ks = 0; ks < 4; ++ks) p = __builtin_amdgcn_mfma_f32_16x16x32_bf16(*(const LAS bf16x8*)(ap + ks * 64), *(const LAS bf16x8*)(bp + ks * 64), p, 0, 0, 0);
#pragma unroll
                for (int r = 0; r < 4; ++r) { const float pv = (i == j && l15 > 4 * l4 + r) ? 0.f : p[r];
                    *(LAS unsigned short*)(L + H_PM + (16 * i + 4 * l4 + r) * HS64 + (16 * j + l15) * 2) = f2bfs(pv); } } }
        __syncthreads();
#pragma unroll
        for (int tb = 0; tb < 4; ++tb) { f32x4 o = (f32x4){0.f, 0.f, 0.f, 0.f};
#pragma unroll
            for (int ks = 0; ks < 2; ++ks) if (32 * ks < 16 * (tb + 1))
                o = __builtin_amdgcn_mfma_f32_16x16x32_bf16(*(const LAS bf16x8*)(L + H_VT + (16 * w + l15) * HS64 + l4 * 16 + ks * 64), *(const LAS bf16x8*)(L + H_PM + (16 * tb + l15) * HS64 + l4 * 16 + ks * 64), o, 0, 0, 0);
            if (ci > 0) {
#pragma unroll
                for (int ks = 0; ks < 4; ++ks)
                    o = __builtin_amdgcn_mfma_f32_16x16x32_bf16(*(const LAS bf16x8*)(L + H_ST + (16 * w + l15) * HS128 + l4 * 16 + ks * 64), *(const LAS bf16x8*)(L + H_QC + (16 * tb + l15) * HS128 + l4 * 16 + ks * 64), o, 0, 0, 0); }
            v2u ov; ov.x = pk2(o[0], o[1]); ov.y = pk2(o[2], o[3]);
            *(v2u*)(OLOC + (size_t)(ci * 64 + 16 * tb + l15) * 512 + 16 * w + 4 * l4) = ov; }
        { const f32x4 dv = *(const LAS f32x4*)(AL + 16 * w + 4 * l4); const f32x4 d = (f32x4){__expf(dv[0]), __expf(dv[1]), __expf(dv[2]), __expf(dv[3])};
          const bf16x8 ka0 = *(const LAS bf16x8*)(L + H_KT + (16 * w + l15) * HS64 + l4 * 16), ka1 = *(const LAS bf16x8*)(L + H_KT + (16 * w + l15) * HS64 + l4 * 16 + 64);
#pragma unroll
          for (int vb = 0; vb < 8; ++vb) { f32x4 s = acc[vb] * d;
              s = __builtin_amdgcn_mfma_f32_16x16x32_bf16(ka0, *(const LAS bf16x8*)(L + H_VT + (16 * vb + l15) * HS64 + l4 * 16), s, 0, 0, 0);
              s = __builtin_amdgcn_mfma_f32_16x16x32_bf16(ka1, *(const LAS bf16x8*)(L + H_VT + (16 * vb + l15) * HS64 + l4 * 16 + 64), s, 0, 0, 0);
              acc[vb] = s; } }
        __syncthreads();
    }
#undef H1_LOAD
    f32x4* U = (f32x4*)(F.ws + WS_U);
#pragma unroll
    for (int vb = 0; vb < 8; ++vb) U[(size_t)((unit * 8 + w) * 8 + vb) * 64 + lane] = acc[vb];
    if (bi == 0) ((float*)(F.ws + WS_DS))[unit * 128 + c] = __expf(asup);
}
__device__ __forceinline__ void hgrn_h3_unit(Frame& F, const Args& A, int unit) {
    const int b = unit >> 5, h = (unit >> 3) & 3, n = unit & 7;
    const int lane = F.lane, w = F.wave, l15 = lane & 15, l4 = lane >> 4;
    LAS unsigned char* L = F.lds;
    const f32x4* U = (const f32x4*)(F.ws + WS_U); const float* DS = (const float*)(F.ws + WS_DS);
    f32x4 S[8];
#pragma unroll
    for (int vb = 0; vb < 8; ++vb) S[vb] = (f32x4){0.f, 0.f, 0.f, 0.f};
    for (int m = 0; m < n; ++m) { const int um = unit - n + m; const f32x4 d = *(const f32x4*)(DS + um * 128 + 16 * w + 4 * l4);
#pragma unroll
        for (int vb = 0; vb < 8; ++vb) S[vb] = S[vb] * d + U[(size_t)((um * 8 + w) * 8 + vb) * 64 + lane]; }
#pragma unroll
    for (int vb = 0; vb < 8; ++vb) { v2u o; o.x = pk2(S[vb][0], S[vb][1]); o.y = pk2(S[vb][2], S[vb][3]);
        *(LAS v2u*)(L + H_ST + (16 * vb + l15) * HS128 + (16 * w + 4 * l4) * 2) = o; }
    __syncthreads();
    const size_t rowbase = (size_t)(b * SEQ + n * 1024 + 128 * w) * 512 + h * 128;
    const bf16* QHAT = (const bf16*)(F.ws + WS_QHAT) + rowbase; const bf16* OLOC = (const bf16*)(F.ws + WS_OLOC) + rowbase;
    const bf16* RGS = (const bf16*)(F.ws + WS_RGS) + rowbase; bf16* REC = (bf16*)(F.ws + WS_REC) + rowbase;
    f32x4 rw[8];
#pragma unroll
    for (int vb = 0; vb < 8; ++vb) rw[vb] = *(const f32x4*)(A.in[11] + 16 * vb + 4 * l4);
#pragma unroll 1
    for (int tb = 0; tb < 8; ++tb) { const size_t tr = (size_t)(16 * tb + l15) * 512;
        bf16x8 qh[4];
#pragma unroll
        for (int ks = 0; ks < 4; ++ks) qh[ks] = *(const bf16x8*)(QHAT + tr + 32 * ks + 8 * l4);
        f32x4 o[8]; float ss = 0.f;
#pragma unroll
        for (int vb = 0; vb < 8; ++vb) { f32x4 a = (f32x4){0.f, 0.f, 0.f, 0.f};
            if (n > 0) {
#pragma unroll
                for (int ks = 0; ks < 4; ++ks) a = __builtin_amdgcn_mfma_f32_16x16x32_bf16(*(const LAS bf16x8*)(L + H_ST + (16 * vb + l15) * HS128 + l4 * 16 + ks * 64), qh[ks], a, 0, 0, 0); }
            const v2u ol = *(const v2u*)(OLOC + tr + 16 * vb + 4 * l4);
            a[0] += bflo(ol.x); a[1] += bfhi(ol.x); a[2] += bflo(ol.y); a[3] += bfhi(ol.y);
            o[vb] = a; ss += (a[0] * a[0] + a[1] * a[1]) + (a[2] * a[2] + a[3] * a[3]); }
        ss += __shfl_xor(ss, 16); ss += __shfl_xor(ss, 32);
        const float r = 1.0f / sqrtf(ss * (1.0f / 128.0f) + EPS);
#pragma unroll
        for (int vb = 0; vb < 8; ++vb) { const v2u g = *(const v2u*)(RGS + tr + 16 * vb + 4 * l4); const f32x4 y = o[vb] * r * rw[vb];
            v2u ov; ov.x = pk2(y[0] * bflo(g.x), y[1] * bfhi(g.x)); ov.y = pk2(y[2] * bflo(g.y), y[3] * bfhi(g.y));
            *(v2u*)(REC + tr + 16 * vb + 4 * l4) = ov; }
    }
    __syncthreads();
}

__device__ __forceinline__ unsigned f2key(float x) {
    const _Float16 hh = (_Float16)x; const unsigned bits = (unsigned)__builtin_bit_cast(unsigned short, hh);
    return (bits & 0x8000u) ? (~bits & 0xffffu) : (bits | 0x8000u);
}
#ifdef TSEL
#define TMARK(k) do { if (F.wave == 0) { const unsigned long long now_ = __builtin_amdgcn_s_memrealtime(); if (F.lane == 0) ((LAS unsigned*)(F.lds + LDSCTL_OFF))[k] += (unsigned)(now_ - tprev_); tprev_ = now_; } } while (0)
#else
#define TMARK(k) do {} while (0)
#endif
constexpr int DSA_VIMG = 73728;
constexpr int DSA_QCTR = 73600;
constexpr int DSA_BIAS = 69632;
constexpr int DSA_CAND = 147456, DSA_CAPC = 448;
typedef unsigned u32x4p __attribute__((ext_vector_type(4)));
__device__ __forceinline__ void dsa_unit(Frame& F, int b, int t0) {
    const int lane = F.lane, w = F.wave, qc = lane & 31, hf = lane >> 5;
    const bf16* KI = (const bf16*)(F.ws + WS_KI) + (size_t)b * SEQ * 64;
    const bf16* QI = (const bf16*)(F.ws + WS_QI) + (size_t)(b * SEQ + t0) * 512;
    const float* WI = (const float*)(F.ws + WS_WI) + (size_t)(b * SEQ + t0) * 8;
    unsigned short* scr = (unsigned short*)(F.ws + WS_SCR) + (size_t)blockIdx.x * (32 * 8192);
    const int nkb = t0 / 32 + 1;
#ifdef TSEL
    unsigned long long tprev_ = __builtin_amdgcn_s_memrealtime();
#endif
    LAS unsigned* hist = (LAS unsigned*)(F.lds);
    for (int i = F.tid; i < 4096; i += NWAVES * 64) ((LAS v4u*)hist)[i] = (v4u){0u, 0u, 0u, 0u};
    if (F.tid == 0) *(LAS unsigned*)(F.lds + DSA_QCTR) = 0u;
    __syncthreads();
    TMARK(0);
    {
        const int l15 = lane & 15, l4 = lane >> 4, qg = w >> 2, ql = 16 * qg + l15;
        bf16x8 qf[8][2]; float wv[8];
#pragma unroll
        for (int h = 0; h < 8; ++h) { wv[h] = WI[ql * 8 + h];
#pragma unroll
            for (int ks = 0; ks < 2; ++ks) qf[h][ks] = *(const bf16x8*)(QI + (size_t)ql * 512 + h * 64 + ks * 32 + l4 * 8); }
        const int lim = t0 + ql - 4 * l4;
        float wh[8];
#pragma unroll
        for (int h = 0; h < 8; ++h) wh[h] = 0.5f * wv[h];
        bf16x8 qs[2];
#pragma unroll
        for (int ks = 0; ks < 2; ++ks) { unsigned pk[4];
#pragma unroll
            for (int j = 0; j < 8; j += 2) { float e0 = 0.f, e1 = 0.f;
#pragma unroll
                for (int h = 0; h < 8; ++h) { e0 += wh[h] * bf1((unsigned short)qf[h][ks][j]); e1 += wh[h] * bf1((unsigned short)qf[h][ks][j + 1]); }
                pk[j >> 1] = pk2(e0, e1); }
            qs[ks] = __builtin_bit_cast(bf16x8, (v4u){pk[0], pk[1], pk[2], pk[3]}); }
        const int nb16 = 2 * nkb;
#define P1_LOAD(K0, K1, KB) do { const int row_ = (KB) * 16 + l15; const bf16* kp_ = KI + (size_t)(row_ < SEQ - 1 ? row_ : SEQ - 1) * 64 + l4 * 8; \
            asm volatile("global_load_dwordx4 %0, %2, off\n\tglobal_load_dwordx4 %1, %2, off offset:64" : "=&v"(K0), "=&v"(K1) : "v"(kp_) : "memory"); } while (0)
#define P1_COMPUTE(K0, K1, KB, OUT) do { const int s0_ = (KB) * 16; f32x4 sc_ = (f32x4){0.f, 0.f, 0.f, 0.f}; \
            sc_ = __builtin_amdgcn_mfma_f32_16x16x32_bf16(K0, qs[0], sc_, 0, 0, 0); sc_ = __builtin_amdgcn_mfma_f32_16x16x32_bf16(K1, qs[1], sc_, 0, 0, 0); \
            _Pragma("unroll") for (int h = 0; h < 8; ++h) { f32x4 a_ = (f32x4){0.f, 0.f, 0.f, 0.f}; \
                a_ = __builtin_amdgcn_mfma_f32_16x16x32_bf16(K0, qf[h][0], a_, 0, 0, 0); a_ = __builtin_amdgcn_mfma_f32_16x16x32_bf16(K1, qf[h][1], a_, 0, 0, 0); \
                _Pragma("unroll") for (int r = 0; r < 4; ++r) sc_[r] = __builtin_fmaf(wh[h], __builtin_fabsf(a_[r]), sc_[r]); } \
            unsigned kk_[4]; \
            _Pragma("unroll") for (int r = 0; r < 4; ++r) { const bool causal_ = s0_ + r <= lim; const unsigned key_ = f2key(sc_[r]); kk_[r] = causal_ ? key_ : 0u; \
                if (causal_) __hip_atomic_fetch_add(hist + ql * 512 + (key_ >> 7), 1u, __ATOMIC_RELAXED, __HIP_MEMORY_SCOPE_WORKGROUP); } \
            OUT.x = kk_[0] | (kk_[1] << 16); OUT.y = kk_[2] | (kk_[3] << 16); } while (0)
        {
        bf16x8 c0a, c0b, c1a, c1b, c2a, c2b, c3a, c3b, n0a, n0b, n1a, n1b, n2a, n2b, n3a, n3b;
        LAS unsigned char* stg = F.lds + DSA_VIMG + w * 9216;
        const int rrow = lane >> 3, rch = lane & 7;
        int kb = 4 * (w & 3);
        P1_LOAD(c0a, c0b, kb); P1_LOAD(c1a, c1b, kb + 1); P1_LOAD(c2a, c2b, kb + 2); P1_LOAD(c3a, c3b, kb + 3);
        asm volatile("s_waitcnt vmcnt(0)" : "+v"(c0a), "+v"(c0b), "+v"(c1a), "+v"(c1b), "+v"(c2a), "+v"(c2b), "+v"(c3a), "+v"(c3b) :: "memory");
#pragma unroll 1
        for (; kb < nb16; kb += 16) {
            P1_LOAD(n0a, n0b, kb + 16); P1_LOAD(n1a, n1b, kb + 17); P1_LOAD(n2a, n2b, kb + 18); P1_LOAD(n3a, n3b, kb + 19);
            v2u o0 = (v2u){0u, 0u}, o1 = o0, o2 = o0, o3 = o0;
            P1_COMPUTE(c0a, c0b, kb, o0);
            if (kb + 1 < nb16) P1_COMPUTE(c1a, c1b, kb + 1, o1);
            if (kb + 2 < nb16) P1_COMPUTE(c2a, c2b, kb + 2, o2);
            if (kb + 3 < nb16) P1_COMPUTE(c3a, c3b, kb + 3, o3);
            TMARK(29);
            *(LAS v2u*)(stg + l15 * 144 + 8 * l4) = o0; *(LAS v2u*)(stg + l15 * 144 + 32 + 8 * l4) = o1; *(LAS v2u*)(stg + l15 * 144 + 64 + 8 * l4) = o2; *(LAS v2u*)(stg + l15 * 144 + 96 + 8 * l4) = o3;
            LDS_WAIT(); asm volatile("" ::: "memory");
            { const v4u lo = *(const LAS v4u*)(stg + rrow * 144 + rch * 16), hi = *(const LAS v4u*)(stg + (rrow + 8) * 144 + rch * 16);
              unsigned short* dst = scr + (size_t)(16 * qg + rrow) * 8192 + kb * 16 + rch * 8;
              *(v4u*)dst = lo; *(v4u*)(dst + 8 * 8192) = hi; }
            LDS_WAIT(); asm volatile("" ::: "memory");
            TMARK(27);
            asm volatile("s_waitcnt vmcnt(2)" : "+v"(n0a), "+v"(n0b), "+v"(n1a), "+v"(n1b), "+v"(n2a), "+v"(n2b), "+v"(n3a), "+v"(n3b) :: "memory");
            TMARK(28);
            c0a = n0a; c0b = n0b; c1a = n1a; c1b = n1b; c2a = n2a; c2b = n2b; c3a = n3a; c3b = n3b;
        }
        }
#undef P1_LOAD
#undef P1_COMPUTE
    }
    TMARK(1);
    __syncthreads();
    TMARK(2);
    LAS unsigned short* idxl = (LAS unsigned short*)(F.lds + 65536) + w * 256;
    const LAS float* btab = (const LAS float*)(F.lds + DSA_BIAS);
    const bf16* KV = (const bf16*)(F.ws + WS_KV) + (size_t)b * SEQ * 256;
    const int nk = nkb * 32, ndw = nk >> 1;
    LAS unsigned* qctr = (LAS unsigned*)(F.lds + DSA_QCTR);
#pragma unroll 1
    for (;;) {
        unsigned qi_ = 0u; if (lane == 0) qi_ = __hip_atomic_fetch_add(qctr, 1u, __ATOMIC_RELAXED, __HIP_MEMORY_SCOPE_WORKGROUP);
        qi_ = (unsigned)__builtin_amdgcn_readfirstlane((int)qi_); if (qi_ >= 32u) break;
        const int ql = 31 - (int)qi_, t = t0 + ql, nvalid = t + 1, nsel = nvalid < 256 ? nvalid : 256;
        const unsigned* rowd = (const unsigned*)(scr + (size_t)ql * 8192);
        int ln = lane; asm volatile("" : "+v"(ln));
        {
        unsigned rv[64];
#pragma unroll
        for (int j = 0; j < 64; ++j) { const unsigned val = rowd[j * 64 + ln]; rv[j] = (ln < ndw - j * 64) ? val : 0u; }
#ifdef TSEL
        asm volatile("s_waitcnt vmcnt(0)" ::: "memory"); TMARK(8);
#endif
        unsigned T = 0u; int need = 0; bool done = false;
        const unsigned long long lt = (1ull << ln) - 1ull; const int ln2 = 2 * ln;
        if (nvalid > 256) {
            const LAS unsigned* hq = hist + ql * 512 + 8 * ln;
            const v4u h0 = *(const LAS v4u*)(hq), h1 = *(const LAS v4u*)(hq + 4);
            const unsigned h8[8] = {h0.x, h0.y, h0.z, h0.w, h1.x, h1.y, h1.z, h1.w};
            const unsigned sl = (h0.x + h0.y) + (h0.z + h0.w) + (h1.x + h1.y) + (h1.z + h1.w);
            unsigned S = sl;
#pragma unroll
            for (int d = 1; d < 64; d <<= 1) { const unsigned tt = __shfl_down(S, d); if (ln + d < 64) S += tt; }
            const int Lb = __popcll(__ballot(S >= 256u)) - 1;
            unsigned cum = S - sl, caL = 0u, cbL = 0u; int Bi = 0; bool found = false;
#pragma unroll
            for (int i = 7; i >= 0; --i) { if (!found && cum + h8[i] >= 256u) { Bi = i; caL = cum; cbL = h8[i]; found = true; } if (!found) cum += h8[i]; }
            TMARK(9);
            const int B = 8 * Lb + __shfl(Bi, Lb); const int ca = (int)__shfl(caL, Lb), cb = (int)__shfl(cbL, Lb);
            LAS unsigned short* glst = (LAS unsigned short*)(F.lds + DSA_VIMG + w * 9216);
            LAS unsigned* elst = (LAS unsigned*)(F.lds + DSA_VIMG + w * 9216 + 3200);
            const unsigned Tg = (unsigned)(B + 1) << 7, Te = (unsigned)B << 7;
            int gc = 0, ec = 0;
#define DSA_COLLECT(K16, IDX) do { const unsigned k_ = (K16), i_ = (IDX); const bool g_ = k_ >= Tg, e_ = (k_ >= Te) && !g_; \
                const int gs_ = g_ ? (gc < 24 ? gc : 24) : 24, es_ = e_ ? (ec < 12 ? ec : 12) : 12; \
                glst[gs_ * 64 + ln] = (unsigned short)i_; elst[es_ * 64 + ln] = (k_ << 16) | (65535u - i_); gc += g_ ? 1 : 0; ec += e_ ? 1 : 0; } while (0)
#pragma unroll
            for (int g = 0; g < 8; ++g) if (g * 1024 < nk) {
#pragma unroll
                for (int j = 8 * g; j < 8 * g + 8; ++j) { const unsigned i0 = (unsigned)(ln2 + 128 * j); DSA_COLLECT(rv[j] & 0xffffu, i0); DSA_COLLECT(rv[j] >> 16, i0 + 1u); } }
#undef DSA_COLLECT
            if (__ballot(gc > 24 || ec > 12) == 0ull) {
                LDS_WAIT(); asm volatile("" ::: "memory");
                TMARK(10);
                int incl = gc;
#pragma unroll
                for (int d = 1; d < 64; d <<= 1) { const int tt = __shfl_up(incl, d); if (ln >= d) incl += tt; }
                const int excl = incl - gc;
#pragma unroll 1
                for (int e = 0; e < 24; ++e) { if (__ballot(e < gc) == 0ull) break; if (e < gc) idxl[excl + e] = glst[e * 64 + ln]; }
                TMARK(11);
                unsigned cv[12]; int emax = 0;
#pragma unroll
                for (int e = 0; e < 12; ++e) { cv[e] = (e < ec) ? elst[e * 64 + ln] : 0u; if (__ballot(e < ec) != 0ull) emax = e + 1; }
                const int needc = 256 - ca; unsigned pref = (unsigned)B << 23;
#define DSA_DESCENT(N) _Pragma("unroll 1") for (int bit = 22; bit >= 0; --bit) { const unsigned c = pref | (1u << bit); int cnt = 0; \
                    _Pragma("unroll") for (int e = 0; e < (N); ++e) cnt += __popcll(__ballot(cv[e] >= c)); \
                    if (cnt >= needc) pref = c; }
                if (emax <= 2) { DSA_DESCENT(2) } else if (emax <= 4) { DSA_DESCENT(4) } else { DSA_DESCENT(12) }
#undef DSA_DESCENT
                TMARK(12);
                int base = ca;
#pragma unroll
                for (int e = 0; e < 12; ++e) if (e < emax) { const bool sl2 = cv[e] >= pref; const unsigned long long m = __ballot(sl2); const int pos = base + __popcll(m & lt);
                    if (sl2 && pos < 256) idxl[pos] = (unsigned short)(65535u - (cv[e] & 0xffffu)); base += __popcll(m); }
                done = true;
            } else {
#pragma unroll 1
                for (int bit = 15; bit >= 0; --bit) { const unsigned cand2 = T | (1u << bit); int c = 0;
#pragma unroll
                    for (int g = 0; g < 8; ++g) if (g * 1024 < nk) {
#pragma unroll
                        for (int j = 8 * g; j < 8 * g + 8; ++j) { c += ((rv[j] & 0xffffu) >= cand2) ? 1 : 0; c += ((rv[j] >> 16) >= cand2) ? 1 : 0; } }
#pragma unroll
                    for (int o = 1; o < 64; o <<= 1) c += __shfl_xor(c, o);
                    if (c >= 256) T = cand2; }
                int c = 0;
#pragma unroll
                for (int g = 0; g < 8; ++g) if (g * 1024 < nk) {
#pragma unroll
                    for (int j = 8 * g; j < 8 * g + 8; ++j) { c += ((rv[j] & 0xffffu) > T) ? 1 : 0; c += ((rv[j] >> 16) > T) ? 1 : 0; } }
#pragma unroll
                for (int o = 1; o < 64; o <<= 1) c += __shfl_xor(c, o);
                need = 256 - c;
            }
        }
        if (!done) {
            int base = 0, tiebase = 0;
#pragma unroll
            for (int g = 0; g < 8; ++g) if (g * 1024 < nk) {
#pragma unroll
                for (int j = 8 * g; j < 8 * g + 8; ++j) { const unsigned lo = rv[j] & 0xffffu, hi = rv[j] >> 16;
                    const bool el = lo == T, eh = hi == T; const unsigned long long mel = __ballot(el), meh = __ballot(eh);
                    const int trl = tiebase + __popcll(mel & lt) + __popcll(meh & lt), trh = trl + (el ? 1 : 0);
                    const bool sl = lo > T || (el && trl < need), sh = hi > T || (eh && trh < need);
                    const unsigned long long msl = __ballot(sl), msh = __ballot(sh);
                    const int pl = base + __popcll(msl & lt) + __popcll(msh & lt), ph = pl + (sl ? 1 : 0);
                    if (sl && pl < 256) idxl[pl] = (unsigned short)(ln2 + 128 * j); if (sh && ph < 256) idxl[ph] = (unsigned short)(ln2 + 128 * j + 1);
                    base += __popcll(msl) + __popcll(msh); tiebase += __popcll(mel) + __popcll(meh); __builtin_amdgcn_sched_barrier(0); } }
        }
        }
        LDS_WAIT(); asm volatile("" ::: "memory");
        TMARK(3);
        {
            int l15 = ln & 15, l4 = ln >> 4; asm volatile("" : "+v"(l15), "+v"(l4));
            const int l4x4 = 4 * l4;
#pragma unroll
            for (int jj = 0; jj < 4; ++jj) { if (ln >= nsel - 64 * jj) idxl[ln + 64 * jj] = 0; }
            LDS_WAIT(); asm volatile("" ::: "memory");
            unsigned short kidx[16]; v2u sidx[16];
#pragma unroll
            for (int blk = 0; blk < 16; ++blk) { kidx[blk] = idxl[16 * blk + l15]; sidx[blk] = *(const LAS v2u*)(idxl + 16 * blk + l4x4); }
            unsigned short vidx0[8];
#pragma unroll
            for (int i = 0; i < 8; ++i) vidx0[i] = idxl[4 * i + l4];
            LDS_WAIT(); asm volatile("" ::: "memory");
            const bf16* qrow = (const bf16*)(F.ws + WS_Q) + (size_t)(b * SEQ + t) * 512 + (l15 & 7) * 64 + 8 * l4;
            bf16x8 bq[2][2];
#pragma unroll
            for (int g = 0; g < 2; ++g)
#pragma unroll
                for (int ks = 0; ks < 2; ++ks) { bf16x8 v = *(const bf16x8*)(qrow + 32 * ks); if ((l15 >> 2) != g) v = (bf16x8){0, 0, 0, 0, 0, 0, 0, 0}; bq[g][ks] = v; }
            f32x4 sa[16];
#pragma unroll
            for (int half = 0; half < 4; ++half) {
                bf16x8 ka[4][4];
#pragma unroll
                for (int bl = 0; bl < 4; ++bl) { const bf16* kr = KV + (size_t)kidx[4 * half + bl] * 256 + 8 * l4;
#pragma unroll
                    for (int i = 0; i < 4; ++i) ka[bl][i] = *(const bf16x8*)(kr + 32 * i); }
#pragma unroll
                for (int bl = 0; bl < 4; ++bl) { f32x4 acc = (f32x4){0.f, 0.f, 0.f, 0.f};
                    acc = __builtin_amdgcn_mfma_f32_16x16x32_bf16(ka[bl][0], bq[0][0], acc, 0, 0, 0); acc = __builtin_amdgcn_mfma_f32_16x16x32_bf16(ka[bl][1], bq[0][1], acc, 0, 0, 0);
                    acc = __builtin_amdgcn_mfma_f32_16x16x32_bf16(ka[bl][2], bq[1][0], acc, 0, 0, 0); acc = __builtin_amdgcn_mfma_f32_16x16x32_bf16(ka[bl][3], bq[1][1], acc, 0, 0, 0);
                    sa[4 * half + bl] = acc; }
                asm volatile("" ::: "memory"); }
            v4u vbuf[2][8];
#pragma unroll
            for (int i = 0; i < 8; ++i) vbuf[0][i] = *(const v4u*)(KV + (size_t)vidx0[i] * 256 + 128 + l15 * 8);
            TMARK(13);
            float mx = -INFINITY; const LAS float* bt = btab + (l15 & 7);
#pragma unroll
            for (int blk = 0; blk < 16; ++blk)
#pragma unroll
                for (int r = 0; r < 4; ++r) { const unsigned sw = (r < 2) ? sidx[blk].x : sidx[blk].y; const int dist = t - (int)((r & 1) ? (sw >> 16) : (sw & 0xffffu));
                    const float bias = bt[(dist < 113 ? dist : 113) * 8];
                    const float v = (l4x4 < nsel - (16 * blk + r)) ? sa[blk][r] + bias : -INFINITY; sa[blk][r] = v; mx = fmaxf(mx, v); }
            mx = fmaxf(mx, __shfl_xor(mx, 16)); mx = fmaxf(mx, __shfl_xor(mx, 32));
            float su = 0.f;
#pragma unroll
            for (int blk = 0; blk < 16; ++blk)
#pragma unroll
                for (int r = 0; r < 4; ++r) { const float e = __expf(sa[blk][r] - mx); sa[blk][r] = e; su += e; }
            su += __shfl_xor(su, 16); su += __shfl_xor(su, 32);
            const float inv = 1.0f / su;
            TMARK(14);
            bf16x8 pf[8];
#pragma unroll
            for (int ks = 0; ks < 8; ++ks) { u32x4p pa; pa.x = pk2(sa[2 * ks][0], sa[2 * ks][1]); pa.y = pk2(sa[2 * ks][2], sa[2 * ks][3]); pa.z = pk2(sa[2 * ks + 1][0], sa[2 * ks + 1][1]); pa.w = pk2(sa[2 * ks + 1][2], sa[2 * ks + 1][3]);
                asm volatile("" : "+v"(pa));
                pf[ks] = __builtin_bit_cast(bf16x8, pa); }
            { unsigned short vi[8];
#pragma unroll
              for (int i = 0; i < 8; ++i) vi[i] = idxl[32 + 4 * i + l4];
              LDS_WAIT(); asm volatile("" ::: "memory");
#pragma unroll
              for (int i = 0; i < 8; ++i) vbuf[1][i] = *(const v4u*)(KV + (size_t)vi[i] * 256 + 128 + l15 * 8); }
            f32x4 oa[2][4];
#pragma unroll
            for (int g = 0; g < 2; ++g)
#pragma unroll
                for (int c = 0; c < 4; ++c) oa[g][c] = (f32x4){0.f, 0.f, 0.f, 0.f};
            LAS unsigned char* vimg = F.lds + DSA_VIMG + w * 9216;
            const unsigned traddr = (unsigned)(size_t)(vimg + (4 * l4 + (l15 >> 2)) * 144 + (l15 & 3) * 8);
#pragma unroll
            for (int ks = 0; ks < 8; ++ks) {
#pragma unroll
                for (int i = 0; i < 8; ++i) *(LAS v4u*)(vimg + (l15 >> 3) * 4608 + (4 * i + l4) * 144 + (l15 & 7) * 16) = vbuf[ks & 1][i];
                if (ks + 2 < 8) { unsigned short vi[8];
#pragma unroll
                    for (int i = 0; i < 8; ++i) vi[i] = idxl[32 * (ks + 2) + 4 * i + l4];
                    LDS_WAIT(); asm volatile("" ::: "memory");
#pragma unroll
                    for (int i = 0; i < 8; ++i) vbuf[ks & 1][i] = *(const v4u*)(KV + (size_t)vi[i] * 256 + 128 + l15 * 8); }
                LDS_WAIT(); asm volatile("" ::: "memory");
                v2u tb[16];
                asm volatile("ds_read_b64_tr_b16 %0, %16 offset:0\n\tds_read_b64_tr_b16 %1, %16 offset:2304\n\tds_read_b64_tr_b16 %2, %16 offset:32\n\tds_read_b64_tr_b16 %3, %16 offset:2336\n\t"
                             "ds_read_b64_tr_b16 %4, %16 offset:64\n\tds_read_b64_tr_b16 %5, %16 offset:2368\n\tds_read_b64_tr_b16 %6, %16 offset:96\n\tds_read_b64_tr_b16 %7, %16 offset:2400\n\t"
                             "ds_read_b64_tr_b16 %8, %16 offset:4608\n\tds_read_b64_tr_b16 %9, %16 offset:6912\n\tds_read_b64_tr_b16 %10, %16 offset:4640\n\tds_read_b64_tr_b16 %11, %16 offset:6944\n\t"
                             "ds_read_b64_tr_b16 %12, %16 offset:4672\n\tds_read_b64_tr_b16 %13, %16 offset:6976\n\tds_read_b64_tr_b16 %14, %16 offset:4704\n\tds_read_b64_tr_b16 %15, %16 offset:7008\n\ts_waitcnt lgkmcnt(0)"
                             : "=&v"(tb[0]), "=&v"(tb[1]), "=&v"(tb[2]), "=&v"(tb[3]), "=&v"(tb[4]), "=&v"(tb[5]), "=&v"(tb[6]), "=&v"(tb[7]),
                               "=&v"(tb[8]), "=&v"(tb[9]), "=&v"(tb[10]), "=&v"(tb[11]), "=&v"(tb[12]), "=&v"(tb[13]), "=&v"(tb[14]), "=&v"(tb[15])
                             : "v"(traddr) : "memory");
#pragma unroll
                for (int g = 0; g < 2; ++g)
#pragma unroll
                    for (int c = 0; c < 4; ++c) { u32x4p bb; bb.x = tb[8 * g + 2 * c].x; bb.y = tb[8 * g + 2 * c].y; bb.z = tb[8 * g + 2 * c + 1].x; bb.w = tb[8 * g + 2 * c + 1].y;
                        oa[g][c] = __builtin_amdgcn_mfma_f32_16x16x32_bf16(pf[ks], __builtin_bit_cast(bf16x8, bb), oa[g][c], 0, 0, 0); }
                asm volatile("" ::: "memory");
            }
            TMARK(15);
            bf16* orow = (bf16*)(F.ws + WS_ATT) + (size_t)(b * SEQ + t) * 512;
#pragma unroll
            for (int r = 0; r < 4; ++r) { const float i0 = __shfl(inv, r), i1 = __shfl(inv, 4 + r);
                if (l4 < 2) {
#pragma unroll
                    for (int c = 0; c < 4; ++c) { const float v = l4 == 0 ? oa[0][c][r] * i0 : oa[1][c][r] * i1; orow[(4 * l4 + r) * 64 + 16 * c + l15] = (bf16)f2bf(v); } } }
        }
        LDS_WAIT(); asm volatile("" ::: "memory");
        TMARK(4);
    }
    __syncthreads();
    TMARK(5);
}

__device__ __forceinline__ void p4_mixers(Frame& F, const Args& A) {
    for (int u = blockIdx.x; u < 256; u += F.G) hgrn_h1_unit(F, u);
    __syncthreads();
    { LAS float* bt = (LAS float*)(F.lds + DSA_BIAS);
      for (int i = F.tid; i < 114 * 8; i += NWAVES * 64) { const int n = i >> 3; int v = n; if (n >= 16) { v = 16 + (int)(__logf((float)n * (1.0f / 16.0f)) * (16.0f / 2.0794415416798357f)); v = v < 31 ? v : 31; }
          bt[i] = A.in[9][v * 8 + (i & 7)]; }
      __syncthreads(); }
    for (int u = blockIdx.x, k = 0; u < 2048; u += F.G, ++k) { const int b = u & 7, sl = u >> 3, sm = (k & 1) ? ((sl & ~31) | (31 - (sl & 31))) : sl; dsa_unit(F, b, (255 - sm) * 32); }
}

__device__ __forceinline__ void p5_rec(Frame& F, const Args& A) { for (int u = blockIdx.x; u < 256; u += F.G) hgrn_h3_unit(F, A, u);
}

__device__ __forceinline__ void p10_final(Frame& F, const Args& A) {
    const int gw = blockIdx.x * NWAVES + F.wave, NGW = F.G * NWAVES; const float* SS = (const float*)(F.ws + WS_X2SS);
    f32x4 wv[4];
#pragma unroll
    for (int j = 0; j < 4; ++j) wv[j] = *(const f32x4*)(A.in[19] + 4 * F.lane + 256 * j);
    for (int m0 = gw; m0 < M; m0 += 4 * NGW) {
        f32x4 v[4][4]; float ss[4];
#pragma unroll
        for (int k = 0; k < 4; ++k) { const int m = m0 + k * NGW < M ? m0 + k * NGW : m0; ss[k] = F.lane < 16 ? SS[(size_t)m * 16 + F.lane] : 0.f;
            const GAS f32x4* xr = (const GAS f32x4*)(F.out + (size_t)m * D) + F.lane;
#pragma unroll
            for (int j = 0; j < 4; ++j) v[k][j] = xr[64 * j]; }
#pragma unroll
        for (int k = 0; k < 4; ++k) { const int m = m0 + k * NGW; const float r = 1.0f / sqrtf(wave_sum(ss[k]) * (1.0f / D) + EPS);
            if (m < M) { GAS f32x4* xo = (GAS f32x4*)(F.out + (size_t)m * D) + F.lane;
#pragma unroll
                for (int j = 0; j < 4; ++j) xo[64 * j] = v[k][j] * r * wv[j]; } }
    }
}

__global__ void __launch_bounds__(NWAVES * 64, 2) fwd_kernel(Args args) {
    extern __shared__ __attribute__((aligned(16))) unsigned char lds[];
    Frame F;
    F.lds = (LAS unsigned char*)lds;
    F.MISC = (volatile LAS unsigned*)(F.lds + MISC_OFF);
    F.tid = threadIdx.x; F.lane = F.tid & 63; F.wave = __builtin_amdgcn_readfirstlane(F.tid >> 6);
    F.G = gridDim.x;
    F.ws = args.ws; F.ctl = (gu32*)(args.ws + WS_CTL); F.out = args.out;
    for (int u = F.tid; u < (LDS_BYTES - LDSCTL_OFF) / 4; u += NWAVES * 64) ((LAS unsigned*)(F.lds + LDSCTL_OFF))[u] = 0u;
    __syncthreads();
    XcdBarrier bar; bar.bar = (unsigned*)(F.ctl + CW_BAR); bar.x = 0; bar.st = nullptr;
    if (N_LAUNCHES == 1) bar = xcd_barrier_post((unsigned*)(F.ctl + CW_BAR), F.MISC + 8);
#ifdef TSEL
    unsigned long long tph_ = __builtin_amdgcn_s_memrealtime(); int phk_ = 0;
#define GRID_BAR() do { if (N_LAUNCHES == 1) { const unsigned long long t1_ = __builtin_amdgcn_s_memrealtime(); xcd_barrier(bar); const unsigned long long t2_ = __builtin_amdgcn_s_memrealtime(); \
        if (F.tid == 0) { ((LAS unsigned*)(F.lds + LDSCTL_OFF))[16 + phk_] += (unsigned)(t1_ - tph_); ((LAS unsigned*)(F.lds + LDSCTL_OFF))[40 + phk_] += (unsigned)(t2_ - t1_); } tph_ = t2_; ++phk_; } } while (0)
#else
#define GRID_BAR() do { if (N_LAUNCHES == 1) xcd_barrier(bar); } while (0)
#endif
    const int lo = args.ph_lo, hi = args.ph_hi;
#ifdef ONLY_PHASE
#define IN(k) ((k) == ONLY_PHASE && lo <= (k) && (k) < hi)
#else
#define IN(k) (lo <= (k) && (k) < hi)
#endif
#define BOTH(k) (IN(k) && IN((k) + 1))
    const float* MOD = (const float*)(F.ws + WS_MOD);

    if (IN(0)) { p0_prologue(F, args); if (BOTH(0)) GRID_BAR(); }
    if (IN(1)) { p1_norm(F, args); if (BOTH(1)) GRID_BAR(); }
    if (IN(2)) {
        pg8::Gemm g{(const bf16*)(F.ws + WS_XN), (const bf16*)(F.ws + WS_WIN), M, NPROJ_PAD, 1024}; pg8::StaticOrder S; S.init(M, NPROJ_PAD, F.G, (int)blockIdx.x);
        pg8::EpiInProj E{(bf16*)(F.ws + WS_CQ), (bf16*)(F.ws + WS_KV), (bf16*)(F.ws + WS_KI), (bf16*)(F.ws + WS_RQ), (bf16*)F.out,
                         (float*)(F.ws + WS_WI), (float*)(F.ws + WS_CQSS), (const float*)(F.ws + WS_LB)};
        pg8::gemm_phase<pg8::EpiInProj, pg8::StaticOrder, PG8_ALIGN, PG8_SP2>(F.lds + RING_OFF, g, S, E);
        if (BOTH(2)) GRID_BAR();
    }
    if (IN(3)) {
        pg8::Gemm g{(const bf16*)(F.ws + WS_CQ), (const bf16*)(F.ws + WS_WQ), M, 1024, 256}; pg8::StaticOrder S; S.init(M, 1024, F.G, (int)blockIdx.x);
        pg8::EpiQ E{(bf16*)(F.ws + WS_Q), (const float*)(F.ws + WS_CQSS)};
        pg8::gemm_phase<pg8::EpiQ, pg8::StaticOrder, PG8_ALIGN, PG8_SP2>(F.lds + RING_OFF, g, S, E);
        if (BOTH(3)) GRID_BAR();
    }
#ifdef TSEL
    if (IN(4)) { const unsigned long long ta_ = __builtin_amdgcn_s_memrealtime(); p4_mixers(F, args); unsigned long long tb_ = __builtin_amdgcn_s_memrealtime(); if (F.tid == 0) ((LAS unsigned*)(F.lds + LDSCTL_OFF))[7] += (unsigned)(tb_ - ta_); if (BOTH(4)) GRID_BAR(); if (F.tid == 0) ((LAS unsigned*)(F.lds + LDSCTL_OFF))[6] += (unsigned)(__builtin_amdgcn_s_memrealtime() - tb_); }
#else
    if (IN(4)) { p4_mixers(F, args); if (BOTH(4)) GRID_BAR(); }
#endif
    if (IN(5)) { p5_rec(F, args); if (BOTH(5)) GRID_BAR(); }
    if (IN(6)) {
        pg8::ChainOrder S; S.init(M, 1024, F.G, (int)blockIdx.x);
        pg8::Gemm g{(const bf16*)(F.ws + WS_ATT), (const bf16*)(F.ws + WS_WBA), 2 * M, 2048, 512}; pg8::EpiBranchChain E{(bf16*)(F.ws + WS_MIX), (const bf16*)F.out};
        pg8::gemm_phase<pg8::EpiBranchChain, pg8::ChainOrder, PG8_ALIGN, PG8_SP2>(F.lds + RING_OFF, g, S, E);
        if (BOTH(6)) GRID_BAR();
    }
    if (IN(7)) {
        pg8::Gemm g{(const bf16*)(F.ws + WS_MIX), (const bf16*)(F.ws + WS_WOUT), M, 1024, 1024}; pg8::StaticOrder S; S.init(M, 1024, F.G, (int)blockIdx.x);
        pg8::EpiOut E{args.in[0], (bf16*)(F.ws + WS_X1), (bf16*)(F.ws + WS_XS), (float*)(F.ws + WS_X1SS), MOD, (const float*)(F.ws + WS_CW2)};
        pg8::gemm_phase<pg8::EpiOut, pg8::StaticOrder, PG8_ALIGN, PG8_SP2>(F.lds + RING_OFF, g, S, E);
        if (BOTH(7)) GRID_BAR();
    }
    if (IN(8)) {
        pg8::Gemm g{(const bf16*)(F.ws + WS_XS), (const bf16*)(F.ws + WS_WGU), M, NGU, 1024}; pg8::StaticOrder S; S.init(M, NGU, F.G, (int)blockIdx.x);
        int pm0 = 0; { const int nN_ = NGU / 256, nwg_ = (M / 256) * nN_; int wg_ = (int)blockIdx.x;
            if (wg_ < nwg_) { const int q_ = nwg_ / 8, r_ = nwg_ % 8, x_ = wg_ % 8, o_ = wg_ / 8; wg_ = (x_ < r_ ? x_ * (q_ + 1) : r_ * (q_ + 1) + (x_ - r_) * q_) + o_;
                const int nig_ = 8 * nN_, fm_ = (wg_ / nig_) * 8, gsz_ = (M / 256 - fm_) < 8 ? (M / 256 - fm_) : 8; pm0 = fm_ + ((wg_ % nig_) % gsz_); } }
        const int g0 = pm0 >> 3, pm7 = pm0 & 7;
        { LAS float* R2L = (LAS float*)(F.lds + RING_BYTES); const float* SS = (const float*)(F.ws + WS_X1SS);
          for (int i = F.tid; i < 1024; i += NWAVES * 64) { const int pm = 8 * (g0 + (i >> 8)) + pm7; float r = 0.f;
              if (pm < M / 256) { const float* p = SS + (size_t)(pm * 256 + (i & 255)) * 16; float s2 = 0.f;
#pragma unroll
                  for (int q = 0; q < 4; ++q) { const f32x4 t = *(const f32x4*)(p + 4 * q); s2 += (t[0] + t[1]) + (t[2] + t[3]); }
                  r = __builtin_amdgcn_rsqf(s2 * (1.0f / 1024.0f) + 1e-6f); }
              R2L[i] = r; }
          LAS float* BL = (LAS float*)(F.lds + RING_BYTES + 4096); const float* bsrc = (const float*)(F.ws + WS_BGU) + (pm0 >> 5) * NGU;
          for (int i = F.tid; i < NGU / 4; i += NWAVES * 64) ((LAS f32x4*)BL)[i] = ((const f32x4*)bsrc)[i];
          __syncthreads(); }
        pg8::EpiGateUp E{(bf16*)(F.ws + WS_HID), (const float*)(F.ws + WS_X1SS), (const float*)(F.ws + WS_BGU), (const LAS float*)(F.lds + RING_BYTES + 4096), pm0 >> 5, (const LAS float*)(F.lds + RING_BYTES), g0, pm7};
        pg8::gemm_phase<pg8::EpiGateUp, pg8::StaticOrder, PG8_ALIGN, PG8_SP2>(F.lds + RING_OFF, g, S, E);
        if (BOTH(8)) GRID_BAR();
    }
    if (IN(9)) {
        pg8::Gemm g{(const bf16*)(F.ws + WS_HID), (const bf16*)(F.ws + WS_WD), M, 1024, FF}; pg8::StaticOrder S; S.init(M, 1024, F.G, (int)blockIdx.x);
        pg8::EpiDown E{(const bf16*)(F.ws + WS_X1), F.out, (float*)(F.ws + WS_X2SS), MOD};
        pg8::gemm_phase<pg8::EpiDown, pg8::StaticOrder, PG8_ALIGN, PG8_SP2>(F.lds + RING_OFF, g, S, E);
        if (BOTH(9)) GRID_BAR();
    }
    if (IN(10)) p10_final(F, args);
#ifdef TSEL
    if (F.tid == 0) ((LAS unsigned*)(F.lds + LDSCTL_OFF))[16 + phk_] += (unsigned)(__builtin_amdgcn_s_memrealtime() - tph_);
    __syncthreads();
    if (blockIdx.x == 0 && F.tid == 0) { const unsigned ticks = ((LAS unsigned*)(F.lds + LDSCTL_OFF))[TSEL]; const unsigned long long t0_ = __builtin_amdgcn_s_memrealtime(); while (__builtin_amdgcn_s_memrealtime() - t0_ < (unsigned long long)ticks) __builtin_amdgcn_s_sleep(8); }
#endif
#undef IN
#undef BOTH
}

extern "C" void kernel_launch(void* const* d_in, const int* in_sizes, int n_in, void* d_out, int out_size, void* d_ws, size_t ws_size, hipStream_t stream) {
    static int grid = 0;
    if (grid == 0) {
        if (n_in != 20 || in_sizes[0] != M * D || out_size != M * D || ws_size < WS_END) { fprintf(stderr, "kernel_launch: unexpected shapes (n_in %d, in0 %d, out %d, ws %zu); nothing launched\n", n_in, n_in > 0 ? in_sizes[0] : -1, out_size, ws_size); grid = -1; return; }
        int dev = 0, cus = 0, per_cu = 0;
        if (hipGetDevice(&dev) != hipSuccess || hipDeviceGetAttribute(&cus, hipDeviceAttributeMultiprocessorCount, dev) != hipSuccess) { grid = -1; return; }
        if (hipFuncSetAttribute((const void*)fwd_kernel, hipFuncAttributeMaxDynamicSharedMemorySize, LDS_BYTES) != hipSuccess) { fprintf(stderr, "kernel_launch: hipFuncSetAttribute failed\n"); grid = -1; return; }
        if (hipOccupancyMaxActiveBlocksPerMultiprocessor(&per_cu, (const void*)fwd_kernel, NWAVES * 64, LDS_BYTES) != hipSuccess || per_cu < 1)
            fprintf(stderr, "kernel_launch: note: occupancy query reports %d workgroups per CU\n", per_cu);
        (void)hipGetLastError();
        grid = cus;
    }
    if (grid < 0) return;
    if (hipMemsetAsync((char*)d_ws + WS_CTL, 0, CTL_ZERO_BYTES, stream) != hipSuccess) { fprintf(stderr, "kernel_launch: memset failed\n"); return; }
    Args a{};
    for (int i = 0; i < 20; ++i) a.in[i] = (const float*)d_in[i];
    a.out = (float*)d_out; a.ws = (unsigned char*)d_ws;
    for (int li = 0; li < N_LAUNCHES; ++li) {
        a.ph_lo = (N_LAUNCHES == 1) ? 0 : li; a.ph_hi = (N_LAUNCHES == 1) ? N_PHASES : li + 1;
        hipLaunchKernelGGL(fwd_kernel, dim3(grid), dim3(NWAVES * 64), LDS_BYTES, stream, a);
        const hipError_t le = hipPeekAtLastError();
        if (le != hipSuccess) { fprintf(stderr, "kernel_launch: launch %d failed: %s\n", li, hipGetErrorName(le)); break; }
    }
}
```

```cpp
#include <hip/hip_runtime.h>
#include <cstdio>
#include <cstdint>
namespace pg8 {
#define PG8_LAS __attribute__((address_space(3)))
typedef unsigned short bf16_t;
typedef short bf16x8 __attribute__((ext_vector_type(8)));
typedef float f32x4 __attribute__((ext_vector_type(4)));
typedef unsigned u32x4 __attribute__((ext_vector_type(4)));
constexpr int BM = 256, BK = 64, HALF = 128, HTB = HALF * BK * 2  , STAGE_BYTES = 8 * HTB, NXCD = 8, WGM = 8;

__host__ __device__ __forceinline__ int lds_byte(int r, int c) { const int st = (r >> 4) * 2 + (c >> 5), rr = r & 15, cc = c & 31, ob = rr * 64 + cc * 2; return st * 1024 + (ob ^ (((ob >> 9) & 1) << 5)); }
__host__ __device__ __forceinline__ void stage_rc(int b, int& R, int& C) { const int st = b / 1024, sb = b % 1024, swz = sb ^ (((sb >> 9) & 1) << 5); R = (st >> 1) * 16 + swz / 64; C = (st & 1) * 32 + (swz % 64) / 2; }
__host__ __device__ __forceinline__ int perm32(int rho) { const int n = rho >> 4, i = rho & 15; return 8 * (i >> 2) + 4 * n + (i & 3); }

struct Unit { int pm, pn; };
struct Gemm { const bf16_t* A; const bf16_t* Bt; int M, N, K; };

struct StaticOrder {
    int nM, nN, nwg, G, c;
    __host__ __device__ void init(int M, int N, int G_, int c_) { nM = M / BM; nN = N / BM; nwg = nM * nN; G = G_; c = c_; }
    __host__ __device__ bool next(int i, Unit& u) const {
        const long L = (long)i * G + c; if (L >= nwg) return false;
        int wgid = (int)L; { const int q = nwg / NXCD, r = nwg % NXCD, xcd = wgid % NXCD, off = wgid / NXCD; wgid = (xcd < r ? xcd * (q + 1) : r * (q + 1) + (xcd - r) * q) + off; }
        const int nig = WGM * nN, gid = wgid / nig, fm = gid * WGM, gsz = (nM - fm) < WGM ? (nM - fm) : WGM;
        u.pm = fm + ((wgid % nig) % gsz); u.pn = (wgid % nig) / gsz; return true;
    }
    __device__ __forceinline__ void a_ready(const Unit&) const {}
    __device__ __forceinline__ void done(const Unit&) const {}
};

__device__ __forceinline__ unsigned cvt_pk_bf16(float lo, float hi) { unsigned r; asm volatile("v_cvt_pk_bf16_f32 %0, %1, %2" : "=v"(r) : "v"(lo), "v"(hi)); return r; }
__device__ __forceinline__ float fsigmoid(float x) { return __builtin_amdgcn_rcpf(1.0f + __expf(-x)); }
__device__ __forceinline__ float fsilu(float x) { return x * fsigmoid(x); }
__device__ __forceinline__ u32x4 pack8(const f32x4 a, const f32x4 b) { u32x4 w; w.x = cvt_pk_bf16(a[0], a[1]); w.y = cvt_pk_bf16(a[2], a[3]); w.z = cvt_pk_bf16(b[0], b[1]); w.w = cvt_pk_bf16(b[2], b[3]); return w; }
__device__ __forceinline__ float bf_lo(unsigned u) { return __builtin_bit_cast(float, u << 16); }
__device__ __forceinline__ float bf_hi(unsigned u) { return __builtin_bit_cast(float, u & 0xffff0000u); }

struct EpiInProj {
    static constexpr bool PERM = true, AFTER_DRAIN = false, CHAIN = false;
    bf16_t *CQ, *KV, *KI, *RQ, *GATES; float *WI, *CQSS; const float* LB;
    __device__ __forceinline__ void operator()(const f32x4 (&acc)[2][2][4][2], const Unit& u, int wr, int wc, int fr, int fq) const {
        const int row0 = u.pm * BM + wr * 64 + fr, pn = u.pn, cl = wc * 32 + 8 * fq;
        if (pn == 0) {
#pragma unroll
            for (int ai = 0; ai < 2; ++ai)
#pragma unroll
                for (int m = 0; m < 4; ++m) { const int row = row0 + ai * HALF + m * 16; float s = 0.f;
#pragma unroll
                    for (int bj = 0; bj < 2; ++bj) { const f32x4 a = acc[ai][bj][m][0], b = acc[ai][bj][m][1];
                        s += (a[0] * a[0] + a[1] * a[1]) + (a[2] * a[2] + a[3] * a[3]) + (b[0] * b[0] + b[1] * b[1]) + (b[2] * b[2] + b[3] * b[3]);
                        *(u32x4*)(CQ + (size_t)row * 256 + cl + bj * HALF) = pack8(a, b); }
                    s += __shfl_xor(s, 16); s += __shfl_xor(s, 32);
                    if (fq == 0) CQSS[(size_t)row * 4 + wc] = s; }
        } else if (pn == 1) {
#pragma unroll
            for (int ai = 0; ai < 2; ++ai)
#pragma unroll
                for (int m = 0; m < 4; ++m) { const int row = row0 + ai * HALF + m * 16;
#pragma unroll
                    for (int bj = 0; bj < 2; ++bj) *(u32x4*)(KV + (size_t)row * 256 + cl + bj * HALF) = pack8(acc[ai][bj][m][0], acc[ai][bj][m][1]); }
        } else if (pn == 2) {
#pragma unroll
            for (int ai = 0; ai < 2; ++ai)
#pragma unroll
                for (int m = 0; m < 4; ++m) { const int row = row0 + ai * HALF + m * 16;
                    if (wc < 2) *(u32x4*)(KI + (size_t)row * 64 + cl) = pack8(acc[ai][0][m][0], acc[ai][0][m][1]);
                    else if (wc == 2 && fq == 0) { *(f32x4*)(WI + (size_t)row * 8) = acc[ai][0][m][0]; *(f32x4*)(WI + (size_t)row * 8 + 4) = acc[ai][0][m][1]; } }
        } else if (pn <= 10) {
            const int kind = (pn - 3) >> 1, cb = ((pn - 3) & 1) * 256 + cl;
            bf16_t* dst = RQ + (size_t)kind * (size_t)(32u << 20);
#pragma unroll
            for (int bj = 0; bj < 2; ++bj) {
                f32x4 l0 = (f32x4){0.f, 0.f, 0.f, 0.f}, l1 = l0;
                if (kind == 1) { l0 = *(const f32x4*)(LB + cb + bj * HALF); l1 = *(const f32x4*)(LB + cb + bj * HALF + 4); }
#pragma unroll
                for (int ai = 0; ai < 2; ++ai)
#pragma unroll
                    for (int m = 0; m < 4; ++m) { const int row = row0 + ai * HALF + m * 16; f32x4 a = acc[ai][bj][m][0], b = acc[ai][bj][m][1];
                        if (kind == 0 || kind == 3) {
#pragma unroll
                            for (int j = 0; j < 4; ++j) { a[j] = fsilu(a[j]); b[j] = fsilu(b[j]); } }
                        else if (kind == 1) {
#pragma unroll
                            for (int j = 0; j < 4; ++j) { a[j] = __logf(l0[j] + (1.0f - l0[j]) * fsigmoid(a[j])); b[j] = __logf(l1[j] + (1.0f - l1[j]) * fsigmoid(b[j])); } }
                        *(u32x4*)(dst + (size_t)row * 512 + cb + bj * HALF) = pack8(a, b); }
            }
        } else {
            const int cb = (pn - 11) * 256 + cl;
#pragma unroll
            for (int ai = 0; ai < 2; ++ai)
#pragma unroll
                for (int m = 0; m < 4; ++m) { const int row = row0 + ai * HALF + m * 16;
#pragma unroll
                    for (int bj = 0; bj < 2; ++bj) { f32x4 a = acc[ai][bj][m][0], b = acc[ai][bj][m][1];
#pragma unroll
                        for (int j = 0; j < 4; ++j) { a[j] = fsigmoid(a[j]) * 255.0f + 0.5f; b[j] = fsigmoid(b[j]) * 255.0f + 0.5f; }
                        unsigned lo = (unsigned)a[0] | ((unsigned)a[1] << 8) | ((unsigned)a[2] << 16) | ((unsigned)a[3] << 24), hi = (unsigned)b[0] | ((unsigned)b[1] << 8) | ((unsigned)b[2] << 16) | ((unsigned)b[3] << 24);
                        typedef unsigned u32x2v __attribute__((ext_vector_type(2)));
                        *(u32x2v*)((unsigned char*)GATES + (size_t)row * 2048 + cb + bj * HALF) = (u32x2v){lo, hi}; } }
        }
    }
};

struct EpiQ {
    static constexpr bool PERM = true, AFTER_DRAIN = false, CHAIN = false;
    bf16_t *Q; const float* CQSS;
    __device__ __forceinline__ void operator()(const f32x4 (&acc)[2][2][4][2], const Unit& u, int wr, int wc, int fr, int fq) const {
        const int row0 = u.pm * BM + wr * 64 + fr, pn = u.pn, cl = (pn & 1) * 256 + wc * 32 + 8 * fq;
        bf16_t* dst = Q + (pn < 2 ? (size_t)0 : (size_t)(32u << 20));
        const float sc = pn < 2 ? 0.125f : 1.0f;
#pragma unroll
        for (int ai = 0; ai < 2; ++ai)
#pragma unroll
            for (int m = 0; m < 4; ++m) { const int row = row0 + ai * HALF + m * 16;
                const f32x4 ss = *(const f32x4*)(CQSS + (size_t)row * 4);
                const float r = __builtin_amdgcn_rsqf(((ss[0] + ss[1]) + (ss[2] + ss[3])) * (1.0f / 256.0f) + 1e-6f) * sc;
#pragma unroll
                for (int bj = 0; bj < 2; ++bj) *(u32x4*)(dst + (size_t)row * 512 + cl + bj * HALF) = pack8(acc[ai][bj][m][0] * r, acc[ai][bj][m][1] * r); }
    }
};

template <int MODE> struct EpiBranch {
    static constexpr bool PERM = true, AFTER_DRAIN = false, CHAIN = false;
    bf16_t* MIX; const bf16_t* GATES;
    __device__ __forceinline__ void operator()(const f32x4 (&acc)[2][2][4][2], const Unit& u, int wr, int wc, int fr, int fq) const {
        const int row0 = u.pm * BM + wr * 64 + fr, cl = u.pn * 256 + wc * 32 + 8 * fq;
#pragma unroll
        for (int ai = 0; ai < 2; ++ai)
#pragma unroll
            for (int m = 0; m < 4; ++m) { const int row = row0 + ai * HALF + m * 16;
#pragma unroll
                for (int bj = 0; bj < 2; ++bj) { const int c = cl + bj * HALF;
                    const u32x4 g = *(const u32x4*)(GATES + (size_t)row * 2048 + MODE * 1024 + c);
                    f32x4 a = acc[ai][bj][m][0], b = acc[ai][bj][m][1];
                    a[0] *= bf_lo(g.x); a[1] *= bf_hi(g.x); a[2] *= bf_lo(g.y); a[3] *= bf_hi(g.y); b[0] *= bf_lo(g.z); b[1] *= bf_hi(g.z); b[2] *= bf_lo(g.w); b[3] *= bf_hi(g.w);
                    if (MODE == 1) { const u32x4 p = *(const u32x4*)(MIX + (size_t)row * 1024 + c);
                        a[0] += bf_lo(p.x); a[1] += bf_hi(p.x); a[2] += bf_lo(p.y); a[3] += bf_hi(p.y); b[0] += bf_lo(p.z); b[1] += bf_hi(p.z); b[2] += bf_lo(p.w); b[3] += bf_hi(p.w); }
                    *(u32x4*)(MIX + (size_t)row * 1024 + c) = pack8(a, b); } }
    }
};

struct EpiOut {
    static constexpr bool PERM = true, AFTER_DRAIN = false, CHAIN = false;
    const float* X; bf16_t* X1; bf16_t* XS; float* X1SS; const float* MOD; const float* CW2;
    __device__ __forceinline__ void operator()(const f32x4 (&acc)[2][2][4][2], const Unit& u, int wr, int wc, int fr, int fq) const {
        const int row0 = u.pm * BM + wr * 64 + fr, cl = u.pn * 256 + wc * 32 + 8 * fq, b = u.pm >> 5;
#pragma unroll
        for (int ai = 0; ai < 2; ++ai)
#pragma unroll
            for (int m = 0; m < 4; ++m) { const int row = row0 + ai * HALF + m * 16; float s = 0.f;
#pragma unroll
                for (int bj = 0; bj < 2; ++bj) { const int c = cl + bj * HALF;
                    const float* xp = X + (size_t)row * 1024 + c; const float* gp = MOD + b * 6144 + 2048 + c; const float* cp = CW2 + b * 1024 + c;
                    const f32x4 v0 = *(const f32x4*)(xp) + *(const f32x4*)(gp) * acc[ai][bj][m][0], v1 = *(const f32x4*)(xp + 4) + *(const f32x4*)(gp + 4) * acc[ai][bj][m][1];
                    *(u32x4*)(X1 + (size_t)row * 1024 + c) = pack8(v0, v1);
                    s += (v0[0] * v0[0] + v0[1] * v0[1]) + (v0[2] * v0[2] + v0[3] * v0[3]) + (v1[0] * v1[0] + v1[1] * v1[1]) + (v1[2] * v1[2] + v1[3] * v1[3]);
                    *(u32x4*)(XS + (size_t)row * 1024 + c) = pack8(v0 * *(const f32x4*)(cp), v1 * *(const f32x4*)(cp + 4)); }
                s += __shfl_xor(s, 16); s += __shfl_xor(s, 32);
                if (fq == 0) X1SS[(size_t)row * 16 + u.pn * 4 + wc] = s; }
    }
};

struct EpiGateUp {
    static constexpr bool PERM = true, AFTER_DRAIN = false, CHAIN = false;
    bf16_t* HID; const float* X1SS; const float* BGU;
    const PG8_LAS float* BL; int bl;
    const PG8_LAS float* R2L; int g0, pm7;
    __device__ __forceinline__ void operator()(const f32x4 (&acc)[2][2][4][2], const Unit& u, int wr, int wc, int fr, int fq) const {
        const int row0 = u.pm * BM + wr * 64 + fr, cl = wc * 32 + 8 * fq, b = u.pm >> 5;
        const int slot = (u.pm >> 3) - g0; const bool cached = slot >= 0 && slot < 4 && (u.pm & 7) == pm7;
        f32x4 bg0, bg1, bu0, bu1;
        if (b == bl) { const PG8_LAS float* bp = BL + u.pn * 256 + cl; bg0 = *(const PG8_LAS f32x4*)(bp); bg1 = *(const PG8_LAS f32x4*)(bp + 4); bu0 = *(const PG8_LAS f32x4*)(bp + 128); bu1 = *(const PG8_LAS f32x4*)(bp + 132); }
        else { const float* bp = BGU + b * 5632 + u.pn * 256 + cl; bg0 = *(const f32x4*)(bp); bg1 = *(const f32x4*)(bp + 4); bu0 = *(const f32x4*)(bp + 128); bu1 = *(const f32x4*)(bp + 132); }
#pragma unroll
        for (int ai = 0; ai < 2; ++ai)
#pragma unroll
            for (int m = 0; m < 4; ++m) { const int row = row0 + ai * HALF + m * 16;
                float r = R2L[(cached ? slot : 0) * 256 + wr * 64 + fr + ai * HALF + m * 16];
                if (!cached) { float s = 0.f;
#pragma unroll
                    for (int q = 0; q < 4; ++q) { const f32x4 t = *(const f32x4*)(X1SS + (size_t)row * 16 + 4 * q); s += (t[0] + t[1]) + (t[2] + t[3]); }
                    r = __builtin_amdgcn_rsqf(s * (1.0f / 1024.0f) + 1e-6f); }
                f32x4 g0v = acc[ai][0][m][0] * r + bg0, g1v = acc[ai][0][m][1] * r + bg1; const f32x4 u0 = acc[ai][1][m][0] * r + bu0, u1 = acc[ai][1][m][1] * r + bu1;
#pragma unroll
                for (int j = 0; j < 4; ++j) { g0v[j] = fsilu(g0v[j]) * u0[j]; g1v[j] = fsilu(g1v[j]) * u1[j]; }
                *(u32x4*)(HID + (size_t)row * 2816 + u.pn * 128 + cl) = pack8(g0v, g1v); }
    }
};

struct EpiDown {
    static constexpr bool PERM = true, AFTER_DRAIN = false, CHAIN = false;
    const bf16_t* X1; bf16_t* X2; float* X2SS; const float* MOD;
    __device__ __forceinline__ void operator()(const f32x4 (&acc)[2][2][4][2], const Unit& u, int wr, int wc, int fr, int fq) const {
        const int row0 = u.pm * BM + wr * 64 + fr, cl = u.pn * 256 + wc * 32 + 8 * fq, b = u.pm >> 5;
#pragma unroll
        for (int ai = 0; ai < 2; ++ai)
#pragma unroll
            for (int m = 0; m < 4; ++m) { const int row = row0 + ai * HALF + m * 16; float s = 0.f;
#pragma unroll
                for (int bj = 0; bj < 2; ++bj) { const int c = cl + bj * HALF;
                    const u32x4 xb = *(const u32x4*)(X1 + (size_t)row * 1024 + c);
                    const f32x4 x0 = (f32x4){bf_lo(xb.x), bf_hi(xb.x), bf_lo(xb.y), bf_hi(xb.y)}, x1 = (f32x4){bf_lo(xb.z), bf_hi(xb.z), bf_lo(xb.w), bf_hi(xb.w)};
                    const f32x4 v0 = x0 + *(const f32x4*)(MOD + b * 6144 + 5120 + c) * acc[ai][bj][m][0], v1 = x1 + *(const f32x4*)(MOD + b * 6144 + 5120 + c + 4) * acc[ai][bj][m][1];
                    *(u32x4*)(X2 + (size_t)row * 1024 + c) = pack8(v0, v1);
                    s += (v0[0] * v0[0] + v0[1] * v0[1]) + (v0[2] * v0[2] + v0[3] * v0[3]) + (v1[0] * v1[0] + v1[1] * v1[1]) + (v1[2] * v1[2] + v1[3] * v1[3]); }
                s += __shfl_xor(s, 16); s += __shfl_xor(s, 32);
                if (fq == 0) X2SS[(size_t)row * 16 + u.pn * 4 + wc] = s; }
    }
};


struct ChainOrder : StaticOrder {
    __device__ bool next(int i, Unit& u) const { Unit t; if (!StaticOrder::next(i >> 1, t)) return false; u.pm = t.pm + ((i & 1) ? 256 : 0); u.pn = t.pn + ((i & 1) ? 4 : 0); return true; }
};
struct EpiBranchChain {
    static constexpr bool PERM = true, AFTER_DRAIN = false, CHAIN = true;
    bf16_t* MIX; const bf16_t* GATES;
    __device__ __forceinline__ bool chain(f32x4 (&acc)[2][2][4][2], const Unit& u, int wr, int wc, int fr, int fq) const {
        const bool second = u.pm >= 256; const int pm = second ? u.pm - 256 : u.pm, pn = second ? u.pn - 4 : u.pn;
        const int row0 = pm * BM + wr * 64 + fr, cl = pn * 256 + wc * 32 + 8 * fq;
#pragma unroll
        for (int ai = 0; ai < 2; ++ai)
#pragma unroll
            for (int m = 0; m < 4; ++m) { const int row = row0 + ai * HALF + m * 16;
#pragma unroll
                for (int bj = 0; bj < 2; ++bj) { const int c = cl + bj * HALF;
                    typedef unsigned u32x2v __attribute__((ext_vector_type(2)));
                    const u32x2v gr = *(const u32x2v*)((const unsigned char*)GATES + (size_t)row * 2048 + 1024 + c);
                    float r[8];
#pragma unroll
                    for (int j = 0; j < 4; ++j) { r[j] = (float)((gr.x >> (8 * j)) & 255u) * (1.0f / 255.0f); r[4 + j] = (float)((gr.y >> (8 * j)) & 255u) * (1.0f / 255.0f); }
#pragma unroll
                    for (int j = 0; j < 8; ++j) r[j] = fmaxf(r[j], 1e-30f);
                    if (!second) { const u32x2v ga = *(const u32x2v*)((const unsigned char*)GATES + (size_t)row * 2048 + c);
                        float a[8];
#pragma unroll
                        for (int j = 0; j < 4; ++j) { a[j] = (float)((ga.x >> (8 * j)) & 255u) * (1.0f / 255.0f); a[4 + j] = (float)((ga.y >> (8 * j)) & 255u) * (1.0f / 255.0f); }
#pragma unroll
                        for (int j = 0; j < 4; ++j) { acc[ai][bj][m][0][j] *= a[j] * __builtin_amdgcn_rcpf(r[j]); acc[ai][bj][m][1][j] *= a[4 + j] * __builtin_amdgcn_rcpf(r[4 + j]); } }
                    else { f32x4 v0 = acc[ai][bj][m][0], v1 = acc[ai][bj][m][1];
#pragma unroll
                        for (int j = 0; j < 4; ++j) { v0[j] *= r[j]; v1[j] *= r[4 + j]; }
                        *(u32x4*)(MIX + (size_t)row * 1024 + c) = pack8(v0, v1); } } }
        return !second;
    }
};
template <class Epi, class Sched, bool ALIGN_EPI = false, bool SP2 = false>
__device__ __forceinline__ void gemm_phase(PG8_LAS unsigned char* lds, const Gemm g, const Sched& S, const Epi& E) {
    const int tid = threadIdx.x, wid = __builtin_amdgcn_readfirstlane(tid >> 6), lane = tid & 63, wr = wid >> 2, wc = wid & 3, fr = lane & 15, fq = lane >> 4;
    const int K = g.K, nt = K / BK;
    unsigned voffA[2], voffB[2];
#pragma unroll
    for (int i = 0; i < 2; ++i) { int R, C; stage_rc(tid * 16 + i * 8192, R, C); const int Rb = Epi::PERM ? ((R & ~31) + perm32(R & 31)) : R;
        voffA[i] = (unsigned)(R * K + C) * 2u; voffB[i] = (unsigned)(Rb * K + C) * 2u; }
    const size_t kstep = (size_t)(BK * 2);
    const size_t hstep = (size_t)HALF * K * 2;
    const size_t tstep = 2 * hstep;
    const unsigned ldsw = (unsigned)wid * 1024u;
    const int aoff = lds_byte(wr * 64 + fr, fq * 8), boff = lds_byte(wc * 32 + fr, fq * 8);
#define PG8_SA(b, h) (((b) * 2 + (h)) * HTB)
#define PG8_SB(b, h) ((4 + (b) * 2 + (h)) * HTB)
#define PG8_STAGE(bufoff, gbase, voff) do { _Pragma("unroll") for (int _i = 0; _i < 2; ++_i) \
        __builtin_amdgcn_global_load_lds((const unsigned*)((const char*)(gbase) + (voff)[_i]), (PG8_LAS unsigned*)(lds + (bufoff) + ldsw + _i * 8192), 16, 0, 0); } while (0)
#define PG8_LDA(dst, b, h) do { _Pragma("unroll") for (int m = 0; m < 4; ++m) _Pragma("unroll") for (int k = 0; k < 2; ++k) dst[m][k] = *(const PG8_LAS bf16x8*)(lds + PG8_SA(b, h) + aoff + m * 2048 + k * 1024); } while (0)
#define PG8_LDB(dst, b, h) do { _Pragma("unroll") for (int n = 0; n < 2; ++n) _Pragma("unroll") for (int k = 0; k < 2; ++k) dst[n][k] = *(const PG8_LAS bf16x8*)(lds + PG8_SB(b, h) + boff + n * 2048 + k * 1024); } while (0)
#define PG8_MMA(ai, bj, At, Bt) do { __builtin_amdgcn_s_setprio(1); _Pragma("unroll") for (int m = 0; m < 4; ++m) _Pragma("unroll") for (int n = 0; n < 2; ++n) _Pragma("unroll") for (int k = 0; k < 2; ++k) \
        acc[ai][bj][m][n] = __builtin_amdgcn_mfma_f32_16x16x32_bf16(Bt[n][k], At[m][k], acc[ai][bj][m][n], 0, 0, 0); __builtin_amdgcn_s_setprio(0); } while (0)
#define PG8_WAIT_V(n) asm volatile("s_waitcnt vmcnt(" #n ")" ::: "memory")
#define PG8_WAIT_L(n) asm volatile("s_waitcnt lgkmcnt(" #n ")" ::: "memory")
#define PG8_BAR __builtin_amdgcn_s_barrier()
#define PG8_SCHED __builtin_amdgcn_sched_barrier(0)
    Unit cur, nxt; int ui = 0;
    if (!S.next(0, cur)) return;
    f32x4 acc[2][2][4][2];
#pragma unroll
    for (int a = 0; a < 2; ++a)
#pragma unroll
        for (int b = 0; b < 2; ++b)
#pragma unroll
            for (int m = 0; m < 4; ++m)
#pragma unroll
                for (int n = 0; n < 2; ++n) acc[a][b][m][n] = (f32x4){0.f, 0.f, 0.f, 0.f};
    bf16x8 At[4][2], B0[2][2], B1[2][2];
    const char* cA = (const char*)g.A + (size_t)cur.pm * tstep; const char* cB = (const char*)g.Bt + (size_t)cur.pn * tstep;
    S.a_ready(cur);
    if constexpr (SP2) {
        PG8_STAGE(PG8_SB(0, 0), cB, voffB); PG8_STAGE(PG8_SB(0, 1), cB + hstep, voffB); PG8_STAGE(PG8_SA(0, 0), cA, voffA); PG8_STAGE(PG8_SA(0, 1), cA + hstep, voffA);
        if (wr == 1) PG8_BAR;
        PG8_WAIT_V(2); PG8_BAR;
        PG8_STAGE(PG8_SB(1, 0), cB + kstep, voffB); PG8_STAGE(PG8_SA(1, 0), cA + kstep, voffA); PG8_STAGE(PG8_SB(1, 1), cB + hstep + kstep, voffB);
        PG8_WAIT_V(6); PG8_BAR;
    } else {
        PG8_STAGE(PG8_SB(0, 0), cB, voffB); PG8_STAGE(PG8_SA(0, 0), cA, voffA); PG8_STAGE(PG8_SB(0, 1), cB + hstep, voffB); PG8_STAGE(PG8_SA(0, 1), cA + hstep, voffA);
        if (wr == 1) PG8_BAR;
        PG8_WAIT_V(4); PG8_BAR;
        PG8_STAGE(PG8_SB(1, 0), cB + kstep, voffB); PG8_STAGE(PG8_SA(1, 0), cA + kstep, voffA); PG8_STAGE(PG8_SB(1, 1), cB + hstep + kstep, voffB);
        PG8_WAIT_V(6); PG8_BAR;
    }
    for (;;) {
        const bool has_next = S.next(ui + 1, nxt);
        const char* nA = has_next ? (const char*)g.A + (size_t)nxt.pm * tstep : cA; const char* nB = has_next ? (const char*)g.Bt + (size_t)nxt.pn * tstep : cB;
        for (int t = 0; t < nt; t += 2) {
            const bool last = (t == nt - 2);
            const char* a1 = cA + (size_t)(t + 1) * kstep;
            const char* a2 = last ? nA : cA + (size_t)(t + 2) * kstep; const char* b2 = last ? nB : cB + (size_t)(t + 2) * kstep;
            const char* a3 = a2 + kstep; const char* b3 = b2 + kstep;
            if (last && has_next) S.a_ready(nxt);
            if constexpr (SP2) {
            PG8_LDB(B0, 0, 0); PG8_LDB(B1, 0, 1); PG8_SCHED; PG8_LDA(At, 0, 0); PG8_STAGE(PG8_SA(1, 1), a1 + hstep, voffA);
            PG8_WAIT_V(8); PG8_WAIT_L(0); PG8_BAR; PG8_MMA(0, 0, At, B0); PG8_MMA(0, 1, At, B1); PG8_BAR; PG8_SCHED;
            PG8_LDA(At, 0, 1); PG8_STAGE(PG8_SB(0, 0), b2, voffB); PG8_STAGE(PG8_SB(0, 1), b2 + hstep, voffB); PG8_STAGE(PG8_SA(0, 0), a2, voffA);
            PG8_WAIT_V(8); PG8_WAIT_L(0); PG8_BAR; PG8_MMA(1, 0, At, B0); PG8_MMA(1, 1, At, B1); PG8_BAR; PG8_SCHED;
            PG8_LDB(B0, 1, 0); PG8_LDB(B1, 1, 1); PG8_SCHED; PG8_LDA(At, 1, 0); PG8_STAGE(PG8_SA(0, 1), a2 + hstep, voffA);
            PG8_WAIT_V(8); PG8_WAIT_L(0); PG8_BAR; PG8_MMA(0, 0, At, B0); PG8_MMA(0, 1, At, B1); PG8_BAR; PG8_SCHED;
            PG8_LDA(At, 1, 1); PG8_STAGE(PG8_SB(1, 0), b3, voffB); PG8_STAGE(PG8_SB(1, 1), b3 + hstep, voffB); PG8_STAGE(PG8_SA(1, 0), a3, voffA);
            PG8_WAIT_V(8); PG8_WAIT_L(0); PG8_BAR; PG8_MMA(1, 0, At, B0); PG8_MMA(1, 1, At, B1); PG8_BAR; PG8_SCHED;
            } else {
            PG8_LDB(B0, 0, 0); PG8_SCHED; PG8_LDA(At, 0, 0); PG8_STAGE(PG8_SA(1, 1), a1 + hstep, voffA);
            PG8_WAIT_L(8); PG8_BAR; PG8_WAIT_L(0); PG8_MMA(0, 0, At, B0); PG8_BAR; PG8_SCHED;
            PG8_LDB(B1, 0, 1); PG8_STAGE(PG8_SB(0, 0), b2, voffB);
            PG8_BAR; PG8_WAIT_L(0); PG8_MMA(0, 1, At, B1); PG8_BAR;
            PG8_LDA(At, 0, 1); PG8_STAGE(PG8_SA(0, 0), a2, voffA);
            PG8_BAR; PG8_WAIT_L(0); PG8_MMA(1, 0, At, B0); PG8_BAR; PG8_SCHED;
            PG8_STAGE(PG8_SB(0, 1), b2 + hstep, voffB);
            PG8_WAIT_V(6); PG8_BAR; PG8_MMA(1, 1, At, B1); PG8_BAR;
            PG8_LDB(B0, 1, 0); PG8_SCHED; PG8_LDA(At, 1, 0); PG8_STAGE(PG8_SA(0, 1), a2 + hstep, voffA);
            PG8_WAIT_L(8); PG8_BAR; PG8_WAIT_L(0); PG8_MMA(0, 0, At, B0); PG8_BAR; PG8_SCHED;
            PG8_LDB(B1, 1, 1); PG8_STAGE(PG8_SB(1, 0), b3, voffB);
            PG8_BAR; PG8_WAIT_L(0); PG8_MMA(0, 1, At, B1); PG8_BAR;
            PG8_LDA(At, 1, 1); PG8_STAGE(PG8_SA(1, 0), a3, voffA);
            PG8_BAR; PG8_WAIT_L(0); PG8_MMA(1, 0, At, B0); PG8_BAR; PG8_SCHED;
            PG8_STAGE(PG8_SB(1, 1), b3 + hstep, voffB);
            PG8_WAIT_V(6); PG8_BAR; PG8_MMA(1, 1, At, B1); PG8_BAR;
            }
        }
        if constexpr (ALIGN_EPI) { if (wr == 0) PG8_BAR; }
        bool keep_acc = false;
        if constexpr (Epi::CHAIN) { keep_acc = E.chain(acc, cur, wr, wc, fr, fq); S.done(cur); }
        else if constexpr (!Epi::AFTER_DRAIN) { E(acc, cur, wr, wc, fr, fq); S.done(cur); }
        if (!has_next) break;
        if (!keep_acc)
#pragma unroll
        for (int a = 0; a < 2; ++a)
#pragma unroll
            for (int b = 0; b < 2; ++b)
#pragma unroll
                for (int m = 0; m < 4; ++m)
#pragma unroll
                    for (int n = 0; n < 2; ++n) acc[a][b][m][n] = (f32x4){0.f, 0.f, 0.f, 0.f};
        cur = nxt; cA = nA; cB = nB; ++ui;
        if constexpr (ALIGN_EPI) { if (wr == 1) PG8_BAR; }
    }
    PG8_WAIT_V(0);
    if constexpr (!ALIGN_EPI) { if (wr == 0) PG8_BAR; }
    PG8_BAR;
    if constexpr (Epi::AFTER_DRAIN) { E.fused(acc, cur, wr, wc, fr, fq, lds, wid, lane); S.done(cur); }
#undef PG8_SA
#undef PG8_SB
#undef PG8_STAGE
#undef PG8_LDA
#undef PG8_LDB
#undef PG8_MMA
#undef PG8_WAIT_V
#undef PG8_WAIT_L
#undef PG8_BAR
#undef PG8_SCHED
}
}
#ifndef PG8_SP2
#define PG8_SP2 true
#endif
#ifndef PG8_ALIGN
#define PG8_ALIGN true
#endif

constexpr int NWAVES = 8;
#ifndef MK_N_LAUNCHES
#define MK_N_LAUNCHES 1
#endif
constexpr int N_PHASES = 11;
constexpr int N_LAUNCHES = MK_N_LAUNCHES;
static_assert(N_LAUNCHES == 1 || N_LAUNCHES == N_PHASES, "MK_N_LAUNCHES is 1 or N_PHASES");

constexpr int NB = 8, SEQ = 8192, D = 1024, M = NB * SEQ;
constexpr int NPROJ = 4680, NPROJ_PAD = 4864, FF = 2816, NGU = 2 * FF;
constexpr float EPS = 1e-6f;

constexpr size_t MiB = 1u << 20;
constexpr size_t WS_CTL = 0, CTL_ZERO_BYTES = 1 * MiB;
constexpr size_t WS_MOD = 1 * MiB;
constexpr size_t WS_LB = WS_MOD + 256 * 1024;
constexpr size_t WS_CW2 = WS_MOD + 320 * 1024;
constexpr size_t WS_BGU = WS_MOD + 512 * 1024;
constexpr size_t WS_WIN = 3 * MiB, WS_WQ = 13 * MiB, WS_WBA = 14 * MiB, WS_WBR = 15 * MiB, WS_WOUT = 16 * MiB, WS_WGU = 18 * MiB, WS_WD = 29 * MiB;
constexpr size_t WS_CQSS = 35 * MiB, WS_X1SS = 36 * MiB, WS_X2SS = 40 * MiB;
constexpr size_t WS_XN = 64 * MiB;
constexpr size_t WS_CQ = 192 * MiB, WS_KV = 224 * MiB, WS_KI = 256 * MiB, WS_WI = 264 * MiB;
constexpr size_t WS_RQ = 272 * MiB, WS_RGL = 336 * MiB, WS_RI = 400 * MiB, WS_RGS = 464 * MiB;
constexpr size_t WS_Q = 528 * MiB, WS_QI = 592 * MiB;
constexpr size_t WS_ATT = 64 * MiB, WS_REC = 128 * MiB;
constexpr size_t WS_SCR = 656 * MiB;
constexpr size_t WS_OLOC = 784 * MiB, WS_QHAT = 848 * MiB, WS_U = 912 * MiB, WS_DS = 928 * MiB;
constexpr size_t WS_MIX = 896 * MiB;
constexpr size_t WS_X1 = 64 * MiB, WS_XS = 320 * MiB, WS_HID = 448 * MiB;
constexpr size_t WS_END = 1024 * MiB;
static_assert(WS_REC == WS_ATT + 64 * MiB && WS_WBR == WS_WBA + 1 * MiB, "the chained branch GEMM views [attn ; rec] and [Wa ; Wr] as one operand each");
static_assert(WS_RGL == WS_RQ + 64 * MiB && WS_RI == WS_RQ + 128 * MiB && WS_RGS == WS_RQ + 192 * MiB && WS_QI == WS_Q + 64 * MiB, "epilogue pointer arithmetic");
static_assert(WS_HID + (size_t)M * FF * 2 <= WS_END && WS_DS + 256 * 128 * 4 <= WS_END, "map");

constexpr int CW_TMO = 0, CW_CODE = 1;
constexpr int CW_BAR = 4096;

constexpr int RING_OFF = 0, RING_BYTES = 131072;
constexpr int LDS_BYTES = 163840;
constexpr int LDSCTL_OFF = LDS_BYTES - 1024, MISC_OFF = LDSCTL_OFF + 320;
static_assert(MISC_OFF + 128 <= LDS_BYTES, "LDS map");

#define GAS __attribute__((address_space(1)))
#define LAS __attribute__((address_space(3)))
typedef unsigned short bf16;
typedef unsigned v4u __attribute__((ext_vector_type(4)));
typedef unsigned v2u __attribute__((ext_vector_type(2)));
typedef float f32x4 __attribute__((ext_vector_type(4)));
typedef float f32x16 __attribute__((ext_vector_type(16)));
typedef short bf16x8 __attribute__((ext_vector_type(8)));
typedef GAS unsigned gu32;
#define RLX_AGENT __ATOMIC_RELAXED, __HIP_MEMORY_SCOPE_AGENT
#define LDS_WAIT() asm volatile("s_waitcnt lgkmcnt(0)" ::: "memory")
#define VM_WAIT() asm volatile("s_waitcnt vmcnt(0)" ::: "memory")
typedef float f32x2_t __attribute__((ext_vector_type(2)));
typedef __bf16 bf16x2_t __attribute__((ext_vector_type(2)));
__device__ __forceinline__ unsigned pk2(float lo, float hi) { const f32x2_t v = {lo, hi}; const bf16x2_t b = __builtin_convertvector(v, bf16x2_t); return __builtin_bit_cast(unsigned, b); }
__device__ __forceinline__ unsigned f2bf(float f) { return pk2(f, 0.f) & 0xffffu; }
__device__ __forceinline__ float bflo(unsigned u) { return __builtin_bit_cast(float, u << 16); }
__device__ __forceinline__ float bfhi(unsigned u) { return __builtin_bit_cast(float, u & 0xffff0000u); }
__device__ __forceinline__ float bf1(bf16 h) { return __builtin_bit_cast(float, (unsigned)h << 16); }

#define XB_TMO      128
#define XB_XCNT(j)  (256  + 64 * (j))
#define XB_XSUB(j)  (1280 + 64 * (j))
#define XB_XGEN(j)  (2304 + 64 * (j))
#define XB_TOP      3328
#define XB_TOPGEN   3392
#define XCD_BAR_WORDS 3456
#define XB_SPIN_CAP (1u << 23)

__device__ __forceinline__ unsigned xb_ld(unsigned* p)              { return __hip_atomic_load(p, __ATOMIC_RELAXED, __HIP_MEMORY_SCOPE_AGENT); }
__device__ __forceinline__ unsigned xb_add(unsigned* p, unsigned v) { return __hip_atomic_fetch_add(p, v, __ATOMIC_RELAXED, __HIP_MEMORY_SCOPE_AGENT); }
__device__ __forceinline__ unsigned xb_xcc_id() { return (unsigned)__builtin_amdgcn_s_getreg((3 << 11) | 20) & 0xFu; }
#define XB_SPIN(cond, bar) do { unsigned _sp = 0; while (cond) { __builtin_amdgcn_s_sleep(1); \
    if ((++_sp & 255u) == 0u) { if (xb_ld(&(bar)[XB_TMO])) break; if (_sp > XB_SPIN_CAP) { atomicAdd(&(bar)[XB_TMO], 1u); break; } } } } while (0)

struct XcdBarrier { unsigned* bar; unsigned x; volatile LAS unsigned* st; };

__device__ __forceinline__ XcdBarrier xcd_barrier_post(unsigned* bar, volatile LAS unsigned* st) {
    XcdBarrier b; b.bar = bar; b.x = xb_xcc_id(); b.st = st;
    if (threadIdx.x == 0) (void)xb_add(&bar[XB_XCNT(b.x)], 1u);
    return b;
}
__device__ __forceinline__ void xcd_barrier_complete(unsigned* bar, unsigned x, unsigned& nloc, unsigned& nx) {
    const unsigned G = gridDim.x * gridDim.y * gridDim.z;
    unsigned sum, cnt, mine, sp = 0u;
    for (;;) {
        sum = 0u; cnt = 0u; mine = 0u;
#pragma unroll
        for (unsigned j = 0; j < 16; ++j) { const unsigned c = xb_ld(&bar[XB_XCNT(j)]); sum += c; cnt += (c > 0u) ? 1u : 0u; mine = (j == x) ? c : mine; }
        if (sum == G) break;
        __builtin_amdgcn_s_sleep(1);
        if ((++sp & 255u) == 0u) { if (xb_ld(&bar[XB_TMO])) break; if (sp > XB_SPIN_CAP) { atomicAdd(&bar[XB_TMO], 1u); break; } }
    }
    nloc = mine > 0u ? mine : 1u; nx = cnt > 0u ? cnt : 1u;
}
__device__ __forceinline__ void xcd_barrier(const XcdBarrier& b) {
    asm volatile("s_waitcnt vmcnt(0)" ::: "memory");
    __syncthreads();
    if (threadIdx.x == 0) {
        unsigned* bar = b.bar;
        __builtin_amdgcn_s_waitcnt(0);
        unsigned nloc = b.st[0], nx = b.st[1];
        if (nloc == 0u) { xcd_barrier_complete(bar, b.x, nloc, nx); b.st[0] = nloc; b.st[1] = nx; }
        const unsigned old = xb_add(&bar[XB_XSUB(b.x)], 1u);
        const unsigned gen = old / nloc;
        if (old + 1u == (gen + 1u) * nloc) {
            __builtin_amdgcn_fence(__ATOMIC_RELEASE, "agent");
            asm volatile("s_waitcnt vmcnt(0)" ::: "memory");
            const unsigned og = xb_add(&bar[XB_TOP], 1u);
            const unsigned tg = og / nx;
            if (og + 1u == (tg + 1u) * nx) xb_add(&bar[XB_TOPGEN], 1u);
            else XB_SPIN(xb_ld(&bar[XB_TOPGEN]) == tg, bar);
            __builtin_amdgcn_fence(__ATOMIC_ACQUIRE, "agent");
            xb_add(&bar[XB_XGEN(b.x)], 1u);
            asm volatile("s_waitcnt vmcnt(0)" ::: "memory");
        } else {
            XB_SPIN(xb_ld(&bar[XB_XGEN(b.x)]) == gen, bar);
            __builtin_amdgcn_fence(__ATOMIC_ACQUIRE, "agent");
            asm volatile("s_waitcnt vmcnt(0)" ::: "memory");
        }
    }
    __syncthreads();
}

struct Frame {
    LAS unsigned char* lds;
    volatile LAS unsigned* MISC;
    gu32* ctl;
    unsigned char* ws;
    int tid, lane, wave;
    int G;
    float* out;
};
__device__ __forceinline__ float wave_sum(float v) {
#pragma unroll
    for (int o = 1; o < 64; o <<= 1) v += __shfl_xor(v, o);
    return v;
}
__device__ __forceinline__ float wave_max(float v) {
#pragma unroll
    for (int o = 1; o < 64; o <<= 1) v = fmaxf(v, __shfl_xor(v, o));
    return v;
}

template <class SrcCol>
__device__ __forceinline__ void transpose_item(const float* W, int ldw, int K, bf16* WT, const float* ks, LAS float* scr, int item, int nblk, int lane, SrcCol src) {
    const int kb = item / nblk, nb = item % nblk, k0 = 64 * kb, n0 = 32 * nb;
    const float* Wp; const int sc = src(n0 + (lane & 31), Wp);
#pragma unroll 8
    for (int i = 0; i < 32; ++i) { const int kk = 2 * i + (lane >> 5); float v = 0.f; if (sc >= 0) { v = Wp[(size_t)(k0 + kk) * ldw + sc]; if (ks) v *= ks[k0 + kk]; } scr[kk * 33 + (lane & 31)] = v; }
    LDS_WAIT(); asm volatile("" ::: "memory");
    const int c = lane & 7;
#pragma unroll
    for (int j = 0; j < 4; ++j) { const int n = (lane >> 3) + 8 * j; const LAS float* s = scr + (8 * c) * 33 + n;
        v4u o; o.x = pk2(s[0 * 33], s[1 * 33]); o.y = pk2(s[2 * 33], s[3 * 33]); o.z = pk2(s[4 * 33], s[5 * 33]); o.w = pk2(s[6 * 33], s[7 * 33]);
        *(GAS v4u*)(WT + (size_t)(n0 + n) * K + k0 + 8 * c) = o; }
    LDS_WAIT(); asm volatile("" ::: "memory");
}
struct Args { const float* in[20]; float* out; unsigned char* ws; int ph_lo, ph_hi; };
template <class SrcCol>
__device__ __forceinline__ void gemv8(Frame& F, const LAS float* vec, int cpg, int ngrp, int ldw, SrcCol src, const float* bias, float* out, int ldo) {
    LAS float* red = (LAS float*)(F.lds + 32768);
    for (int jb = blockIdx.x; jb < ngrp; jb += F.G) {
        const int col = F.tid & 31, kg = F.tid >> 5; float a[8];
#pragma unroll
        for (int b = 0; b < 8; ++b) a[b] = 0.f;
        const float* Wp = nullptr; int sc = -1;
        if (col < cpg) sc = src(jb * cpg + col, Wp);
        if (sc >= 0) for (int k = kg * 64; k < kg * 64 + 64; ++k) { const float w = Wp[(size_t)k * ldw + sc];
#pragma unroll
            for (int b = 0; b < 8; ++b) a[b] += vec[b * 1024 + k] * w; }
#pragma unroll
        for (int b = 0; b < 8; ++b) red[(kg * 8 + b) * 32 + col] = a[b];
        __syncthreads();
        if (F.tid < 256) { const int b = F.tid >> 5, c2 = F.tid & 31;
            if (c2 < cpg) { float s = 0.f; for (int k2 = 0; k2 < 16; ++k2) s += red[(k2 * 8 + b) * 32 + c2]; const int jj = jb * cpg + c2; out[b * ldo + jj] = s + (bias ? bias[jj] : 0.f); } }
        __syncthreads();
    }
}
struct SrcWin { const float* W; __device__ __forceinline__ int operator()(int d, const float*& Wp) const { Wp = W; return d < 584 ? d : (d < 768 ? -1 : d - 184); } };
__device__ __forceinline__ const float* psel(const float* a, const float* b, bool takeb) { const unsigned long long x = (unsigned long long)a, y = (unsigned long long)b, m = takeb ? ~0ull : 0ull; return (const float*)(x ^ ((x ^ y) & m)); }
struct SrcWq { const float *Wa, *Wb; __device__ __forceinline__ int operator()(int d, const float*& Wp) const { Wp = psel(Wa, Wb, d >= 512); return d & 511; } };
struct SrcId { const float* W; __device__ __forceinline__ int operator()(int d, const float*& Wp) const { Wp = W; return d; } };
struct SrcGu { const float *Wg, *Wu; __device__ __forceinline__ int operator()(int d, const float*& Wp) const { const int t = d >> 8, w = d & 255; Wp = psel(Wg, Wu, w >= 128); return t * 128 + (w & 127); } };

__device__ __forceinline__ void p0_prologue(Frame& F, const Args& A) {
    LAS float* cact = (LAS float*)(F.lds);
    for (int i = F.tid; i < 8192; i += NWAVES * 64) { const float v = A.in[1][i]; cact[i] = v / (1.0f + __expf(-v)); }
    __syncthreads();
    gemv8(F, cact, 24, 256, 6144, SrcId{A.in[2]}, A.in[3], (float*)(F.ws + WS_MOD), 6144);
    if (blockIdx.x == 0) { const float* l = A.in[10]; float* LB = (float*)(F.ws + WS_LB);
        for (int c = F.tid; c < 512; c += NWAVES * 64) LB[c] = 1.0f / (1.0f + __expf(l[512 + c] - l[c])); }
    __syncthreads();
    LAS float* scr = (LAS float*)(F.lds + 49152 + F.wave * 8448);
    const int gw = blockIdx.x * NWAVES + F.wave, NGW = F.G * NWAVES;
    constexpr int I_IN = 16 * 152, I_Q = 4 * 32, I_BA = 8 * 32, I_BR = 8 * 32, I_O = 16 * 32, I_GU = 16 * 176, I_D = 44 * 32;
    constexpr int NITEMS = I_IN + I_Q + I_BA + I_BR + I_O + I_GU + I_D;
    for (int it = gw; it < NITEMS; it += NGW) {
        int r = it;
        if (r < I_IN) { transpose_item(A.in[5], NPROJ, 1024, (bf16*)(F.ws + WS_WIN), nullptr, scr, r, 152, F.lane, SrcWin{A.in[5]}); continue; } r -= I_IN;
        if (r < I_Q) { transpose_item(nullptr, 512, 256, (bf16*)(F.ws + WS_WQ), A.in[6], scr, r, 32, F.lane, SrcWq{A.in[7], A.in[8]}); continue; } r -= I_Q;
        if (r < I_BA) { transpose_item(nullptr, 1024, 512, (bf16*)(F.ws + WS_WBA), nullptr, scr, r, 32, F.lane, SrcId{A.in[12]}); continue; } r -= I_BA;
        if (r < I_BR) { transpose_item(nullptr, 1024, 512, (bf16*)(F.ws + WS_WBR), nullptr, scr, r, 32, F.lane, SrcId{A.in[13]}); continue; } r -= I_BR;
        if (r < I_O) { transpose_item(nullptr, 1024, 1024, (bf16*)(F.ws + WS_WOUT), nullptr, scr, r, 32, F.lane, SrcId{A.in[14]}); continue; } r -= I_O;
        if (r < I_GU) { transpose_item(nullptr, FF, 1024, (bf16*)(F.ws + WS_WGU), nullptr, scr, r, 176, F.lane, SrcGu{A.in[16], A.in[17]}); continue; } r -= I_GU;
        transpose_item(nullptr, 1024, FF, (bf16*)(F.ws + WS_WD), nullptr, scr, r, 32, F.lane, SrcId{A.in[18]});
    }
}

__device__ __forceinline__ void p1_norm(Frame& F, const Args& A) {
    const float* MOD = (const float*)(F.ws + WS_MOD);
    { float* CW2 = (float*)(F.ws + WS_CW2); const int g = blockIdx.x * (NWAVES * 64) + F.tid;
      if (g < 8192) { const int b = g >> 10, c = g & 1023; CW2[g] = A.in[15][c] * (1.0f + MOD[b * 6144 + 4096 + c]); } }
    { LAS float* sh2 = (LAS float*)(F.lds);
      for (int i = F.tid; i < 8192; i += NWAVES * 64) sh2[i] = MOD[(i >> 10) * 6144 + 3072 + (i & 1023)];
      __syncthreads();
      gemv8(F, sh2, 22, 256, FF, SrcGu{A.in[16], A.in[17]}, nullptr, (float*)(F.ws + WS_BGU), NGU); }
    const int gw = blockIdx.x * NWAVES + F.wave, NGW = F.G * NWAVES; bf16* XN = (bf16*)(F.ws + WS_XN);
    for (int m0 = gw; m0 < M; m0 += 4 * NGW) {
        f32x4 v[4][4]; float r[4];
#pragma unroll
        for (int k = 0; k < 4; ++k) { const int m = m0 + k * NGW < M ? m0 + k * NGW : m0; const GAS f32x4* xr = (const GAS f32x4*)(A.in[0] + (size_t)m * D) + F.lane;
#pragma unroll
            for (int j = 0; j < 4; ++j) v[k][j] = xr[64 * j]; }
#pragma unroll
        for (int k = 0; k < 4; ++k) { float s = 0.f;
#pragma unroll
            for (int j = 0; j < 4; ++j) s += (v[k][j].x * v[k][j].x + v[k][j].y * v[k][j].y) + (v[k][j].z * v[k][j].z + v[k][j].w * v[k][j].w);
            r[k] = 1.0f / sqrtf(wave_sum(s) * (1.0f / D) + EPS); }
#pragma unroll
        for (int k = 0; k < 4; ++k) { const int m = m0 + k * NGW; if (m < M) { const int b = m >> 13;
            GAS unsigned long long* o8 = (GAS unsigned long long*)(XN + (size_t)m * D) + F.lane;
#pragma unroll
            for (int j = 0; j < 4; ++j) { const int c = 4 * F.lane + 256 * j;
                const f32x4 w = *(const f32x4*)(A.in[4] + c), sc = *(const f32x4*)(MOD + b * 6144 + 1024 + c), sh = *(const f32x4*)(MOD + b * 6144 + c);
                const f32x4 y = v[k][j] * r[k] * w * (sc + 1.0f) + sh;
                o8[64 * j] = (unsigned long long)pk2(y.x, y.y) | ((unsigned long long)pk2(y.z, y.w) << 32); } } }
    }
}

constexpr int H_QC = 0, H_QB = 17408, H_K = 34816, H_KT = 78336, H_VT = 96768, H_PM = 115200, H_ST = 124416, H_BT = 159232, H_AL = 161280;
constexpr int HS128 = 272, HS64 = 144;
__device__ __forceinline__ unsigned short f2bfs(float f) { return (unsigned short)f2bf(f); }
__device__ __forceinline__ void hgrn_h1_unit(Frame& F, int unit) {
    const int b = unit >> 5, h = (unit >> 3) & 3, n = unit & 7;
    const int tid = F.tid, lane = F.lane, w = F.wave, c = tid & 127, bi = tid >> 7, l15 = lane & 15, l4 = lane >> 4;
    const size_t rowbase = (size_t)(b * SEQ + n * 1024) * 512 + h * 128;
    const bf16* RQ = (const bf16*)(F.ws + WS_RQ) + rowbase; const bf16* RGL = (const bf16*)(F.ws + WS_RGL) + rowbase; const bf16* RI = (const bf16*)(F.ws + WS_RI) + rowbase;
    bf16* OLOC = (bf16*)(F.ws + WS_OLOC) + rowbase; bf16* QHAT = (bf16*)(F.ws + WS_QHAT) + rowbase;
    LAS unsigned char* L = F.lds; LAS float* BT = (LAS float*)(L + H_BT); LAS float* AL = (LAS float*)(L + H_AL);
    f32x4 acc[8];
#pragma unroll
    for (int vb = 0; vb < 8; ++vb) acc[vb] = (f32x4){0.f, 0.f, 0.f, 0.f};
    float asup = 0.f;
    for (int i = tid; i < 64 * HS64 / 4; i += NWAVES * 64) ((LAS unsigned*)(L + H_PM))[i] = 0u;
    unsigned short gr[16], qr[16], vr[16];
#define H1_LOAD(CI) do { const size_t r0_ = (size_t)((CI) * 64 + bi * 16) * 512 + c; \
        _Pragma("unroll") for (int r = 0; r < 16; ++r) { gr[r] = RGL[r0_ + (size_t)r * 512]; qr[r] = RQ[r0_ + (size_t)r * 512]; vr[r] = RI[r0_ + (size_t)r * 512]; } } while (0)
    H1_LOAD(0);
#pragma unroll 1
    for (int ci = 0; ci < 16; ++ci) {
        const size_t r0 = (size_t)(ci * 64 + bi * 16) * 512 + c;
        float eg[16], qq[16], el[16];
        { float run = 0.f, prod = 1.f;
#pragma unroll
          for (int r = 0; r < 16; ++r) { const float g = bf1(gr[r]); run += g; eg[r] = __expf(g); prod *= eg[r]; el[r] = prod; qq[r] = bf1(qr[r]); }
          BT[bi * 128 + c] = run; }
        if (ci > 0) {
#pragma unroll
            for (int vb = 0; vb < 8; ++vb) { v2u o; o.x = pk2(acc[vb][0], acc[vb][1]); o.y = pk2(acc[vb][2], acc[vb][3]);
                *(LAS v2u*)(L + H_ST + (16 * vb + l15) * HS128 + (16 * w + 4 * l4) * 2) = o; } }
        { v4u v0, v1; v0.x = vr[0] | ((unsigned)vr[1] << 16); v0.y = vr[2] | ((unsigned)vr[3] << 16); v0.z = vr[4] | ((unsigned)vr[5] << 16); v0.w = vr[6] | ((unsigned)vr[7] << 16);
          v1.x = vr[8] | ((unsigned)vr[9] << 16); v1.y = vr[10] | ((unsigned)vr[11] << 16); v1.z = vr[12] | ((unsigned)vr[13] << 16); v1.w = vr[14] | ((unsigned)vr[15] << 16);
          *(LAS v4u*)(L + H_VT + c * HS64 + bi * 32) = v0; *(LAS v4u*)(L + H_VT + c * HS64 + bi * 32 + 16) = v1; }
        __syncthreads();
        const float b0 = BT[c], b1 = BT[128 + c], b2 = BT[256 + c], b3 = BT[384 + c];
        const float ab1 = b0, ab2 = b0 + b1, ab3 = ab2 + b2, alast = ab3 + b3;
        const float ab = bi == 0 ? 0.f : bi == 1 ? ab1 : bi == 2 ? ab2 : ab3;
        if (bi == 0) AL[c] = alast;
        const float eAb = __expf(ab), eSup = __expf(asup), fEnd = __expf(alast - ab);
        const float fK0 = __expf(0.f - ab), fK1 = __expf(ab1 - ab), fK2 = __expf(ab2 - ab), fK3 = __expf(ab3 - ab);
        unsigned kp[8];
#pragma unroll
        for (int r = 0; r < 16; ++r) { const int t = bi * 16 + r;
            const float qb = qq[r] * el[r], qc = qb * eAb, kk = 1.0f - eg[r], ki = kk * __builtin_amdgcn_rcpf(el[r]);
            *(LAS unsigned short*)(L + H_QC + t * HS128 + c * 2) = f2bfs(qc);
            QHAT[r0 + (size_t)r * 512] = f2bfs(qc * eSup);
            *(LAS unsigned short*)(L + H_QB + t * HS128 + c * 2) = f2bfs(qb);
            const unsigned ke = f2bf(ki * fEnd); if (r & 1) kp[r >> 1] |= ke << 16; else kp[r >> 1] = ke;
            if (bi <= 0) *(LAS unsigned short*)(L + H_K + (0 + t) * HS128 + c * 2) = f2bfs(ki * fK0);
            if (bi <= 1) *(LAS unsigned short*)(L + H_K + (16 + t) * HS128 + c * 2) = f2bfs(ki * fK1);
            if (bi <= 2) *(LAS unsigned short*)(L + H_K + (48 + t) * HS128 + c * 2) = f2bfs(ki * fK2);
            *(LAS unsigned short*)(L + H_K + (96 + t) * HS128 + c * 2) = f2bfs(ki * fK3); }
        *(LAS v4u*)(L + H_KT + c * HS64 + bi * 32) = (v4u){kp[0], kp[1], kp[2], kp[3]}; *(LAS v4u*)(L + H_KT + c * HS64 + bi * 32 + 16) = (v4u){kp[4], kp[5], kp[6], kp[7]};
        asup += alast;
        if (ci + 1 < 16) H1_LOAD(ci + 1);
        __syncthreads();
#pragma unroll
        for (int rep = 0; rep < 2; ++rep) { const int tile = w + 8 * rep;
            if (tile < 10) { const int i = tile < 1 ? 0 : tile < 3 ? 1 : tile < 6 ? 2 : 3, j = tile - (i * (i + 1)) / 2;
                const LAS unsigned char* ap = L + H_QB + (16 * i + l15) * HS128 + l4 * 16; const LAS unsigned char* bp = L + H_K + (8 * i * (i + 1) + 16 * j + l15) * HS128 + l4 * 16;
                f32x4 p = (f32x4){0.f, 0.f, 0.f, 0.f};
#pragma unroll
                for (int ks = 0; ks < 4; ++ks) p = __builtin_amdgcn_mfma_f32_16x16x32_bf16(*(const LAS bf16x8*)(ap + ks * 64), *(const LAS bf16x8*)(bp + ks * 64), p, 0, 0, 0);
#pragma unroll
                for (int r = 0; r < 4; ++r) { const float pv = (i == j && l15 > 4 * l4 + r) ? 0.f : p[r];
                    *(LAS unsigned short*)(L + H_PM + (16 * i + 4 * l4 + r) * HS64 + (16 * j + l15) * 2) = f2bfs(pv); } } }
        __syncthreads();
#pragma unroll
        for (int tb = 0; tb < 4; ++tb) { f32x4 o = (f32x4){0.f, 0.f, 0.f, 0.f};
#pragma unroll
            for (int ks = 0; ks < 2; ++ks) if (32 * ks < 16 * (tb + 1))
                o = __builtin_amdgcn_mfma_f32_16x16x32_bf16(*(const LAS bf16x8*)(L + H_VT + (16 * w + l15) * HS64 + l4 * 16 + ks * 64), *(const LAS bf16x8*)(L + H_PM + (16 * tb + l15) * HS64 + l4 * 16 + ks * 64), o, 0, 0, 0);
            if (ci > 0) {
#pragma unroll
                for (int ks = 0; ks < 4; ++ks)
                    o = __builtin_amdgcn_mfma_f32_16x16x32_bf16(*(const LAS bf16x8*)(L + H_ST + (16 * w + l15) * HS128 + l4 * 16 + ks * 64), *(const LAS bf16x8*)(L + H_QC + (16 * tb + l15) * HS128 + l4 * 16 + ks * 64), o, 0, 0, 0); }
            v2u ov; ov.x = pk2(o[0], o[1]); ov.y = pk2(o[2], o[3]);
            *(v2u*)(OLOC + (size_t)(ci * 64 + 16 * tb + l15) * 512 + 16 * w + 4 * l4) = ov; }
        { const f32x4 dv = *(const LAS f32x4*)(AL + 16 * w + 4 * l4); const f32x4 d = (f32x4){__expf(dv[0]), __expf(dv[1]), __expf(dv[2]), __expf(dv[3])};
          const bf16x8 ka0 = *(const LAS bf16x8*)(L + H_KT + (16 * w + l15) * HS64 + l4 * 16), ka1 = *(const LAS bf16x8*)(L + H_KT + (16 * w + l15) * HS64 + l4 * 16 + 64);
#pragma unroll
          for (int vb = 0; vb < 8; ++vb) { f32x4 s = acc[vb] * d;
              s = __builtin_amdgcn_mfma_f32_16x16x32_bf16(ka0, *(const LAS bf16x8*)(L + H_VT + (16 * vb + l15) * HS64 + l4 * 16), s, 0, 0, 0);
              s = __builtin_amdgcn_mfma_f32_16x16x32_bf16(ka1, *(const LAS bf16x8*)(L + H_VT + (16 * vb + l15) * HS64 + l4 * 16 + 64), s, 0, 0, 0);
              acc[vb] = s; } }
        __syncthreads();
    }
#undef H1_LOAD
    f32x4* U = (f32x4*)(F.ws + WS_U);
#pragma unroll
    for (int vb = 0; vb < 8; ++vb) U[(size_t)((unit * 8 + w) * 8 + vb) * 64 + lane] = acc[vb];
    if (bi == 0) ((float*)(F.ws + WS_DS))[unit * 128 + c] = __expf(asup);
}
__device__ __forceinline__ void hgrn_h3_unit(Frame& F, const Args& A, int unit) {
    const int b = unit >> 5, h = (unit >> 3) & 3, n = unit & 7;
    const int lane = F.lane, w = F.wave, l15 = lane & 15, l4 = lane >> 4;
    LAS unsigned char* L = F.lds;
    const f32x4* U = (const f32x4*)(F.ws + WS_U); const float* DS = (const float*)(F.ws + WS_DS);
    f32x4 S[8];
#pragma unroll
    for (int vb = 0; vb < 8; ++vb) S[vb] = (f32x4){0.f, 0.f, 0.f, 0.f};
    for (int m = 0; m < n; ++m) { const int um = unit - n + m; const f32x4 d = *(const f32x4*)(DS + um * 128 + 16 * w + 4 * l4);
#pragma unroll
        for (int vb = 0; vb < 8; ++vb) S[vb] = S[vb] * d + U[(size_t)((um * 8 + w) * 8 + vb) * 64 + lane]; }
#pragma unroll
    for (int vb = 0; vb < 8; ++vb) { v2u o; o.x = pk2(S[vb][0], S[vb][1]); o.y = pk2(S[vb][2], S[vb][3]);
        *(LAS v2u*)(L + H_ST + (16 * vb + l15) * HS128 + (16 * w + 4 * l4) * 2) = o; }
    __syncthreads();
    const size_t rowbase = (size_t)(b * SEQ + n * 1024 + 128 * w) * 512 + h * 128;
    const bf16* QHAT = (const bf16*)(F.ws + WS_QHAT) + rowbase; const bf16* OLOC = (const bf16*)(F.ws + WS_OLOC) + rowbase;
    const bf16* RGS = (const bf16*)(F.ws + WS_RGS) + rowbase; bf16* REC = (bf16*)(F.ws + WS_REC) + rowbase;
    f32x4 rw[8];
#pragma unroll
    for (int vb = 0; vb < 8; ++vb) rw[vb] = *(const f32x4*)(A.in[11] + 16 * vb + 4 * l4);
#pragma unroll 1
    for (int tb = 0; tb < 8; ++tb) { const size_t tr = (size_t)(16 * tb + l15) * 512;
        bf16x8 qh[4];
#pragma unroll
        for (int ks = 0; ks < 4; ++ks) qh[ks] = *(const bf16x8*)(QHAT + tr + 32 * ks + 8 * l4);
        f32x4 o[8]; float ss = 0.f;
#pragma unroll
        for (int vb = 0; vb < 8; ++vb) { f32x4 a = (f32x4){0.f, 0.f, 0.f, 0.f};
            if (n > 0) {
#pragma unroll
                for (int ks = 0; ks < 4; ++ks) a = __builtin_amdgcn_mfma_f32_16x16x32_bf16(*(const LAS bf16x8*)(L + H_ST + (16 * vb + l15) * HS128 + l4 * 16 + ks * 64), qh[ks], a, 0, 0, 0); }
            const v2u ol = *(const v2u*)(OLOC + tr + 16 * vb + 4 * l4);
            a[0] += bflo(ol.x); a[1] += bfhi(ol.x); a[2] += bflo(ol.y); a[3] += bfhi(ol.y);
            o[vb] = a; ss += (a[0] * a[0] + a[1] * a[1]) + (a[2] * a[2] + a[3] * a[3]); }
        ss += __shfl_xor(ss, 16); ss += __shfl_xor(ss, 32);
        const float r = 1.0f / sqrtf(ss * (1.0f / 128.0f) + EPS);
#pragma unroll
        for (int vb = 0; vb < 8; ++vb) { const v2u g = *(const v2u*)(RGS + tr + 16 * vb + 4 * l4); const f32x4 y = o[vb] * r * rw[vb];
            v2u ov; ov.x = pk2(y[0] * bflo(g.x), y[1] * bfhi(g.x)); ov.y = pk2(y[2] * bflo(g.y), y[3] * bfhi(g.y));
            *(v2u*)(REC + tr + 16 * vb + 4 * l4) = ov; }
    }
    __syncthreads();
}

__device__ __forceinline__ unsigned f2key(float x) {
    const _Float16 hh = (_Float16)x; const unsigned bits = (unsigned)__builtin_bit_cast(unsigned short, hh);
    return (bits & 0x8000u) ? (~bits & 0xffffu) : (bits | 0x8000u);
}
#ifdef TSEL
#define TMARK(k) do { if (F.wave == 0) { const unsigned long long now_ = __builtin_amdgcn_s_memrealtime(); if (F.lane == 0) ((LAS unsigned*)(F.lds + LDSCTL_OFF))[k] += (unsigned)(now_ - tprev_); tprev_ = now_; } } while (0)
#else
#define TMARK(k) do {} while (0)
#endif
constexpr int DSA_VIMG = 73728;
constexpr int DSA_QCTR = 73600;
constexpr int DSA_BIAS = 69632;
constexpr int DSA_CAND = 147456, DSA_CAPC = 448;
typedef unsigned u32x4p __attribute__((ext_vector_type(4)));
__device__ __forceinline__ void dsa_unit(Frame& F, int b, int t0) {
    const int lane = F.lane, w = F.wave, qc = lane & 31, hf = lane >> 5;
    const bf16* KI = (const bf16*)(F.ws + WS_KI) + (size_t)b * SEQ * 64;
    const bf16* QI = (const bf16*)(F.ws + WS_QI) + (size_t)(b * SEQ + t0) * 512;
    const float* WI = (const float*)(F.ws + WS_WI) + (size_t)(b * SEQ + t0) * 8;
    unsigned short* scr = (unsigned short*)(F.ws + WS_SCR) + (size_t)blockIdx.x * (32 * 8192);
    const int nkb = t0 / 32 + 1;
#ifdef TSEL
    unsigned long long tprev_ = __builtin_amdgcn_s_memrealtime();
#endif
    LAS unsigned* hist = (LAS unsigned*)(F.lds);
    for (int i = F.tid; i < 4096; i += NWAVES * 64) ((LAS v4u*)hist)[i] = (v4u){0u, 0u, 0u, 0u};
    if (F.tid == 0) *(LAS unsigned*)(F.lds + DSA_QCTR) = 0u;
    __syncthreads();
    TMARK(0);
    {
        const int l15 = lane & 15, l4 = lane >> 4, qg = w >> 2, ql = 16 * qg + l15;
        bf16x8 qf[8][2]; float wv[8];
#pragma unroll
        for (int h = 0; h < 8; ++h) { wv[h] = WI[ql * 8 + h];
#pragma unroll
            for (int ks = 0; ks < 2; ++ks) qf[h][ks] = *(const bf16x8*)(QI + (size_t)ql * 512 + h * 64 + ks * 32 + l4 * 8); }
        const int lim = t0 + ql - 4 * l4;
        float wh[8];
#pragma unroll
        for (int h = 0; h < 8; ++h) wh[h] = 0.5f * wv[h];
        bf16x8 qs[2];
#pragma unroll
        for (int ks = 0; ks < 2; ++ks) { unsigned pk[4];
#pragma unroll
            for (int j = 0; j < 8; j += 2) { float e0 = 0.f, e1 = 0.f;
#pragma unroll
                for (int h = 0; h < 8; ++h) { e0 += wh[h] * bf1((unsigned short)qf[h][ks][j]); e1 += wh[h] * bf1((unsigned short)qf[h][ks][j + 1]); }
                pk[j >> 1] = pk2(e0, e1); }
            qs[ks] = __builtin_bit_cast(bf16x8, (v4u){pk[0], pk[1], pk[2], pk[3]}); }
        const int nb16 = 2 * nkb;
#define P1_LOAD(K0, K1, KB) do { const int row_ = (KB) * 16 + l15; const bf16* kp_ = KI + (size_t)(row_ < SEQ - 1 ? row_ : SEQ - 1) * 64 + l4 * 8; \
            asm volatile("global_load_dwordx4 %0, %2, off\n\tglobal_load_dwordx4 %1, %2, off offset:64" : "=&v"(K0), "=&v"(K1) : "v"(kp_) : "memory"); } while (0)
#define P1_COMPUTE(K0, K1, KB, OUT) do { const int s0_ = (KB) * 16; f32x4 sc_ = (f32x4){0.f, 0.f, 0.f, 0.f}; \
            sc_ = __builtin_amdgcn_mfma_f32_16x16x32_bf16(K0, qs[0], sc_, 0, 0, 0); sc_ = __builtin_amdgcn_mfma_f32_16x16x32_bf16(K1, qs[1], sc_, 0, 0, 0); \
            _Pragma("unroll") for (int h = 0; h < 8; ++h) { f32x4 a_ = (f32x4){0.f, 0.f, 0.f, 0.f}; \
                a_ = __builtin_amdgcn_mfma_f32_16x16x32_bf16(K0, qf[h][0], a_, 0, 0, 0); a_ = __builtin_amdgcn_mfma_f32_16x16x32_bf16(K1, qf[h][1], a_, 0, 0, 0); \
                _Pragma("unroll") for (int r = 0; r < 4; ++r) sc_[r] = __builtin_fmaf(wh[h], __builtin_fabsf(a_[r]), sc_[r]); } \
            unsigned kk_[4]; \
            _Pragma("unroll") for (int r = 0; r < 4; ++r) { const bool causal_ = s0_ + r <= lim; const unsigned key_ = f2key(sc_[r]); kk_[r] = causal_ ? key_ : 0u; \
                __hip_atomic_fetch_add(hist + ql * 512 + (causal_ ? (key_ >> 7) : 0u), 1u, __ATOMIC_RELAXED, __HIP_MEMORY_SCOPE_WORKGROUP); } \
            OUT.x = kk_[0] | (kk_[1] << 16); OUT.y = kk_[2] | (kk_[3] << 16); } while (0)
        {
        bf16x8 c0a, c0b, c1a, c1b, c2a, c2b, c3a, c3b, n0a, n0b, n1a, n1b, n2a, n2b, n3a, n3b;
        LAS unsigned char* stg = F.lds + DSA_VIMG + w * 9216;
        const int rrow = lane >> 3, rch = lane & 7;
        int kb = 4 * (w & 3);
        P1_LOAD(c0a, c0b, kb); P1_LOAD(c1a, c1b, kb + 1); P1_LOAD(c2a, c2b, kb + 2); P1_LOAD(c3a, c3b, kb + 3);
        asm volatile("s_waitcnt vmcnt(0)" : "+v"(c0a), "+v"(c0b), "+v"(c1a), "+v"(c1b), "+v"(c2a), "+v"(c2b), "+v"(c3a), "+v"(c3b) :: "memory");
#pragma unroll 1
        for (; kb < nb16; kb += 16) {
            P1_LOAD(n0a, n0b, kb + 16); P1_LOAD(n1a, n1b, kb + 17); P1_LOAD(n2a, n2b, kb + 18); P1_LOAD(n3a, n3b, kb + 19);
            v2u o0 = (v2u){0u, 0u}, o1 = o0, o2 = o0, o3 = o0;
            P1_COMPUTE(c0a, c0b, kb, o0);
            P1_COMPUTE(c1a, c1b, kb + 1, o1); P1_COMPUTE(c2a, c2b, kb + 2, o2); P1_COMPUTE(c3a, c3b, kb + 3, o3);
            TMARK(29);
            *(LAS v2u*)(stg + l15 * 144 + 8 * l4) = o0; *(LAS v2u*)(stg + l15 * 144 + 32 + 8 * l4) = o1; *(LAS v2u*)(stg + l15 * 144 + 64 + 8 * l4) = o2; *(LAS v2u*)(stg + l15 * 144 + 96 + 8 * l4) = o3;
            LDS_WAIT(); asm volatile("" ::: "memory");
            { const v4u lo = *(const LAS v4u*)(stg + rrow * 144 + rch * 16), hi = *(const LAS v4u*)(stg + (rrow + 8) * 144 + rch * 16);
              unsigned short* dst = scr + (size_t)(16 * qg + rrow) * 8192 + kb * 16 + rch * 8;
              *(v4u*)dst = lo; *(v4u*)(dst + 8 * 8192) = hi; }
            LDS_WAIT(); asm volatile("" ::: "memory");
            TMARK(27);
            asm volatile("s_waitcnt vmcnt(2)" : "+v"(n0a), "+v"(n0b), "+v"(n1a), "+v"(n1b), "+v"(n2a), "+v"(n2b), "+v"(n3a), "+v"(n3b) :: "memory");
            TMARK(28);
            c0a = n0a; c0b = n0b; c1a = n1a; c1b = n1b; c2a = n2a; c2b = n2b; c3a = n3a; c3b = n3b;
        }
        }
#undef P1_LOAD
#undef P1_COMPUTE
    }
    TMARK(1);
    __syncthreads();
    TMARK(2);
    LAS unsigned short* idxl = (LAS unsigned short*)(F.lds + 65536) + w * 256;
    const LAS float* btab = (const LAS float*)(F.lds + DSA_BIAS);
    const bf16* KV = (const bf16*)(F.ws + WS_KV) + (size_t)b * SEQ * 256;
    const int nk = nkb * 32, ndw = nk >> 1;
    LAS unsigned* qctr = (LAS unsigned*)(F.lds + DSA_QCTR);
#pragma unroll 1
    for (;;) {
        unsigned qi_ = 0u; if (lane == 0) qi_ = __hip_atomic_fetch_add(qctr, 1u, __ATOMIC_RELAXED, __HIP_MEMORY_SCOPE_WORKGROUP);
        qi_ = (unsigned)__builtin_amdgcn_readfirstlane((int)qi_); if (qi_ >= 32u) break;
        const int ql = 31 - (int)qi_, t = t0 + ql, nvalid = t + 1, nsel = nvalid < 256 ? nvalid : 256;
        const unsigned* rowd = (const unsigned*)(scr + (size_t)ql * 8192);
        int ln = lane; asm volatile("" : "+v"(ln));
        {
        unsigned rv[64];
#pragma unroll
        for (int j = 0; j < 64; ++j) { const unsigned val = rowd[j * 64 + ln]; rv[j] = (ln < ndw - j * 64) ? val : 0u; }
#ifdef TSEL
        asm volatile("s_waitcnt vmcnt(0)" ::: "memory"); TMARK(8);
#endif
        unsigned T = 0u; int need = 0; bool done = false;
        const unsigned long long lt = (1ull << ln) - 1ull; const int ln2 = 2 * ln;
        if (nvalid > 256) {
            const LAS unsigned* hq = hist + ql * 512 + 8 * ln;
            const v4u h0 = *(const LAS v4u*)(hq), h1 = *(const LAS v4u*)(hq + 4);
            const unsigned h8[8] = {h0.x, h0.y, h0.z, h0.w, h1.x, h1.y, h1.z, h1.w};
            const unsigned sl = (h0.x + h0.y) + (h0.z + h0.w) + (h1.x + h1.y) + (h1.z + h1.w);
            unsigned S = sl;
#pragma unroll
            for (int d = 1; d < 64; d <<= 1) { const unsigned tt = __shfl_down(S, d); if (ln + d < 64) S += tt; }
            const int Lb = __popcll(__ballot(S >= 256u)) - 1;
            unsigned cum = S - sl, caL = 0u, cbL = 0u; int Bi = 0; bool found = false;
#pragma unroll
            for (int i = 7; i >= 0; --i) { if (!found && cum + h8[i] >= 256u) { Bi = i; caL = cum; cbL = h8[i]; found = true; } if (!found) cum += h8[i]; }
            TMARK(9);
            const int B = 8 * Lb + __shfl(Bi, Lb); const int ca = (int)__shfl(caL, Lb), cb = (int)__shfl(cbL, Lb);
            LAS unsigned short* glst = (LAS unsigned short*)(F.lds + DSA_VIMG + w * 9216);
            LAS unsigned* elst = (LAS unsigned*)(F.lds + DSA_VIMG + w * 9216 + 3200);
            const unsigned Tg = (unsigned)(B + 1) << 7, Te = (unsigned)B << 7;
            int gc = 0, ec = 0;
#define DSA_COLLECT(K16, IDX) do { const unsigned k_ = (K16), i_ = (IDX); const bool g_ = k_ >= Tg, e_ = (k_ >= Te) && !g_; \
                const int gs_ = g_ ? (gc < 24 ? gc : 24) : 24, es_ = e_ ? (ec < 12 ? ec : 12) : 12; \
                glst[gs_ * 64 + ln] = (unsigned short)i_; elst[es_ * 64 + ln] = (k_ << 16) | (65535u - i_); gc += g_ ? 1 : 0; ec += e_ ? 1 : 0; } while (0)
#pragma unroll
            for (int g = 0; g < 8; ++g) if (g * 1024 < nk) {
#pragma unroll
                for (int j = 8 * g; j < 8 * g + 8; ++j) { const unsigned i0 = (unsigned)(ln2 + 128 * j); DSA_COLLECT(rv[j] & 0xffffu, i0); DSA_COLLECT(rv[j] >> 16, i0 + 1u); } }
#undef DSA_COLLECT
            if (__ballot(gc > 24 || ec > 12) == 0ull) {
                LDS_WAIT(); asm volatile("" ::: "memory");
                TMARK(10);
                int incl = gc;
#pragma unroll
                for (int d = 1; d < 64; d <<= 1) { const int tt = __shfl_up(incl, d); if (ln >= d) incl += tt; }
                const int excl = incl - gc;
#pragma unroll 1
                for (int e = 0; e < 24; ++e) { if (__ballot(e < gc) == 0ull) break; if (e < gc) idxl[excl + e] = glst[e * 64 + ln]; }
                TMARK(11);
                unsigned cv[12]; int emax = 0;
#pragma unroll
                for (int e = 0; e < 12; ++e) { cv[e] = (e < ec) ? elst[e * 64 + ln] : 0u; if (__ballot(e < ec) != 0ull) emax = e + 1; }
                const int needc = 256 - ca; unsigned pref = (unsigned)B << 23;
#define DSA_DESCENT(N) _Pragma("unroll 1") for (int bit = 22; bit >= 0; --bit) { const unsigned c = pref | (1u << bit); int cnt = 0; \
                    _Pragma("unroll") for (int e = 0; e < (N); ++e) cnt += __popcll(__ballot(cv[e] >= c)); \
                    if (cnt >= needc) pref = c; }
                if (emax <= 2) { DSA_DESCENT(2) } else if (emax <= 4) { DSA_DESCENT(4) } else { DSA_DESCENT(12) }
#undef DSA_DESCENT
                TMARK(12);
                int base = ca;
#pragma unroll
                for (int e = 0; e < 12; ++e) if (e < emax) { const bool sl2 = cv[e] >= pref; const unsigned long long m = __ballot(sl2); const int pos = base + __popcll(m & lt);
                    if (sl2 && pos < 256) idxl[pos] = (unsigned short)(65535u - (cv[e] & 0xffffu)); base += __popcll(m); }
                done = true;
            } else {
#pragma unroll 1
                for (int bit = 15; bit >= 0; --bit) { const unsigned cand2 = T | (1u << bit); int c = 0;
#pragma unroll
                    for (int g = 0; g < 8; ++g) if (g * 1024 < nk) {
#pragma unroll
                        for (int j = 8 * g; j < 8 * g + 8; ++j) { c += ((rv[j] & 0xffffu) >= cand2) ? 1 : 0; c += ((rv[j] >> 16) >= cand2) ? 1 : 0; } }
#pragma unroll
                    for (int o = 1; o < 64; o <<= 1) c += __shfl_xor(c, o);
                    if (c >= 256) T = cand2; }
                int c = 0;
#pragma unroll
                for (int g = 0; g < 8; ++g) if (g * 1024 < nk) {
#pragma unroll
                    for (int j = 8 * g; j < 8 * g + 8; ++j) { c += ((rv[j] & 0xffffu) > T) ? 1 : 0; c += ((rv[j] >> 16) > T) ? 1 : 0; } }
#pragma unroll
                for (int o = 1; o < 64; o <<= 1) c += __shfl_xor(c, o);
                need = 256 - c;
            }
        }
        if (!done) {
            int base = 0, tiebase = 0;
#pragma unroll
            for (int g = 0; g < 8; ++g) if (g * 1024 < nk) {
#pragma unroll
                for (int j = 8 * g; j < 8 * g + 8; ++j) { const unsigned lo = rv[j] & 0xffffu, hi = rv[j] >> 16;
                    const bool el = lo == T, eh = hi == T; const unsigned long long mel = __ballot(el), meh = __ballot(eh);
                    const int trl = tiebase + __popcll(mel & lt) + __popcll(meh & lt), trh = trl + (el ? 1 : 0);
                    const bool sl = lo > T || (el && trl < need), sh = hi > T || (eh && trh < need);
                    const unsigned long long msl = __ballot(sl), msh = __ballot(sh);
                    const int pl = base + __popcll(msl & lt) + __popcll(msh & lt), ph = pl + (sl ? 1 : 0);
                    if (sl && pl < 256) idxl[pl] = (unsigned short)(ln2 + 128 * j); if (sh && ph < 256) idxl[ph] = (unsigned short)(ln2 + 128 * j + 1);
                    base += __popcll(msl) + __popcll(msh); tiebase += __popcll(mel) + __popcll(meh); __builtin_amdgcn_sched_barrier(0); } }
        }
        }
        LDS_WAIT(); asm volatile("" ::: "memory");
        TMARK(3);
        {
            int l15 = ln & 15, l4 = ln >> 4; asm volatile("" : "+v"(l15), "+v"(l4));
            const int l4x4 = 4 * l4;
#pragma unroll
            for (int jj = 0; jj < 4; ++jj) { if (ln >= nsel - 64 * jj) idxl[ln + 64 * jj] = 0; }
            LDS_WAIT(); asm volatile("" ::: "memory");
            unsigned short kidx[16]; v2u sidx[16];
#pragma unroll
            for (int blk = 0; blk < 16; ++blk) { kidx[blk] = idxl[16 * blk + l15]; sidx[blk] = *(const LAS v2u*)(idxl + 16 * blk + l4x4); }
            unsigned short vidx0[8];
#pragma unroll
            for (int i = 0; i < 8; ++i) vidx0[i] = idxl[4 * i + l4];
            LDS_WAIT(); asm volatile("" ::: "memory");
            const bf16* qrow = (const bf16*)(F.ws + WS_Q) + (size_t)(b * SEQ + t) * 512 + (l15 & 7) * 64 + 8 * l4;
            bf16x8 bq[2][2];
#pragma unroll
            for (int g = 0; g < 2; ++g)
#pragma unroll
                for (int ks = 0; ks < 2; ++ks) { bf16x8 v = *(const bf16x8*)(qrow + 32 * ks); if ((l15 >> 2) != g) v = (bf16x8){0, 0, 0, 0, 0, 0, 0, 0}; bq[g][ks] = v; }
            f32x4 sa[16];
#pragma unroll
            for (int half = 0; half < 4; ++half) {
                bf16x8 ka[4][4];
#pragma unroll
                for (int bl = 0; bl < 4; ++bl) { const bf16* kr = KV + (size_t)kidx[4 * half + bl] * 256 + 8 * l4;
#pragma unroll
                    for (int i = 0; i < 4; ++i) ka[bl][i] = *(const bf16x8*)(kr + 32 * i); }
#pragma unroll
                for (int bl = 0; bl < 4; ++bl) { f32x4 acc = (f32x4){0.f, 0.f, 0.f, 0.f};
                    acc = __builtin_amdgcn_mfma_f32_16x16x32_bf16(ka[bl][0], bq[0][0], acc, 0, 0, 0); acc = __builtin_amdgcn_mfma_f32_16x16x32_bf16(ka[bl][1], bq[0][1], acc, 0, 0, 0);
                    acc = __builtin_amdgcn_mfma_f32_16x16x32_bf16(ka[bl][2], bq[1][0], acc, 0, 0, 0); acc = __builtin_amdgcn_mfma_f32_16x16x32_bf16(ka[bl][3], bq[1][1], acc, 0, 0, 0);
                    sa[4 * half + bl] = acc; }
                asm volatile("" ::: "memory"); }
            v4u vbuf[2][8];
#pragma unroll
            for (int i = 0; i < 8; ++i) vbuf[0][i] = *(const v4u*)(KV + (size_t)vidx0[i] * 256 + 128 + l15 * 8);
            TMARK(13);
            float mx = -INFINITY; const LAS float* bt = btab + (l15 & 7);
#pragma unroll
            for (int blk = 0; blk < 16; ++blk)
#pragma unroll
                for (int r = 0; r < 4; ++r) { const unsigned sw = (r < 2) ? sidx[blk].x : sidx[blk].y; const int dist = t - (int)((r & 1) ? (sw >> 16) : (sw & 0xffffu));
                    const float bias = bt[(dist < 113 ? dist : 113) * 8];
                    const float v = (l4x4 < nsel - (16 * blk + r)) ? sa[blk][r] + bias : -INFINITY; sa[blk][r] = v; mx = fmaxf(mx, v); }
            mx = fmaxf(mx, __shfl_xor(mx, 16)); mx = fmaxf(mx, __shfl_xor(mx, 32));
            float su = 0.f;
#pragma unroll
            for (int blk = 0; blk < 16; ++blk)
#pragma unroll
                for (int r = 0; r < 4; ++r) { const float e = __expf(sa[blk][r] - mx); sa[blk][r] = e; su += e; }
            su += __shfl_xor(su, 16); su += __shfl_xor(su, 32);
            const float inv = 1.0f / su;
            TMARK(14);
            bf16x8 pf[8];
#pragma unroll
            for (int ks = 0; ks < 8; ++ks) { u32x4p pa; pa.x = pk2(sa[2 * ks][0], sa[2 * ks][1]); pa.y = pk2(sa[2 * ks][2], sa[2 * ks][3]); pa.z = pk2(sa[2 * ks + 1][0], sa[2 * ks + 1][1]); pa.w = pk2(sa[2 * ks + 1][2], sa[2 * ks + 1][3]);
                asm volatile("" : "+v"(pa));
                pf[ks] = __builtin_bit_cast(bf16x8, pa); }
            { unsigned short vi[8];
#pragma unroll
              for (int i = 0; i < 8; ++i) vi[i] = idxl[32 + 4 * i + l4];
              LDS_WAIT(); asm volatile("" ::: "memory");
#pragma unroll
              for (int i = 0; i < 8; ++i) vbuf[1][i] = *(const v4u*)(KV + (size_t)vi[i] * 256 + 128 + l15 * 8); }
            f32x4 oa[2][4];
#pragma unroll
            for (int g = 0; g < 2; ++g)
#pragma unroll
                for (int c = 0; c < 4; ++c) oa[g][c] = (f32x4){0.f, 0.f, 0.f, 0.f};
            LAS unsigned char* vimg = F.lds + DSA_VIMG + w * 9216;
            const unsigned traddr = (unsigned)(size_t)(vimg + (4 * l4 + (l15 >> 2)) * 144 + (l15 & 3) * 8);
#pragma unroll
            for (int ks = 0; ks < 8; ++ks) {
#pragma unroll
                for (int i = 0; i < 8; ++i) *(LAS v4u*)(vimg + (l15 >> 3) * 4608 + (4 * i + l4) * 144 + (l15 & 7) * 16) = vbuf[ks & 1][i];
                if (ks + 2 < 8) { unsigned short vi[8];
#pragma unroll
                    for (int i = 0; i < 8; ++i) vi[i] = idxl[32 * (ks + 2) + 4 * i + l4];
                    LDS_WAIT(); asm volatile("" ::: "memory");
#pragma unroll
                    for (int i = 0; i < 8; ++i) vbuf[ks & 1][i] = *(const v4u*)(KV + (size_t)vi[i] * 256 + 128 + l15 * 8); }
                LDS_WAIT(); asm volatile("" ::: "memory");
                v2u tb[16];
                asm volatile("ds_read_b64_tr_b16 %0, %16 offset:0\n\tds_read_b64_tr_b16 %1, %16 offset:2304\n\tds_read_b64_tr_b16 %2, %16 offset:32\n\tds_read_b64_tr_b16 %3, %16 offset:2336\n\t"
                             "ds_read_b64_tr_b16 %4, %16 offset:64\n\tds_read_b64_tr_b16 %5, %16 offset:2368\n\tds_read_b64_tr_b16 %6, %16 offset:96\n\tds_read_b64_tr_b16 %7, %16 offset:2400\n\t"
                             "ds_read_b64_tr_b16 %8, %16 offset:4608\n\tds_read_b64_tr_b16 %9, %16 offset:6912\n\tds_read_b64_tr_b16 %10, %16 offset:4640\n\tds_read_b64_tr_b16 %11, %16 offset:6944\n\t"
                             "ds_read_b64_tr_b16 %12, %16 offset:4672\n\tds_read_b64_tr_b16 %13, %16 offset:6976\n\tds_read_b64_tr_b16 %14, %16 offset:4704\n\tds_read_b64_tr_b16 %15, %16 offset:7008\n\ts_waitcnt lgkmcnt(0)"
                             : "=&v"(tb[0]), "=&v"(tb[1]), "=&v"(tb[2]), "=&v"(tb[3]), "=&v"(tb[4]), "=&v"(tb[5]), "=&v"(tb[6]), "=&v"(tb[7]),
                               "=&v"(tb[8]), "=&v"(tb[9]), "=&v"(tb[10]), "=&v"(tb[11]), "=&v"(tb[12]), "=&v"(tb[13]), "=&v"(tb[14]), "=&v"(tb[15])
                             : "v"(traddr) : "memory");
#pragma unroll
                for (int g = 0; g < 2; ++g)
#pragma unroll
                    for (int c = 0; c < 4; ++c) { u32x4p bb; bb.x = tb[8 * g + 2 * c].x; bb.y = tb[8 * g + 2 * c].y; bb.z = tb[8 * g + 2 * c + 1].x; bb.w = tb[8 * g + 2 * c + 1].y;
                        oa[g][c] = __builtin_amdgcn_mfma_f32_16x16x32_bf16(pf[ks], __builtin_bit_cast(bf16x8, bb), oa[g][c], 0, 0, 0); }
                asm volatile("" ::: "memory");
            }
            TMARK(15);
            bf16* orow = (bf16*)(F.ws + WS_ATT) + (size_t)(b * SEQ + t) * 512;
#pragma unroll
            for (int r = 0; r < 4; ++r) { const float i0 = __shfl(inv, r), i1 = __shfl(inv, 4 + r);
                if (l4 < 2) {
#pragma unroll
                    for (int c = 0; c < 4; ++c) { const float v = l4 == 0 ? oa[0][c][r] * i0 : oa[1][c][r] * i1; orow[(4 * l4 + r) * 64 + 16 * c + l15] = (bf16)f2bf(v); } } }
        }
        LDS_WAIT(); asm volatile("" ::: "memory");
        TMARK(4);
    }
    __syncthreads();
    TMARK(5);
}

__device__ __forceinline__ void p4_mixers(Frame& F, const Args& A) {
    for (int u = blockIdx.x; u < 256; u += F.G) hgrn_h1_unit(F, u);
    __syncthreads();
    { LAS float* bt = (LAS float*)(F.lds + DSA_BIAS);
      for (int i = F.tid; i < 114 * 8; i += NWAVES * 64) { const int n = i >> 3; int v = n; if (n >= 16) { v = 16 + (int)(__logf((float)n * (1.0f / 16.0f)) * (16.0f / 2.0794415416798357f)); v = v < 31 ? v : 31; }
          bt[i] = A.in[9][v * 8 + (i & 7)]; }
      __syncthreads(); }
    for (int u = blockIdx.x, k = 0; u < 2048; u += F.G, ++k) { const int b = u & 7, sl = u >> 3, sm = (k & 1) ? ((sl & ~31) | (31 - (sl & 31))) : sl; dsa_unit(F, b, (255 - sm) * 32); }
}

__device__ __forceinline__ void p5_rec(Frame& F, const Args& A) { for (int u = blockIdx.x; u < 256; u += F.G) hgrn_h3_unit(F, A, u);
}

__device__ __forceinline__ void p10_final(Frame& F, const Args& A) {
    const int gw = blockIdx.x * NWAVES + F.wave, NGW = F.G * NWAVES; const float* SS = (const float*)(F.ws + WS_X2SS);
    f32x4 wv[4];
#pragma unroll
    for (int j = 0; j < 4; ++j) wv[j] = *(const f32x4*)(A.in[19] + 4 * F.lane + 256 * j);
    const bf16* X2 = (const bf16*)(F.ws + WS_XS);
    for (int m0 = gw; m0 < M; m0 += 4 * NGW) {
        v2u v[4][4]; float ss[4];
#pragma unroll
        for (int k = 0; k < 4; ++k) { const int m = m0 + k * NGW < M ? m0 + k * NGW : m0; ss[k] = F.lane < 16 ? SS[(size_t)m * 16 + F.lane] : 0.f;
            const v2u* xr = (const v2u*)(X2 + (size_t)m * D) + F.lane;
#pragma unroll
            for (int j = 0; j < 4; ++j) v[k][j] = xr[64 * j]; }
#pragma unroll
        for (int k = 0; k < 4; ++k) { const int m = m0 + k * NGW; const float r = 1.0f / sqrtf(wave_sum(ss[k]) * (1.0f / D) + EPS);
            if (m < M) { GAS f32x4* xo = (GAS f32x4*)(F.out + (size_t)m * D) + F.lane;
#pragma unroll
                for (int j = 0; j < 4; ++j) xo[64 * j] = (f32x4){bflo(v[k][j].x), bfhi(v[k][j].x), bflo(v[k][j].y), bfhi(v[k][j].y)} * r * wv[j]; } }
    }
}

__global__ void __launch_bounds__(NWAVES * 64, 2) fwd_kernel(Args args) {
    extern __shared__ __attribute__((aligned(16))) unsigned char lds[];
    Frame F;
    F.lds = (LAS unsigned char*)lds;
    F.MISC = (volatile LAS unsigned*)(F.lds + MISC_OFF);
    F.tid = threadIdx.x; F.lane = F.tid & 63; F.wave = __builtin_amdgcn_readfirstlane(F.tid >> 6);
    F.G = gridDim.x;
    F.ws = args.ws; F.ctl = (gu32*)(args.ws + WS_CTL); F.out = args.out;
    for (int u = F.tid; u < (LDS_BYTES - LDSCTL_OFF) / 4; u += NWAVES * 64) ((LAS unsigned*)(F.lds + LDSCTL_OFF))[u] = 0u;
    __syncthreads();
    XcdBarrier bar; bar.bar = (unsigned*)(F.ctl + CW_BAR); bar.x = 0; bar.st = nullptr;
    if (N_LAUNCHES == 1) bar = xcd_barrier_post((unsigned*)(F.ctl + CW_BAR), F.MISC + 8);
#ifdef TSEL
    unsigned long long tph_ = __builtin_amdgcn_s_memrealtime(); int phk_ = 0;
#define GRID_BAR() do { if (N_LAUNCHES == 1) { const unsigned long long t1_ = __builtin_amdgcn_s_memrealtime(); xcd_barrier(bar); const unsigned long long t2_ = __builtin_amdgcn_s_memrealtime(); \
        if (F.tid == 0) { ((LAS unsigned*)(F.lds + LDSCTL_OFF))[16 + phk_] += (unsigned)(t1_ - tph_); ((LAS unsigned*)(F.lds + LDSCTL_OFF))[40 + phk_] += (unsigned)(t2_ - t1_); } tph_ = t2_; ++phk_; } } while (0)
#else
#define GRID_BAR() do { if (N_LAUNCHES == 1) xcd_barrier(bar); } while (0)
#endif
    const int lo = args.ph_lo, hi = args.ph_hi;
#ifdef ONLY_PHASE
#define IN(k) ((k) == ONLY_PHASE && lo <= (k) && (k) < hi)
#else
#define IN(k) (lo <= (k) && (k) < hi)
#endif
#define BOTH(k) (IN(k) && IN((k) + 1))
    const float* MOD = (const float*)(F.ws + WS_MOD);

    if (IN(0)) { p0_prologue(F, args); if (BOTH(0)) GRID_BAR(); }
    if (IN(1)) { p1_norm(F, args); if (BOTH(1)) GRID_BAR(); }
    if (IN(2)) {
        pg8::Gemm g{(const bf16*)(F.ws + WS_XN), (const bf16*)(F.ws + WS_WIN), M, NPROJ_PAD, 1024}; pg8::StaticOrder S; S.init(M, NPROJ_PAD, F.G, (int)blockIdx.x);
        pg8::EpiInProj E{(bf16*)(F.ws + WS_CQ), (bf16*)(F.ws + WS_KV), (bf16*)(F.ws + WS_KI), (bf16*)(F.ws + WS_RQ), (bf16*)F.out,
                         (float*)(F.ws + WS_WI), (float*)(F.ws + WS_CQSS), (const float*)(F.ws + WS_LB)};
        pg8::gemm_phase<pg8::EpiInProj, pg8::StaticOrder, PG8_ALIGN, PG8_SP2>(F.lds + RING_OFF, g, S, E);
        if (BOTH(2)) GRID_BAR();
    }
    if (IN(3)) {
        pg8::Gemm g{(const bf16*)(F.ws + WS_CQ), (const bf16*)(F.ws + WS_WQ), M, 1024, 256}; pg8::StaticOrder S; S.init(M, 1024, F.G, (int)blockIdx.x);
        pg8::EpiQ E{(bf16*)(F.ws + WS_Q), (const float*)(F.ws + WS_CQSS)};
        pg8::gemm_phase<pg8::EpiQ, pg8::StaticOrder, PG8_ALIGN, PG8_SP2>(F.lds + RING_OFF, g, S, E);
        if (BOTH(3)) GRID_BAR();
    }
#ifdef TSEL
    if (IN(4)) { const unsigned long long ta_ = __builtin_amdgcn_s_memrealtime(); p4_mixers(F, args); unsigned long long tb_ = __builtin_amdgcn_s_memrealtime(); if (F.tid == 0) ((LAS unsigned*)(F.lds + LDSCTL_OFF))[7] += (unsigned)(tb_ - ta_); if (BOTH(4)) GRID_BAR(); if (F.tid == 0) ((LAS unsigned*)(F.lds + LDSCTL_OFF))[6] += (unsigned)(__builtin_amdgcn_s_memrealtime() - tb_); }
#else
    if (IN(4)) { p4_mixers(F, args); if (BOTH(4)) GRID_BAR(); }
#endif
    if (IN(5)) { p5_rec(F, args); if (BOTH(5)) GRID_BAR(); }
    if (IN(6)) {
        pg8::ChainOrder S; S.init(M, 1024, F.G, (int)blockIdx.x);
        pg8::Gemm g{(const bf16*)(F.ws + WS_ATT), (const bf16*)(F.ws + WS_WBA), 2 * M, 2048, 512}; pg8::EpiBranchChain E{(bf16*)(F.ws + WS_MIX), (const bf16*)F.out};
        pg8::gemm_phase<pg8::EpiBranchChain, pg8::ChainOrder, PG8_ALIGN, PG8_SP2>(F.lds + RING_OFF, g, S, E);
        if (BOTH(6)) GRID_BAR();
    }
    if (IN(7)) {
        pg8::Gemm g{(const bf16*)(F.ws + WS_MIX), (const bf16*)(F.ws + WS_WOUT), M, 1024, 1024}; pg8::StaticOrder S; S.init(M, 1024, F.G, (int)blockIdx.x);
        pg8::EpiOut E{args.in[0], (bf16*)(F.ws + WS_X1), (bf16*)(F.ws + WS_XS), (float*)(F.ws + WS_X1SS), MOD, (const float*)(F.ws + WS_CW2)};
        pg8::gemm_phase<pg8::EpiOut, pg8::StaticOrder, PG8_ALIGN, PG8_SP2>(F.lds + RING_OFF, g, S, E);
        if (BOTH(7)) GRID_BAR();
    }
    if (IN(8)) {
        pg8::Gemm g{(const bf16*)(F.ws + WS_XS), (const bf16*)(F.ws + WS_WGU), M, NGU, 1024}; pg8::StaticOrder S; S.init(M, NGU, F.G, (int)blockIdx.x);
        int pm0 = 0; { const int nN_ = NGU / 256, nwg_ = (M / 256) * nN_; int wg_ = (int)blockIdx.x;
            if (wg_ < nwg_) { const int q_ = nwg_ / 8, r_ = nwg_ % 8, x_ = wg_ % 8, o_ = wg_ / 8; wg_ = (x_ < r_ ? x_ * (q_ + 1) : r_ * (q_ + 1) + (x_ - r_) * q_) + o_;
                const int nig_ = 8 * nN_, fm_ = (wg_ / nig_) * 8, gsz_ = (M / 256 - fm_) < 8 ? (M / 256 - fm_) : 8; pm0 = fm_ + ((wg_ % nig_) % gsz_); } }
        const int g0 = pm0 >> 3, pm7 = pm0 & 7;
        { LAS float* R2L = (LAS float*)(F.lds + RING_BYTES); const float* SS = (const float*)(F.ws + WS_X1SS);
          for (int i = F.tid; i < 1024; i += NWAVES * 64) { const int pm = 8 * (g0 + (i >> 8)) + pm7; float r = 0.f;
              if (pm < M / 256) { const float* p = SS + (size_t)(pm * 256 + (i & 255)) * 16; float s2 = 0.f;
#pragma unroll
                  for (int q = 0; q < 4; ++q) { const f32x4 t = *(const f32x4*)(p + 4 * q); s2 += (t[0] + t[1]) + (t[2] + t[3]); }
                  r = __builtin_amdgcn_rsqf(s2 * (1.0f / 1024.0f) + 1e-6f); }
              R2L[i] = r; }
          LAS float* BL = (LAS float*)(F.lds + RING_BYTES + 4096); const float* bsrc = (const float*)(F.ws + WS_BGU) + (pm0 >> 5) * NGU;
          for (int i = F.tid; i < NGU / 4; i += NWAVES * 64) ((LAS f32x4*)BL)[i] = ((const f32x4*)bsrc)[i];
          __syncthreads(); }
        pg8::EpiGateUp E{(bf16*)(F.ws + WS_HID), (const float*)(F.ws + WS_X1SS), (const float*)(F.ws + WS_BGU), (const LAS float*)(F.lds + RING_BYTES + 4096), pm0 >> 5, (const LAS float*)(F.lds + RING_BYTES), g0, pm7};
        pg8::gemm_phase<pg8::EpiGateUp, pg8::StaticOrder, PG8_ALIGN, PG8_SP2>(F.lds + RING_OFF, g, S, E);
        if (BOTH(8)) GRID_BAR();
    }
    if (IN(9)) {
        pg8::Gemm g{(const bf16*)(F.ws + WS_HID), (const bf16*)(F.ws + WS_WD), M, 1024, FF}; pg8::StaticOrder S; S.init(M, 1024, F.G, (int)blockIdx.x);
        pg8::EpiDown E{(const bf16*)(F.ws + WS_X1), (bf16*)(F.ws + WS_XS), (float*)(F.ws + WS_X2SS), MOD};
        pg8::gemm_phase<pg8::EpiDown, pg8::StaticOrder, PG8_ALIGN, PG8_SP2>(F.lds + RING_OFF, g, S, E);
        if (BOTH(9)) GRID_BAR();
    }
    if (IN(10)) p10_final(F, args);
#ifdef TSEL
    if (F.tid == 0) ((LAS unsigned*)(F.lds + LDSCTL_OFF))[16 + phk_] += (unsigned)(__builtin_amdgcn_s_memrealtime() - tph_);
    __syncthreads();
    if (blockIdx.x == 0 && F.tid == 0) { const unsigned ticks = ((LAS unsigned*)(F.lds + LDSCTL_OFF))[TSEL]; const unsigned long long t0_ = __builtin_amdgcn_s_memrealtime(); while (__builtin_amdgcn_s_memrealtime() - t0_ < (unsigned long long)ticks) __builtin_amdgcn_s_sleep(8); }
#endif
#undef IN
#undef BOTH
}

extern "C" void kernel_launch(void* const* d_in, const int* in_sizes, int n_in, void* d_out, int out_size, void* d_ws, size_t ws_size, hipStream_t stream) {
    static int grid = 0;
    if (grid == 0) {
        if (n_in != 20 || in_sizes[0] != M * D || out_size != M * D || ws_size < WS_END) { fprintf(stderr, "kernel_launch: unexpected shapes (n_in %d, in0 %d, out %d, ws %zu); nothing launched\n", n_in, n_in > 0 ? in_sizes[0] : -1, out_size, ws_size); grid = -1; return; }
        int dev = 0, cus = 0, per_cu = 0;
        if (hipGetDevice(&dev) != hipSuccess || hipDeviceGetAttribute(&cus, hipDeviceAttributeMultiprocessorCount, dev) != hipSuccess) { grid = -1; return; }
        if (hipFuncSetAttribute((const void*)fwd_kernel, hipFuncAttributeMaxDynamicSharedMemorySize, LDS_BYTES) != hipSuccess) { fprintf(stderr, "kernel_launch: hipFuncSetAttribute failed\n"); grid = -1; return; }
        if (hipOccupancyMaxActiveBlocksPerMultiprocessor(&per_cu, (const void*)fwd_kernel, NWAVES * 64, LDS_BYTES) != hipSuccess || per_cu < 1)
            fprintf(stderr, "kernel_launch: note: occupancy query reports %d workgroups per CU\n", per_cu);
        (void)hipGetLastError();
        grid = cus;
    }
    if (grid < 0) return;
    if (hipMemsetAsync((char*)d_ws + WS_CTL, 0, CTL_ZERO_BYTES, stream) != hipSuccess) { fprintf(stderr, "kernel_launch: memset failed\n"); return; }
    Args a{};
    for (int i = 0; i < 20; ++i) a.in[i] = (const float*)d_in[i];
    a.out = (float*)d_out; a.ws = (unsigned char*)d_ws;
    for (int li = 0; li < N_LAUNCHES; ++li) {
        a.ph_lo = (N_LAUNCHES == 1) ? 0 : li; a.ph_hi = (N_LAUNCHES == 1) ? N_PHASES : li + 1;
        hipLaunchKernelGGL(fwd_kernel, dim3(grid), dim3(NWAVES * 64), LDS_BYTES, stream, a);
        const hipError_t le = hipPeekAtLastError();
        if (le != hipSuccess) { fprintf(stderr, "kernel_launch: launch %d failed: %s\n", li, hipGetErrorName(le)); break; }
    }
}
```

```cpp
#include <hip/hip_runtime.h>
#include <cstdio>
#include <cstdint>
namespace pg8 {
#define PG8_LAS __attribute__((address_space(3)))
typedef unsigned short bf16_t;
typedef short bf16x8 __attribute__((ext_vector_type(8)));
typedef float f32x4 __attribute__((ext_vector_type(4)));
typedef unsigned u32x4 __attribute__((ext_vector_type(4)));
constexpr int BM = 256, BK = 64, HALF = 128, HTB = HALF * BK * 2  , STAGE_BYTES = 8 * HTB, NXCD = 8, WGM = 8;

__host__ __device__ __forceinline__ int lds_byte(int r, int c) { const int st = (r >> 4) * 2 + (c >> 5), rr = r & 15, cc = c & 31, ob = rr * 64 + cc * 2; return st * 1024 + (ob ^ (((ob >> 9) & 1) << 5)); }
__host__ __device__ __forceinline__ void stage_rc(int b, int& R, int& C) { const int st = b / 1024, sb = b % 1024, swz = sb ^ (((sb >> 9) & 1) << 5); R = (st >> 1) * 16 + swz / 64; C = (st & 1) * 32 + (swz % 64) / 2; }
__host__ __device__ __forceinline__ int perm32(int rho) { const int n = rho >> 4, i = rho & 15; return 8 * (i >> 2) + 4 * n + (i & 3); }

struct Unit { int pm, pn; };
struct Gemm { const bf16_t* A; const bf16_t* Bt; int M, N, K; };

struct StaticOrder {
    int nM, nN, nwg, G, c;
    __host__ __device__ void init(int M, int N, int G_, int c_) { nM = M / BM; nN = N / BM; nwg = nM * nN; G = G_; c = c_; }
    __host__ __device__ bool next(int i, Unit& u) const {
        const long L = (long)i * G + c; if (L >= nwg) return false;
        int wgid = (int)L; { const int q = nwg / NXCD, r = nwg % NXCD, xcd = wgid % NXCD, off = wgid / NXCD; wgid = (xcd < r ? xcd * (q + 1) : r * (q + 1) + (xcd - r) * q) + off; }
        const int nig = WGM * nN, gid = wgid / nig, fm = gid * WGM, gsz = (nM - fm) < WGM ? (nM - fm) : WGM;
        u.pm = fm + ((wgid % nig) % gsz); u.pn = (wgid % nig) / gsz; return true;
    }
    __device__ __forceinline__ void a_ready(const Unit&) const {}
    __device__ __forceinline__ void done(const Unit&) const {}
};

__device__ __forceinline__ unsigned cvt_pk_bf16(float lo, float hi) { unsigned r; asm volatile("v_cvt_pk_bf16_f32 %0, %1, %2" : "=v"(r) : "v"(lo), "v"(hi)); return r; }
__device__ __forceinline__ float fsigmoid(float x) { return __builtin_amdgcn_rcpf(1.0f + __expf(-x)); }
__device__ __forceinline__ float fsilu(float x) { return x * fsigmoid(x); }
__device__ __forceinline__ u32x4 pack8(const f32x4 a, const f32x4 b) { u32x4 w; w.x = cvt_pk_bf16(a[0], a[1]); w.y = cvt_pk_bf16(a[2], a[3]); w.z = cvt_pk_bf16(b[0], b[1]); w.w = cvt_pk_bf16(b[2], b[3]); return w; }
__device__ __forceinline__ float bf_lo(unsigned u) { return __builtin_bit_cast(float, u << 16); }
__device__ __forceinline__ float bf_hi(unsigned u) { return __builtin_bit_cast(float, u & 0xffff0000u); }

struct EpiInProj {
    static constexpr bool PERM = true, AFTER_DRAIN = false, CHAIN = false;
    bf16_t *CQ, *KV, *KI, *RQ, *GATES; float *WI, *CQSS; const float* LB; unsigned char* K8; unsigned char* V8; float gtb;
    __device__ __forceinline__ void operator()(const f32x4 (&acc)[2][2][4][2], const Unit& u, int wr, int wc, int fr, int fq) const {
        const int row0 = u.pm * BM + wr * 64 + fr, pn = u.pn, cl = wc * 32 + 8 * fq;
        if (pn == 0) {
#pragma unroll
            for (int ai = 0; ai < 2; ++ai)
#pragma unroll
                for (int m = 0; m < 4; ++m) { const int row = row0 + ai * HALF + m * 16; float s = 0.f;
#pragma unroll
                    for (int bj = 0; bj < 2; ++bj) { const f32x4 a = acc[ai][bj][m][0], b = acc[ai][bj][m][1];
                        s += (a[0] * a[0] + a[1] * a[1]) + (a[2] * a[2] + a[3] * a[3]) + (b[0] * b[0] + b[1] * b[1]) + (b[2] * b[2] + b[3] * b[3]);
                        *(u32x4*)(CQ + (size_t)row * 256 + cl + bj * HALF) = pack8(a, b); }
                    s += __shfl_xor(s, 16); s += __shfl_xor(s, 32);
                    if (fq == 0) CQSS[(size_t)row * 4 + wc] = s; }
        } else if (pn == 1) {
#pragma unroll
            for (int ai = 0; ai < 2; ++ai)
#pragma unroll
                for (int m = 0; m < 4; ++m) { const int row = row0 + ai * HALF + m * 16;
#pragma unroll
                    for (int bj = 0; bj < 2; ++bj) *(u32x4*)(KV + (size_t)row * 256 + cl + bj * HALF) = pack8(acc[ai][bj][m][0], acc[ai][bj][m][1]);
                    { const f32x4 a = acc[ai][0][m][0], b = acc[ai][0][m][1]; typedef unsigned u32x2k __attribute__((ext_vector_type(2)));
                      int lo = __builtin_amdgcn_cvt_pk_fp8_f32(a[0], a[1], 0, false); lo = __builtin_amdgcn_cvt_pk_fp8_f32(a[2], a[3], lo, true);
                      int hi = __builtin_amdgcn_cvt_pk_fp8_f32(b[0], b[1], 0, false); hi = __builtin_amdgcn_cvt_pk_fp8_f32(b[2], b[3], hi, true);
                      *(u32x2k*)(K8 + (size_t)row * 128 + cl) = (u32x2k){(unsigned)lo, (unsigned)hi}; }
                    { const f32x4 a = acc[ai][1][m][0], b = acc[ai][1][m][1]; typedef unsigned u32x2k __attribute__((ext_vector_type(2)));
                      int lo = __builtin_amdgcn_cvt_pk_fp8_f32(a[0], a[1], 0, false); lo = __builtin_amdgcn_cvt_pk_fp8_f32(a[2], a[3], lo, true);
                      int hi = __builtin_amdgcn_cvt_pk_fp8_f32(b[0], b[1], 0, false); hi = __builtin_amdgcn_cvt_pk_fp8_f32(b[2], b[3], hi, true);
                      *(u32x2k*)(V8 + (size_t)row * 128 + cl) = (u32x2k){(unsigned)lo, (unsigned)hi}; } }
        } else if (pn == 2) {
#pragma unroll
            for (int ai = 0; ai < 2; ++ai)
#pragma unroll
                for (int m = 0; m < 4; ++m) { const int row = row0 + ai * HALF + m * 16;
                    if (wc < 2) *(u32x4*)(KI + (size_t)row * 64 + cl) = pack8(acc[ai][0][m][0], acc[ai][0][m][1]);
                    else if (wc == 2 && fq == 0) { *(f32x4*)(WI + (size_t)row * 8) = acc[ai][0][m][0]; *(f32x4*)(WI + (size_t)row * 8 + 4) = acc[ai][0][m][1]; } }
        } else if (pn <= 10) {
            const int kind = (pn - 3) >> 1, cb = ((pn - 3) & 1) * 256 + cl;
            bf16_t* dst = RQ + (size_t)kind * (size_t)(32u << 20);
#pragma unroll
            for (int bj = 0; bj < 2; ++bj) {
                f32x4 l0 = (f32x4){0.f, 0.f, 0.f, 0.f}, l1 = l0;
                if (kind == 1) { l0 = *(const f32x4*)(LB + cb + bj * HALF); l1 = *(const f32x4*)(LB + cb + bj * HALF + 4); }
#pragma unroll
                for (int ai = 0; ai < 2; ++ai)
#pragma unroll
                    for (int m = 0; m < 4; ++m) { const int row = row0 + ai * HALF + m * 16; f32x4 a = acc[ai][bj][m][0], b = acc[ai][bj][m][1];
                        if (kind == 0 || kind == 3) {
#pragma unroll
                            for (int j = 0; j < 4; ++j) { a[j] = fsilu(a[j]); b[j] = fsilu(b[j]); } }
                        else if (kind == 1) {
#pragma unroll
                            for (int j = 0; j < 4; ++j) { a[j] = __logf(l0[j] + (1.0f - l0[j]) * fsigmoid(a[j])); b[j] = __logf(l1[j] + (1.0f - l1[j]) * fsigmoid(b[j])); } }
                        *(u32x4*)(dst + (size_t)row * 512 + cb + bj * HALF) = pack8(a, b); }
            }
        } else {
            const int cb = (pn - 11) * 256 + cl;
#pragma unroll
            for (int ai = 0; ai < 2; ++ai)
#pragma unroll
                for (int m = 0; m < 4; ++m) { const int row = row0 + ai * HALF + m * 16;
#pragma unroll
                    for (int bj = 0; bj < 2; ++bj) { f32x4 a = acc[ai][bj][m][0], b = acc[ai][bj][m][1];
                        unsigned ga[4], gb[4];
#pragma unroll
                        for (int j = 0; j < 4; ++j) { ga[j] = *(const PG8_LAS unsigned char*)(size_t)(unsigned)(int)__builtin_amdgcn_fmed3f(__builtin_fmaf(a[j], 128.0f, gtb), gtb - 1024.0f, gtb + 1023.0f);
                                                      gb[j] = *(const PG8_LAS unsigned char*)(size_t)(unsigned)(int)__builtin_amdgcn_fmed3f(__builtin_fmaf(b[j], 128.0f, gtb), gtb - 1024.0f, gtb + 1023.0f); }
                        unsigned lo = ga[0] | (ga[1] << 8) | (ga[2] << 16) | (ga[3] << 24), hi = gb[0] | (gb[1] << 8) | (gb[2] << 16) | (gb[3] << 24);
                        typedef unsigned u32x2v __attribute__((ext_vector_type(2)));
                        *(u32x2v*)((unsigned char*)GATES + (size_t)row * 2048 + cb + bj * HALF) = (u32x2v){lo, hi}; } }
        }
    }
};

struct EpiQ {
    static constexpr bool PERM = true, AFTER_DRAIN = false, CHAIN = false;
    bf16_t *Q; const float* CQSS;
    __device__ __forceinline__ void operator()(const f32x4 (&acc)[2][2][4][2], const Unit& u, int wr, int wc, int fr, int fq) const {
        const int row0 = u.pm * BM + wr * 64 + fr, pn = u.pn, cl = (pn & 1) * 256 + wc * 32 + 8 * fq;
        bf16_t* dst = Q + (pn < 2 ? (size_t)0 : (size_t)(32u << 20));
        const float sc = pn < 2 ? 0.125f * 1.4426950408889634f : 1.0f;
#pragma unroll
        for (int ai = 0; ai < 2; ++ai)
#pragma unroll
            for (int m = 0; m < 4; ++m) { const int row = row0 + ai * HALF + m * 16;
                const f32x4 ss = *(const f32x4*)(CQSS + (size_t)row * 4);
                const float r = __builtin_amdgcn_rsqf(((ss[0] + ss[1]) + (ss[2] + ss[3])) * (1.0f / 256.0f) + 1e-6f) * sc;
#pragma unroll
                for (int bj = 0; bj < 2; ++bj) *(u32x4*)(dst + (size_t)row * 512 + cl + bj * HALF) = pack8(acc[ai][bj][m][0] * r, acc[ai][bj][m][1] * r); }
    }
};

template <int MODE> struct EpiBranch {
    static constexpr bool PERM = true, AFTER_DRAIN = false, CHAIN = false;
    bf16_t* MIX; const bf16_t* GATES;
    __device__ __forceinline__ void operator()(const f32x4 (&acc)[2][2][4][2], const Unit& u, int wr, int wc, int fr, int fq) const {
        const int row0 = u.pm * BM + wr * 64 + fr, cl = u.pn * 256 + wc * 32 + 8 * fq;
#pragma unroll
        for (int ai = 0; ai < 2; ++ai)
#pragma unroll
            for (int m = 0; m < 4; ++m) { const int row = row0 + ai * HALF + m * 16;
#pragma unroll
                for (int bj = 0; bj < 2; ++bj) { const int c = cl + bj * HALF;
                    const u32x4 g = *(const u32x4*)(GATES + (size_t)row * 2048 + MODE * 1024 + c);
                    f32x4 a = acc[ai][bj][m][0], b = acc[ai][bj][m][1];
                    a[0] *= bf_lo(g.x); a[1] *= bf_hi(g.x); a[2] *= bf_lo(g.y); a[3] *= bf_hi(g.y); b[0] *= bf_lo(g.z); b[1] *= bf_hi(g.z); b[2] *= bf_lo(g.w); b[3] *= bf_hi(g.w);
                    if (MODE == 1) { const u32x4 p = *(const u32x4*)(MIX + (size_t)row * 1024 + c);
                        a[0] += bf_lo(p.x); a[1] += bf_hi(p.x); a[2] += bf_lo(p.y); a[3] += bf_hi(p.y); b[0] += bf_lo(p.z); b[1] += bf_hi(p.z); b[2] += bf_lo(p.w); b[3] += bf_hi(p.w); }
                    *(u32x4*)(MIX + (size_t)row * 1024 + c) = pack8(a, b); } }
    }
};

struct EpiOut {
    static constexpr bool PERM = true, AFTER_DRAIN = false, CHAIN = false;
    const float* X; bf16_t* X1; bf16_t* XS; float* X1SS; const float* MOD; const float* CW2;
    __device__ __forceinline__ void operator()(const f32x4 (&acc)[2][2][4][2], const Unit& u, int wr, int wc, int fr, int fq) const {
        const int row0 = u.pm * BM + wr * 64 + fr, cl = u.pn * 256 + wc * 32 + 8 * fq, b = u.pm >> 5;
#pragma unroll
        for (int ai = 0; ai < 2; ++ai)
#pragma unroll
            for (int m = 0; m < 4; ++m) { const int row = row0 + ai * HALF + m * 16; float s = 0.f;
#pragma unroll
                for (int bj = 0; bj < 2; ++bj) { const int c = cl + bj * HALF;
                    const float* xp = X + (size_t)row * 1024 + c; const float* gp = MOD + b * 6144 + 2048 + c; const float* cp = CW2 + b * 1024 + c;
                    const f32x4 v0 = *(const f32x4*)(xp) + *(const f32x4*)(gp) * acc[ai][bj][m][0], v1 = *(const f32x4*)(xp + 4) + *(const f32x4*)(gp + 4) * acc[ai][bj][m][1];
                    *(u32x4*)(X1 + (size_t)row * 1024 + c) = pack8(v0, v1);
                    s += (v0[0] * v0[0] + v0[1] * v0[1]) + (v0[2] * v0[2] + v0[3] * v0[3]) + (v1[0] * v1[0] + v1[1] * v1[1]) + (v1[2] * v1[2] + v1[3] * v1[3]);
                    *(u32x4*)(XS + (size_t)row * 1024 + c) = pack8(v0 * *(const f32x4*)(cp), v1 * *(const f32x4*)(cp + 4)); }
                s += __shfl_xor(s, 16); s += __shfl_xor(s, 32);
                if (fq == 0) X1SS[(size_t)row * 16 + u.pn * 4 + wc] = s; }
    }
};

struct EpiGateUp {
    static constexpr bool PERM = true, AFTER_DRAIN = false, CHAIN = false;
    bf16_t* HID; const float* X1SS; const float* BGU;
    const PG8_LAS float* BL; int bl;
    const PG8_LAS float* R2L; int g0, pm7;
    __device__ __forceinline__ void operator()(const f32x4 (&acc)[2][2][4][2], const Unit& u, int wr, int wc, int fr, int fq) const {
        const int row0 = u.pm * BM + wr * 64 + fr, cl = wc * 32 + 8 * fq, b = u.pm >> 5;
        const int slot = (u.pm >> 3) - g0; const bool cached = slot >= 0 && slot < 4 && (u.pm & 7) == pm7;
        f32x4 bg0, bg1, bu0, bu1;
        if (b == bl) { const PG8_LAS float* bp = BL + u.pn * 256 + cl; bg0 = *(const PG8_LAS f32x4*)(bp); bg1 = *(const PG8_LAS f32x4*)(bp + 4); bu0 = *(const PG8_LAS f32x4*)(bp + 128); bu1 = *(const PG8_LAS f32x4*)(bp + 132); }
        else { const float* bp = BGU + b * 5632 + u.pn * 256 + cl; bg0 = *(const f32x4*)(bp); bg1 = *(const f32x4*)(bp + 4); bu0 = *(const f32x4*)(bp + 128); bu1 = *(const f32x4*)(bp + 132); }
#pragma unroll
        for (int ai = 0; ai < 2; ++ai)
#pragma unroll
            for (int m = 0; m < 4; ++m) { const int row = row0 + ai * HALF + m * 16;
                float r = R2L[(cached ? slot : 0) * 256 + wr * 64 + fr + ai * HALF + m * 16];
                if (!cached) { float s = 0.f;
#pragma unroll
                    for (int q = 0; q < 4; ++q) { const f32x4 t = *(const f32x4*)(X1SS + (size_t)row * 16 + 4 * q); s += (t[0] + t[1]) + (t[2] + t[3]); }
                    r = __builtin_amdgcn_rsqf(s * (1.0f / 1024.0f) + 1e-6f); }
                f32x4 g0v = acc[ai][0][m][0] * r + bg0, g1v = acc[ai][0][m][1] * r + bg1; const f32x4 u0 = acc[ai][1][m][0] * r + bu0, u1 = acc[ai][1][m][1] * r + bu1;
#pragma unroll
                for (int j = 0; j < 4; ++j) { g0v[j] = fsilu(g0v[j]) * u0[j]; g1v[j] = fsilu(g1v[j]) * u1[j]; }
                *(u32x4*)(HID + (size_t)row * 2816 + u.pn * 128 + cl) = pack8(g0v, g1v); }
    }
};

struct EpiDown {
    static constexpr bool PERM = true, AFTER_DRAIN = false, CHAIN = false;
    const bf16_t* X1; bf16_t* X2; float* X2SS; const float* MOD;
    __device__ __forceinline__ void operator()(const f32x4 (&acc)[2][2][4][2], const Unit& u, int wr, int wc, int fr, int fq) const {
        const int row0 = u.pm * BM + wr * 64 + fr, cl = u.pn * 256 + wc * 32 + 8 * fq, b = u.pm >> 5;
#pragma unroll
        for (int ai = 0; ai < 2; ++ai)
#pragma unroll
            for (int m = 0; m < 4; ++m) { const int row = row0 + ai * HALF + m * 16; float s = 0.f;
#pragma unroll
                for (int bj = 0; bj < 2; ++bj) { const int c = cl + bj * HALF;
                    const u32x4 xb = *(const u32x4*)(X1 + (size_t)row * 1024 + c);
                    const f32x4 x0 = (f32x4){bf_lo(xb.x), bf_hi(xb.x), bf_lo(xb.y), bf_hi(xb.y)}, x1 = (f32x4){bf_lo(xb.z), bf_hi(xb.z), bf_lo(xb.w), bf_hi(xb.w)};
                    const f32x4 v0 = x0 + *(const f32x4*)(MOD + b * 6144 + 5120 + c) * acc[ai][bj][m][0], v1 = x1 + *(const f32x4*)(MOD + b * 6144 + 5120 + c + 4) * acc[ai][bj][m][1];
                    *(u32x4*)(X2 + (size_t)row * 1024 + c) = pack8(v0, v1);
                    s += (v0[0] * v0[0] + v0[1] * v0[1]) + (v0[2] * v0[2] + v0[3] * v0[3]) + (v1[0] * v1[0] + v1[1] * v1[1]) + (v1[2] * v1[2] + v1[3] * v1[3]); }
                s += __shfl_xor(s, 16); s += __shfl_xor(s, 32);
                if (fq == 0) X2SS[(size_t)row * 16 + u.pn * 4 + wc] = s; }
    }
};


struct ChainOrder : StaticOrder {
    __device__ bool next(int i, Unit& u) const { Unit t; if (!StaticOrder::next(i >> 1, t)) return false; u.pm = t.pm + ((i & 1) ? 256 : 0); u.pn = t.pn + ((i & 1) ? 4 : 0); return true; }
};
struct EpiBranchChain {
    static constexpr bool PERM = true, AFTER_DRAIN = false, CHAIN = true;
    bf16_t* MIX; const bf16_t* GATES;
    __device__ __forceinline__ bool chain(f32x4 (&acc)[2][2][4][2], const Unit& u, int wr, int wc, int fr, int fq) const {
        const bool second = u.pm >= 256; const int pm = second ? u.pm - 256 : u.pm, pn = second ? u.pn - 4 : u.pn;
        const int row0 = pm * BM + wr * 64 + fr, cl = pn * 256 + wc * 32 + 8 * fq;
#pragma unroll
        for (int ai = 0; ai < 2; ++ai)
#pragma unroll
            for (int m = 0; m < 4; ++m) { const int row = row0 + ai * HALF + m * 16;
#pragma unroll
                for (int bj = 0; bj < 2; ++bj) { const int c = cl + bj * HALF;
                    typedef unsigned u32x2v __attribute__((ext_vector_type(2)));
                    const u32x2v gr = *(const u32x2v*)((const unsigned char*)GATES + (size_t)row * 2048 + 1024 + c);
                    float r[8];
#pragma unroll
                    for (int j = 0; j < 4; ++j) { r[j] = (float)((gr.x >> (8 * j)) & 255u) * (1.0f / 255.0f); r[4 + j] = (float)((gr.y >> (8 * j)) & 255u) * (1.0f / 255.0f); }
#pragma unroll
                    for (int j = 0; j < 8; ++j) r[j] = fmaxf(r[j], 1e-30f);
                    if (!second) { const u32x2v ga = *(const u32x2v*)((const unsigned char*)GATES + (size_t)row * 2048 + c);
                        float a[8];
#pragma unroll
                        for (int j = 0; j < 4; ++j) { a[j] = (float)((ga.x >> (8 * j)) & 255u) * (1.0f / 255.0f); a[4 + j] = (float)((ga.y >> (8 * j)) & 255u) * (1.0f / 255.0f); }
#pragma unroll
                        for (int j = 0; j < 4; ++j) { acc[ai][bj][m][0][j] *= a[j] * __builtin_amdgcn_rcpf(r[j]); acc[ai][bj][m][1][j] *= a[4 + j] * __builtin_amdgcn_rcpf(r[4 + j]); } }
                    else { f32x4 v0 = acc[ai][bj][m][0], v1 = acc[ai][bj][m][1];
#pragma unroll
                        for (int j = 0; j < 4; ++j) { v0[j] *= r[j]; v1[j] *= r[4 + j]; }
                        *(u32x4*)(MIX + (size_t)row * 1024 + c) = pack8(v0, v1); } } }
        return !second;
    }
};

struct OneUnit : StaticOrder { int round; __device__ bool next(int i, Unit& u) const { return i == 0 ? StaticOrder::next(round, u) : false; } };
struct EpiDownNorm {
    static constexpr bool PERM = true, AFTER_DRAIN = true, CHAIN = false;
    const bf16_t* X1; float* OUT; const float* MOD; const float* FW; unsigned* xbuf; unsigned* cnt; unsigned* tmo;
    __device__ __forceinline__ void fused(f32x4 (&acc)[2][2][4][2], const Unit& u, int wr, int wc, int fr, int fq, PG8_LAS unsigned char* lds, int wid, int lane) const {
        PG8_LAS float* P = (PG8_LAS float*)lds;
        PG8_LAS float* S = (PG8_LAS float*)(lds + 4096);
        PG8_LAS unsigned* flag = (PG8_LAS unsigned*)(lds + 5120);
        const int row0 = u.pm * BM + wr * 64 + fr, cl = u.pn * 256 + wc * 32 + 8 * fq, b = u.pm >> 5;
#pragma unroll
        for (int ai = 0; ai < 2; ++ai)
#pragma unroll
            for (int m = 0; m < 4; ++m) { const int row = row0 + ai * HALF + m * 16; float s = 0.f;
#pragma unroll
                for (int bj = 0; bj < 2; ++bj) { const int c = cl + bj * HALF;
                    const u32x4 xb = *(const u32x4*)(X1 + (size_t)row * 1024 + c);
                    const f32x4 x0 = (f32x4){bf_lo(xb.x), bf_hi(xb.x), bf_lo(xb.y), bf_hi(xb.y)}, x1 = (f32x4){bf_lo(xb.z), bf_hi(xb.z), bf_lo(xb.w), bf_hi(xb.w)};
                    const f32x4 v0 = x0 + *(const f32x4*)(MOD + b * 6144 + 5120 + c) * acc[ai][bj][m][0], v1 = x1 + *(const f32x4*)(MOD + b * 6144 + 5120 + c + 4) * acc[ai][bj][m][1];
                    acc[ai][bj][m][0] = v0; acc[ai][bj][m][1] = v1;
                    s += (v0[0] * v0[0] + v0[1] * v0[1]) + (v0[2] * v0[2] + v0[3] * v0[3]) + (v1[0] * v1[0] + v1[1] * v1[1]) + (v1[2] * v1[2] + v1[3] * v1[3]); }
                s += __shfl_xor(s, 16); s += __shfl_xor(s, 32);
                if (fq == 0) P[(ai * HALF + wr * 64 + m * 16 + fr) * 4 + wc] = s; }
        asm volatile("s_waitcnt lgkmcnt(0)" ::: "memory"); __builtin_amdgcn_s_barrier(); asm volatile("" ::: "memory");
        const int rowl = wid * 32 + (lane & 31);
        if (lane < 32) { const float tot = (P[rowl * 4 + 0] + P[rowl * 4 + 1]) + (P[rowl * 4 + 2] + P[rowl * 4 + 3]);
            __hip_atomic_store(xbuf + ((size_t)(u.pm * BM + rowl) * 4 + u.pn), __float_as_uint(tot), __ATOMIC_RELAXED, __HIP_MEMORY_SCOPE_AGENT); }
        asm volatile("s_waitcnt vmcnt(0)" ::: "memory");
        if (lane == 0) __hip_atomic_fetch_add(cnt + 64 * u.pm, 1u, __ATOMIC_RELAXED, __HIP_MEMORY_SCOPE_AGENT);
        if (wid == 0) {
            bool dead = false; const unsigned long long t0 = __builtin_amdgcn_s_memrealtime();
            for (;;) {
                if ((unsigned)__builtin_amdgcn_readfirstlane(__hip_atomic_load(cnt + 64 * u.pm, __ATOMIC_RELAXED, __HIP_MEMORY_SCOPE_AGENT)) >= 32u) break;
                if (__builtin_amdgcn_s_memrealtime() - t0 > 2000000ull) { if (lane == 0) __hip_atomic_store(tmo, 1u, __ATOMIC_RELAXED, __HIP_MEMORY_SCOPE_AGENT); dead = true; break; }
                __builtin_amdgcn_s_sleep(2);
            }
            __builtin_amdgcn_fence(__ATOMIC_ACQUIRE, "agent");
            if (lane == 0) flag[0] = dead ? 1u : 0u;
        }
        asm volatile("s_waitcnt vmcnt(0) lgkmcnt(0)" ::: "memory"); __builtin_amdgcn_s_barrier(); asm volatile("" ::: "memory");
        const bool bad = flag[0] != 0u;
        if (lane < 32) { const unsigned* slot = xbuf + (size_t)(u.pm * BM + rowl) * 4; float q = 0.f;
#pragma unroll
            for (int t = 0; t < 4; ++t) q += __uint_as_float(__hip_atomic_load(slot + t, __ATOMIC_RELAXED, __HIP_MEMORY_SCOPE_AGENT));
            S[rowl] = 1.0f / sqrtf(q * (1.0f / 1024.0f) + 1e-6f); }
        asm volatile("s_waitcnt lgkmcnt(0)" ::: "memory"); __builtin_amdgcn_s_barrier(); asm volatile("" ::: "memory");
        const float qnan = __builtin_nanf("");
#pragma unroll
        for (int bj = 0; bj < 2; ++bj) { const int c = cl + bj * HALF; const f32x4 w0 = *(const f32x4*)(FW + c), w1 = *(const f32x4*)(FW + c + 4);
#pragma unroll
            for (int ai = 0; ai < 2; ++ai)
#pragma unroll
                for (int m = 0; m < 4; ++m) { const int rl = ai * HALF + wr * 64 + m * 16 + fr; const float r = S[rl];
                    f32x4 o0 = acc[ai][bj][m][0] * r * w0, o1 = acc[ai][bj][m][1] * r * w1;
                    if (bad) { o0 = (f32x4){qnan, qnan, qnan, qnan}; o1 = o0; }
                    float* op = OUT + (size_t)(u.pm * BM + rl) * 1024 + c; *(f32x4*)op = o0; *(f32x4*)(op + 4) = o1; } }
        asm volatile("s_waitcnt lgkmcnt(0)" ::: "memory"); __builtin_amdgcn_s_barrier(); asm volatile("" ::: "memory");
    }
};

struct RevOrder : StaticOrder { __device__ bool next(int i, Unit& u) const { const bool ok = StaticOrder::next(i, u); u.pm = (u.pm & ~31) | (31 - (u.pm & 31)); return ok; } };
template <class Epi, class Sched, bool ALIGN_EPI = false, bool SP2 = false>
__device__ __forceinline__ void gemm_phase(PG8_LAS unsigned char* lds, const Gemm g, const Sched& S, const Epi& E) {
    const int tid = threadIdx.x, wid = __builtin_amdgcn_readfirstlane(tid >> 6), lane = tid & 63, wr = wid >> 2, wc = wid & 3, fr = lane & 15, fq = lane >> 4;
    const int K = g.K, nt = K / BK;
    unsigned voffA[2], voffB[2];
#pragma unroll
    for (int i = 0; i < 2; ++i) { int R, C; stage_rc(tid * 16 + i * 8192, R, C); const int Rb = Epi::PERM ? ((R & ~31) + perm32(R & 31)) : R;
        voffA[i] = (unsigned)(R * K + C) * 2u; voffB[i] = (unsigned)(Rb * K + C) * 2u; }
    const size_t kstep = (size_t)(BK * 2);
    const size_t hstep = (size_t)HALF * K * 2;
    const size_t tstep = 2 * hstep;
    const unsigned ldsw = (unsigned)wid * 1024u;
    const int aoff = lds_byte(wr * 64 + fr, fq * 8), boff = lds_byte(wc * 32 + fr, fq * 8);
#define PG8_SA(b, h) (((b) * 2 + (h)) * HTB)
#define PG8_SB(b, h) ((4 + (b) * 2 + (h)) * HTB)
#define PG8_STAGE(bufoff, gbase, voff) do { _Pragma("unroll") for (int _i = 0; _i < 2; ++_i) \
        __builtin_amdgcn_global_load_lds((const unsigned*)((const char*)(gbase) + (voff)[_i]), (PG8_LAS unsigned*)(lds + (bufoff) + ldsw + _i * 8192), 16, 0, 0); } while (0)
#define PG8_LDA(dst, b, h) do { _Pragma("unroll") for (int m = 0; m < 4; ++m) _Pragma("unroll") for (int k = 0; k < 2; ++k) dst[m][k] = *(const PG8_LAS bf16x8*)(lds + PG8_SA(b, h) + aoff + m * 2048 + k * 1024); } while (0)
#define PG8_LDB(dst, b, h) do { _Pragma("unroll") for (int n = 0; n < 2; ++n) _Pragma("unroll") for (int k = 0; k < 2; ++k) dst[n][k] = *(const PG8_LAS bf16x8*)(lds + PG8_SB(b, h) + boff + n * 2048 + k * 1024); } while (0)
#define PG8_MMA(ai, bj, At, Bt) do { __builtin_amdgcn_s_setprio(1); _Pragma("unroll") for (int m = 0; m < 4; ++m) _Pragma("unroll") for (int n = 0; n < 2; ++n) _Pragma("unroll") for (int k = 0; k < 2; ++k) \
        acc[ai][bj][m][n] = __builtin_amdgcn_mfma_f32_16x16x32_bf16(Bt[n][k], At[m][k], acc[ai][bj][m][n], 0, 0, 0); __builtin_amdgcn_s_setprio(0); } while (0)
#define PG8_WAIT_V(n) asm volatile("s_waitcnt vmcnt(" #n ")" ::: "memory")
#define PG8_WAIT_L(n) asm volatile("s_waitcnt lgkmcnt(" #n ")" ::: "memory")
#define PG8_BAR __builtin_amdgcn_s_barrier()
#define PG8_SCHED __builtin_amdgcn_sched_barrier(0)
    Unit cur, nxt; int ui = 0;
    if (!S.next(0, cur)) return;
    f32x4 acc[2][2][4][2];
#pragma unroll
    for (int a = 0; a < 2; ++a)
#pragma unroll
        for (int b = 0; b < 2; ++b)
#pragma unroll
            for (int m = 0; m < 4; ++m)
#pragma unroll
                for (int n = 0; n < 2; ++n) acc[a][b][m][n] = (f32x4){0.f, 0.f, 0.f, 0.f};
    bf16x8 At[4][2], B0[2][2], B1[2][2];
    const char* cA = (const char*)g.A + (size_t)cur.pm * tstep; const char* cB = (const char*)g.Bt + (size_t)cur.pn * tstep;
    S.a_ready(cur);
    if constexpr (SP2) {
        PG8_STAGE(PG8_SB(0, 0), cB, voffB); PG8_STAGE(PG8_SB(0, 1), cB + hstep, voffB); PG8_STAGE(PG8_SA(0, 0), cA, voffA); PG8_STAGE(PG8_SA(0, 1), cA + hstep, voffA);
        if (wr == 1) PG8_BAR;
        PG8_WAIT_V(2); PG8_BAR;
        PG8_STAGE(PG8_SB(1, 0), cB + kstep, voffB); PG8_STAGE(PG8_SA(1, 0), cA + kstep, voffA); PG8_STAGE(PG8_SB(1, 1), cB + hstep + kstep, voffB);
        PG8_WAIT_V(6); PG8_BAR;
    } else {
        PG8_STAGE(PG8_SB(0, 0), cB, voffB); PG8_STAGE(PG8_SA(0, 0), cA, voffA); PG8_STAGE(PG8_SB(0, 1), cB + hstep, voffB); PG8_STAGE(PG8_SA(0, 1), cA + hstep, voffA);
        if (wr == 1) PG8_BAR;
        PG8_WAIT_V(4); PG8_BAR;
        PG8_STAGE(PG8_SB(1, 0), cB + kstep, voffB); PG8_STAGE(PG8_SA(1, 0), cA + kstep, voffA); PG8_STAGE(PG8_SB(1, 1), cB + hstep + kstep, voffB);
        PG8_WAIT_V(6); PG8_BAR;
    }
    for (;;) {
        const bool has_next = S.next(ui + 1, nxt);
        const char* nA = has_next ? (const char*)g.A + (size_t)nxt.pm * tstep : cA; const char* nB = has_next ? (const char*)g.Bt + (size_t)nxt.pn * tstep : cB;
        for (int t = 0; t < nt; t += 2) {
            const bool last = (t == nt - 2);
            const char* a1 = cA + (size_t)(t + 1) * kstep;
            const char* a2 = last ? nA : cA + (size_t)(t + 2) * kstep; const char* b2 = last ? nB : cB + (size_t)(t + 2) * kstep;
            const char* a3 = a2 + kstep; const char* b3 = b2 + kstep;
            if (last && has_next) S.a_ready(nxt);
            if constexpr (SP2) {
            PG8_LDB(B0, 0, 0); PG8_LDB(B1, 0, 1); PG8_SCHED; PG8_LDA(At, 0, 0); PG8_STAGE(PG8_SA(1, 1), a1 + hstep, voffA);
            PG8_WAIT_V(8); PG8_WAIT_L(0); PG8_BAR; PG8_MMA(0, 0, At, B0); PG8_MMA(0, 1, At, B1); PG8_BAR; PG8_SCHED;
            PG8_LDA(At, 0, 1); PG8_STAGE(PG8_SB(0, 0), b2, voffB); PG8_STAGE(PG8_SB(0, 1), b2 + hstep, voffB); PG8_STAGE(PG8_SA(0, 0), a2, voffA);
            PG8_WAIT_V(8); PG8_WAIT_L(0); PG8_BAR; PG8_MMA(1, 0, At, B0); PG8_MMA(1, 1, At, B1); PG8_BAR; PG8_SCHED;
            PG8_LDB(B0, 1, 0); PG8_LDB(B1, 1, 1); PG8_SCHED; PG8_LDA(At, 1, 0); PG8_STAGE(PG8_SA(0, 1), a2 + hstep, voffA);
            PG8_WAIT_V(8); PG8_WAIT_L(0); PG8_BAR; PG8_MMA(0, 0, At, B0); PG8_MMA(0, 1, At, B1); PG8_BAR; PG8_SCHED;
            PG8_LDA(At, 1, 1); PG8_STAGE(PG8_SB(1, 0), b3, voffB); PG8_STAGE(PG8_SB(1, 1), b3 + hstep, voffB); PG8_STAGE(PG8_SA(1, 0), a3, voffA);
            PG8_WAIT_V(8); PG8_WAIT_L(0); PG8_BAR; PG8_MMA(1, 0, At, B0); PG8_MMA(1, 1, At, B1); PG8_BAR; PG8_SCHED;
            } else {
            PG8_LDB(B0, 0, 0); PG8_SCHED; PG8_LDA(At, 0, 0); PG8_STAGE(PG8_SA(1, 1), a1 + hstep, voffA);
            PG8_WAIT_L(8); PG8_BAR; PG8_WAIT_L(0); PG8_MMA(0, 0, At, B0); PG8_BAR; PG8_SCHED;
            PG8_LDB(B1, 0, 1); PG8_STAGE(PG8_SB(0, 0), b2, voffB);
            PG8_BAR; PG8_WAIT_L(0); PG8_MMA(0, 1, At, B1); PG8_BAR;
            PG8_LDA(At, 0, 1); PG8_STAGE(PG8_SA(0, 0), a2, voffA);
            PG8_BAR; PG8_WAIT_L(0); PG8_MMA(1, 0, At, B0); PG8_BAR; PG8_SCHED;
            PG8_STAGE(PG8_SB(0, 1), b2 + hstep, voffB);
            PG8_WAIT_V(6); PG8_BAR; PG8_MMA(1, 1, At, B1); PG8_BAR;
            PG8_LDB(B0, 1, 0); PG8_SCHED; PG8_LDA(At, 1, 0); PG8_STAGE(PG8_SA(0, 1), a2 + hstep, voffA);
            PG8_WAIT_L(8); PG8_BAR; PG8_WAIT_L(0); PG8_MMA(0, 0, At, B0); PG8_BAR; PG8_SCHED;
            PG8_LDB(B1, 1, 1); PG8_STAGE(PG8_SB(1, 0), b3, voffB);
            PG8_BAR; PG8_WAIT_L(0); PG8_MMA(0, 1, At, B1); PG8_BAR;
            PG8_LDA(At, 1, 1); PG8_STAGE(PG8_SA(1, 0), a3, voffA);
            PG8_BAR; PG8_WAIT_L(0); PG8_MMA(1, 0, At, B0); PG8_BAR; PG8_SCHED;
            PG8_STAGE(PG8_SB(1, 1), b3 + hstep, voffB);
            PG8_WAIT_V(6); PG8_BAR; PG8_MMA(1, 1, At, B1); PG8_BAR;
            }
        }
        if constexpr (ALIGN_EPI) { if (wr == 0) PG8_BAR; }
        bool keep_acc = false;
#ifdef TSEL
        const unsigned long long te0_ = __builtin_amdgcn_s_memrealtime();
#endif
        if constexpr (Epi::CHAIN) { keep_acc = E.chain(acc, cur, wr, wc, fr, fq); S.done(cur); }
        else if constexpr (!Epi::AFTER_DRAIN) { E(acc, cur, wr, wc, fr, fq); S.done(cur); }
#ifdef TSEL
        if (threadIdx.x == 0) { ((PG8_LAS unsigned*)(lds + 162816))[53] += (unsigned)(__builtin_amdgcn_s_memrealtime() - te0_); ((PG8_LAS unsigned*)(lds + 162816))[60 + ((PG8_LAS unsigned*)(lds + 162816))[54]] += (unsigned)(__builtin_amdgcn_s_memrealtime() - te0_); }
#endif
        if (!has_next) break;
        if (!keep_acc)
#pragma unroll
        for (int a = 0; a < 2; ++a)
#pragma unroll
            for (int b = 0; b < 2; ++b)
#pragma unroll
                for (int m = 0; m < 4; ++m)
#pragma unroll
                    for (int n = 0; n < 2; ++n) acc[a][b][m][n] = (f32x4){0.f, 0.f, 0.f, 0.f};
        cur = nxt; cA = nA; cB = nB; ++ui;
        if constexpr (ALIGN_EPI) { if (wr == 1) PG8_BAR; }
    }
    PG8_WAIT_V(0);
    if constexpr (!ALIGN_EPI) { if (wr == 0) PG8_BAR; }
    PG8_BAR;
    if constexpr (Epi::AFTER_DRAIN) { E.fused(acc, cur, wr, wc, fr, fq, lds, wid, lane); S.done(cur); }
#undef PG8_SA
#undef PG8_SB
#undef PG8_STAGE
#undef PG8_LDA
#undef PG8_LDB
#undef PG8_MMA
#undef PG8_WAIT_V
#undef PG8_WAIT_L
#undef PG8_BAR
#undef PG8_SCHED
}
}
#ifndef PG8_SP2
#define PG8_SP2 true
#endif
#ifndef PG8_ALIGN
#define PG8_ALIGN true
#endif

constexpr int NWAVES = 8;
#ifndef MK_N_LAUNCHES
#define MK_N_LAUNCHES 1
#endif
constexpr int N_PHASES = 11;
#ifndef MK_FUSE_P9
#define MK_FUSE_P9 0
#endif
constexpr int N_LAUNCHES = MK_N_LAUNCHES;
static_assert(N_LAUNCHES == 1 || N_LAUNCHES == N_PHASES, "MK_N_LAUNCHES is 1 or N_PHASES");

constexpr int NB = 8, SEQ = 8192, D = 1024, M = NB * SEQ;
constexpr int NPROJ = 4680, NPROJ_PAD = 4864, FF = 2816, NGU = 2 * FF;
constexpr float EPS = 1e-6f;

constexpr size_t MiB = 1u << 20;
constexpr size_t WS_CTL = 0, CTL_ZERO_BYTES = 1 * MiB;
constexpr size_t WS_MOD = 1 * MiB;
constexpr size_t WS_LB = WS_MOD + 256 * 1024;
constexpr size_t WS_CW2 = WS_MOD + 320 * 1024;
constexpr size_t WS_BGU = WS_MOD + 512 * 1024;
constexpr size_t WS_WIN = 3 * MiB, WS_WQ = 13 * MiB, WS_WBA = 14 * MiB, WS_WBR = 15 * MiB, WS_WOUT = 16 * MiB, WS_WGU = 18 * MiB, WS_WD = 29 * MiB;
constexpr size_t WS_CQSS = 35 * MiB, WS_X1SS = 36 * MiB, WS_X2SS = 40 * MiB;
constexpr size_t WS_XN = 64 * MiB;
constexpr size_t WS_CQ = 192 * MiB, WS_KV = 224 * MiB, WS_KI = 256 * MiB, WS_WI = 264 * MiB;
constexpr size_t WS_V8 = 56 * MiB;
constexpr size_t WS_K8 = 48 * MiB;
constexpr size_t WS_RQ = 272 * MiB, WS_RGL = 336 * MiB, WS_RI = 400 * MiB, WS_RGS = 464 * MiB;
constexpr size_t WS_Q = 528 * MiB, WS_QI = 592 * MiB;
constexpr size_t WS_ATT = 64 * MiB, WS_REC = 128 * MiB;
constexpr size_t WS_SCR = 656 * MiB;
constexpr size_t WS_OLOC = 784 * MiB, WS_QHAT = 848 * MiB, WS_U = 912 * MiB, WS_DS = 928 * MiB;
constexpr size_t WS_MIX = 896 * MiB;
constexpr size_t WS_X1 = 64 * MiB, WS_XS = 320 * MiB, WS_HID = 448 * MiB;
constexpr size_t WS_END = 1024 * MiB;
static_assert(WS_REC == WS_ATT + 64 * MiB && WS_WBR == WS_WBA + 1 * MiB, "the chained branch GEMM views [attn ; rec] and [Wa ; Wr] as one operand each");
static_assert(WS_RGL == WS_RQ + 64 * MiB && WS_RI == WS_RQ + 128 * MiB && WS_RGS == WS_RQ + 192 * MiB && WS_QI == WS_Q + 64 * MiB, "epilogue pointer arithmetic");
static_assert(WS_HID + (size_t)M * FF * 2 <= WS_END && WS_DS + 256 * 128 * 4 <= WS_END, "map");

constexpr int CW_TMO = 0, CW_CODE = 1;
constexpr int CW_BAR = 4096;
constexpr int CW_PANEL = 16384;
constexpr size_t WS_XCHG = 44 * MiB;

constexpr int RING_OFF = 0, RING_BYTES = 131072;
constexpr int LDS_BYTES = 163840;
constexpr int LDSCTL_OFF = LDS_BYTES - 1024, MISC_OFF = LDSCTL_OFF + 320;
static_assert(MISC_OFF + 128 <= LDS_BYTES, "LDS map");

#define GAS __attribute__((address_space(1)))
#define LAS __attribute__((address_space(3)))
typedef unsigned short bf16;
typedef unsigned v4u __attribute__((ext_vector_type(4)));
typedef unsigned v2u __attribute__((ext_vector_type(2)));
typedef float f32x4 __attribute__((ext_vector_type(4)));
typedef float f32x16 __attribute__((ext_vector_type(16)));
typedef short bf16x8 __attribute__((ext_vector_type(8)));
typedef GAS unsigned gu32;
#define RLX_AGENT __ATOMIC_RELAXED, __HIP_MEMORY_SCOPE_AGENT
#define LDS_WAIT() asm volatile("s_waitcnt lgkmcnt(0)" ::: "memory")
#define VM_WAIT() asm volatile("s_waitcnt vmcnt(0)" ::: "memory")
typedef float f32x2_t __attribute__((ext_vector_type(2)));
typedef __bf16 bf16x2_t __attribute__((ext_vector_type(2)));
typedef _Float16 half2_t __attribute__((ext_vector_type(2)));
typedef short short2_t __attribute__((ext_vector_type(2)));
__device__ __forceinline__ unsigned pk2(float lo, float hi) { const f32x2_t v = {lo, hi}; const bf16x2_t b = __builtin_convertvector(v, bf16x2_t); return __builtin_bit_cast(unsigned, b); }
__device__ __forceinline__ unsigned f2bf(float f) { return pk2(f, 0.f) & 0xffffu; }
__device__ __forceinline__ float bflo(unsigned u) { return __builtin_bit_cast(float, u << 16); }
__device__ __forceinline__ float bfhi(unsigned u) { return __builtin_bit_cast(float, u & 0xffff0000u); }
__device__ __forceinline__ float bf1(bf16 h) { return __builtin_bit_cast(float, (unsigned)h << 16); }

#define XB_TMO      128
#define XB_XCNT(j)  (256  + 64 * (j))
#define XB_XSUB(j)  (1280 + 64 * (j))
#define XB_XGEN(j)  (2304 + 64 * (j))
#define XB_TOP      3328
#define XB_TOPGEN   3392
#define XCD_BAR_WORDS 3456
#define XB_SPIN_CAP (1u << 23)

__device__ __forceinline__ unsigned xb_ld(unsigned* p)              { return __hip_atomic_load(p, __ATOMIC_RELAXED, __HIP_MEMORY_SCOPE_AGENT); }
__device__ __forceinline__ unsigned xb_add(unsigned* p, unsigned v) { return __hip_atomic_fetch_add(p, v, __ATOMIC_RELAXED, __HIP_MEMORY_SCOPE_AGENT); }
__device__ __forceinline__ unsigned xb_xcc_id() { return (unsigned)__builtin_amdgcn_s_getreg((3 << 11) | 20) & 0xFu; }
#define XB_SPIN(cond, bar) do { unsigned _sp = 0; while (cond) { __builtin_amdgcn_s_sleep(1); \
    if ((++_sp & 255u) == 0u) { if (xb_ld(&(bar)[XB_TMO])) break; if (_sp > XB_SPIN_CAP) { atomicAdd(&(bar)[XB_TMO], 1u); break; } } } } while (0)

struct XcdBarrier { unsigned* bar; unsigned x; volatile LAS unsigned* st; };

__device__ __forceinline__ XcdBarrier xcd_barrier_post(unsigned* bar, volatile LAS unsigned* st) {
    XcdBarrier b; b.bar = bar; b.x = xb_xcc_id(); b.st = st;
    if (threadIdx.x == 0) (void)xb_add(&bar[XB_XCNT(b.x)], 1u);
    return b;
}
__device__ __forceinline__ void xcd_barrier_complete(unsigned* bar, unsigned x, unsigned& nloc, unsigned& nx) {
    const unsigned G = gridDim.x * gridDim.y * gridDim.z;
    unsigned sum, cnt, mine, sp = 0u;
    for (;;) {
        sum = 0u; cnt = 0u; mine = 0u;
#pragma unroll
        for (unsigned j = 0; j < 16; ++j) { const unsigned c = xb_ld(&bar[XB_XCNT(j)]); sum += c; cnt += (c > 0u) ? 1u : 0u; mine = (j == x) ? c : mine; }
        if (sum == G) break;
        __builtin_amdgcn_s_sleep(1);
        if ((++sp & 255u) == 0u) { if (xb_ld(&bar[XB_TMO])) break; if (sp > XB_SPIN_CAP) { atomicAdd(&bar[XB_TMO], 1u); break; } }
    }
    nloc = mine > 0u ? mine : 1u; nx = cnt > 0u ? cnt : 1u;
}
__device__ __forceinline__ void xcd_barrier(const XcdBarrier& b) {
    asm volatile("s_waitcnt vmcnt(0)" ::: "memory");
    __syncthreads();
    if (threadIdx.x == 0) {
        unsigned* bar = b.bar;
        __builtin_amdgcn_s_waitcnt(0);
        unsigned nloc = b.st[0], nx = b.st[1];
        if (nloc == 0u) { xcd_barrier_complete(bar, b.x, nloc, nx); b.st[0] = nloc; b.st[1] = nx; }
        const unsigned old = xb_add(&bar[XB_XSUB(b.x)], 1u);
        const unsigned gen = old / nloc;
        if (old + 1u == (gen + 1u) * nloc) {
            __builtin_amdgcn_fence(__ATOMIC_RELEASE, "agent");
            asm volatile("s_waitcnt vmcnt(0)" ::: "memory");
            const unsigned og = xb_add(&bar[XB_TOP], 1u);
            const unsigned tg = og / nx;
            if (og + 1u == (tg + 1u) * nx) xb_add(&bar[XB_TOPGEN], 1u);
            else XB_SPIN(xb_ld(&bar[XB_TOPGEN]) == tg, bar);
            __builtin_amdgcn_fence(__ATOMIC_ACQUIRE, "agent");
            xb_add(&bar[XB_XGEN(b.x)], 1u);
            asm volatile("s_waitcnt vmcnt(0)" ::: "memory");
        } else {
            XB_SPIN(xb_ld(&bar[XB_XGEN(b.x)]) == gen, bar);
            __builtin_amdgcn_fence(__ATOMIC_ACQUIRE, "agent");
            asm volatile("s_waitcnt vmcnt(0)" ::: "memory");
        }
    }
    __syncthreads();
}

struct Frame {
    LAS unsigned char* lds;
    volatile LAS unsigned* MISC;
    gu32* ctl;
    unsigned char* ws;
    int tid, lane, wave;
    int G;
    float* out;
};
__device__ __forceinline__ float wave_sum(float v) {
#pragma unroll
    for (int o = 1; o < 64; o <<= 1) v += __shfl_xor(v, o);
    return v;
}
__device__ __forceinline__ float wave_max(float v) {
#pragma unroll
    for (int o = 1; o < 64; o <<= 1) v = fmaxf(v, __shfl_xor(v, o));
    return v;
}

template <class SrcCol>
__device__ __forceinline__ void transpose_item(const float* W, int ldw, int K, bf16* WT, const float* ks, LAS float* scr, int item, int nblk, int lane, SrcCol src) {
    const int kb = item / nblk, nb = item % nblk, k0 = 64 * kb, n0 = 32 * nb;
    const float* Wp; const int sc = src(n0 + (lane & 31), Wp);
#pragma unroll 8
    for (int i = 0; i < 32; ++i) { const int kk = 2 * i + (lane >> 5); float v = 0.f; if (sc >= 0) { v = Wp[(size_t)(k0 + kk) * ldw + sc]; if (ks) v *= ks[k0 + kk]; } scr[kk * 33 + (lane & 31)] = v; }
    LDS_WAIT(); asm volatile("" ::: "memory");
    const int c = lane & 7;
#pragma unroll
    for (int j = 0; j < 4; ++j) { const int n = (lane >> 3) + 8 * j; const LAS float* s = scr + (8 * c) * 33 + n;
        v4u o; o.x = pk2(s[0 * 33], s[1 * 33]); o.y = pk2(s[2 * 33], s[3 * 33]); o.z = pk2(s[4 * 33], s[5 * 33]); o.w = pk2(s[6 * 33], s[7 * 33]);
        *(GAS v4u*)(WT + (size_t)(n0 + n) * K + k0 + 8 * c) = o; }
    LDS_WAIT(); asm volatile("" ::: "memory");
}
struct Args { const float* in[20]; float* out; unsigned char* ws; int ph_lo, ph_hi; };
template <class SrcCol>
__device__ __forceinline__ void gemv8(Frame& F, const LAS float* vec, int cpg, int ngrp, int ldw, SrcCol src, const float* bias, float* out, int ldo) {
    LAS float* red = (LAS float*)(F.lds + 32768);
    for (int jb = blockIdx.x; jb < ngrp; jb += F.G) {
        const int col = F.tid & 31, kg = F.tid >> 5; float a[8];
#pragma unroll
        for (int b = 0; b < 8; ++b) a[b] = 0.f;
        const float* Wp = nullptr; int sc = -1;
        if (col < cpg) sc = src(jb * cpg + col, Wp);
        if (sc >= 0) for (int k = kg * 64; k < kg * 64 + 64; ++k) { const float w = Wp[(size_t)k * ldw + sc];
#pragma unroll
            for (int b = 0; b < 8; ++b) a[b] += vec[b * 1024 + k] * w; }
#pragma unroll
        for (int b = 0; b < 8; ++b) red[(kg * 8 + b) * 32 + col] = a[b];
        __syncthreads();
        if (F.tid < 256) { const int b = F.tid >> 5, c2 = F.tid & 31;
            if (c2 < cpg) { float s = 0.f; for (int k2 = 0; k2 < 16; ++k2) s += red[(k2 * 8 + b) * 32 + c2]; const int jj = jb * cpg + c2; out[b * ldo + jj] = s + (bias ? bias[jj] : 0.f); } }
        __syncthreads();
    }
}
struct SrcWin { const float* W; __device__ __forceinline__ int operator()(int d, const float*& Wp) const { Wp = W; return d < 584 ? d : (d < 768 ? -1 : d - 184); } };
__device__ __forceinline__ const float* psel(const float* a, const float* b, bool takeb) { const unsigned long long x = (unsigned long long)a, y = (unsigned long long)b, m = takeb ? ~0ull : 0ull; return (const float*)(x ^ ((x ^ y) & m)); }
struct SrcWq { const float *Wa, *Wb; __device__ __forceinline__ int operator()(int d, const float*& Wp) const { Wp = psel(Wa, Wb, d >= 512); return d & 511; } };
struct SrcId { const float* W; __device__ __forceinline__ int operator()(int d, const float*& Wp) const { Wp = W; return d; } };
struct SrcGu { const float *Wg, *Wu; __device__ __forceinline__ int operator()(int d, const float*& Wp) const { const int t = d >> 8, w = d & 255; Wp = psel(Wg, Wu, w >= 128); return t * 128 + (w & 127); } };

__device__ __forceinline__ void p0_prologue(Frame& F, const Args& A) {
    LAS float* cact = (LAS float*)(F.lds);
    for (int i = F.tid; i < 8192; i += NWAVES * 64) { const float v = A.in[1][i]; cact[i] = v / (1.0f + __expf(-v)); }
    __syncthreads();
    gemv8(F, cact, 24, 256, 6144, SrcId{A.in[2]}, A.in[3], (float*)(F.ws + WS_MOD), 6144);
    if (blockIdx.x == 0) { const float* l = A.in[10]; float* LB = (float*)(F.ws + WS_LB);
        for (int c = F.tid; c < 512; c += NWAVES * 64) LB[c] = 1.0f / (1.0f + __expf(l[512 + c] - l[c])); }
    __syncthreads();
    LAS float* scr = (LAS float*)(F.lds + 49152 + F.wave * 8448);
    const int gw = blockIdx.x * NWAVES + F.wave, NGW = F.G * NWAVES;
    constexpr int I_IN = 16 * 152, I_Q = 4 * 32, I_BA = 8 * 32, I_BR = 8 * 32, I_O = 16 * 32, I_GU = 16 * 176, I_D = 44 * 32;
    constexpr int NITEMS = I_IN + I_Q + I_BA + I_BR + I_O + I_GU + I_D;
    for (int it = gw; it < NITEMS; it += NGW) {
        int r = it;
        if (r < I_IN) { transpose_item(A.in[5], NPROJ, 1024, (bf16*)(F.ws + WS_WIN), nullptr, scr, r, 152, F.lane, SrcWin{A.in[5]}); continue; } r -= I_IN;
        if (r < I_Q) { transpose_item(nullptr, 512, 256, (bf16*)(F.ws + WS_WQ), A.in[6], scr, r, 32, F.lane, SrcWq{A.in[7], A.in[8]}); continue; } r -= I_Q;
        if (r < I_BA) { transpose_item(nullptr, 1024, 512, (bf16*)(F.ws + WS_WBA), nullptr, scr, r, 32, F.lane, SrcId{A.in[12]}); continue; } r -= I_BA;
        if (r < I_BR) { transpose_item(nullptr, 1024, 512, (bf16*)(F.ws + WS_WBR), nullptr, scr, r, 32, F.lane, SrcId{A.in[13]}); continue; } r -= I_BR;
        if (r < I_O) { transpose_item(nullptr, 1024, 1024, (bf16*)(F.ws + WS_WOUT), nullptr, scr, r, 32, F.lane, SrcId{A.in[14]}); continue; } r -= I_O;
        if (r < I_GU) { transpose_item(nullptr, FF, 1024, (bf16*)(F.ws + WS_WGU), nullptr, scr, r, 176, F.lane, SrcGu{A.in[16], A.in[17]}); continue; } r -= I_GU;
        transpose_item(nullptr, 1024, FF, (bf16*)(F.ws + WS_WD), nullptr, scr, r, 32, F.lane, SrcId{A.in[18]});
    }
}

__device__ __forceinline__ void p1_norm(Frame& F, const Args& A) {
    const float* MOD = (const float*)(F.ws + WS_MOD);
    { float* CW2 = (float*)(F.ws + WS_CW2); const int g = blockIdx.x * (NWAVES * 64) + F.tid;
      if (g < 8192) { const int b = g >> 10, c = g & 1023; CW2[g] = A.in[15][c] * (1.0f + MOD[b * 6144 + 4096 + c]); } }
    { LAS float* sh2 = (LAS float*)(F.lds);
      for (int i = F.tid; i < 8192; i += NWAVES * 64) sh2[i] = MOD[(i >> 10) * 6144 + 3072 + (i & 1023)];
      __syncthreads();
      gemv8(F, sh2, 22, 256, FF, SrcGu{A.in[16], A.in[17]}, nullptr, (float*)(F.ws + WS_BGU), NGU); }
    const int gw = blockIdx.x * NWAVES + F.wave, NGW = F.G * NWAVES; bf16* XN = (bf16*)(F.ws + WS_XN);
    for (int m0 = gw; m0 < M; m0 += 4 * NGW) {
        f32x4 v[4][4]; float r[4];
#pragma unroll
        for (int k = 0; k < 4; ++k) { const int m = m0 + k * NGW < M ? m0 + k * NGW : m0; const GAS f32x4* xr = (const GAS f32x4*)(A.in[0] + (size_t)m * D) + F.lane;
#pragma unroll
            for (int j = 0; j < 4; ++j) v[k][j] = xr[64 * j]; }
#pragma unroll
        for (int k = 0; k < 4; ++k) { float s = 0.f;
#pragma unroll
            for (int j = 0; j < 4; ++j) s += (v[k][j].x * v[k][j].x + v[k][j].y * v[k][j].y) + (v[k][j].z * v[k][j].z + v[k][j].w * v[k][j].w);
            r[k] = 1.0f / sqrtf(wave_sum(s) * (1.0f / D) + EPS); }
#pragma unroll
        for (int k = 0; k < 4; ++k) { const int m = m0 + k * NGW; if (m < M) { const int b = m >> 13;
            GAS unsigned long long* o8 = (GAS unsigned long long*)(XN + (size_t)m * D) + F.lane;
#pragma unroll
            for (int j = 0; j < 4; ++j) { const int c = 4 * F.lane + 256 * j;
                const f32x4 w = *(const f32x4*)(A.in[4] + c), sc = *(const f32x4*)(MOD + b * 6144 + 1024 + c), sh = *(const f32x4*)(MOD + b * 6144 + c);
                const f32x4 y = v[k][j] * r[k] * w * (sc + 1.0f) + sh;
                o8[64 * j] = (unsigned long long)pk2(y.x, y.y) | ((unsigned long long)pk2(y.z, y.w) << 32); } } }
    }
}

constexpr int H_QC = 0, H_QB = 17408, H_K = 34816, H_KT = 78336, H_VT = 96768, H_PM = 115200, H_ST = 124416, H_BT = 159232, H_AL = 161280;
constexpr int HS128 = 272, HS64 = 144;
__device__ __forceinline__ unsigned short f2bfs(float f) { return (unsigned short)f2bf(f); }
__device__ __forceinline__ void hgrn_h1_unit(Frame& F, int unit) {
    const int b = unit >> 5, h = (unit >> 3) & 3, n = unit & 7;
    const int tid = F.tid, lane = F.lane, w = F.wave, c = tid & 127, bi = tid >> 7, l15 = lane & 15, l4 = lane >> 4;
    const size_t rowbase = (size_t)(b * SEQ + n * 1024) * 512 + h * 128;
    const bf16* RQ = (const bf16*)(F.ws + WS_RQ) + rowbase; const bf16* RGL = (const bf16*)(F.ws + WS_RGL) + rowbase; const bf16* RI = (const bf16*)(F.ws + WS_RI) + rowbase;
    bf16* OLOC = (bf16*)(F.ws + WS_OLOC) + rowbase; bf16* QHAT = (bf16*)(F.ws + WS_QHAT) + rowbase;
    LAS unsigned char* L = F.lds; LAS float* BT = (LAS float*)(L + H_BT); LAS float* AL = (LAS float*)(L + H_AL);
    f32x4 acc[8];
#pragma unroll
    for (int vb = 0; vb < 8; ++vb) acc[vb] = (f32x4){0.f, 0.f, 0.f, 0.f};
    float asup = 0.f;
    for (int i = tid; i < 64 * HS64 / 4; i += NWAVES * 64) ((LAS unsigned*)(L + H_PM))[i] = 0u;
    unsigned short gr[16], qr[16], vr[16];
#define H1_LOAD(CI) do { const size_t r0_ = (size_t)((CI) * 64 + bi * 16) * 512 + c; \
        _Pragma("unroll") for (int r = 0; r < 16; ++r) { gr[r] = RGL[r0_ + (size_t)r * 512]; qr[r] = RQ[r0_ + (size_t)r * 512]; vr[r] = RI[r0_ + (size_t)r * 512]; } } while (0)
    H1_LOAD(0);
#pragma unroll 1
    for (int ci = 0; ci < 16; ++ci) {
        const size_t r0 = (size_t)(ci * 64 + bi * 16) * 512 + c;
        float eg[16], qq[16], el[16];
        { float run = 0.f, prod = 1.f;
#pragma unroll
          for (int r = 0; r < 16; ++r) { const float g = bf1(gr[r]); run += g; eg[r] = __expf(g); prod *= eg[r]; el[r] = prod; qq[r] = bf1(qr[r]); }
          BT[bi * 128 + c] = run; }
        if (ci > 0) {
#pragma unroll
            for (int vb = 0; vb < 8; ++vb) { v2u o; o.x = pk2(acc[vb][0], acc[vb][1]); o.y = pk2(acc[vb][2], acc[vb][3]);
                *(LAS v2u*)(L + H_ST + (16 * vb + l15) * HS128 + (16 * w + 4 * l4) * 2) = o; } }
        { v4u v0, v1; v0.x = vr[0] | ((unsigned)vr[1] << 16); v0.y = vr[2] | ((unsigned)vr[3] << 16); v0.z = vr[4] | ((unsigned)vr[5] << 16); v0.w = vr[6] | ((unsigned)vr[7] << 16);
          v1.x = vr[8] | ((unsigned)vr[9] << 16); v1.y = vr[10] | ((unsigned)vr[11] << 16); v1.z = vr[12] | ((unsigned)vr[13] << 16); v1.w = vr[14] | ((unsigned)vr[15] << 16);
          *(LAS v4u*)(L + H_VT + c * HS64 + bi * 32) = v0; *(LAS v4u*)(L + H_VT + c * HS64 + bi * 32 + 16) = v1; }
        __syncthreads();
        const float b0 = BT[c], b1 = BT[128 + c], b2 = BT[256 + c], b3 = BT[384 + c];
        const float ab1 = b0, ab2 = b0 + b1, ab3 = ab2 + b2, alast = ab3 + b3;
        const float ab = bi == 0 ? 0.f : bi == 1 ? ab1 : bi == 2 ? ab2 : ab3;
        if (bi == 0) AL[c] = alast;
        const float eAb = __expf(ab), eSup = __expf(asup), fEnd = __expf(alast - ab);
        const float fK0 = __expf(0.f - ab), fK1 = __expf(ab1 - ab), fK2 = __expf(ab2 - ab), fK3 = __expf(ab3 - ab);
        unsigned kp[8];
#pragma unroll
        for (int r = 0; r < 16; ++r) { const int t = bi * 16 + r;
            const float qb = qq[r] * el[r], qc = qb * eAb, kk = 1.0f - eg[r], ki = kk * __builtin_amdgcn_rcpf(el[r]);
            *(LAS unsigned short*)(L + H_QC + t * HS128 + c * 2) = f2bfs(qc);
            QHAT[r0 + (size_t)r * 512] = f2bfs(qc * eSup);
            *(LAS unsigned short*)(L + H_QB + t * HS128 + c * 2) = f2bfs(qb);
            const unsigned ke = f2bf(ki * fEnd); if (r & 1) kp[r >> 1] |= ke << 16; else kp[r >> 1] = ke;
            if (bi <= 0) *(LAS unsigned short*)(L + H_K + (0 + t) * HS128 + c * 2) = f2bfs(ki * fK0);
            if (bi <= 1) *(LAS unsigned short*)(L + H_K + (16 + t) * HS128 + c * 2) = f2bfs(ki * fK1);
            if (bi <= 2) *(LAS unsigned short*)(L + H_K + (48 + t) * HS128 + c * 2) = f2bfs(ki * fK2);
            *(LAS unsigned short*)(L + H_K + (96 + t) * HS128 + c * 2) = f2bfs(ki * fK3); }
        *(LAS v4u*)(L + H_KT + c * HS64 + bi * 32) = (v4u){kp[0], kp[1], kp[2], kp[3]}; *(LAS v4u*)(L + H_KT + c * HS64 + bi * 32 + 16) = (v4u){kp[4], kp[5], kp[6], kp[7]};
        asup += alast;
        if (ci + 1 < 16) H1_LOAD(ci + 1);
        __syncthreads();
#pragma unroll
        for (int rep = 0; rep < 2; ++rep) { const int tile = w + 8 * rep;
            if (tile < 10) { const int i = tile < 1 ? 0 : tile < 3 ? 1 : tile < 6 ? 2 : 3, j = tile - (i * (i + 1)) / 2;
                const LAS unsigned char* ap = L + H_QB + (16 * i + l15) * HS128 + l4 * 16; const LAS unsigned char* bp = L + H_K + (8 * i * (i + 1) + 16 * j + l15) * HS128 + l4 * 16;
                f32x4 p = (f32x4){0.f, 0.f, 0.f, 0.f};
#pragma unroll
                for (int ks = 0; ks < 4; ++ks) p = __builtin_amdgcn_mfma_f32_16x16x32_bf16(*(const LAS bf16x8*)(ap + ks * 64), *(const LAS bf16x8*)(bp + ks * 64), p, 0, 0, 0);
#pragma unroll
                for (int r = 0; r < 4; ++r) { const float pv = (i == j && l15 > 4 * l4 + r) ? 0.f : p[r];
                    *(LAS unsigned short*)(L + H_PM + (16 * i + 4 * l4 + r) * HS64 + (16 * j + l15) * 2) = f2bfs(pv); } } }
        __syncthreads();
#pragma unroll
        for (int tb = 0; tb < 4; ++tb) { f32x4 o = (f32x4){0.f, 0.f, 0.f, 0.f};
#pragma unroll
            for (int ks = 0; ks < 2; ++ks) if (32 * ks < 16 * (tb + 1))
                o = __builtin_amdgcn_mfma_f32_16x16x32_bf16(*(const LAS bf16x8*)(L + H_VT + (16 * w + l15) * HS64 + l4 * 16 + ks * 64), *(const LAS bf16x8*)(L + H_PM + (16 * tb + l15) * HS64 + l4 * 16 + ks * 64), o, 0, 0, 0);
            if (ci > 0) {
#pragma unroll
                for (int ks = 0; ks < 4; ++ks)
                    o = __builtin_amdgcn_mfma_f32_16x16x32_bf16(*(const LAS bf16x8*)(L + H_ST + (16 * w + l15) * HS128 + l4 * 16 + ks * 64), *(const LAS bf16x8*)(L + H_QC + (16 * tb + l15) * HS128 + l4 * 16 + ks * 64), o, 0, 0, 0); }
            v2u ov; ov.x = pk2(o[0], o[1]); ov.y = pk2(o[2], o[3]);
            *(v2u*)(OLOC + (size_t)(ci * 64 + 16 * tb + l15) * 512 + 16 * w + 4 * l4) = ov; }
        { const f32x4 dv = *(const LAS f32x4*)(AL + 16 * w + 4 * l4); const f32x4 d = (f32x4){__expf(dv[0]), __expf(dv[1]), __expf(dv[2]), __expf(dv[3])};
          const bf16x8 ka0 = *(const LAS bf16x8*)(L + H_KT + (16 * w + l15) * HS64 + l4 * 16), ka1 = *(const LAS bf16x8*)(L + H_KT + (16 * w + l15) * HS64 + l4 * 16 + 64);
#pragma unroll
          for (int vb = 0; vb < 8; ++vb) { f32x4 s = acc[vb] * d;
              s = __builtin_amdgcn_mfma_f32_16x16x32_bf16(ka0, *(const LAS bf16x8*)(L + H_VT + (16 * vb + l15) * HS64 + l4 * 16), s, 0, 0, 0);
              s = __builtin_amdgcn_mfma_f32_16x16x32_bf16(ka1, *(const LAS bf16x8*)(L + H_VT + (16 * vb + l15) * HS64 + l4 * 16 + 64), s, 0, 0, 0);
              acc[vb] = s; } }
        __syncthreads();
    }
#undef H1_LOAD
    f32x4* U = (f32x4*)(F.ws + WS_U);
#pragma unroll
    for (int vb = 0; vb < 8; ++vb) U[(size_t)((unit * 8 + w) * 8 + vb) * 64 + lane] = acc[vb];
    if (bi == 0) ((float*)(F.ws + WS_DS))[unit * 128 + c] = __expf(asup);
}
__device__ __forceinline__ void hgrn_h3_unit(Frame& F, const Args& A, int unit) {
    const int b = unit >> 5, h = (unit >> 3) & 3, n = unit & 7;
    const int lane = F.lane, w = F.wave, l15 = lane & 15, l4 = lane >> 4;
    LAS unsigned char* L = F.lds;
    const f32x4* U = (const f32x4*)(F.ws + WS_U); const float* DS = (const float*)(F.ws + WS_DS);
    f32x4 S[8];
#pragma unroll
    for (int vb = 0; vb < 8; ++vb) S[vb] = (f32x4){0.f, 0.f, 0.f, 0.f};
    for (int m = 0; m < n; ++m) { const int um = unit - n + m; const f32x4 d = *(const f32x4*)(DS + um * 128 + 16 * w + 4 * l4);
#pragma unroll
        for (int vb = 0; vb < 8; ++vb) S[vb] = S[vb] * d + U[(size_t)((um * 8 + w) * 8 + vb) * 64 + lane]; }
#pragma unroll
    for (int vb = 0; vb < 8; ++vb) { v2u o; o.x = pk2(S[vb][0], S[vb][1]); o.y = pk2(S[vb][2], S[vb][3]);
        *(LAS v2u*)(L + H_ST + (16 * vb + l15) * HS128 + (16 * w + 4 * l4) * 2) = o; }
    __syncthreads();
    const size_t rowbase = (size_t)(b * SEQ + n * 1024 + 128 * w) * 512 + h * 128;
    const bf16* QHAT = (const bf16*)(F.ws + WS_QHAT) + rowbase; const bf16* OLOC = (const bf16*)(F.ws + WS_OLOC) + rowbase;
    const bf16* RGS = (const bf16*)(F.ws + WS_RGS) + rowbase; bf16* REC = (bf16*)(F.ws + WS_REC) + rowbase;
    f32x4 rw[8];
#pragma unroll
    for (int vb = 0; vb < 8; ++vb) rw[vb] = *(const f32x4*)(A.in[11] + 16 * vb + 4 * l4);
#pragma unroll 1
    for (int tb = 0; tb < 8; ++tb) { const size_t tr = (size_t)(16 * tb + l15) * 512;
        bf16x8 qh[4];
#pragma unroll
        for (int ks = 0; ks < 4; ++ks) qh[ks] = *(const bf16x8*)(QHAT + tr + 32 * ks + 8 * l4);
        const int doff = 16 * (l4 & 1) + 8 * (l4 >> 1);
        v2u olp[8], gp[8];
#pragma unroll
        for (int p = 0; p < 4; ++p) { const v4u lo4 = *(const v4u*)(OLOC + tr + 32 * p + doff), lg4 = *(const v4u*)(RGS + tr + 32 * p + doff);
            auto sx = __builtin_amdgcn_permlane16_swap(lo4.x, lo4.z, false, false); auto sy = __builtin_amdgcn_permlane16_swap(lo4.y, lo4.w, false, false);
            olp[2 * p] = (v2u){sx[0], sy[0]}; olp[2 * p + 1] = (v2u){sx[1], sy[1]};
            auto tx = __builtin_amdgcn_permlane16_swap(lg4.x, lg4.z, false, false); auto ty = __builtin_amdgcn_permlane16_swap(lg4.y, lg4.w, false, false);
            gp[2 * p] = (v2u){tx[0], ty[0]}; gp[2 * p + 1] = (v2u){tx[1], ty[1]}; }
        f32x4 o[8]; float ss = 0.f;
#pragma unroll
        for (int vb = 0; vb < 8; ++vb) { f32x4 a = (f32x4){0.f, 0.f, 0.f, 0.f};
            if (n > 0) {
#pragma unroll
                for (int ks = 0; ks < 4; ++ks) a = __builtin_amdgcn_mfma_f32_16x16x32_bf16(*(const LAS bf16x8*)(L + H_ST + (16 * vb + l15) * HS128 + l4 * 16 + ks * 64), qh[ks], a, 0, 0, 0); }
            const v2u ol = olp[vb];
            a[0] += bflo(ol.x); a[1] += bfhi(ol.x); a[2] += bflo(ol.y); a[3] += bfhi(ol.y);
            o[vb] = a; ss += (a[0] * a[0] + a[1] * a[1]) + (a[2] * a[2] + a[3] * a[3]); }
        ss += __shfl_xor(ss, 16); ss += __shfl_xor(ss, 32);
        const float r = 1.0f / sqrtf(ss * (1.0f / 128.0f) + EPS);
#pragma unroll
        for (int p = 0; p < 4; ++p) { v2u ov[2];
#pragma unroll
            for (int q = 0; q < 2; ++q) { const int vb = 2 * p + q; const v2u g = gp[vb]; const f32x4 y = o[vb] * r * rw[vb];
                ov[q].x = pk2(y[0] * bflo(g.x), y[1] * bfhi(g.x)); ov[q].y = pk2(y[2] * bflo(g.y), y[3] * bfhi(g.y)); }
            auto sx = __builtin_amdgcn_permlane16_swap(ov[0].x, ov[1].x, false, false); auto sy = __builtin_amdgcn_permlane16_swap(ov[0].y, ov[1].y, false, false);
            *(v4u*)(REC + tr + 32 * p + doff) = (v4u){sx[0], sy[0], sx[1], sy[1]}; }
    }
    __syncthreads();
}

__device__ __forceinline__ unsigned f2key(float x) {
    const _Float16 hh = (_Float16)x; const unsigned bits = (unsigned)__builtin_bit_cast(unsigned short, hh);
    return (bits & 0x8000u) ? (~bits & 0xffffu) : (bits | 0x8000u);
}
#ifdef TSEL
#ifndef TSUM
#define TSUM(T_) T_[TSEL]
#endif
#define TMARK(k) do { if (F.wave == 0) { const unsigned long long now_ = __builtin_amdgcn_s_memrealtime(); if (F.lane == 0) ((LAS unsigned*)(F.lds + LDSCTL_OFF))[k] += (unsigned)(now_ - tprev_); tprev_ = now_; } } while (0)
#else
#define TMARK(k) do {} while (0)
#endif
constexpr int DSA_VIMG = 73728;
constexpr int DSA_QCTR = 73600;
constexpr int DSA_BIAS = 69632;
constexpr int DSA_CAND = 147456, DSA_CAPC = 448;
typedef unsigned u32x4p __attribute__((ext_vector_type(4)));
__device__ __forceinline__ void dsa_unit(Frame& F, int b, int t0) {
    const int lane = F.lane, w = F.wave, qc = lane & 31, hf = lane >> 5;
    const bf16* KI = (const bf16*)(F.ws + WS_KI) + (size_t)b * SEQ * 64;
    const bf16* QI = (const bf16*)(F.ws + WS_QI) + (size_t)(b * SEQ + t0) * 512;
    const float* WI = (const float*)(F.ws + WS_WI) + (size_t)(b * SEQ + t0) * 8;
    unsigned short* scr = (unsigned short*)(F.ws + WS_SCR) + (size_t)blockIdx.x * (32 * 8192);
    const int nkb = t0 / 32 + 1;
#ifdef TSEL
    unsigned long long tprev_ = __builtin_amdgcn_s_memrealtime();
#endif
    LAS unsigned* hist = (LAS unsigned*)(F.lds);
    for (int i = F.tid; i < 4096; i += NWAVES * 64) ((LAS v4u*)hist)[i] = (v4u){0u, 0u, 0u, 0u};
    if (F.tid == 0) *(LAS unsigned*)(F.lds + DSA_QCTR) = 0u;
    __syncthreads();
    TMARK(0);
    {
        const int l15 = lane & 15, l4 = lane >> 4, qg = w >> 2, ql = 16 * qg + l15;
        bf16x8 qf[8][2]; float wv[8];
#pragma unroll
        for (int h = 0; h < 8; ++h) { wv[h] = WI[ql * 8 + h];
#pragma unroll
            for (int ks = 0; ks < 2; ++ks) qf[h][ks] = *(const bf16x8*)(QI + (size_t)ql * 512 + h * 64 + ks * 32 + l4 * 8); }
        const int lim = t0 + ql - 4 * l4;
        LAS unsigned* hrow = hist + ql * 512;
        float wh[8];
#pragma unroll
        for (int h = 0; h < 8; ++h) wh[h] = 0.5f * wv[h];
        bf16x8 qs[2];
#pragma unroll
        for (int ks = 0; ks < 2; ++ks) { unsigned pk[4];
#pragma unroll
            for (int j = 0; j < 8; j += 2) { float e0 = 0.f, e1 = 0.f;
#pragma unroll
                for (int h = 0; h < 8; ++h) { e0 += wh[h] * bf1((unsigned short)qf[h][ks][j]); e1 += wh[h] * bf1((unsigned short)qf[h][ks][j + 1]); }
                pk[j >> 1] = pk2(e0, e1); }
            qs[ks] = __builtin_bit_cast(bf16x8, (v4u){pk[0], pk[1], pk[2], pk[3]}); }
        const int nb16 = 2 * nkb;
#define P1_LOAD(K0, K1, KB) do { const int row_ = (KB) * 16 + l15; const bf16* kp_ = KI + (size_t)(row_ < SEQ - 1 ? row_ : SEQ - 1) * 64 + l4 * 8; \
            asm volatile("global_load_dwordx4 %0, %2, off\n\tglobal_load_dwordx4 %1, %2, off offset:64" : "=&v"(K0), "=&v"(K1) : "v"(kp_) : "memory"); } while (0)
#define P1_COMPUTE(K0, K1, KB, OUT, MASK) do { const int s0_ = (KB) * 16; f32x4 sc_ = (f32x4){0.f, 0.f, 0.f, 0.f}; \
            sc_ = __builtin_amdgcn_mfma_f32_16x16x32_bf16(K0, qs[0], sc_, 0, 0, 0); sc_ = __builtin_amdgcn_mfma_f32_16x16x32_bf16(K1, qs[1], sc_, 0, 0, 0); \
            float e0_ = sc_[0], e1_ = sc_[1], e2_ = sc_[2], e3_ = sc_[3]; \
            _Pragma("unroll") for (int hg = 0; hg < 2; ++hg) { f32x4 a_[4];        \
                _Pragma("unroll") for (int i = 0; i < 4; ++i) a_[i] = __builtin_amdgcn_mfma_f32_16x16x32_bf16(K0, qf[4 * hg + i][0], (f32x4){0.f, 0.f, 0.f, 0.f}, 0, 0, 0); \
                _Pragma("unroll") for (int i = 0; i < 4; ++i) a_[i] = __builtin_amdgcn_mfma_f32_16x16x32_bf16(K1, qf[4 * hg + i][1], a_[i], 0, 0, 0); \
                __builtin_amdgcn_sched_group_barrier(0x008, 8, 0); \
                _Pragma("unroll") for (int i = 0; i < 4; ++i) { const float wq_ = wh[4 * hg + i]; \
                    e0_ = __builtin_fmaf(wq_, __builtin_fabsf(a_[i][0]), e0_); e1_ = __builtin_fmaf(wq_, __builtin_fabsf(a_[i][1]), e1_); \
                    e2_ = __builtin_fmaf(wq_, __builtin_fabsf(a_[i][2]), e2_); e3_ = __builtin_fmaf(wq_, __builtin_fabsf(a_[i][3]), e3_); \
                    asm("" : "+v"(e0_), "+v"(e1_), "+v"(e2_), "+v"(e3_)); } \
                __builtin_amdgcn_sched_group_barrier(0x002, 16, 0); } \
            const half2_t h01_ = __builtin_convertvector((f32x2_t){e0_, e1_}, half2_t), h23_ = __builtin_convertvector((f32x2_t){e2_, e3_}, half2_t); \
            const short2_t b01_ = __builtin_bit_cast(short2_t, h01_), b23_ = __builtin_bit_cast(short2_t, h23_); \
            unsigned k01_ = __builtin_bit_cast(unsigned, b01_) ^ (__builtin_bit_cast(unsigned, b01_ >> 15) | 0x80008000u), k23_ = __builtin_bit_cast(unsigned, b23_) ^ (__builtin_bit_cast(unsigned, b23_ >> 15) | 0x80008000u); \
            if (MASK) { k01_ &= (s0_ <= lim ? 0xffffu : 0u) | (s0_ + 1 <= lim ? 0xffff0000u : 0u); k23_ &= (s0_ + 2 <= lim ? 0xffffu : 0u) | (s0_ + 3 <= lim ? 0xffff0000u : 0u); } \
            unsigned b0_ = __builtin_amdgcn_ubfe(k01_, 7, 9), b1_ = k01_ >> 23, b2_ = __builtin_amdgcn_ubfe(k23_, 7, 9), b3_ = k23_ >> 23; asm("" : "+v"(b0_), "+v"(b1_), "+v"(b2_), "+v"(b3_));        \
            __hip_atomic_fetch_add(hrow + b0_, 1u, __ATOMIC_RELAXED, __HIP_MEMORY_SCOPE_WORKGROUP); __hip_atomic_fetch_add(hrow + b1_, 1u, __ATOMIC_RELAXED, __HIP_MEMORY_SCOPE_WORKGROUP); \
            __hip_atomic_fetch_add(hrow + b2_, 1u, __ATOMIC_RELAXED, __HIP_MEMORY_SCOPE_WORKGROUP); __hip_atomic_fetch_add(hrow + b3_, 1u, __ATOMIC_RELAXED, __HIP_MEMORY_SCOPE_WORKGROUP); \
            OUT.x = k01_; OUT.y = k23_; } while (0)
        {
        bf16x8 c0a, c0b, c1a, c1b, c2a, c2b, c3a, c3b, n0a, n0b, n1a, n1b, n2a, n2b, n3a, n3b;
        LAS unsigned char* stg = F.lds + DSA_VIMG + w * 9216;
        const int rrow = lane >> 3, rch = lane & 7;
        int kb = 4 * (w & 3);
        P1_LOAD(c0a, c0b, kb); P1_LOAD(c1a, c1b, kb + 1); P1_LOAD(c2a, c2b, kb + 2); P1_LOAD(c3a, c3b, kb + 3);
        asm volatile("s_waitcnt vmcnt(0)" : "+v"(c0a), "+v"(c0b), "+v"(c1a), "+v"(c1b), "+v"(c2a), "+v"(c2b), "+v"(c3a), "+v"(c3b) :: "memory");
        const int nfull = min(nb16, (t0 >> 4) + qg - 3);
#pragma unroll 1
        for (; kb < nfull; kb += 16) {
            P1_LOAD(n0a, n0b, kb + 16); P1_LOAD(n1a, n1b, kb + 17); P1_LOAD(n2a, n2b, kb + 18); P1_LOAD(n3a, n3b, kb + 19);
            v2u o0 = (v2u){0u, 0u}, o1 = o0, o2 = o0, o3 = o0;
            P1_COMPUTE(c0a, c0b, kb, o0, false);
            P1_COMPUTE(c1a, c1b, kb + 1, o1, false); P1_COMPUTE(c2a, c2b, kb + 2, o2, false); P1_COMPUTE(c3a, c3b, kb + 3, o3, false);
            TMARK(29);
            *(LAS v2u*)(stg + l15 * 144 + 8 * l4) = o0; *(LAS v2u*)(stg + l15 * 144 + 32 + 8 * l4) = o1; *(LAS v2u*)(stg + l15 * 144 + 64 + 8 * l4) = o2; *(LAS v2u*)(stg + l15 * 144 + 96 + 8 * l4) = o3;
            LDS_WAIT(); asm volatile("" ::: "memory");
            { const v4u lo = *(const LAS v4u*)(stg + rrow * 144 + rch * 16), hi = *(const LAS v4u*)(stg + (rrow + 8) * 144 + rch * 16);
              unsigned short* dst = scr + (size_t)(16 * qg + rrow) * 8192 + kb * 16 + rch * 8;
              *(v4u*)dst = lo; *(v4u*)(dst + 8 * 8192) = hi; }
            LDS_WAIT(); asm volatile("" ::: "memory");
            TMARK(27);
            asm volatile("s_waitcnt vmcnt(2)" : "+v"(n0a), "+v"(n0b), "+v"(n1a), "+v"(n1b), "+v"(n2a), "+v"(n2b), "+v"(n3a), "+v"(n3b) :: "memory");
            TMARK(28);
            c0a = n0a; c0b = n0b; c1a = n1a; c1b = n1b; c2a = n2a; c2b = n2b; c3a = n3a; c3b = n3b;
        }
#pragma unroll 1
        for (; kb < nb16; kb += 16) {
            P1_LOAD(n0a, n0b, kb + 16); P1_LOAD(n1a, n1b, kb + 17); P1_LOAD(n2a, n2b, kb + 18); P1_LOAD(n3a, n3b, kb + 19);
            v2u o0 = (v2u){0u, 0u}, o1 = o0, o2 = o0, o3 = o0;
            P1_COMPUTE(c0a, c0b, kb, o0, true);
            P1_COMPUTE(c1a, c1b, kb + 1, o1, true); P1_COMPUTE(c2a, c2b, kb + 2, o2, true); P1_COMPUTE(c3a, c3b, kb + 3, o3, true);
            TMARK(29);
            *(LAS v2u*)(stg + l15 * 144 + 8 * l4) = o0; *(LAS v2u*)(stg + l15 * 144 + 32 + 8 * l4) = o1; *(LAS v2u*)(stg + l15 * 144 + 64 + 8 * l4) = o2; *(LAS v2u*)(stg + l15 * 144 + 96 + 8 * l4) = o3;
            LDS_WAIT(); asm volatile("" ::: "memory");
            { const v4u lo = *(const LAS v4u*)(stg + rrow * 144 + rch * 16), hi = *(const LAS v4u*)(stg + (rrow + 8) * 144 + rch * 16);
              unsigned short* dst = scr + (size_t)(16 * qg + rrow) * 8192 + kb * 16 + rch * 8;
              *(v4u*)dst = lo; *(v4u*)(dst + 8 * 8192) = hi; }
            LDS_WAIT(); asm volatile("" ::: "memory");
            TMARK(27);
            asm volatile("s_waitcnt vmcnt(2)" : "+v"(n0a), "+v"(n0b), "+v"(n1a), "+v"(n1b), "+v"(n2a), "+v"(n2b), "+v"(n3a), "+v"(n3b) :: "memory");
            TMARK(28);
            c0a = n0a; c0b = n0b; c1a = n1a; c1b = n1b; c2a = n2a; c2b = n2b; c3a = n3a; c3b = n3b;
        }
        }
#undef P1_LOAD
#undef P1_COMPUTE
    }
    TMARK(1);
    __syncthreads();
    TMARK(2);
    LAS unsigned short* idxl = (LAS unsigned short*)(F.lds + 65536) + w * 256;
    const LAS float* btab = (const LAS float*)(F.lds + DSA_BIAS);
    const bf16* KV = (const bf16*)(F.ws + WS_KV) + (size_t)b * SEQ * 256;
    const unsigned char* K8 = F.ws + WS_K8 + (size_t)b * SEQ * 128; const unsigned char* V8 = F.ws + WS_V8 + (size_t)b * SEQ * 128;
    const int nk = nkb * 32, ndw = nk >> 1;
    LAS unsigned* qctr = (LAS unsigned*)(F.lds + DSA_QCTR);
#pragma unroll 1
    for (;;) {
        unsigned qi_ = 0u; if (lane == 0) qi_ = __hip_atomic_fetch_add(qctr, 1u, __ATOMIC_RELAXED, __HIP_MEMORY_SCOPE_WORKGROUP);
        qi_ = (unsigned)__builtin_amdgcn_readfirstlane((int)qi_); if (qi_ >= 32u) break;
        const int ql = 31 - (int)qi_, t = t0 + ql, nvalid = t + 1, nsel = nvalid < 256 ? nvalid : 256;
        const unsigned* rowd = (const unsigned*)(scr + (size_t)ql * 8192);
        int ln = lane; asm volatile("" : "+v"(ln));
        {
        unsigned rv[64];
#pragma unroll
        for (int j = 0; j < 64; ++j) { const unsigned val = rowd[j * 64 + ln]; rv[j] = (ln < ndw - j * 64) ? val : 0u; }
#ifdef TSEL
        asm volatile("s_waitcnt vmcnt(0)" ::: "memory"); TMARK(8);
#endif
        unsigned T = 0u; int need = 0; bool done = false;
        const unsigned long long lt = (1ull << ln) - 1ull; const int ln2 = 2 * ln;
        if (nvalid > 256) {
            const LAS unsigned* hq = hist + ql * 512 + 8 * ln;
            const v4u h0 = *(const LAS v4u*)(hq), h1 = *(const LAS v4u*)(hq + 4);
            const unsigned h8[8] = {h0.x, h0.y, h0.z, h0.w, h1.x, h1.y, h1.z, h1.w};
            const unsigned sl = (h0.x + h0.y) + (h0.z + h0.w) + (h1.x + h1.y) + (h1.z + h1.w);
            int Lb = 63; unsigned cum = 0u;
#pragma unroll 1
            for (;;) { const unsigned sLb = (unsigned)__builtin_amdgcn_readlane((int)sl, Lb); if (cum + sLb >= 256u || Lb == 0) break; cum += sLb; --Lb; }
            unsigned caL = 0u, cbL = 0u; int Bi = 0; bool found = false;
#pragma unroll
            for (int i = 7; i >= 0; --i) { const unsigned hb = (unsigned)__builtin_amdgcn_readlane((int)h8[i], Lb);
                if (!found && cum + hb >= 256u) { Bi = i; caL = cum; cbL = hb; found = true; } if (!found) cum += hb; }
            TMARK(9);
            const int B = 8 * Lb + Bi; const int ca = (int)caL, cb = (int)cbL;
            LAS unsigned* elst = (LAS unsigned*)(F.lds + DSA_VIMG + w * 9216);
            const unsigned Te = (unsigned)B << 7; const unsigned n0 = 65535u - (unsigned)ln2;
            int ec = 0; LAS unsigned char* elane = (LAS unsigned char*)(elst + ln);
#define DSA_COLLECT(KEXPR, K16, OFF) do { const bool e_ = (K16) >= Te; int es_ = e_ ? ec : 35; asm("" : "+v"(es_)); \
                *(LAS unsigned*)(elane + (es_ << 8)) = (KEXPR) | (n0 - (unsigned)(OFF)); ec = min(ec + (e_ ? 1 : 0), 35); } while (0)
#pragma unroll
            for (int g = 0; g < 8; ++g) if (g * 1024 < nk) {
#pragma unroll
                for (int j = 8 * g; j < 8 * g + 8; ++j) { DSA_COLLECT(rv[j] << 16, rv[j] & 0xffffu, 128 * j); DSA_COLLECT(rv[j] & 0xffff0000u, rv[j] >> 16, 128 * j + 1); } }
#undef DSA_COLLECT
            constexpr int NCV = 20;
            if (__ballot(ec > NCV) == 0ull) {
                LDS_WAIT(); asm volatile("" ::: "memory");
                TMARK(10);
                unsigned cv[NCV]; int emax = 0;
#pragma unroll
                for (int e = 0; e < NCV; ++e) { cv[e] = (e < ec) ? elst[e * 64 + ln] : 0u; if (__ballot(e < ec) != 0ull) emax = e + 1; }
                TMARK(11);
                const int needc = 256; unsigned pref = (unsigned)B << 23;
#define DSA_DESCENT(N) { int cntp = 0; _Pragma("unroll 1") for (int bit = 22; bit >= 16; --bit) { const unsigned c = pref | (1u << bit); int cnt = 0; \
                    _Pragma("unroll") for (int e = 0; e < (N); ++e) cnt += __popcll(__ballot(cv[e] >= c)); \
                    if (cnt >= needc) pref = c; } \
                    _Pragma("unroll") for (int e = 0; e < (N); ++e) cntp += __popcll(__ballot(cv[e] >= pref)); \
                    if (cntp != needc) { _Pragma("unroll 1") for (int bit = 15; bit >= 0; --bit) { const unsigned c = pref | (1u << bit); int cnt = 0; \
                        _Pragma("unroll") for (int e = 0; e < (N); ++e) cnt += __popcll(__ballot(cv[e] >= c)); \
                        if (cnt >= needc) pref = c; } } }
                if (emax <= 12) { DSA_DESCENT(12) } else if (emax <= 16) { DSA_DESCENT(16) } else { DSA_DESCENT(NCV) }
#undef DSA_DESCENT
                TMARK(12);
                int base = 0;
#pragma unroll
                for (int e = 0; e < NCV; ++e) if (e < emax) { const bool sl2 = cv[e] >= pref; const unsigned long long m = __ballot(sl2); const int pos = base + __popcll(m & lt);
                    if (sl2 && pos < 256) idxl[pos] = (unsigned short)(65535u - (cv[e] & 0xffffu)); base += __popcll(m); }
                done = true;
            } else {
#pragma unroll 1
                for (int bit = 15; bit >= 0; --bit) { const unsigned cand2 = T | (1u << bit); int c = 0;
#pragma unroll
                    for (int g = 0; g < 8; ++g) if (g * 1024 < nk) {
#pragma unroll
                        for (int j = 8 * g; j < 8 * g + 8; ++j) { c += ((rv[j] & 0xffffu) >= cand2) ? 1 : 0; c += ((rv[j] >> 16) >= cand2) ? 1 : 0; } }
#pragma unroll
                    for (int o = 1; o < 64; o <<= 1) c += __shfl_xor(c, o);
                    if (c >= 256) T = cand2; }
                int c = 0;
#pragma unroll
                for (int g = 0; g < 8; ++g) if (g * 1024 < nk) {
#pragma unroll
                    for (int j = 8 * g; j < 8 * g + 8; ++j) { c += ((rv[j] & 0xffffu) > T) ? 1 : 0; c += ((rv[j] >> 16) > T) ? 1 : 0; } }
#pragma unroll
                for (int o = 1; o < 64; o <<= 1) c += __shfl_xor(c, o);
                need = 256 - c;
            }
        }
        if (!done) {
            int base = 0, tiebase = 0;
#pragma unroll
            for (int g = 0; g < 8; ++g) if (g * 1024 < nk) {
#pragma unroll
                for (int j = 8 * g; j < 8 * g + 8; ++j) { const unsigned lo = rv[j] & 0xffffu, hi = rv[j] >> 16;
                    const bool el = lo == T, eh = hi == T; const unsigned long long mel = __ballot(el), meh = __ballot(eh);
                    const int trl = tiebase + __popcll(mel & lt) + __popcll(meh & lt), trh = trl + (el ? 1 : 0);
                    const bool sl = lo > T || (el && trl < need), sh = hi > T || (eh && trh < need);
                    const unsigned long long msl = __ballot(sl), msh = __ballot(sh);
                    const int pl = base + __popcll(msl & lt) + __popcll(msh & lt), ph = pl + (sl ? 1 : 0);
                    if (sl && pl < 256) idxl[pl] = (unsigned short)(ln2 + 128 * j); if (sh && ph < 256) idxl[ph] = (unsigned short)(ln2 + 128 * j + 1);
                    base += __popcll(msl) + __popcll(msh); tiebase += __popcll(mel) + __popcll(meh); __builtin_amdgcn_sched_barrier(0); } }
        }
        }
        LDS_WAIT(); asm volatile("" ::: "memory");
        TMARK(3);
        {
            int l15 = ln & 15, l4 = ln >> 4; asm volatile("" : "+v"(l15), "+v"(l4));
            const int l4x4 = 4 * l4;
#pragma unroll
            for (int jj = 0; jj < 4; ++jj) { if (ln >= nsel - 64 * jj) idxl[ln + 64 * jj] = 0; }
            LDS_WAIT(); asm volatile("" ::: "memory");
            unsigned short kidx[16];
#pragma unroll
            for (int blk = 0; blk < 16; ++blk) kidx[blk] = idxl[16 * blk + l15];
            int gq = ln >> 3, gp = ln & 7; asm volatile("" : "+v"(gq), "+v"(gp));
            unsigned short vidx0[4];
#pragma unroll
            for (int i = 0; i < 4; ++i) vidx0[i] = idxl[8 * i + gq];
            LDS_WAIT(); asm volatile("" ::: "memory");
            long bq[2][2];
            { const bf16* qp = (const bf16*)(F.ws + WS_Q) + (size_t)(b * SEQ + t) * 512 + (l15 & 7) * 64 + 16 * l4;
#pragma unroll
              for (int ks = 0; ks < 2; ++ks) { const bf16x8 v = *(const bf16x8*)(qp + 8 * ks);
                int w0 = __builtin_amdgcn_cvt_pk_fp8_f32(8.0f * bf1((unsigned short)v[0]), 8.0f * bf1((unsigned short)v[1]), 0, false); w0 = __builtin_amdgcn_cvt_pk_fp8_f32(8.0f * bf1((unsigned short)v[2]), 8.0f * bf1((unsigned short)v[3]), w0, true);
                int w1 = __builtin_amdgcn_cvt_pk_fp8_f32(8.0f * bf1((unsigned short)v[4]), 8.0f * bf1((unsigned short)v[5]), 0, false); w1 = __builtin_amdgcn_cvt_pk_fp8_f32(8.0f * bf1((unsigned short)v[6]), 8.0f * bf1((unsigned short)v[7]), w1, true);
                const long q8 = (long)(((unsigned long long)(unsigned)w1 << 32) | (unsigned long long)(unsigned)w0);
#pragma unroll
                for (int g = 0; g < 2; ++g) bq[g][ks] = ((l15 >> 2) != g) ? 0l : q8; } }
            f32x4 sa[16];
#pragma unroll
            for (int half = 0; half < 2; ++half) {
                v4u ka[8][2];
#pragma unroll
                for (int bl = 0; bl < 8; ++bl) { const unsigned char* kr = K8 + (size_t)kidx[8 * half + bl] * 128 + 16 * l4;
                    ka[bl][0] = *(const v4u*)kr; ka[bl][1] = *(const v4u*)(kr + 64); }
#pragma unroll
                for (int bl = 0; bl < 8; ++bl) { f32x4 acc = (f32x4){0.f, 0.f, 0.f, 0.f};
#pragma unroll
                    for (int g = 0; g < 2; ++g) { const v4u kq = ka[bl][g];
                        const long k0 = (long)(((unsigned long long)kq.y << 32) | (unsigned long long)kq.x), k1 = (long)(((unsigned long long)kq.w << 32) | (unsigned long long)kq.z);
                        acc = __builtin_amdgcn_mfma_f32_16x16x32_fp8_fp8(k0, bq[g][0], acc, 0, 0, 0); acc = __builtin_amdgcn_mfma_f32_16x16x32_fp8_fp8(k1, bq[g][1], acc, 0, 0, 0); }
                    sa[8 * half + bl] = acc; }
                asm volatile("" ::: "memory"); }
            v4u vbuf[2][4];
#pragma unroll
            for (int i = 0; i < 4; ++i) vbuf[0][i] = *(const v4u*)(V8 + (size_t)vidx0[i] * 128 + 16 * gp);
            TMARK(13);
            v2u sidx[16];
#pragma unroll
            for (int blk = 0; blk < 16; ++blk) sidx[blk] = *(const LAS v2u*)(idxl + 16 * blk + l4x4);
            LDS_WAIT(); asm volatile("" ::: "memory");
            float mx = -INFINITY; const LAS float* bt = btab + (l15 & 7);
            if (nsel == 256) {
#pragma unroll
                for (int hb = 0; hb < 2; ++hb) { float bv[8][4];
#pragma unroll
                    for (int b8 = 0; b8 < 8; ++b8)
#pragma unroll
                        for (int r = 0; r < 4; ++r) { const int blk = 8 * hb + b8; const unsigned sw = (r < 2) ? sidx[blk].x : sidx[blk].y; const int dist = t - (int)((r & 1) ? (sw >> 16) : (sw & 0xffffu));
                            bv[b8][r] = bt[(dist < 113 ? dist : 113) * 8]; }
                    LDS_WAIT(); asm volatile("" ::: "memory");
#pragma unroll
                    for (int b8 = 0; b8 < 8; ++b8)
#pragma unroll
                        for (int r = 0; r < 4; ++r) { const int blk = 8 * hb + b8; const float v = __builtin_fmaf(sa[blk][r], 0.125f, bv[b8][r]); sa[blk][r] = v; mx = fmaxf(mx, v); } }
            } else {
#pragma unroll
                for (int blk = 0; blk < 16; ++blk)
#pragma unroll
                    for (int r = 0; r < 4; ++r) { const unsigned sw = (r < 2) ? sidx[blk].x : sidx[blk].y; const int dist = t - (int)((r & 1) ? (sw >> 16) : (sw & 0xffffu));
                        const float bias = bt[(dist < 113 ? dist : 113) * 8];
                        const float v = (l4x4 < nsel - (16 * blk + r)) ? __builtin_fmaf(sa[blk][r], 0.125f, bias) : -INFINITY; sa[blk][r] = v; mx = fmaxf(mx, v); }
            }
            mx = fmaxf(mx, __shfl_xor(mx, 16)); mx = fmaxf(mx, __shfl_xor(mx, 32));
            float su = 0.f; const float mx8 = mx - 8.0f;
#pragma unroll
            for (int blk = 0; blk < 16; ++blk)
#pragma unroll
                for (int r = 0; r < 4; ++r) { const float e = __builtin_amdgcn_exp2f(sa[blk][r] - mx8); sa[blk][r] = e; su += e; }
            su += __shfl_xor(su, 16); su += __shfl_xor(su, 32);
            const float inv = 1.0f / su;
            TMARK(14);
            long pf[8];
#pragma unroll
            for (int ks = 0; ks < 8; ++ks) { int w0 = __builtin_amdgcn_cvt_pk_fp8_f32(sa[2 * ks][0], sa[2 * ks][1], 0, false); w0 = __builtin_amdgcn_cvt_pk_fp8_f32(sa[2 * ks][2], sa[2 * ks][3], w0, true);
                int w1 = __builtin_amdgcn_cvt_pk_fp8_f32(sa[2 * ks + 1][0], sa[2 * ks + 1][1], 0, false); w1 = __builtin_amdgcn_cvt_pk_fp8_f32(sa[2 * ks + 1][2], sa[2 * ks + 1][3], w1, true);
                asm volatile("" : "+v"(w0), "+v"(w1));
                pf[ks] = (long)(((unsigned long long)(unsigned)w1 << 32) | (unsigned long long)(unsigned)w0); }
            { unsigned short vi[4];
#pragma unroll
              for (int i = 0; i < 4; ++i) vi[i] = idxl[32 + 8 * i + gq];
              LDS_WAIT(); asm volatile("" ::: "memory");
#pragma unroll
              for (int i = 0; i < 4; ++i) vbuf[1][i] = *(const v4u*)(V8 + (size_t)vi[i] * 128 + 16 * gp); }
            f32x4 oa[2][4];
#pragma unroll
            for (int g = 0; g < 2; ++g)
#pragma unroll
                for (int c = 0; c < 4; ++c) oa[g][c] = (f32x4){0.f, 0.f, 0.f, 0.f};
            LAS unsigned char* vimg = F.lds + DSA_VIMG + w * 9216;
            const int trr = l15 >> 1, trs = trr < 4 ? l4x4 + trr : 12 + l4x4 + trr;
            const unsigned traddr = (unsigned)(size_t)(vimg + (trs & 15) * 80 + (trs >> 4) * 1312 + (l15 & 1) * 8);
            const unsigned wraddr = (unsigned)(size_t)(vimg + (gp >> 2) * 2624 + (gp & 3) * 16 + gq * 80);
#pragma unroll
            for (int ks = 0; ks < 8; ++ks) {
#pragma unroll
                for (int i = 0; i < 4; ++i) *(LAS v4u*)(size_t)(wraddr + (i >> 1) * 1312 + (i & 1) * 640) = vbuf[ks & 1][i];
                if (ks + 2 < 8) { unsigned short vi[4];
#pragma unroll
                    for (int i = 0; i < 4; ++i) vi[i] = idxl[32 * (ks + 2) + 8 * i + gq];
                    LDS_WAIT(); asm volatile("" ::: "memory");
#pragma unroll
                    for (int i = 0; i < 4; ++i) vbuf[ks & 1][i] = *(const v4u*)(V8 + (size_t)vi[i] * 128 + 16 * gp); }
                LDS_WAIT(); asm volatile("" ::: "memory");
                v2u tb[8];
                asm volatile("ds_read_b64_tr_b8 %0, %8 offset:0\n\tds_read_b64_tr_b8 %1, %8 offset:16\n\tds_read_b64_tr_b8 %2, %8 offset:32\n\tds_read_b64_tr_b8 %3, %8 offset:48\n\t"
                             "ds_read_b64_tr_b8 %4, %8 offset:2624\n\tds_read_b64_tr_b8 %5, %8 offset:2640\n\tds_read_b64_tr_b8 %6, %8 offset:2656\n\tds_read_b64_tr_b8 %7, %8 offset:2672\n\ts_waitcnt lgkmcnt(0)"
                             : "=&v"(tb[0]), "=&v"(tb[1]), "=&v"(tb[2]), "=&v"(tb[3]), "=&v"(tb[4]), "=&v"(tb[5]), "=&v"(tb[6]), "=&v"(tb[7])
                             : "v"(traddr) : "memory");
#pragma unroll
                for (int g = 0; g < 2; ++g)
#pragma unroll
                    for (int c = 0; c < 4; ++c) { const long vb = (long)(((unsigned long long)tb[4 * g + c].y << 32) | (unsigned long long)tb[4 * g + c].x);
                        oa[g][c] = __builtin_amdgcn_mfma_f32_16x16x32_fp8_fp8(pf[ks], vb, oa[g][c], 0, 0, 0); }
                asm volatile("" ::: "memory");
            }
            TMARK(15);
            bf16* orow = (bf16*)(F.ws + WS_ATT) + (size_t)(b * SEQ + t) * 512;
#pragma unroll
            for (int r = 0; r < 4; ++r) { const float i0 = __shfl(inv, r), i1 = __shfl(inv, 4 + r);
                if (l4 < 2) {
#pragma unroll
                    for (int c = 0; c < 4; ++c) { const float v = l4 == 0 ? oa[0][c][r] * i0 : oa[1][c][r] * i1; orow[(4 * l4 + r) * 64 + 16 * c + l15] = (bf16)f2bf(v); } } }
        }
        LDS_WAIT(); asm volatile("" ::: "memory");
        TMARK(4);
    }
    __syncthreads();
    TMARK(5);
}

__device__ __forceinline__ void p4_mixers(Frame& F, const Args& A) {
    for (int u = blockIdx.x; u < 256; u += F.G) hgrn_h1_unit(F, u);
    __syncthreads();
    { LAS float* bt = (LAS float*)(F.lds + DSA_BIAS);
      for (int i = F.tid; i < 114 * 8; i += NWAVES * 64) { const int n = i >> 3; int v = n; if (n >= 16) { v = 16 + (int)(__logf((float)n * (1.0f / 16.0f)) * (16.0f / 2.0794415416798357f)); v = v < 31 ? v : 31; }
          bt[i] = A.in[9][v * 8 + (i & 7)] * 1.4426950408889634f; }
      __syncthreads(); }
    for (int u = blockIdx.x, k = 0; u < 2048; u += F.G, ++k) { const int b = u & 7, sl = u >> 3, sm = (k & 1) ? ((sl & ~31) | (31 - (sl & 31))) : sl; dsa_unit(F, b, (255 - sm) * 32); }
}

__device__ __forceinline__ void p5_rec(Frame& F, const Args& A) { for (int u = blockIdx.x; u < 256; u += F.G) hgrn_h3_unit(F, A, u);
}

__device__ __forceinline__ void p10_final(Frame& F, const Args& A) {
    const int gw = blockIdx.x * NWAVES + F.wave, NGW = F.G * NWAVES; const float* SS = (const float*)(F.ws + WS_X2SS);
    f32x4 wv[4];
#pragma unroll
    for (int j = 0; j < 4; ++j) wv[j] = *(const f32x4*)(A.in[19] + 4 * F.lane + 256 * j);
    const bf16* X2 = (const bf16*)(F.ws + WS_XS);
    for (int m0 = gw; m0 < M; m0 += 4 * NGW) {
        v2u v[4][4]; float ss[4];
#pragma unroll
        for (int k = 0; k < 4; ++k) { const int m = m0 + k * NGW < M ? m0 + k * NGW : m0; ss[k] = F.lane < 16 ? SS[(size_t)m * 16 + F.lane] : 0.f;
            const v2u* xr = (const v2u*)(X2 + (size_t)m * D) + F.lane;
#pragma unroll
            for (int j = 0; j < 4; ++j) v[k][j] = xr[64 * j]; }
#pragma unroll
        for (int k = 0; k < 4; ++k) { const int m = m0 + k * NGW; const float r = 1.0f / sqrtf(wave_sum(ss[k]) * (1.0f / D) + EPS);
            if (m < M) { GAS f32x4* xo = (GAS f32x4*)(F.out + (size_t)m * D) + F.lane;
#pragma unroll
                for (int j = 0; j < 4; ++j) xo[64 * j] = (f32x4){bflo(v[k][j].x), bfhi(v[k][j].x), bflo(v[k][j].y), bfhi(v[k][j].y)} * r * wv[j]; } }
    }
}

__global__ void __launch_bounds__(NWAVES * 64, 2) fwd_kernel(Args args) {
    extern __shared__ __attribute__((aligned(16))) unsigned char lds[];
    Frame F;
    F.lds = (LAS unsigned char*)lds;
    F.MISC = (volatile LAS unsigned*)(F.lds + MISC_OFF);
    F.tid = threadIdx.x; F.lane = F.tid & 63; F.wave = __builtin_amdgcn_readfirstlane(F.tid >> 6);
    F.G = gridDim.x;
    F.ws = args.ws; F.ctl = (gu32*)(args.ws + WS_CTL); F.out = args.out;
    for (int u = F.tid; u < (LDS_BYTES - LDSCTL_OFF) / 4; u += NWAVES * 64) ((LAS unsigned*)(F.lds + LDSCTL_OFF))[u] = 0u;
    __syncthreads();
    XcdBarrier bar; bar.bar = (unsigned*)(F.ctl + CW_BAR); bar.x = 0; bar.st = nullptr;
    if (N_LAUNCHES == 1) bar = xcd_barrier_post((unsigned*)(F.ctl + CW_BAR), F.MISC + 8);
#ifdef TSEL
    unsigned long long tph_ = __builtin_amdgcn_s_memrealtime(); int phk_ = 0;
#define GRID_BAR() do { if (N_LAUNCHES == 1) { const unsigned long long t1_ = __builtin_amdgcn_s_memrealtime(); xcd_barrier(bar); const unsigned long long t2_ = __builtin_amdgcn_s_memrealtime(); \
        if (F.tid == 0) { ((LAS unsigned*)(F.lds + LDSCTL_OFF))[16 + phk_] += (unsigned)(t1_ - tph_); ((LAS unsigned*)(F.lds + LDSCTL_OFF))[40 + phk_] += (unsigned)(t2_ - t1_); ((LAS unsigned*)(F.lds + LDSCTL_OFF))[52] += (unsigned)(t2_ - t1_); } tph_ = t2_; ++phk_; } } while (0)
#else
#define GRID_BAR() do { if (N_LAUNCHES == 1) xcd_barrier(bar); } while (0)
#endif
    const int lo = args.ph_lo, hi = args.ph_hi;
#ifdef ONLY_PHASE
#define IN(k) ((k) == ONLY_PHASE && lo <= (k) && (k) < hi)
#else
#define IN(k) (lo <= (k) && (k) < hi)
#endif
#define BOTH(k) (IN(k) && IN((k) + 1))
    const float* MOD = (const float*)(F.ws + WS_MOD);

    if (IN(0)) { p0_prologue(F, args); if (BOTH(0)) GRID_BAR(); }
    if (IN(1)) { p1_norm(F, args); if (BOTH(1)) GRID_BAR(); }
    if (IN(2)) {
        pg8::Gemm g{(const bf16*)(F.ws + WS_XN), (const bf16*)(F.ws + WS_WIN), M, NPROJ_PAD, 1024}; pg8::StaticOrder S; S.init(M, NPROJ_PAD, F.G, (int)blockIdx.x);
        { LAS unsigned char* gt = F.lds + RING_BYTES;
          for (int i = F.tid; i < 2048; i += NWAVES * 64) { const float xg = ((float)(i - 1024) + 0.5f) * (1.0f / 128.0f); gt[i] = (unsigned char)(255.0f / (1.0f + __expf(-xg)) + 0.5f); }
          __syncthreads(); }
        pg8::EpiInProj E{(bf16*)(F.ws + WS_CQ), (bf16*)(F.ws + WS_KV), (bf16*)(F.ws + WS_KI), (bf16*)(F.ws + WS_RQ), (bf16*)F.out,
                         (float*)(F.ws + WS_WI), (float*)(F.ws + WS_CQSS), (const float*)(F.ws + WS_LB), F.ws + WS_K8, F.ws + WS_V8, (float)(RING_BYTES + 1024)};
        pg8::gemm_phase<pg8::EpiInProj, pg8::StaticOrder, PG8_ALIGN, PG8_SP2>(F.lds + RING_OFF, g, S, E);
        if (BOTH(2)) GRID_BAR();
    }
    if (IN(3)) {
        pg8::Gemm g{(const bf16*)(F.ws + WS_CQ), (const bf16*)(F.ws + WS_WQ), M, 1024, 256}; pg8::StaticOrder S; S.init(M, 1024, F.G, (int)blockIdx.x);
        pg8::EpiQ E{(bf16*)(F.ws + WS_Q), (const float*)(F.ws + WS_CQSS)};
        pg8::gemm_phase<pg8::EpiQ, pg8::StaticOrder, PG8_ALIGN, PG8_SP2>(F.lds + RING_OFF, g, S, E);
        if (BOTH(3)) GRID_BAR();
    }
#ifdef TSEL
    if (IN(4)) { const unsigned long long ta_ = __builtin_amdgcn_s_memrealtime(); p4_mixers(F, args); unsigned long long tb_ = __builtin_amdgcn_s_memrealtime(); if (F.tid == 0) ((LAS unsigned*)(F.lds + LDSCTL_OFF))[7] += (unsigned)(tb_ - ta_); if (BOTH(4)) GRID_BAR(); if (F.tid == 0) ((LAS unsigned*)(F.lds + LDSCTL_OFF))[6] += (unsigned)(__builtin_amdgcn_s_memrealtime() - tb_); }
#else
    if (IN(4)) { p4_mixers(F, args); if (BOTH(4)) GRID_BAR(); }
#endif
    if (IN(5)) { p5_rec(F, args); if (BOTH(5)) GRID_BAR(); }
    if (IN(6)) {
        pg8::ChainOrder S; S.init(M, 1024, F.G, (int)blockIdx.x);
        pg8::Gemm g{(const bf16*)(F.ws + WS_ATT), (const bf16*)(F.ws + WS_WBA), 2 * M, 2048, 512}; pg8::EpiBranchChain E{(bf16*)(F.ws + WS_MIX), (const bf16*)F.out};
        pg8::gemm_phase<pg8::EpiBranchChain, pg8::ChainOrder, PG8_ALIGN, PG8_SP2>(F.lds + RING_OFF, g, S, E);
        if (BOTH(6)) GRID_BAR();
    }
    if (IN(7)) {
        pg8::Gemm g{(const bf16*)(F.ws + WS_MIX), (const bf16*)(F.ws + WS_WOUT), M, 1024, 1024}; pg8::StaticOrder S; S.init(M, 1024, F.G, (int)blockIdx.x);
        pg8::EpiOut E{args.in[0], (bf16*)(F.ws + WS_X1), (bf16*)(F.ws + WS_XS), (float*)(F.ws + WS_X1SS), MOD, (const float*)(F.ws + WS_CW2)};
        pg8::gemm_phase<pg8::EpiOut, pg8::StaticOrder, PG8_ALIGN, PG8_SP2>(F.lds + RING_OFF, g, S, E);
        if (BOTH(7)) GRID_BAR();
    }
    if (IN(8)) {
        pg8::Gemm g{(const bf16*)(F.ws + WS_XS), (const bf16*)(F.ws + WS_WGU), M, NGU, 1024}; pg8::StaticOrder S; S.init(M, NGU, F.G, (int)blockIdx.x);
        int pm0 = 0; { const int nN_ = NGU / 256, nwg_ = (M / 256) * nN_; int wg_ = (int)blockIdx.x;
            if (wg_ < nwg_) { const int q_ = nwg_ / 8, r_ = nwg_ % 8, x_ = wg_ % 8, o_ = wg_ / 8; wg_ = (x_ < r_ ? x_ * (q_ + 1) : r_ * (q_ + 1) + (x_ - r_) * q_) + o_;
                const int nig_ = 8 * nN_, fm_ = (wg_ / nig_) * 8, gsz_ = (M / 256 - fm_) < 8 ? (M / 256 - fm_) : 8; pm0 = fm_ + ((wg_ % nig_) % gsz_); } }
        const int g0 = pm0 >> 3, pm7 = pm0 & 7;
        { LAS float* R2L = (LAS float*)(F.lds + RING_BYTES); const float* SS = (const float*)(F.ws + WS_X1SS);
          for (int i = F.tid; i < 1024; i += NWAVES * 64) { const int pm = 8 * (g0 + (i >> 8)) + pm7; float r = 0.f;
              if (pm < M / 256) { const float* p = SS + (size_t)(pm * 256 + (i & 255)) * 16; float s2 = 0.f;
#pragma unroll
                  for (int q = 0; q < 4; ++q) { const f32x4 t = *(const f32x4*)(p + 4 * q); s2 += (t[0] + t[1]) + (t[2] + t[3]); }
                  r = __builtin_amdgcn_rsqf(s2 * (1.0f / 1024.0f) + 1e-6f); }
              R2L[i] = r; }
          LAS float* BL = (LAS float*)(F.lds + RING_BYTES + 4096); const float* bsrc = (const float*)(F.ws + WS_BGU) + (pm0 >> 5) * NGU;
          for (int i = F.tid; i < NGU / 4; i += NWAVES * 64) ((LAS f32x4*)BL)[i] = ((const f32x4*)bsrc)[i];
          __syncthreads(); }
        pg8::EpiGateUp E{(bf16*)(F.ws + WS_HID), (const float*)(F.ws + WS_X1SS), (const float*)(F.ws + WS_BGU), (const LAS float*)(F.lds + RING_BYTES + 4096), pm0 >> 5, (const LAS float*)(F.lds + RING_BYTES), g0, pm7};
        pg8::gemm_phase<pg8::EpiGateUp, pg8::StaticOrder, PG8_ALIGN, PG8_SP2>(F.lds + RING_OFF, g, S, E);
        if (BOTH(8)) GRID_BAR();
    }
    if (IN(9)) {
        pg8::Gemm g{(const bf16*)(F.ws + WS_HID), (const bf16*)(F.ws + WS_WD), M, 1024, FF};
        if (MK_FUSE_P9 && F.G == 256 && N_LAUNCHES == 1) {
            pg8::EpiDownNorm E{(const bf16*)(F.ws + WS_X1), F.out, MOD, args.in[19], (unsigned*)(F.ws + WS_XCHG), (unsigned*)(F.ctl + CW_PANEL), (unsigned*)(F.ctl + CW_TMO)};
#pragma unroll 1
            for (int r = 0; r < 4; ++r) { pg8::OneUnit S; S.init(M, 1024, F.G, (int)blockIdx.x); S.round = r;
                pg8::gemm_phase<pg8::EpiDownNorm, pg8::OneUnit, false, PG8_SP2>(F.lds + RING_OFF, g, S, E); __syncthreads(); }
        } else {
            pg8::RevOrder S; S.init(M, 1024, F.G, (int)blockIdx.x);
            pg8::EpiDown E{(const bf16*)(F.ws + WS_X1), (bf16*)(F.ws + WS_XS), (float*)(F.ws + WS_X2SS), MOD};
            pg8::gemm_phase<pg8::EpiDown, pg8::RevOrder, PG8_ALIGN, PG8_SP2>(F.lds + RING_OFF, g, S, E);
            if (BOTH(9)) GRID_BAR();
        }
    }
    if (IN(10) && !(MK_FUSE_P9 && F.G == 256 && N_LAUNCHES == 1)) p10_final(F, args);
#ifdef TSEL
    if (F.tid == 0) ((LAS unsigned*)(F.lds + LDSCTL_OFF))[16 + phk_] += (unsigned)(__builtin_amdgcn_s_memrealtime() - tph_);
    __syncthreads();
    if (blockIdx.x == 0 && F.tid == 0) { const LAS unsigned* T_ = (const LAS unsigned*)(F.lds + LDSCTL_OFF); const unsigned ticks = TSUM(T_); const unsigned long long t0_ = __builtin_amdgcn_s_memrealtime(); while (__builtin_amdgcn_s_memrealtime() - t0_ < (unsigned long long)ticks) __builtin_amdgcn_s_sleep(8); }
#endif
#undef IN
#undef BOTH
}

extern "C" void kernel_launch(void* const* d_in, const int* in_sizes, int n_in, void* d_out, int out_size, void* d_ws, size_t ws_size, hipStream_t stream) {
    static int grid = 0;
    if (grid == 0) {
        if (n_in != 20 || in_sizes[0] != M * D || out_size != M * D || ws_size < WS_END) { fprintf(stderr, "kernel_launch: unexpected shapes (n_in %d, in0 %d, out %d, ws %zu); nothing launched\n", n_in, n_in > 0 ? in_sizes[0] : -1, out_size, ws_size); grid = -1; return; }
        int dev = 0, cus = 0, per_cu = 0;
        if (hipGetDevice(&dev) != hipSuccess || hipDeviceGetAttribute(&cus, hipDeviceAttributeMultiprocessorCount, dev) != hipSuccess) { grid = -1; return; }
        if (hipFuncSetAttribute((const void*)fwd_kernel, hipFuncAttributeMaxDynamicSharedMemorySize, LDS_BYTES) != hipSuccess) { fprintf(stderr, "kernel_launch: hipFuncSetAttribute failed\n"); grid = -1; return; }
        if (hipOccupancyMaxActiveBlocksPerMultiprocessor(&per_cu, (const void*)fwd_kernel, NWAVES * 64, LDS_BYTES) != hipSuccess || per_cu < 1)
            fprintf(stderr, "kernel_launch: note: occupancy query reports %d workgroups per CU\n", per_cu);
        (void)hipGetLastError();
        grid = cus;
    }
    if (grid < 0) return;
    if (hipMemsetAsync((char*)d_ws + WS_CTL, 0, CTL_ZERO_BYTES, stream) != hipSuccess) { fprintf(stderr, "kernel_launch: memset failed\n"); return; }
    Args a{};
    for (int i = 0; i < 20; ++i) a.in[i] = (const float*)d_in[i];
    a.out = (float*)d_out; a.ws = (unsigned char*)d_ws;
    for (int li = 0; li < N_LAUNCHES; ++li) {
        a.ph_lo = (N_LAUNCHES == 1) ? 0 : li; a.ph_hi = (N_LAUNCHES == 1) ? N_PHASES : li + 1;
        hipLaunchKernelGGL(fwd_kernel, dim3(grid), dim3(NWAVES * 64), LDS_BYTES, stream, a);
        const hipError_t le = hipPeekAtLastError();
        if (le != hipSuccess) { fprintf(stderr, "kernel_launch: launch %d failed: %s\n", li, hipGetErrorName(le)); break; }
    }
}
```
